# Optimizing an MI355X kernel written in HIP

```python
import jax, jax.numpy as jnp
from jax import lax
import numpy as np

D_MODEL = 1024
BATCH = 2
SEQ = 8192
DEPTH = 2

CHUNK = 64
N_MEM = 256
EPS = 1e-6

A_HEADS = 8
A_HEAD_DIM = 64
A_WIDTH = A_HEADS * A_HEAD_DIM
A_LEFT_CHUNKS = 8
A_BAND = (A_LEFT_CHUNKS + 1) * CHUNK
A_MAX_REL = 256

B_HEADS = 4
B_KEY_DIM = 64
B_VAL_DIM = 128
B_KEY_WIDTH = B_HEADS * B_KEY_DIM
B_VAL_WIDTH = B_HEADS * B_VAL_DIM
B_GATE_RANK = 16
B_GATE_TAU = 16.0

N_BRANCH = 2
BRANCH_WIDTH = 512
IN_SPLITS = (A_WIDTH, A_WIDTH, A_WIDTH, B_KEY_WIDTH, B_KEY_WIDTH, B_VAL_WIDTH, B_GATE_RANK, B_VAL_WIDTH, N_BRANCH * D_MODEL)
IN_WIDTH = sum(IN_SPLITS)

X_HEADS = 4
X_HEAD_DIM = D_MODEL // X_HEADS

N_GROUPS = 4
EXPERTS_PER_GROUP = 8
EXPERT_FF = 256
EXPERT_TOP_K = 2

kernel_name = "hybrid_chunk_band_gla_hier_moe_trunk"


def rmsnorm(x, g):
    xf = x.astype(jnp.float32)
    y = xf * lax.rsqrt(jnp.mean(xf * xf, axis=-1, keepdims=True) + EPS)
    return (y * g.astype(jnp.float32)).astype(x.dtype)


def chunk_band_attention(q, k, v, rel_table):
    b, L, h, dh = q.shape
    nc = L // CHUNK
    q = q.reshape(b, nc, CHUNK, h, dh)
    pad = ((0, 0), (A_LEFT_CHUNKS, 0), (0, 0), (0, 0), (0, 0))
    kp = jnp.pad(k.reshape(b, nc, CHUNK, h, dh), pad)
    vp = jnp.pad(v.reshape(b, nc, CHUNK, h, dh), pad)
    kb = jnp.concatenate([kp[:, j:j + nc] for j in range(A_LEFT_CHUNKS + 1)], axis=2)
    vb = jnp.concatenate([vp[:, j:j + nc] for j in range(A_LEFT_CHUNKS + 1)], axis=2)
    q_in_band = A_LEFT_CHUNKS * CHUNK + jnp.arange(CHUNK)[:, None]
    rel = q_in_band - jnp.arange(A_BAND)[None, :]
    idx = jnp.clip(rel, -A_MAX_REL, A_MAX_REL) + A_MAX_REL
    bias = rel_table.astype(jnp.float32)[:, idx]
    key_chunk = jnp.arange(nc)[:, None] + (jnp.arange(A_BAND) // CHUNK)[None, :] - A_LEFT_CHUNKS
    valid = key_chunk >= 0
    s = jnp.einsum('bnqhd,bnkhd->bhnqk', q, kb).astype(jnp.float32) * (dh ** -0.5) + bias[:, None]
    s = jnp.where(valid[None, None, :, None, :], s, -jnp.inf)
    p = jax.nn.softmax(s, axis=-1).astype(v.dtype)
    o = jnp.einsum('bhnqk,bnkhd->bnqhd', p, vb)
    return o.reshape(b, L, h * dh)


def gated_linear_attention(q, k, v, log_a):
    b, L, h, dk = q.shape
    dv = v.shape[-1]
    nc = L // CHUNK

    def to_chunks(t):
        return t.reshape(b, nc, CHUNK, h, t.shape[-1]).transpose(1, 0, 3, 2, 4)

    tri = jnp.tril(jnp.ones((CHUNK, CHUNK), dtype=bool))

    def step(S, inp):
        qc, kc, vc, gc = inp
        cum = jnp.cumsum(gc, axis=2)
        inter = jnp.einsum('bhtk,bhkv->bhtv', qc * jnp.exp(cum), S)
        diff = cum[:, :, :, None, :] - cum[:, :, None, :, :]
        decay = jnp.exp(jnp.where(tri[:, :, None], diff, -jnp.inf))
        attn = jnp.einsum('bhtk,bhsk,bhtsk->bhts', qc, kc, decay)
        intra = jnp.einsum('bhts,bhsv->bhtv', attn, vc)
        last = cum[:, :, -1:, :]
        S = jnp.exp(last[:, :, 0, :])[..., None] * S + jnp.einsum('bhsk,bhsv->bhkv', kc * jnp.exp(last - cum), vc)
        return S, inter + intra

    S0 = jnp.zeros((b, h, dk, dv), jnp.float32)
    _, o = lax.scan(step, S0, (to_chunks(q), to_chunks(k), to_chunks(v), to_chunks(log_a)))
    return o.transpose(1, 0, 3, 2, 4).reshape(b, L, h, dv)


def hybrid_mixer(hn, w_in, rel_bias, gla_w_alpha, gla_b_alpha, gla_norm_g, w_branch, w_mix_out):
    b, L, d = hn.shape
    offsets = [int(o) for o in np.cumsum(IN_SPLITS)[:-1]]
    proj = hn @ w_in
    aq, ak, av, bq, bk, bv, b_alpha, b_r, gates = jnp.split(proj, offsets, axis=-1)
    o_a = chunk_band_attention(aq.reshape(b, L, A_HEADS, A_HEAD_DIM), ak.reshape(b, L, A_HEADS, A_HEAD_DIM),
                               av.reshape(b, L, A_HEADS, A_HEAD_DIM), rel_bias)
    log_a = jax.nn.log_sigmoid((b_alpha @ gla_w_alpha + gla_b_alpha).astype(jnp.float32)) / B_GATE_TAU
    o_b = gated_linear_attention(
        bq.reshape(b, L, B_HEADS, B_KEY_DIM).astype(jnp.float32) * (B_KEY_DIM ** -0.5),
        bk.reshape(b, L, B_HEADS, B_KEY_DIM).astype(jnp.float32),
        bv.reshape(b, L, B_HEADS, B_VAL_DIM).astype(jnp.float32),
        log_a.reshape(b, L, B_HEADS, B_KEY_DIM))
    o_b = rmsnorm(o_b, gla_norm_g) * jax.nn.silu(b_r.reshape(b, L, B_HEADS, B_VAL_DIM).astype(jnp.float32))
    o_b = o_b.reshape(b, L, B_VAL_WIDTH).astype(hn.dtype)
    g_a, g_b = jnp.split(jax.nn.sigmoid(gates), N_BRANCH, axis=-1)
    merged = g_a * (o_a @ w_branch[0]) + g_b * (o_b @ w_branch[1])
    return merged @ w_mix_out


def cross_attention(hn, mem_n, w_q, w_kv, w_o):
    b, L, d = hn.shape
    m = mem_n.shape[1]
    q = (hn @ w_q).reshape(b, L, X_HEADS, X_HEAD_DIM)
    k, v = jnp.split(mem_n @ w_kv, 2, axis=-1)
    k = k.reshape(b, m, X_HEADS, X_HEAD_DIM)
    v = v.reshape(b, m, X_HEADS, X_HEAD_DIM)
    s = jnp.einsum('blhd,bmhd->bhlm', q, k).astype(jnp.float32) * (X_HEAD_DIM ** -0.5)
    p = jax.nn.softmax(s, axis=-1).astype(v.dtype)
    o = jnp.einsum('bhlm,bmhd->blhd', p, v).reshape(b, L, d)
    return o @ w_o


def hierarchical_moe(hn, w_gr, b_gr, w_er, b_er, w_gate, w_up, w_down):
    b, L, d = hn.shape
    t = hn.reshape(-1, d)
    g_logits = (t @ w_gr).astype(jnp.float32) + b_gr.astype(jnp.float32)
    g_idx = jnp.argmax(g_logits, axis=-1)
    g_w = jnp.take_along_axis(jax.nn.softmax(g_logits, axis=-1), g_idx[:, None], axis=-1)
    e_logits = ((t @ w_er).astype(jnp.float32) + b_er.astype(jnp.float32)).reshape(-1, N_GROUPS, EXPERTS_PER_GROUP)
    e_sel = jnp.take_along_axis(e_logits, g_idx[:, None, None], axis=1)[:, 0]
    top_v, top_i = lax.top_k(e_sel, EXPERT_TOP_K)
    top_w = jax.nn.softmax(top_v, axis=-1) * g_w
    in_group = jnp.sum(jax.nn.one_hot(top_i, EXPERTS_PER_GROUP, dtype=jnp.float32) * top_w[..., None], axis=1)
    gate = (jax.nn.one_hot(g_idx, N_GROUPS, dtype=jnp.float32)[:, :, None] * in_group[:, None, :]).astype(t.dtype)
    y = jnp.zeros_like(t)
    for g in range(N_GROUPS):
        hid = jax.nn.silu(jnp.einsum('td,edf->tef', t, w_gate[g])) * jnp.einsum('td,edf->tef', t, w_up[g])
        y = y + jnp.einsum('tef,efd->td', hid * gate[:, g, :, None], w_down[g])
    return y.reshape(b, L, d)


def setup_inputs(seed: int = 0) -> dict:
    key = jax.random.key(seed)
    ks = iter(jax.random.split(key, 32))

    def nrm(shape, scale):
        return jax.random.normal(next(ks), shape, jnp.float32) * scale

    def gain(shape):
        return 1.0 + nrm(shape, 0.02)

    D, G, E, F = D_MODEL, N_GROUPS, EXPERTS_PER_GROUP, EXPERT_FF
    return {
        "x": nrm((BATCH, SEQ, D), 1.0),
        "mem": nrm((BATCH, N_MEM, D), 1.0),
        "norm_mix_g": gain((DEPTH, D)),
        "w_in": nrm((DEPTH, D, IN_WIDTH), D ** -0.5),
        "rel_bias": nrm((DEPTH, A_HEADS, 2 * A_MAX_REL + 1), 0.1),
        "gla_w_alpha": nrm((DEPTH, B_GATE_RANK, B_KEY_WIDTH), B_GATE_RANK ** -0.5),
        "gla_b_alpha": nrm((DEPTH, B_KEY_WIDTH), 0.1),
        "gla_norm_g": gain((DEPTH, B_VAL_DIM)),
        "w_branch": nrm((DEPTH, N_BRANCH, BRANCH_WIDTH, D), BRANCH_WIDTH ** -0.5),
        "w_mix_out": nrm((DEPTH, D, D), D ** -0.5),
        "norm_x_g": gain((DEPTH, D)),
        "mem_norm_g": gain((D,)),
        "w_xq": nrm((DEPTH, D, D), D ** -0.5),
        "w_xkv": nrm((DEPTH, D, 2 * D), D ** -0.5),
        "w_xo": nrm((DEPTH, D, D), D ** -0.5),
        "norm_ffn_g": gain((DEPTH, D)),
        "w_group_router": nrm((DEPTH, D, G), D ** -0.5),
        "b_group_router": nrm((DEPTH, G), 0.01),
        "w_expert_router": nrm((DEPTH, D, G * E), D ** -0.5),
        "b_expert_router": nrm((DEPTH, G * E), 0.01),
        "w_exp_gate": nrm((DEPTH, G, E, D, F), D ** -0.5),
        "w_exp_up": nrm((DEPTH, G, E, D, F), D ** -0.5),
        "w_exp_down": nrm((DEPTH, G, E, F, D), F ** -0.5),
        "final_norm_g": gain((D,)),
    }


def reference(x, mem, norm_mix_g, w_in, rel_bias, gla_w_alpha, gla_b_alpha, gla_norm_g, w_branch, w_mix_out,
              norm_x_g, mem_norm_g, w_xq, w_xkv, w_xo, norm_ffn_g, w_group_router, b_group_router,
              w_expert_router, b_expert_router, w_exp_gate, w_exp_up, w_exp_down, final_norm_g):
    mem_n = rmsnorm(mem, mem_norm_g)
    for l in range(DEPTH):
        h = rmsnorm(x, norm_mix_g[l])
        x = x + hybrid_mixer(h, w_in[l], rel_bias[l], gla_w_alpha[l], gla_b_alpha[l], gla_norm_g[l],
                             w_branch[l], w_mix_out[l])
        h = rmsnorm(x, norm_x_g[l])
        x = x + cross_attention(h, mem_n, w_xq[l], w_xkv[l], w_xo[l])
        h = rmsnorm(x, norm_ffn_g[l])
        x = x + hierarchical_moe(h, w_group_router[l], b_group_router[l], w_expert_router[l], b_expert_router[l],
                                 w_exp_gate[l], w_exp_up[l], w_exp_down[l])
    return rmsnorm(x, final_norm_g)
```

```cpp
#include <hip/hip_runtime.h>
#include <cstdint>
#include <cstdio>
#include <cmath>

namespace cfg {
constexpr int D = 1024, NB = 2, L = 8192, T = NB * L, DEPTH = 2;
constexpr int CH = 64, NMEM = 256;
constexpr int AH = 8, AW = 512, ALC = 8, ABAND = 576, AMAXREL = 256;
constexpr int BH = 4, BKW = 256, BVW = 512, BR = 16;
constexpr int INW = 5136;
constexpr int OFF_AQ = 0, OFF_BQ = 1536, OFF_GA = 3088, OFF_GB = 4112;
constexpr int XH = 4, XD = 256;
constexpr int NG = 4, EPG = 8, EF = 256;
constexpr float EPS = 1e-6f;
}
using namespace cfg;

__global__ void __launch_bounds__(256) k_rmsnorm(const float* x, const float* __restrict__ g, float* out, int rows) {
    __shared__ float red[4];
    const int r = blockIdx.x; if (r >= rows) return;
    const float4 v = ((const float4*)(x + (size_t)r * D))[threadIdx.x];
    float s = v.x * v.x + v.y * v.y + v.z * v.z + v.w * v.w;
    for (int o = 32; o > 0; o >>= 1) s += __shfl_xor(s, o);
    if ((threadIdx.x & 63) == 0) red[threadIdx.x >> 6] = s;
    __syncthreads();
    s = red[0] + red[1] + red[2] + red[3];
    const float rs = rsqrtf(s * (1.0f / D) + EPS);
    const float4 gg = ((const float4*)g)[threadIdx.x];
    float4 o; o.x = v.x * rs * gg.x; o.y = v.y * rs * gg.y; o.z = v.z * rs * gg.z; o.w = v.w * rs * gg.w;
    ((float4*)(out + (size_t)r * D))[threadIdx.x] = o;
}

__global__ void __launch_bounds__(256) k_gemm(const float* __restrict__ A, int lda, const float* __restrict__ Bm, int ldb, float* __restrict__ C, int ldc,
                                              int M, int N, int K, int accumulate) {
    __shared__ float As[16][68];
    __shared__ float Bs[16][68];
    const int tx = threadIdx.x & 15, ty = threadIdx.x >> 4;
    const int m0 = blockIdx.y * 64, n0 = blockIdx.x * 64;
    float acc[4][4];
#pragma unroll
    for (int i = 0; i < 4; ++i)
#pragma unroll
        for (int j = 0; j < 4; ++j) acc[i][j] = 0.f;
    for (int k0 = 0; k0 < K; k0 += 16) {
        for (int i = threadIdx.x; i < 1024; i += 256) { const int r = i >> 4, kk = i & 15; As[kk][r] = A[(size_t)(m0 + r) * lda + k0 + kk]; }
        for (int i = threadIdx.x; i < 1024; i += 256) { const int kk = i >> 6, c = i & 63; Bs[kk][c] = (n0 + c < N) ? Bm[(size_t)(k0 + kk) * ldb + n0 + c] : 0.f; }
        __syncthreads();
#pragma unroll
        for (int kk = 0; kk < 16; ++kk) {
            float a[4], b[4];
#pragma unroll
            for (int i = 0; i < 4; ++i) { a[i] = As[kk][ty * 4 + i]; b[i] = Bs[kk][tx * 4 + i]; }
#pragma unroll
            for (int i = 0; i < 4; ++i)
#pragma unroll
                for (int j = 0; j < 4; ++j) acc[i][j] += a[i] * b[j];
        }
        __syncthreads();
    }
#pragma unroll
    for (int i = 0; i < 4; ++i)
#pragma unroll
        for (int j = 0; j < 4; ++j) {
            const int r = m0 + ty * 4 + i, c = n0 + tx * 4 + j;
            if (c < N) { float* p = C + (size_t)r * ldc + c; *p = accumulate ? (*p + acc[i][j]) : acc[i][j]; }
        }
}

__device__ __forceinline__ float sigmoidf_(float x) { return 1.0f / (1.0f + expf(-x)); }
__device__ __forceinline__ float siluf_(float x) { return x / (1.0f + expf(-x)); }
__device__ __forceinline__ float log_sigmoidf_(float x) { return fminf(x, 0.f) - log1pf(expf(-fabsf(x))); }

__global__ void __launch_bounds__(64) k_band_attn(const float* __restrict__ qkv, int ld, const float* __restrict__ rel  , float* __restrict__ oa  ) {
    const int nc = L / CH;
    const int blk = blockIdx.x; const int n = blk % nc, h = (blk / nc) % AH, b = blk / (nc * AH);
    const int qi = threadIdx.x;
    const size_t qrow = (size_t)(b * L + n * CH + qi);
    float q[64], acc[64];
#pragma unroll
    for (int d = 0; d < 64; d += 4) { const float4 v = *(const float4*)(qkv + qrow * ld + h * 64 + d); q[d] = v.x; q[d + 1] = v.y; q[d + 2] = v.z; q[d + 3] = v.w; }
#pragma unroll
    for (int d = 0; d < 64; ++d) acc[d] = 0.f;
    float m = -INFINITY, l = 0.f;
    for (int j = 0; j < ABAND; ++j) {
        const int kc = n + (j >> 6) - ALC; if (kc < 0) continue;
        const size_t krow = (size_t)(b * L + kc * CH + (j & 63));
        const float* kp = qkv + krow * ld + 512 + h * 64; const float* vp = qkv + krow * ld + 1024 + h * 64;
        float s = 0.f;
#pragma unroll
        for (int d = 0; d < 64; d += 4) { const float4 v = *(const float4*)(kp + d); s += q[d] * v.x + q[d + 1] * v.y + q[d + 2] * v.z + q[d + 3] * v.w; }
        int relp = (ALC * CH + qi) - j; relp = relp < -AMAXREL ? -AMAXREL : (relp > AMAXREL ? AMAXREL : relp);
        s = s * 0.125f + rel[h * (2 * AMAXREL + 1) + relp + AMAXREL];
        const float mn = fmaxf(m, s), corr = expf(m - mn), p = expf(s - mn);
        l = l * corr + p; m = mn;
#pragma unroll
        for (int d = 0; d < 64; d += 4) { const float4 v = *(const float4*)(vp + d);
            acc[d] = acc[d] * corr + p * v.x; acc[d + 1] = acc[d + 1] * corr + p * v.y; acc[d + 2] = acc[d + 2] * corr + p * v.z; acc[d + 3] = acc[d + 3] * corr + p * v.w; }
    }
    const float inv = 1.0f / l;
#pragma unroll
    for (int d = 0; d < 64; d += 4) { float4 o; o.x = acc[d] * inv; o.y = acc[d + 1] * inv; o.z = acc[d + 2] * inv; o.w = acc[d + 3] * inv; *(float4*)(oa + qrow * AW + h * 64 + d) = o; }
}

__global__ void __launch_bounds__(256) k_loga(const float* __restrict__ pb, int ld, const float* __restrict__ Wa  , const float* __restrict__ ba, float* __restrict__ loga  ) {
    const size_t t = blockIdx.x; const int c = threadIdx.x;
    float s = ba[c];
#pragma unroll
    for (int r = 0; r < BR; ++r) s += pb[t * ld + 1024 + r] * Wa[r * BKW + c];
    loga[t * BKW + c] = log_sigmoidf_(s) * (1.0f / 16.0f);
}

__global__ void __launch_bounds__(128) k_gla(const float* __restrict__ pb, int ld, const float* __restrict__ loga, float* __restrict__ oraw) {
    __shared__ float sq[2][64], sk[2][64], sa[2][64];
    const int b = blockIdx.x / BH, h = blockIdx.x % BH, v = threadIdx.x;
    float S[64];
#pragma unroll
    for (int k = 0; k < 64; ++k) S[k] = 0.f;
    for (int t = 0; t < L; ++t) {
        const size_t row = (size_t)(b * L + t); const int bf = t & 1;
        if (v < 64) { sq[bf][v] = pb[row * ld + h * 64 + v] * 0.125f; sa[bf][v] = expf(loga[row * BKW + h * 64 + v]); }
        else { sk[bf][v - 64] = pb[row * ld + 256 + h * 64 + (v - 64)]; }
        const float vv = pb[row * ld + 512 + h * 128 + v];
        __syncthreads();
        float o = 0.f;
#pragma unroll
        for (int k = 0; k < 64; ++k) { S[k] = sa[bf][k] * S[k] + sk[bf][k] * vv; o += sq[bf][k] * S[k]; }
        oraw[row * BVW + h * 128 + v] = o;
    }
}

__global__ void __launch_bounds__(256) k_gla_post(float* __restrict__ ob, const float* __restrict__ pb, int ld, const float* __restrict__ g  ) {
    const int w = blockIdx.x * 4 + (threadIdx.x >> 6), lane = threadIdx.x & 63;
    const size_t t = w / BH; const int h = w % BH;
    float* p = ob + t * BVW + h * 128;
    const float a = p[lane], c = p[lane + 64];
    float s = a * a + c * c;
    for (int o = 32; o > 0; o >>= 1) s += __shfl_xor(s, o);
    const float rs = rsqrtf(s * (1.0f / 128.0f) + EPS);
    const float r0 = pb[t * ld + 1040 + h * 128 + lane], r1 = pb[t * ld + 1040 + h * 128 + lane + 64];
    p[lane] = a * rs * g[lane] * siluf_(r0); p[lane + 64] = c * rs * g[lane + 64] * siluf_(r1);
}

__global__ void __launch_bounds__(256) k_gate_mul(float* merged, const float* gate, const float* tmp, int accumulate) {
    const size_t i = (size_t)blockIdx.x * 256 + threadIdx.x;
    const float v = sigmoidf_(gate[i]) * tmp[i];
    merged[i] = accumulate ? merged[i] + v : v;
}

__global__ void __launch_bounds__(256) k_xattn(const float* __restrict__ q, const float* __restrict__ kv, float* __restrict__ out) {
    __shared__ float qs[256], ps[256], red[4];
    const size_t t = blockIdx.x / XH; const int h = blockIdx.x % XH, b = (int)(t / L), j = threadIdx.x;
    qs[j] = q[t * D + h * XD + j];
    __syncthreads();
    const float* kp = kv + (size_t)(b * NMEM + j) * 2048 + h * XD;
    float s = 0.f;
    for (int d = 0; d < XD; d += 4) { const float4 v = *(const float4*)(kp + d); s += qs[d] * v.x + qs[d + 1] * v.y + qs[d + 2] * v.z + qs[d + 3] * v.w; }
    s *= 0.0625f;
    float m = s;
    for (int o = 32; o > 0; o >>= 1) m = fmaxf(m, __shfl_xor(m, o));
    if ((j & 63) == 0) red[j >> 6] = m;
    __syncthreads();
    m = fmaxf(fmaxf(red[0], red[1]), fmaxf(red[2], red[3]));
    __syncthreads();
    const float p = expf(s - m);
    float l = p;
    for (int o = 32; o > 0; o >>= 1) l += __shfl_xor(l, o);
    if ((j & 63) == 0) red[j >> 6] = l;
    ps[j] = p;
    __syncthreads();
    l = red[0] + red[1] + red[2] + red[3];
    const float* vp = kv + (size_t)(b * NMEM) * 2048 + 1024 + h * XD + j;
    float o = 0.f;
    for (int jj = 0; jj < NMEM; ++jj) o += ps[jj] * vp[(size_t)jj * 2048];
    out[t * D + h * XD + j] = o / l;
}

__global__ void __launch_bounds__(256) k_route(const float* __restrict__ gl, const float* __restrict__ el, const float* __restrict__ bg, const float* __restrict__ be,
                                               int* __restrict__ sel_e, float* __restrict__ sel_w) {
    const size_t t = (size_t)blockIdx.x * 256 + threadIdx.x;
    float g[4]; float gm = -INFINITY; int gi = 0;
#pragma unroll
    for (int i = 0; i < 4; ++i) { g[i] = gl[t * 4 + i] + bg[i]; if (g[i] > gm) { gm = g[i]; gi = i; } }
    float gs = 0.f;
#pragma unroll
    for (int i = 0; i < 4; ++i) gs += expf(g[i] - gm);
    const float gw = 1.0f / gs;
    float v0 = -INFINITY, v1 = -INFINITY; int i0 = 0, i1 = 0;
    for (int e = 0; e < EPG; ++e) {
        const float x = el[t * 32 + gi * EPG + e] + be[gi * EPG + e];
        if (x > v0) { v1 = v0; i1 = i0; v0 = x; i0 = e; } else if (x > v1) { v1 = x; i1 = e; }
    }
    const float e1 = expf(v1 - v0), den = 1.0f + e1;
    sel_e[t * 2] = gi * EPG + i0; sel_e[t * 2 + 1] = gi * EPG + i1;
    sel_w[t * 2] = gw / den; sel_w[t * 2 + 1] = gw * e1 / den;
}

__global__ void __launch_bounds__(256) k_moe(const float* __restrict__ h, const float* __restrict__ Wg, const float* __restrict__ Wu, const float* __restrict__ Wd,
                                             const int* __restrict__ sel_e, const float* __restrict__ sel_w, float* __restrict__ x) {
    __shared__ float hs[1024], hid[256];
    const size_t t = blockIdx.x; const int f = threadIdx.x;
    for (int i = f; i < D; i += 256) hs[i] = h[t * D + i];
    float y0 = 0.f, y1 = 0.f, y2 = 0.f, y3 = 0.f;
    for (int s = 0; s < 2; ++s) {
        const int e = sel_e[t * 2 + s]; const float w = sel_w[t * 2 + s];
        __syncthreads();
        const float* wg = Wg + (size_t)e * D * EF + f; const float* wu = Wu + (size_t)e * D * EF + f;
        float ga = 0.f, up = 0.f;
        for (int d = 0; d < D; ++d) { ga += hs[d] * wg[(size_t)d * EF]; up += hs[d] * wu[(size_t)d * EF]; }
        hid[f] = siluf_(ga) * up * w;
        __syncthreads();
        const float* wd = Wd + (size_t)e * EF * D + f;
        for (int ff = 0; ff < EF; ++ff) { const float hv = hid[ff]; const float* r = wd + (size_t)ff * D; y0 += hv * r[0]; y1 += hv * r[256]; y2 += hv * r[512]; y3 += hv * r[768]; }
    }
    float* xr = x + t * D + f;
    xr[0] += y0; xr[256] += y1; xr[512] += y2; xr[768] += y3;
}

static void gemm(hipStream_t s, const float* A, int lda, const float* B, int ldb, float* C, int ldc, int M, int N, int K, int acc) {
    dim3 grid((N + 63) / 64, M / 64);
    hipLaunchKernelGGL(k_gemm, grid, dim3(256), 0, s, A, lda, B, ldb, C, ldc, M, N, K, acc);
}

extern "C" void kernel_launch(void* const* d_in, const int* in_sizes, int n_in, void* d_out, int out_size, void* d_ws, size_t ws_size, hipStream_t stream) {
    const float* x_in = (const float*)d_in[0];
    const float* mem = (const float*)d_in[1];
    const float* norm_mix_g = (const float*)d_in[2];
    const float* w_in = (const float*)d_in[3];
    const float* rel_bias = (const float*)d_in[4];
    const float* gla_w_alpha = (const float*)d_in[5];
    const float* gla_b_alpha = (const float*)d_in[6];
    const float* gla_norm_g = (const float*)d_in[7];
    const float* w_branch = (const float*)d_in[8];
    const float* w_mix_out = (const float*)d_in[9];
    const float* norm_x_g = (const float*)d_in[10];
    const float* mem_norm_g = (const float*)d_in[11];
    const float* w_xq = (const float*)d_in[12];
    const float* w_xkv = (const float*)d_in[13];
    const float* w_xo = (const float*)d_in[14];
    const float* norm_ffn_g = (const float*)d_in[15];
    const float* w_gr = (const float*)d_in[16];
    const float* b_gr = (const float*)d_in[17];
    const float* w_er = (const float*)d_in[18];
    const float* b_er = (const float*)d_in[19];
    const float* w_eg = (const float*)d_in[20];
    const float* w_eu = (const float*)d_in[21];
    const float* w_ed = (const float*)d_in[22];
    const float* final_g = (const float*)d_in[23];

    constexpr size_t MiB = 1u << 20;
    char* ws = (char*)d_ws;
    float* H = (float*)(ws + 0 * MiB);
    float* BIG = (float*)(ws + 64 * MiB);
    float* OA = (float*)(ws + 162 * MiB);
    float* OB = (float*)(ws + 194 * MiB);
    float* MG = (float*)(ws + 226 * MiB);
    float* MEMN = (float*)(ws + 290 * MiB);
    float* KV = (float*)(ws + 292 * MiB);
    float* LOGA = (float*)(ws + 300 * MiB);
    float* GL = (float*)(ws + 316 * MiB);
    float* EL = GL + (size_t)T * 4;
    int* SELE = (int*)(EL + (size_t)T * 32);
    float* SELW = (float*)(SELE + (size_t)T * 2);
    if (ws_size < 320 * MiB) { fprintf(stderr, "kernel_launch: ws too small (%zu)\n", ws_size); return; }
    float* X = (float*)d_out;

    hipMemcpyAsync(X, x_in, (size_t)T * D * 4, hipMemcpyDeviceToDevice, stream);
    hipLaunchKernelGGL(k_rmsnorm, dim3(NB * NMEM), dim3(256), 0, stream, mem, mem_norm_g, MEMN, NB * NMEM);
    for (int l = 0; l < DEPTH; ++l) gemm(stream, MEMN, D, w_xkv + (size_t)l * D * 2 * D, 2 * D, KV + (size_t)l * NB * NMEM * 2 * D, 2 * D, NB * NMEM, 2 * D, D, 0);

    for (int l = 0; l < DEPTH; ++l) {
        const float* Win = w_in + (size_t)l * D * INW;
        hipLaunchKernelGGL(k_rmsnorm, dim3(T), dim3(256), 0, stream, X, norm_mix_g + l * D, H, T);
        gemm(stream, H, D, Win + OFF_AQ, INW, BIG, 1536, T, 1536, D, 0);
        hipLaunchKernelGGL(k_band_attn, dim3(NB * AH * (L / CH)), dim3(64), 0, stream, BIG, 1536, rel_bias + (size_t)l * AH * (2 * AMAXREL + 1), OA);
        gemm(stream, H, D, Win + OFF_BQ, INW, BIG, 1552, T, 1552, D, 0);
        hipLaunchKernelGGL(k_loga, dim3(T), dim3(256), 0, stream, BIG, 1552, gla_w_alpha + (size_t)l * BR * BKW, gla_b_alpha + (size_t)l * BKW, LOGA);
        hipLaunchKernelGGL(k_gla, dim3(NB * BH), dim3(128), 0, stream, BIG, 1552, LOGA, OB);
        hipLaunchKernelGGL(k_gla_post, dim3(T * BH / 4), dim3(256), 0, stream, OB, BIG, 1552, gla_norm_g + (size_t)l * 128);
        gemm(stream, H, D, Win + OFF_GA, INW, BIG, D, T, D, D, 0);
        gemm(stream, OA, AW, w_branch + (size_t)(l * 2 + 0) * AW * D, D, MG, D, T, D, AW, 0);
        hipLaunchKernelGGL(k_gate_mul, dim3(T * D / 256), dim3(256), 0, stream, MG, BIG, MG, 0);
        gemm(stream, H, D, Win + OFF_GB, INW, BIG, D, T, D, D, 0);
        gemm(stream, OB, BVW, w_branch + (size_t)(l * 2 + 1) * BVW * D, D, H, D, T, D, BVW, 0);
        hipLaunchKernelGGL(k_gate_mul, dim3(T * D / 256), dim3(256), 0, stream, MG, BIG, H, 1);
        gemm(stream, MG, D, w_mix_out + (size_t)l * D * D, D, X, D, T, D, D, 1);
        hipLaunchKernelGGL(k_rmsnorm, dim3(T), dim3(256), 0, stream, X, norm_x_g + l * D, H, T);
        gemm(stream, H, D, w_xq + (size_t)l * D * D, D, BIG, D, T, D, D, 0);
        hipLaunchKernelGGL(k_xattn, dim3(T * XH), dim3(256), 0, stream, BIG, KV + (size_t)l * NB * NMEM * 2 * D, MG);
        gemm(stream, MG, D, w_xo + (size_t)l * D * D, D, X, D, T, D, D, 1);
        hipLaunchKernelGGL(k_rmsnorm, dim3(T), dim3(256), 0, stream, X, norm_ffn_g + l * D, H, T);
        gemm(stream, H, D, w_gr + (size_t)l * D * NG, NG, GL, NG, T, NG, D, 0);
        gemm(stream, H, D, w_er + (size_t)l * D * NG * EPG, NG * EPG, EL, NG * EPG, T, NG * EPG, D, 0);
        hipLaunchKernelGGL(k_route, dim3(T / 256), dim3(256), 0, stream, GL, EL, b_gr + l * NG, b_er + l * NG * EPG, SELE, SELW);
        const size_t eoff = (size_t)l * NG * EPG * D * EF;
        hipLaunchKernelGGL(k_moe, dim3(T), dim3(256), 0, stream, H, w_eg + eoff, w_eu + eoff, w_ed + eoff, SELE, SELW, X);
    }
    hipLaunchKernelGGL(k_rmsnorm, dim3(T), dim3(256), 0, stream, X, final_g, X, T);
}
```

```cpp
#include <hip/hip_runtime.h>
#include <cstdint>
#include <cstdio>
#include <cmath>

namespace cfg {
constexpr int D = 1024, NB = 2, L = 8192, T = NB * L, DEPTH = 2;
constexpr int CH = 64, NMEM = 256, NCH = L / CH;
constexpr int AH = 8, AW = 512, ALC = 8, ABAND = 576, AMAXREL = 256, RELW = 2 * AMAXREL + 1;
constexpr int BH = 4, BKW = 256, BVW = 512, BR = 16;
constexpr int INW = 5136;
constexpr int XH = 4, XD = 256;
constexpr int NG = 4, EPG = 8, NE = NG * EPG, EF = 256;
constexpr float EPS = 1e-6f;
constexpr int NPROJ = 5376;
constexpr int NPROJ_A = 13 * 256, NPROJ_B = 8 * 256;

constexpr size_t MiB = 1u << 20;
constexpr size_t WS_CTL = 0, CTL_BYTES = 2 * MiB;
constexpr size_t WS_WDENSE = 2 * MiB, WDENSE_STRIDE = 23 * MiB;
constexpr size_t WD_WIN = 0, WD_WB = 11 * MiB, WD_WMO = 13 * MiB, WD_WXQ = 15 * MiB, WD_WXKV = 17 * MiB, WD_WXO = 21 * MiB;
constexpr size_t WS_WEXP = 48 * MiB, WEXP_STRIDE = 48 * MiB;
constexpr size_t WS_XB = 144 * MiB;
constexpr size_t WS_MIX = 176 * MiB;
constexpr size_t WS_AQ = WS_MIX, WS_AK = WS_MIX + 16 * MiB, WS_AV = WS_MIX + 32 * MiB, WS_BQ = WS_MIX + 48 * MiB, WS_BK = WS_MIX + 56 * MiB,
                 WS_BV = WS_MIX + 64 * MiB, WS_BRS = WS_MIX + 80 * MiB, WS_LOGA = WS_MIX + 96 * MiB;
constexpr size_t WS_GA = WS_MIX, WS_GB = WS_MIX + 32 * MiB, WS_MG = WS_MIX + 64 * MiB;
constexpr size_t WS_Q = WS_MIX;
constexpr size_t WS_MEMN = 288 * MiB, WS_KVB = 289 * MiB;
constexpr size_t WS_SEL = 293 * MiB;
constexpr size_t WS_SSP = 294 * MiB;
constexpr size_t WS_END = 301 * MiB;
constexpr size_t DO_OAB = 0, DO_ST = 32 * MiB, DO_TMP = 32 * MiB;
}
using namespace cfg;

#define LAS __attribute__((address_space(3)))
typedef unsigned short bf16_t;
typedef float f32x4 __attribute__((ext_vector_type(4)));
typedef unsigned u32x4 __attribute__((ext_vector_type(4)));
typedef unsigned u32x2 __attribute__((ext_vector_type(2)));

__device__ __forceinline__ float bf2f(unsigned short b) { return __uint_as_float((unsigned)b << 16); }
__device__ __forceinline__ float bflo(unsigned w) { return __uint_as_float(w << 16); }
__device__ __forceinline__ float bfhi(unsigned w) { return __uint_as_float(w & 0xffff0000u); }
__device__ __forceinline__ unsigned pkbf(float lo, float hi) { unsigned r; asm volatile("v_cvt_pk_bf16_f32 %0, %1, %2" : "=v"(r) : "v"(lo), "v"(hi)); return r; }
__device__ __forceinline__ unsigned short f2bf(float f) { return (unsigned short)(pkbf(f, 0.f) & 0xffffu); }
__device__ __forceinline__ float fsigmoid(float x) { return __builtin_amdgcn_rcpf(1.0f + __expf(-x)); }
__device__ __forceinline__ float fsilu(float x) { return x * fsigmoid(x); }
__device__ __forceinline__ float flogsigmoid(float x) { return fminf(x, 0.f) - __logf(1.0f + __expf(-fabsf(x))); }
__device__ __forceinline__ float wave_sum(float v) {
#pragma unroll
    for (int o = 1; o < 64; o <<= 1) v += __shfl_xor(v, o);
    return v;
}
__device__ __forceinline__ unsigned char* opaque_ptr(unsigned char* p) { asm volatile("" : "+s"(p)); return p; }
__device__ __forceinline__ int tid_now() { int t = (int)threadIdx.x; asm volatile("" : "+v"(t)); return t; }
namespace pg8 {
#define PG8_LAS __attribute__((address_space(3)))
typedef unsigned short bf16_t;
typedef short bf16x8 __attribute__((ext_vector_type(8)));
typedef float f32x4 __attribute__((ext_vector_type(4)));
typedef unsigned u32x4 __attribute__((ext_vector_type(4)));
constexpr int BM = 256, BK = 64, HALF = 128, HTB = HALF * BK * 2  , STAGE_BYTES = 8 * HTB, NXCD = 8, WGM = 8;

__host__ __device__ __forceinline__ int lds_byte(int r, int c) { const int st = (r >> 4) * 2 + (c >> 5), rr = r & 15, cc = c & 31, ob = rr * 64 + cc * 2; return st * 1024 + (ob ^ (((ob >> 9) & 1) << 5)); }
__host__ __device__ __forceinline__ void stage_rc(int b, int& R, int& C) { const int st = b / 1024, sb = b % 1024, swz = sb ^ (((sb >> 9) & 1) << 5); R = (st >> 1) * 16 + swz / 64; C = (st & 1) * 32 + (swz % 64) / 2; }
__host__ __device__ __forceinline__ int perm32(int rho) { const int n = rho >> 4, i = rho & 15; return 8 * (i >> 2) + 4 * n + (i & 3); }

struct Unit { int pm, pn; };
struct Gemm { const bf16_t* A; const bf16_t* Bt; int M, N, K, lda, ldb, pad; };

struct StaticOrder {
    int nM, nN, nwg, G, c;
    __host__ __device__ void init(int M, int N, int G_, int c_) { nM = M / BM; nN = N / BM; nwg = nM * nN; G = G_; c = c_; }
    __host__ __device__ bool next(int i, Unit& u) const {
        const long L = (long)i * G + c; if (L >= nwg) return false;
        int wgid = (int)L; { const int q = nwg / NXCD, r = nwg % NXCD, xcd = wgid % NXCD, off = wgid / NXCD; wgid = (xcd < r ? xcd * (q + 1) : r * (q + 1) + (xcd - r) * q) + off; }
        const int nig = WGM * nN, gid = wgid / nig, fm = gid * WGM, gsz = (nM - fm) < WGM ? (nM - fm) : WGM;
        u.pm = fm + ((wgid % nig) % gsz); u.pn = (wgid % nig) / gsz; return true;
    }
    __device__ __forceinline__ void a_ready(const Unit&) const {}
    __device__ __forceinline__ void done(const Unit&) const {}
};


template <class Epi, class Sched, bool ALIGN_EPI = false, bool SP2 = false>
__device__ __forceinline__ void gemm_phase(PG8_LAS unsigned char* lds, const Gemm g, const Sched& S, const Epi& E) {
    const int tid = tid_now(), wid = __builtin_amdgcn_readfirstlane(tid >> 6), lane = tid & 63, wr = wid >> 2, wc = wid & 3, fr = lane & 15, fq = lane >> 4;
    const int K = g.K, nt = K / BK;
    unsigned voffA[2], voffB[2];
#pragma unroll
    for (int i = 0; i < 2; ++i) { int R, C; stage_rc(tid * 16 + i * 8192, R, C); const int Rb = Epi::PERM ? ((R & ~31) + perm32(R & 31)) : R;
        voffA[i] = (unsigned)(R * g.lda + C) * 2u; voffB[i] = (unsigned)(Rb * g.ldb + C) * 2u; }
    const size_t kstep = (size_t)(BK * 2);
    const size_t hstepA = (size_t)HALF * g.lda * 2, hstepB = (size_t)HALF * g.ldb * 2;
    const size_t tstepA = 2 * hstepA, tstepB = 2 * hstepB;
    const unsigned ldsw = (unsigned)wid * 1024u;
    const int aoff = lds_byte(wr * 64 + fr, fq * 8), boff = lds_byte(wc * 32 + fr, fq * 8);
#define PG8_SA(b, h) (((b) * 2 + (h)) * HTB)
#define PG8_SB(b, h) ((4 + (b) * 2 + (h)) * HTB)
#define PG8_STAGE(bufoff, gbase, voff) do { _Pragma("unroll") for (int _i = 0; _i < 2; ++_i) \
        __builtin_amdgcn_global_load_lds((const unsigned*)((const char*)(gbase) + (voff)[_i]), (PG8_LAS unsigned*)(lds + (bufoff) + ldsw + _i * 8192), 16, 0, 0); } while (0)
#define PG8_LDA(dst, b, h) do { _Pragma("unroll") for (int m = 0; m < 4; ++m) _Pragma("unroll") for (int k = 0; k < 2; ++k) dst[m][k] = *(const PG8_LAS bf16x8*)(lds + PG8_SA(b, h) + aoff + m * 2048 + k * 1024); } while (0)
#define PG8_LDB(dst, b, h) do { _Pragma("unroll") for (int n = 0; n < 2; ++n) _Pragma("unroll") for (int k = 0; k < 2; ++k) dst[n][k] = *(const PG8_LAS bf16x8*)(lds + PG8_SB(b, h) + boff + n * 2048 + k * 1024); } while (0)
#define PG8_MMA(ai, bj, At, Bt) do { __builtin_amdgcn_s_setprio(1); _Pragma("unroll") for (int m = 0; m < 4; ++m) _Pragma("unroll") for (int n = 0; n < 2; ++n) _Pragma("unroll") for (int k = 0; k < 2; ++k) \
        acc[ai][bj][m][n] = __builtin_amdgcn_mfma_f32_16x16x32_bf16(Bt[n][k], At[m][k], acc[ai][bj][m][n], 0, 0, 0); __builtin_amdgcn_s_setprio(0); } while (0)
#define PG8_WAIT_V(n) asm volatile("s_waitcnt vmcnt(" #n ")" ::: "memory")
#define PG8_WAIT_L(n) asm volatile("s_waitcnt lgkmcnt(" #n ")" ::: "memory")
#define PG8_BAR __builtin_amdgcn_s_barrier()
#define PG8_SCHED __builtin_amdgcn_sched_barrier(0)
    Unit cur, nxt; int ui = 0;
    if (!S.next(0, cur)) return;
    f32x4 acc[2][2][4][2];
#pragma unroll
    for (int a = 0; a < 2; ++a)
#pragma unroll
        for (int b = 0; b < 2; ++b)
#pragma unroll
            for (int m = 0; m < 4; ++m)
#pragma unroll
                for (int n = 0; n < 2; ++n) acc[a][b][m][n] = (f32x4){0.f, 0.f, 0.f, 0.f};
    bf16x8 At[4][2], B0[2][2], B1[2][2];
    const char* cA = (const char*)g.A + (size_t)cur.pm * tstepA; const char* cB = (const char*)g.Bt + (size_t)cur.pn * tstepB;
    S.a_ready(cur);
    if constexpr (SP2) {
        PG8_STAGE(PG8_SB(0, 0), cB, voffB); PG8_STAGE(PG8_SB(0, 1), cB + hstepB, voffB); PG8_STAGE(PG8_SA(0, 0), cA, voffA); PG8_STAGE(PG8_SA(0, 1), cA + hstepA, voffA);
        if (wr == 1) PG8_BAR;
        PG8_WAIT_V(2); PG8_BAR;
        PG8_STAGE(PG8_SB(1, 0), cB + kstep, voffB); PG8_STAGE(PG8_SA(1, 0), cA + kstep, voffA); PG8_STAGE(PG8_SB(1, 1), cB + hstepB + kstep, voffB);
        PG8_WAIT_V(6); PG8_BAR;
    } else {
        PG8_STAGE(PG8_SB(0, 0), cB, voffB); PG8_STAGE(PG8_SA(0, 0), cA, voffA); PG8_STAGE(PG8_SB(0, 1), cB + hstepB, voffB); PG8_STAGE(PG8_SA(0, 1), cA + hstepA, voffA);
        if (wr == 1) PG8_BAR;
        PG8_WAIT_V(4); PG8_BAR;
        PG8_STAGE(PG8_SB(1, 0), cB + kstep, voffB); PG8_STAGE(PG8_SA(1, 0), cA + kstep, voffA); PG8_STAGE(PG8_SB(1, 1), cB + hstepB + kstep, voffB);
        PG8_WAIT_V(6); PG8_BAR;
    }
    for (;;) {
        const bool has_next = S.next(ui + 1, nxt);
        const char* nA = has_next ? (const char*)g.A + (size_t)nxt.pm * tstepA : cA; const char* nB = has_next ? (const char*)g.Bt + (size_t)nxt.pn * tstepB : cB;
        for (int t = 0; t < nt; t += 2) {
            const bool last = (t == nt - 2);
            const char* a1 = cA + (size_t)(t + 1) * kstep;
            const char* a2 = last ? nA : cA + (size_t)(t + 2) * kstep; const char* b2 = last ? nB : cB + (size_t)(t + 2) * kstep;
            const char* a3 = a2 + kstep; const char* b3 = b2 + kstep;
            if (last && has_next) S.a_ready(nxt);
            if constexpr (SP2) {
            PG8_LDB(B0, 0, 0); PG8_LDB(B1, 0, 1); PG8_SCHED; PG8_LDA(At, 0, 0); PG8_STAGE(PG8_SA(1, 1), a1 + hstepA, voffA);
            PG8_WAIT_V(8); PG8_WAIT_L(0); PG8_BAR; PG8_MMA(0, 0, At, B0); PG8_MMA(0, 1, At, B1); PG8_BAR; PG8_SCHED;
            PG8_LDA(At, 0, 1); PG8_STAGE(PG8_SB(0, 0), b2, voffB); PG8_STAGE(PG8_SB(0, 1), b2 + hstepB, voffB); PG8_STAGE(PG8_SA(0, 0), a2, voffA);
            PG8_WAIT_V(8); PG8_WAIT_L(0); PG8_BAR; PG8_MMA(1, 0, At, B0); PG8_MMA(1, 1, At, B1); PG8_BAR; PG8_SCHED;
            PG8_LDB(B0, 1, 0); PG8_LDB(B1, 1, 1); PG8_SCHED; PG8_LDA(At, 1, 0); PG8_STAGE(PG8_SA(0, 1), a2 + hstepA, voffA);
            PG8_WAIT_V(8); PG8_WAIT_L(0); PG8_BAR; PG8_MMA(0, 0, At, B0); PG8_MMA(0, 1, At, B1); PG8_BAR; PG8_SCHED;
            PG8_LDA(At, 1, 1); PG8_STAGE(PG8_SB(1, 0), b3, voffB); PG8_STAGE(PG8_SB(1, 1), b3 + hstepB, voffB); PG8_STAGE(PG8_SA(1, 0), a3, voffA);
            PG8_WAIT_V(8); PG8_WAIT_L(0); PG8_BAR; PG8_MMA(1, 0, At, B0); PG8_MMA(1, 1, At, B1); PG8_BAR; PG8_SCHED;
            } else {
            PG8_LDB(B0, 0, 0); PG8_SCHED; PG8_LDA(At, 0, 0); PG8_STAGE(PG8_SA(1, 1), a1 + hstepA, voffA);
            PG8_WAIT_L(8); PG8_BAR; PG8_WAIT_L(0); PG8_MMA(0, 0, At, B0); PG8_BAR; PG8_SCHED;
            PG8_LDB(B1, 0, 1); PG8_STAGE(PG8_SB(0, 0), b2, voffB);
            PG8_BAR; PG8_WAIT_L(0); PG8_MMA(0, 1, At, B1); PG8_BAR;
            PG8_LDA(At, 0, 1); PG8_STAGE(PG8_SA(0, 0), a2, voffA);
            PG8_BAR; PG8_WAIT_L(0); PG8_MMA(1, 0, At, B0); PG8_BAR; PG8_SCHED;
            PG8_STAGE(PG8_SB(0, 1), b2 + hstepB, voffB);
            PG8_WAIT_V(6); PG8_BAR; PG8_MMA(1, 1, At, B1); PG8_BAR;
            PG8_LDB(B0, 1, 0); PG8_SCHED; PG8_LDA(At, 1, 0); PG8_STAGE(PG8_SA(0, 1), a2 + hstepA, voffA);
            PG8_WAIT_L(8); PG8_BAR; PG8_WAIT_L(0); PG8_MMA(0, 0, At, B0); PG8_BAR; PG8_SCHED;
            PG8_LDB(B1, 1, 1); PG8_STAGE(PG8_SB(1, 0), b3, voffB);
            PG8_BAR; PG8_WAIT_L(0); PG8_MMA(0, 1, At, B1); PG8_BAR;
            PG8_LDA(At, 1, 1); PG8_STAGE(PG8_SA(1, 0), a3, voffA);
            PG8_BAR; PG8_WAIT_L(0); PG8_MMA(1, 0, At, B0); PG8_BAR; PG8_SCHED;
            PG8_STAGE(PG8_SB(1, 1), b3 + hstepB, voffB);
            PG8_WAIT_V(6); PG8_BAR; PG8_MMA(1, 1, At, B1); PG8_BAR;
            }
        }
        if constexpr (ALIGN_EPI) { if (wr == 0) PG8_BAR; }
        if constexpr (!Epi::AFTER_DRAIN) { E(acc, cur, wr, wc, fr, fq); S.done(cur); }
        if (!has_next) break;
#pragma unroll
        for (int a = 0; a < 2; ++a)
#pragma unroll
            for (int b = 0; b < 2; ++b)
#pragma unroll
                for (int m = 0; m < 4; ++m)
#pragma unroll
                    for (int n = 0; n < 2; ++n) acc[a][b][m][n] = (f32x4){0.f, 0.f, 0.f, 0.f};
        cur = nxt; cA = nA; cB = nB; ++ui;
        if constexpr (ALIGN_EPI) { if (wr == 1) PG8_BAR; }
    }
    PG8_WAIT_V(0);
    if constexpr (!ALIGN_EPI) { if (wr == 0) PG8_BAR; }
    PG8_BAR;
    if constexpr (Epi::AFTER_DRAIN) { E.fused(acc, cur, wr, wc, fr, fq, lds, wid, lane); S.done(cur); }
#undef PG8_SA
#undef PG8_SB
#undef PG8_STAGE
#undef PG8_LDA
#undef PG8_LDB
#undef PG8_MMA
#undef PG8_WAIT_V
#undef PG8_WAIT_L
#undef PG8_BAR
#undef PG8_SCHED
}
}
#define XB_TMO      128
#define XB_XCNT(j)  (256  + 64 * (j))
#define XB_XSUB(j)  (1280 + 64 * (j))
#define XB_XGEN(j)  (2304 + 64 * (j))
#define XB_TOP      3328
#define XB_TOPGEN   3392
#define XCD_BAR_WORDS 3456
#define XB_SPIN_CAP (1u << 18)

__device__ __forceinline__ unsigned xb_ld(unsigned* p)              { return __hip_atomic_load(p, __ATOMIC_RELAXED, __HIP_MEMORY_SCOPE_AGENT); }
__device__ __forceinline__ unsigned xb_add(unsigned* p, unsigned v) { return __hip_atomic_fetch_add(p, v, __ATOMIC_RELAXED, __HIP_MEMORY_SCOPE_AGENT); }
__device__ __forceinline__ unsigned xb_xcc_id() { return (unsigned)__builtin_amdgcn_s_getreg((3 << 11) | 20) & 0xFu; }
#define XB_SPIN(cond, bar) do { unsigned _sp = 0; while (cond) { __builtin_amdgcn_s_sleep(1); \
    if ((++_sp & 255u) == 0u) { if (xb_ld(&(bar)[XB_TMO])) break; if (_sp > XB_SPIN_CAP) { atomicAdd(&(bar)[XB_TMO], 1u); break; } } } } while (0)

struct XcdBarrier {
    unsigned* bar; unsigned x;
    volatile LAS unsigned* st;
};

__device__ __forceinline__ XcdBarrier xcd_barrier_post(unsigned* bar, volatile LAS unsigned* st) {
    XcdBarrier b; b.bar = bar; b.x = xb_xcc_id(); b.st = st;
    if (threadIdx.x == 0) (void)xb_add(&bar[XB_XCNT(b.x)], 1u);
    return b;
}
__device__ __forceinline__ void xcd_barrier_complete(unsigned* bar, unsigned x, unsigned& nloc, unsigned& nx) {
    const unsigned G = gridDim.x * gridDim.y * gridDim.z;
    unsigned sum, cnt, mine, sp = 0u;
    for (;;) {
        sum = 0u; cnt = 0u; mine = 0u;
#pragma unroll
        for (unsigned j = 0; j < 16; ++j) { const unsigned c = xb_ld(&bar[XB_XCNT(j)]); sum += c; cnt += (c > 0u) ? 1u : 0u; mine = (j == x) ? c : mine; }
        if (sum == G) break;
        __builtin_amdgcn_s_sleep(1);
        if ((++sp & 255u) == 0u) { if (xb_ld(&bar[XB_TMO])) break; if (sp > XB_SPIN_CAP) { atomicAdd(&bar[XB_TMO], 1u); break; } }
    }
    nloc = mine > 0u ? mine : 1u; nx = cnt > 0u ? cnt : 1u;
}

__device__ __forceinline__ void xcd_barrier(const XcdBarrier& b) {
    asm volatile("s_waitcnt vmcnt(0)" ::: "memory");
    __syncthreads();
    if (threadIdx.x == 0) {
        unsigned* bar = b.bar;
        __builtin_amdgcn_s_waitcnt(0);
        unsigned nloc = b.st[0], nx = b.st[1];
        if (nloc == 0u) { xcd_barrier_complete(bar, b.x, nloc, nx); b.st[0] = nloc; b.st[1] = nx; }
        const unsigned old = xb_add(&bar[XB_XSUB(b.x)], 1u);
        const unsigned gen = old / nloc;
        if (old + 1u == (gen + 1u) * nloc) {
            __builtin_amdgcn_fence(__ATOMIC_RELEASE, "agent");
            asm volatile("s_waitcnt vmcnt(0)" ::: "memory");
            const unsigned og = xb_add(&bar[XB_TOP], 1u);
            const unsigned tg = og / nx;
            if (og + 1u == (tg + 1u) * nx) xb_add(&bar[XB_TOPGEN], 1u);
            else XB_SPIN(xb_ld(&bar[XB_TOPGEN]) == tg, bar);
            __builtin_amdgcn_fence(__ATOMIC_ACQUIRE, "agent");
            xb_add(&bar[XB_XGEN(b.x)], 1u);
            asm volatile("s_waitcnt vmcnt(0)" ::: "memory");
        } else {
            XB_SPIN(xb_ld(&bar[XB_XGEN(b.x)]) == gen, bar);
            __builtin_amdgcn_fence(__ATOMIC_ACQUIRE, "agent");
            asm volatile("s_waitcnt vmcnt(0)" ::: "memory");
        }
    }
    __syncthreads();
}
typedef pg8::f32x4 A4;
#define EPI_ROWS_BEGIN _Pragma("unroll") for (int ai = 0; ai < 2; ++ai) _Pragma("unroll") for (int m = 0; m < 4; ++m) { const int row = u.pm * 256 + ai * 128 + wr * 64 + m * 16 + fr;
#define EPI_ROWS_END }
__device__ __forceinline__ float rstd_of(const float* ss, int row, int fq) {
    if (!ss) return 1.0f;
    const f32x4 p = *(const f32x4*)(ss + (size_t)row * 16 + fq * 4);
    float s = (p[0] + p[1]) + (p[2] + p[3]);
    s += __shfl_xor(s, 16); s += __shfl_xor(s, 32);
    return rsqrtf(s * (1.0f / D) + EPS);
}
__device__ __forceinline__ float rstd_row(const float* ss, size_t row) {
    const f32x4* p = (const f32x4*)(ss + row * 16); float s = 0.f;
#pragma unroll
    for (int i = 0; i < 4; ++i) { const f32x4 v = p[i]; s += (v[0] + v[1]) + (v[2] + v[3]); }
    return rsqrtf(s * (1.0f / D) + EPS);
}
__device__ __forceinline__ u32x4 pack8(const A4& a, const A4& b) { u32x4 w; w.x = pkbf(a[0], a[1]); w.y = pkbf(a[2], a[3]); w.z = pkbf(b[0], b[1]); w.w = pkbf(b[2], b[3]); return w; }
__device__ __forceinline__ void unpack8(const u32x4& w, A4& a, A4& b) { a[0] = bflo(w.x); a[1] = bfhi(w.x); a[2] = bflo(w.y); a[3] = bfhi(w.y); b[0] = bflo(w.z); b[1] = bfhi(w.z); b[2] = bflo(w.w); b[3] = bfhi(w.w); }

struct EpiScale {
    static constexpr bool PERM = true, AFTER_DRAIN = false;
    bf16_t* O; const float* ss; int ld; float scale;
    __device__ __forceinline__ void operator()(const A4 (&acc)[2][2][4][2], const pg8::Unit& u, int wr, int wc, int fr, int fq) const {
        const int col0 = u.pn * 256 + wc * 32 + 8 * fq;
        EPI_ROWS_BEGIN
            const float s = rstd_of(ss, row, fq) * scale;
#pragma unroll
            for (int bj = 0; bj < 2; ++bj) *(u32x4*)(O + (size_t)row * ld + col0 + bj * 128) = pack8(acc[ai][bj][m][0] * s, acc[ai][bj][m][1] * s);
        EPI_ROWS_END
    }
};

struct EpiProj {
    static constexpr bool PERM = true, AFTER_DRAIN = false;
    bf16_t *AQ, *AK, *AV, *BQ, *BK, *BV, *BRS, *GA, *GB; float* LOGA; const float* ss; const float* balpha; int tile0, pad;
    __device__ __forceinline__ void operator()(const A4 (&acc)[2][2][4][2], const pg8::Unit& u, int wr, int wc, int fr, int fq) const {
        const int tile = u.pn + tile0;
        bf16_t* dst; int ld, c0, mode = 0; float sc = 1.f;
        if (tile < 2) { dst = AQ; ld = 512; c0 = tile * 256; sc = 0.125f; }
        else if (tile < 4) { dst = AK; ld = 512; c0 = (tile - 2) * 256; }
        else if (tile < 6) { dst = AV; ld = 512; c0 = (tile - 4) * 256; }
        else if (tile == 6) { dst = BQ; ld = 256; c0 = 0; sc = 0.125f; }
        else if (tile == 7) { dst = BK; ld = 256; c0 = 0; }
        else if (tile < 10) { dst = BV; ld = 512; c0 = (tile - 8) * 256; }
        else if (tile < 12) { dst = BRS; ld = 512; c0 = (tile - 10) * 256; mode = 1; }
        else if (tile == 12) { dst = nullptr; ld = 256; c0 = 0; mode = 3; }
        else if (tile < 17) { dst = GA; ld = 1024; c0 = (tile - 13) * 256; mode = 2; }
        else { dst = GB; ld = 1024; c0 = (tile - 17) * 256; mode = 2; }
        const int cl = wc * 32 + 8 * fq;
        EPI_ROWS_BEGIN
            const float s = rstd_of(ss, row, fq) * sc;
#pragma unroll
            for (int bj = 0; bj < 2; ++bj) {
                A4 v0 = acc[ai][bj][m][0] * s, v1 = acc[ai][bj][m][1] * s;
                const int c = cl + bj * 128;
                if (mode == 3) {
                    const A4 b0 = *(const A4*)(balpha + c), b1 = *(const A4*)(balpha + c + 4);
#pragma unroll
                    for (int i = 0; i < 4; ++i) { v0[i] = flogsigmoid(v0[i] + b0[i]) * 0.0625f; v1[i] = flogsigmoid(v1[i] + b1[i]) * 0.0625f; }
                    float* o = LOGA + (size_t)row * 256 + c; *(A4*)o = v0; *(A4*)(o + 4) = v1;
                } else {
                    if (mode == 1) {
#pragma unroll
                        for (int i = 0; i < 4; ++i) { v0[i] = fsilu(v0[i]); v1[i] = fsilu(v1[i]); }
                    } else if (mode == 2) {
#pragma unroll
                        for (int i = 0; i < 4; ++i) { v0[i] = fsigmoid(v0[i]); v1[i] = fsigmoid(v1[i]); }
                    }
                    *(u32x4*)(dst + (size_t)row * ld + c0 + c) = pack8(v0, v1);
                }
            }
        EPI_ROWS_END
    }
};

struct EpiGate {
    static constexpr bool PERM = true, AFTER_DRAIN = false;
    const bf16_t* G; const bf16_t* ADD; bf16_t* O;
    __device__ __forceinline__ void operator()(const A4 (&acc)[2][2][4][2], const pg8::Unit& u, int wr, int wc, int fr, int fq) const {
        const int col0 = u.pn * 256 + wc * 32 + 8 * fq;
        EPI_ROWS_BEGIN
#pragma unroll
            for (int bj = 0; bj < 2; ++bj) {
                const size_t off = (size_t)row * D + col0 + bj * 128;
                A4 g0, g1; unpack8(*(const u32x4*)(G + off), g0, g1);
                A4 v0 = acc[ai][bj][m][0] * g0, v1 = acc[ai][bj][m][1] * g1;
                if (ADD) { A4 a0, a1; unpack8(*(const u32x4*)(ADD + off), a0, a1); v0 += a0; v1 += a1; }
                *(u32x4*)(O + off) = pack8(v0, v1);
            }
        EPI_ROWS_END
    }
};

struct EpiResid {
    static constexpr bool PERM = true, AFTER_DRAIN = false;
    bf16_t* X; float* ss_out;
    __device__ __forceinline__ void operator()(const A4 (&acc)[2][2][4][2], const pg8::Unit& u, int wr, int wc, int fr, int fq) const {
        const int col0 = u.pn * 256 + wc * 32 + 8 * fq;
        EPI_ROWS_BEGIN
            float q = 0.f;
#pragma unroll
            for (int bj = 0; bj < 2; ++bj) {
                const size_t off = (size_t)row * D + col0 + bj * 128;
                A4 x0, x1; unpack8(*(const u32x4*)(X + off), x0, x1);
                x0 += acc[ai][bj][m][0]; x1 += acc[ai][bj][m][1];
                q += (x0[0] * x0[0] + x0[1] * x0[1]) + (x0[2] * x0[2] + x0[3] * x0[3]) + (x1[0] * x1[0] + x1[1] * x1[1]) + (x1[2] * x1[2] + x1[3] * x1[3]);
                *(u32x4*)(X + off) = pack8(x0, x1);
            }
            q += __shfl_xor(q, 16); q += __shfl_xor(q, 32);
            if (fq == 0) ss_out[(size_t)row * 16 + u.pn * 4 + wc] = q;
        EPI_ROWS_END
    }
};

__device__ __forceinline__ void conv_item(const float* __restrict__ W, int ldw, const float* __restrict__ gk, bf16_t* __restrict__ WT, int ldt, int k0, int n0, LAS float* scr, int lane) {
    float4 v[8];
#pragma unroll
    for (int i = 0; i < 8; ++i) { const int kk = (lane >> 3) + 8 * i; v[i] = *(const float4*)(W + (size_t)(k0 + kk) * ldw + n0 + (lane & 7) * 4); }
#pragma unroll
    for (int i = 0; i < 8; ++i) { const int kk = (lane >> 3) + 8 * i; const float s = gk ? gk[k0 + kk] : 1.0f; LAS float* p = scr + kk * 33 + (lane & 7) * 4;
        p[0] = v[i].x * s; p[1] = v[i].y * s; p[2] = v[i].z * s; p[3] = v[i].w * s; }
    asm volatile("s_waitcnt lgkmcnt(0)" ::: "memory");
    const int c = lane & 7;
#pragma unroll
    for (int j = 0; j < 4; ++j) { const int n = (lane >> 3) + 8 * j; const LAS float* s = scr + (8 * c) * 33 + n;
        u32x4 o; o.x = pkbf(s[0 * 33], s[1 * 33]); o.y = pkbf(s[2 * 33], s[3 * 33]); o.z = pkbf(s[4 * 33], s[5 * 33]); o.w = pkbf(s[6 * 33], s[7 * 33]);
        *(u32x4*)(WT + (size_t)(n0 + n) * ldt + k0 + 8 * c) = o; }
    asm volatile("s_waitcnt lgkmcnt(0)" ::: "memory");
}

struct InPtrs {
    const float *x, *mem, *norm_mix_g, *w_in, *rel_bias, *gla_w_alpha, *gla_b_alpha, *gla_norm_g, *w_branch, *w_mix_out, *norm_x_g, *mem_norm_g, *w_xq, *w_xkv, *w_xo,
                *norm_ffn_g, *w_gr, *b_gr, *w_er, *b_er, *w_eg, *w_eu, *w_ed, *final_g;
};

struct ConvJob { const float* W; const float* gk; bf16_t* WT; int ldw, ldt, K, N; };
__device__ __forceinline__ ConvJob dense_job(const InPtrs& in, unsigned char* ws, int l, int j) {
    unsigned char* wd = ws + WS_WDENSE + (size_t)l * WDENSE_STRIDE;
    const float* Win = in.w_in + (size_t)l * D * INW; bf16_t* WIN_T = (bf16_t*)(wd + WD_WIN);
    const float* gm = in.norm_mix_g + l * D;
    ConvJob J;
    switch (j) {
    case 0: J = {Win + 0, gm, WIN_T + (size_t)0 * D, INW, D, D, 1536}; break;
    case 1: J = {Win + 1536, gm, WIN_T + (size_t)1536 * D, INW, D, D, 512}; break;
    case 2: J = {Win + 2048, gm, WIN_T + (size_t)2048 * D, INW, D, D, 512}; break;
    case 3: J = {Win + 2576, gm, WIN_T + (size_t)2560 * D, INW, D, D, 512}; break;
    case 4: J = {Win + 3088, gm, WIN_T + (size_t)3328 * D, INW, D, D, 2048}; break;
    case 5: J = {in.w_branch + (size_t)(l * 2 + 0) * 512 * D, nullptr, (bf16_t*)(wd + WD_WB), D, D, 512, D}; break;
    case 6: J = {in.w_branch + (size_t)(l * 2 + 1) * 512 * D, nullptr, (bf16_t*)(wd + WD_WB) + 512, D, D, 512, D}; break;
    case 7: J = {in.w_mix_out + (size_t)l * D * D, nullptr, (bf16_t*)(wd + WD_WMO), D, D, D, D}; break;
    case 8: J = {in.w_xq + (size_t)l * D * D, in.norm_x_g + l * D, (bf16_t*)(wd + WD_WXQ), D, D, D, D}; break;
    case 9: J = {in.w_xkv + (size_t)l * D * 2 * D, nullptr, (bf16_t*)(wd + WD_WXKV), 2 * D, D, D, 2 * D}; break;
    default: J = {in.w_xo + (size_t)l * D * D, nullptr, (bf16_t*)(wd + WD_WXO), D, D, D, D}; break;
    }
    return J;
}

__device__ __forceinline__ void ph_prologue(const InPtrs& in, unsigned char* ws, LAS unsigned char* lds, int vcu, int G) {
    const int tid = tid_now(), lane = tid & 63, wave = __builtin_amdgcn_readfirstlane(tid >> 6);
    LAS float* scr = (LAS float*)(lds + wave * 16384);
    const int gw = vcu * 8 + wave, NGW = G * 8;
#pragma nounroll
    for (int lj = 0; lj < DEPTH * 11; ++lj) {
            const int l = lj / 11, j = lj % 11;
            const ConvJob J = dense_job(in, ws, l, j);
            const int nnb = J.N / 32, nit = (J.K / 64) * nnb;
#pragma nounroll
            for (int it = gw; it < nit; it += NGW) conv_item(J.W, J.ldw, J.gk, J.WT, J.ldt, (it / nnb) * 64, (it % nnb) * 32, scr, lane);
        }
#pragma nounroll
    for (int l = 0; l < DEPTH; ++l) {
        bf16_t* WIN_T = (bf16_t*)(ws + WS_WDENSE + (size_t)l * WDENSE_STRIDE + WD_WIN);
        const float* Win = in.w_in + (size_t)l * D * INW; const float* Wa = in.gla_w_alpha + (size_t)l * BR * BKW; const float* gm = in.norm_mix_g + l * D;
        for (int i = vcu * 512 + tid; i < 256 * D; i += G * 512) {
            const int c = i >> 10, k = i & 1023; float s = 0.f;
#pragma unroll
            for (int r = 0; r < BR; ++r) s += Win[(size_t)k * INW + 2560 + r] * Wa[r * BKW + c];
            WIN_T[(size_t)(3072 + c) * D + k] = f2bf(s * gm[k]);
        }
    }
    bf16_t* XB = (bf16_t*)(ws + WS_XB); float* ss0 = (float*)(ws + WS_SSP);
    for (int r = gw; r < T; r += NGW) {
        const float4* xr = (const float4*)(in.x + (size_t)r * D) + lane; float s = 0.f;
#pragma unroll
        for (int j = 0; j < 4; ++j) { const float4 v = xr[64 * j]; s += v.x * v.x + v.y * v.y + v.z * v.z + v.w * v.w;
            u32x2 o; o.x = pkbf(v.x, v.y); o.y = pkbf(v.z, v.w); *(u32x2*)(XB + (size_t)r * D + (lane + 64 * j) * 4) = o; }
        s = wave_sum(s); if (lane < 16) ss0[(size_t)r * 16 + lane] = lane == 0 ? s : 0.f;
    }
    bf16_t* MEMN = (bf16_t*)(ws + WS_MEMN);
    for (int r = gw; r < NB * NMEM; r += NGW) {
        const float4* xr = (const float4*)(in.mem + (size_t)r * D) + lane; float4 v[4]; float s = 0.f;
#pragma unroll
        for (int j = 0; j < 4; ++j) { v[j] = xr[64 * j]; s += v[j].x * v[j].x + v[j].y * v[j].y + v[j].z * v[j].z + v[j].w * v[j].w; }
        const float rs = rsqrtf(wave_sum(s) * (1.0f / D) + EPS);
#pragma unroll
        for (int j = 0; j < 4; ++j) { const float4 g = ((const float4*)in.mem_norm_g)[lane + 64 * j];
            u32x2 o; o.x = pkbf(v[j].x * rs * g.x, v[j].y * rs * g.y); o.y = pkbf(v[j].z * rs * g.z, v[j].w * rs * g.w); *(u32x2*)(MEMN + (size_t)r * D + (lane + 64 * j) * 4) = o; }
    }
}

__device__ __forceinline__ void d_band_attn(int blk, int qi, const bf16_t* __restrict__ AQ, const bf16_t* __restrict__ AK, const bf16_t* __restrict__ AV, const float* __restrict__ rel, bf16_t* __restrict__ OAB) {
    const int n = blk % NCH, h = (blk / NCH) % AH, b = blk / (NCH * AH);
    const size_t qrow = (size_t)(b * L + n * CH + qi);
    float q[64], acc[64];
#pragma unroll
    for (int d = 0; d < 64; d += 8) { const u32x4 w = *(const u32x4*)(AQ + qrow * AW + h * 64 + d);
        q[d] = bflo(w.x); q[d + 1] = bfhi(w.x); q[d + 2] = bflo(w.y); q[d + 3] = bfhi(w.y); q[d + 4] = bflo(w.z); q[d + 5] = bfhi(w.z); q[d + 6] = bflo(w.w); q[d + 7] = bfhi(w.w); }
#pragma unroll
    for (int d = 0; d < 64; ++d) acc[d] = 0.f;
    float m = -INFINITY, l = 0.f;
    for (int j = 0; j < ABAND; ++j) {
        const int kc = n + (j >> 6) - ALC; if (kc < 0) continue;
        const size_t krow = (size_t)(b * L + kc * CH + (j & 63));
        const bf16_t* kp = AK + krow * AW + h * 64; const bf16_t* vp = AV + krow * AW + h * 64;
        float s = 0.f;
#pragma unroll
        for (int d = 0; d < 64; d += 8) { const u32x4 w = *(const u32x4*)(kp + d);
            s += q[d] * bflo(w.x) + q[d + 1] * bfhi(w.x) + q[d + 2] * bflo(w.y) + q[d + 3] * bfhi(w.y) + q[d + 4] * bflo(w.z) + q[d + 5] * bfhi(w.z) + q[d + 6] * bflo(w.w) + q[d + 7] * bfhi(w.w); }
        int relp = (ALC * CH + qi) - j; relp = relp < -AMAXREL ? -AMAXREL : (relp > AMAXREL ? AMAXREL : relp);
        s = s + rel[h * RELW + relp + AMAXREL];
        const float mn = fmaxf(m, s), corr = __expf(m - mn), p = __expf(s - mn);
        l = l * corr + p; m = mn;
#pragma unroll
        for (int d = 0; d < 64; d += 8) { const u32x4 w = *(const u32x4*)(vp + d);
            acc[d] = acc[d] * corr + p * bflo(w.x); acc[d + 1] = acc[d + 1] * corr + p * bfhi(w.x); acc[d + 2] = acc[d + 2] * corr + p * bflo(w.y); acc[d + 3] = acc[d + 3] * corr + p * bfhi(w.y);
            acc[d + 4] = acc[d + 4] * corr + p * bflo(w.z); acc[d + 5] = acc[d + 5] * corr + p * bfhi(w.z); acc[d + 6] = acc[d + 6] * corr + p * bflo(w.w); acc[d + 7] = acc[d + 7] * corr + p * bfhi(w.w); }
    }
    const float inv = 1.0f / l;
#pragma unroll
    for (int d = 0; d < 64; d += 8) { u32x4 o; o.x = pkbf(acc[d] * inv, acc[d + 1] * inv); o.y = pkbf(acc[d + 2] * inv, acc[d + 3] * inv); o.z = pkbf(acc[d + 4] * inv, acc[d + 5] * inv); o.w = pkbf(acc[d + 6] * inv, acc[d + 7] * inv);
        *(u32x4*)(OAB + qrow * D + h * 64 + d) = o; }
}

__device__ __forceinline__ void d_gla(int item, LAS float* sm  , const bf16_t* __restrict__ BQ, const bf16_t* __restrict__ BK, const bf16_t* __restrict__ BV, const float* __restrict__ LOGA, float* __restrict__ raw) {
    LAS float* sq = sm; LAS float* sk = sm + 128; LAS float* sa = sm + 256;
    const int b = item / BH, h = item % BH, v = tid_now();
    float S[64];
#pragma unroll
    for (int k = 0; k < 64; ++k) S[k] = 0.f;
    for (int t = 0; t < L; ++t) {
        const size_t row = (size_t)(b * L + t); const int bf = (t & 1) * 64;
        float vv = 0.f;
        if (v < 64) { sq[bf + v] = bf2f(BQ[row * BKW + h * 64 + v]); sa[bf + v] = __expf(LOGA[row * BKW + h * 64 + v]); }
        else if (v < 128) { sk[bf + v - 64] = bf2f(BK[row * BKW + h * 64 + (v - 64)]); }
        if (v < 128) vv = bf2f(BV[row * BVW + h * 128 + v]);
        __syncthreads();
        if (v < 128) {
            float o = 0.f;
#pragma unroll
            for (int k = 0; k < 64; ++k) { S[k] = sa[bf + k] * S[k] + sk[bf + k] * vv; o += sq[bf + k] * S[k]; }
            raw[row * BVW + h * 128 + v] = o;
        }
    }
}
__device__ __forceinline__ void d_gla_post(int w, int lane, const float* __restrict__ raw, const bf16_t* __restrict__ BRS, const float* __restrict__ g, bf16_t* __restrict__ OAB) {
    const size_t t = w / BH; const int h = w % BH;
    const float* p = raw + t * BVW + h * 128;
    const float a = p[lane], c = p[lane + 64];
    const float rs = rsqrtf(wave_sum(a * a + c * c) * (1.0f / 128.0f) + EPS);
    const bf16_t* br = BRS + t * BVW + h * 128;
    bf16_t* o = OAB + t * D + 512 + h * 128;
    o[lane] = f2bf(a * rs * g[lane] * bf2f(br[lane])); o[lane + 64] = f2bf(c * rs * g[lane + 64] * bf2f(br[lane + 64]));
}

__device__ __forceinline__ void d_xattn(int item, int j, LAS float* sm, bf16_t* QO, const bf16_t* __restrict__ kv) {
    LAS float* qs = sm; LAS float* ps = sm + 256; LAS float* red = sm + 512;
    const size_t t = item / XH; const int h = item % XH, b = (int)(t / L);
    qs[j] = bf2f(QO[t * D + h * XD + j]);
    __syncthreads();
    const bf16_t* kp = kv + (size_t)(b * NMEM + j) * 2048 + h * XD;
    float s = 0.f;
    for (int d = 0; d < XD; d += 8) { const u32x4 w = *(const u32x4*)(kp + d);
        s += qs[d] * bflo(w.x) + qs[d + 1] * bfhi(w.x) + qs[d + 2] * bflo(w.y) + qs[d + 3] * bfhi(w.y) + qs[d + 4] * bflo(w.z) + qs[d + 5] * bfhi(w.z) + qs[d + 6] * bflo(w.w) + qs[d + 7] * bfhi(w.w); }
    float m = s;
    for (int o = 32; o > 0; o >>= 1) m = fmaxf(m, __shfl_xor(m, o));
    if ((j & 63) == 0) red[j >> 6] = m;
    __syncthreads();
    m = fmaxf(fmaxf(red[0], red[1]), fmaxf(red[2], red[3]));
    __syncthreads();
    const float p = __expf(s - m);
    float l = wave_sum(p);
    if ((j & 63) == 0) red[j >> 6] = l;
    ps[j] = p;
    __syncthreads();
    l = red[0] + red[1] + red[2] + red[3];
    const bf16_t* vp = kv + (size_t)(b * NMEM) * 2048 + 1024 + h * XD + j;
    float o = 0.f;
    for (int jj = 0; jj < NMEM; ++jj) o += ps[jj] * bf2f(vp[(size_t)jj * 2048]);
    QO[t * D + h * XD + j] = f2bf(o / l);
    __syncthreads();
}

__device__ __forceinline__ void d_route(size_t t, int lane, const bf16_t* __restrict__ XB, const float* __restrict__ ss, const float* __restrict__ g, const float* __restrict__ wgr, const float* __restrict__ bgr,
                                        const float* __restrict__ wer, const float* __restrict__ ber, int* __restrict__ sel_e, float* __restrict__ sel_w) {
    const float rs = rstd_row(ss, t);
    float gl[4], el[32];
#pragma unroll
    for (int i = 0; i < 4; ++i) gl[i] = 0.f;
#pragma unroll
    for (int i = 0; i < 32; ++i) el[i] = 0.f;
    for (int i = 0; i < 16; ++i) { const int d = lane + 64 * i; const float hv = bf2f(XB[t * D + d]) * rs * g[d];
#pragma unroll
        for (int o = 0; o < 4; ++o) gl[o] += hv * wgr[d * NG + o];
#pragma unroll
        for (int o = 0; o < 32; ++o) el[o] += hv * wer[d * NE + o]; }
#pragma unroll
    for (int i = 0; i < 4; ++i) gl[i] = wave_sum(gl[i]) + bgr[i];
#pragma unroll
    for (int i = 0; i < 32; ++i) el[i] = wave_sum(el[i]) + ber[i];
    float gm = gl[0]; int gi = 0;
#pragma unroll
    for (int i = 1; i < 4; ++i) if (gl[i] > gm) { gm = gl[i]; gi = i; }
    float gs = 0.f;
#pragma unroll
    for (int i = 0; i < 4; ++i) gs += __expf(gl[i] - gm);
    const float gw = 1.0f / gs;
    float v0 = -INFINITY, v1 = -INFINITY; int i0 = 0, i1 = 0;
#pragma unroll
    for (int gg = 0; gg < 4; ++gg)
#pragma unroll
        for (int e = 0; e < EPG; ++e) if (gg == gi) { const float x = el[gg * EPG + e];
            if (x > v0) { v1 = v0; i1 = i0; v0 = x; i0 = e; } else if (x > v1) { v1 = x; i1 = e; } }
    const float e1 = __expf(v1 - v0), den = 1.0f + e1;
    if (lane == 0) { sel_e[t * 2] = gi * EPG + i0; sel_e[t * 2 + 1] = gi * EPG + i1; sel_w[t * 2] = gw / den; sel_w[t * 2 + 1] = gw * e1 / den; }
}

__device__ __forceinline__ void d_moe(size_t t, int f, LAS float* sm, bf16_t* XB, const float* __restrict__ ss, const float* __restrict__ g, const float* __restrict__ Wg, const float* __restrict__ Wu, const float* __restrict__ Wd,
                                      const int* __restrict__ sel_e, const float* __restrict__ sel_w, float* __restrict__ ss_next) {
    LAS float* hs = sm; LAS float* hid = sm + 1024; LAS float* red = sm + 1280;
    const float rs = rstd_row(ss, t);
    for (int i = f; i < D; i += 256) hs[i] = bf2f(XB[t * D + i]) * rs * g[i];
    float y0 = 0.f, y1 = 0.f, y2 = 0.f, y3 = 0.f;
    for (int s = 0; s < 2; ++s) {
        const int e = sel_e[t * 2 + s]; const float w = sel_w[t * 2 + s];
        __syncthreads();
        const float* wg = Wg + (size_t)e * D * EF + f; const float* wu = Wu + (size_t)e * D * EF + f;
        float ga = 0.f, up = 0.f;
        for (int d = 0; d < D; ++d) { ga += hs[d] * wg[(size_t)d * EF]; up += hs[d] * wu[(size_t)d * EF]; }
        hid[f] = ga / (1.0f + __expf(-ga)) * up * w;
        __syncthreads();
        const float* wd = Wd + (size_t)e * EF * D + f;
        for (int ff = 0; ff < EF; ++ff) { const float hv = hid[ff]; const float* r = wd + (size_t)ff * D; y0 += hv * r[0]; y1 += hv * r[256]; y2 += hv * r[512]; y3 += hv * r[768]; }
    }
    bf16_t* xr = XB + t * D + f;
    const float x0 = bf2f(xr[0]) + y0, x1 = bf2f(xr[256]) + y1, x2 = bf2f(xr[512]) + y2, x3 = bf2f(xr[768]) + y3;
    xr[0] = f2bf(x0); xr[256] = f2bf(x1); xr[512] = f2bf(x2); xr[768] = f2bf(x3);
    const float q = wave_sum(x0 * x0 + x1 * x1 + x2 * x2 + x3 * x3);
    __syncthreads();
    if ((f & 63) == 0) red[f >> 6] = q;
    __syncthreads();
    if (f < 16) ss_next[t * 16 + f] = f == 0 ? (red[0] + red[1]) + (red[2] + red[3]) : 0.f;
    __syncthreads();
}

__device__ __forceinline__ void d_final(size_t t, int i, const bf16_t* __restrict__ XB, const float* __restrict__ ss, const float* __restrict__ g, float* __restrict__ out) {
    const float rs = rstd_row(ss, t);
    const u32x2 w = *(const u32x2*)(XB + t * D + i * 4); const float4 gg = ((const float4*)g)[i];
    float4 o; o.x = bflo(w.x) * rs * gg.x; o.y = bfhi(w.x) * rs * gg.y; o.z = bflo(w.y) * rs * gg.z; o.w = bfhi(w.y) * rs * gg.w;
    ((float4*)(out + t * D))[i] = o;
}
#ifndef MK_LAUNCHES
#define MK_LAUNCHES 1
#endif
constexpr int RING_BYTES = 131072, MISC_OFF = RING_BYTES + 512, LDS_BYTES = 147456;
constexpr int CW_BAR = 1024;
constexpr size_t CTL_ZERO_BYTES = 64 * 1024;
static_assert((CW_BAR + XCD_BAR_WORDS) * 4 <= (int)CTL_ZERO_BYTES, "barrier words inside the memset region");
constexpr int N_PHASES = 2 + 10 * DEPTH;

struct MKArgs { InPtrs in; unsigned char* ws; unsigned char* dout; int ph_lo, ph_hi; };

__global__ void __launch_bounds__(512, 2) mk_fwd(MKArgs a) {
    extern __shared__ __attribute__((aligned(16))) unsigned char lds_raw[];
    LAS unsigned char* lds = (LAS unsigned char*)lds_raw;
    const int G = (int)gridDim.x, vcu = (int)blockIdx.x;
    volatile LAS unsigned* MISC = (volatile LAS unsigned*)(lds + MISC_OFF);
    if (threadIdx.x < 16) MISC[threadIdx.x] = 0u;
    __syncthreads();
    const bool one_launch = (a.ph_hi - a.ph_lo) > 1;
    XcdBarrier bar; bar.bar = (unsigned*)(a.ws + WS_CTL) + CW_BAR; bar.x = 0; bar.st = MISC + 8;
    if (one_launch) bar = xcd_barrier_post((unsigned*)(a.ws + WS_CTL) + CW_BAR, MISC + 8);

    const InPtrs& in = a.in;
#define SS ((float*)(ws + WS_SSP))
#define XB ((bf16_t*)(ws + WS_XB))
#define AQ ((bf16_t*)(ws + WS_AQ))
#define AK ((bf16_t*)(ws + WS_AK))
#define AV ((bf16_t*)(ws + WS_AV))
#define BQ ((bf16_t*)(ws + WS_BQ))
#define BK ((bf16_t*)(ws + WS_BK))
#define BV ((bf16_t*)(ws + WS_BV))
#define BRS ((bf16_t*)(ws + WS_BRS))
#define GA ((bf16_t*)(ws + WS_GA))
#define GB ((bf16_t*)(ws + WS_GB))
#define MG ((bf16_t*)(ws + WS_MG))
#define Q ((bf16_t*)(ws + WS_Q))
#define MEMN ((bf16_t*)(ws + WS_MEMN))
#define KVB ((bf16_t*)(ws + WS_KVB))
#define LOGA ((float*)(ws + WS_LOGA))
#define OAB ((bf16_t*)(dout + DO_OAB))
#define RAW ((float*)(dout + DO_ST))
#define TMP ((bf16_t*)(dout + DO_TMP))
#define SELE ((int*)(ws + WS_SEL))
#define SELW ((float*)(ws + WS_SEL + (size_t)T * 2 * 4))
#define WD(l) (ws + WS_WDENSE + (size_t)(l) * WDENSE_STRIDE)
#define SSA(i) (SS + (size_t)(i) * T * 16)
#define MK_EP(l, t0) EpiProj{AQ, AK, AV, BQ, BK, BV, BRS, GA, GB, LOGA, SSA(3 * (l)), in.gla_b_alpha + (size_t)(l) * BKW, (t0), 0}
    int ph = 0;
#define PH_ON (ph >= a.ph_lo && ph < a.ph_hi)
#define PH_PTRS unsigned char* ws = opaque_ptr(a.ws); unsigned char* dout = opaque_ptr(a.dout); (void)ws; (void)dout; const int tid = tid_now(), lane = tid & 63, wave = __builtin_amdgcn_readfirstlane(tid >> 6); (void)lane; (void)wave;
#define PH_END do { if (PH_ON && ph + 1 < a.ph_hi) xcd_barrier(bar); ++ph; } while (0)
#define GEMM(EpiT, gm, ep) do { pg8::StaticOrder S_; S_.init((gm).M, (gm).N, G, vcu); pg8::gemm_phase<EpiT, pg8::StaticOrder, true, true>(lds, gm, S_, ep); } while (0)

    if (PH_ON) { PH_PTRS ph_prologue(in, ws, lds, vcu, G); }
    PH_END;

#pragma nounroll
    for (int l = 0; l < DEPTH; ++l) {
        if (PH_ON) { PH_PTRS
            if (l == 0) {
#pragma nounroll
                for (int l2 = 0; l2 < DEPTH; ++l2) {
                    const pg8::Gemm g{MEMN, (const bf16_t*)(ws + WS_WDENSE + (size_t)l2 * WDENSE_STRIDE + WD_WXKV), NB * NMEM, 2 * D, D, D, D, 0};
                    const EpiScale e{KVB + (size_t)l2 * NB * NMEM * 2 * D, nullptr, 2 * D, 1.0f};
                    GEMM(EpiScale, g, e);
                }
            }
            const pg8::Gemm g{XB, (const bf16_t*)(WD(l) + WD_WIN), T, NPROJ_A, D, D, D, 0}; const EpiProj e = MK_EP(l, 0);
            GEMM(EpiProj, g, e);
        }
        PH_END;
        if (PH_ON) { PH_PTRS
            if (vcu < NB * BH) d_gla(vcu, (LAS float*)lds, BQ, BK, BV, LOGA, RAW);
            else {
                const float* rel = in.rel_bias + (size_t)l * AH * RELW;
                for (int it = (vcu - NB * BH) * 8 + wave; it < NB * AH * NCH; it += (G - NB * BH) * 8) d_band_attn(it, lane, AQ, AK, AV, rel, OAB);
            }
        }
        PH_END;
        if (PH_ON) { PH_PTRS
            for (int w = vcu * 8 + wave; w < T * BH; w += G * 8) d_gla_post(w, lane, RAW, BRS, in.gla_norm_g + (size_t)l * 128, OAB);
            const pg8::Gemm g{XB, (const bf16_t*)(WD(l) + WD_WIN) + (size_t)NPROJ_A * D, T, NPROJ_B, D, D, D, 0}; const EpiProj e = MK_EP(l, 13);
            GEMM(EpiProj, g, e);
        }
        PH_END;
        if (PH_ON) { PH_PTRS
            { const pg8::Gemm g{OAB, (const bf16_t*)(WD(l) + WD_WB), T, D, 512, D, D, 0}; const EpiGate e{GA, nullptr, TMP}; GEMM(EpiGate, g, e); }
            { const pg8::Gemm g{OAB + 512, (const bf16_t*)(WD(l) + WD_WB) + 512, T, D, 512, D, D, 0}; const EpiGate e{GB, TMP, MG}; GEMM(EpiGate, g, e); }
        }
        PH_END;
        if (PH_ON) { PH_PTRS const pg8::Gemm g{MG, (const bf16_t*)(WD(l) + WD_WMO), T, D, D, D, D, 0}; const EpiResid e{XB, SSA(3 * l + 1)}; GEMM(EpiResid, g, e); }
        PH_END;
        if (PH_ON) { PH_PTRS const pg8::Gemm g{XB, (const bf16_t*)(WD(l) + WD_WXQ), T, D, D, D, D, 0}; const EpiScale e{Q, SSA(3 * l + 1), D, 0.0625f}; GEMM(EpiScale, g, e); }
        PH_END;
        if (PH_ON) { PH_PTRS
            LAS float* sm = (LAS float*)lds + (tid >> 8) * 528;
            for (int base = vcu * 2; base < T * XH; base += G * 2) d_xattn(base + (tid >> 8), tid & 255, sm, Q, KVB + (size_t)l * NB * NMEM * 2 * D);
        }
        PH_END;
        if (PH_ON) { PH_PTRS const pg8::Gemm g{Q, (const bf16_t*)(WD(l) + WD_WXO), T, D, D, D, D, 0}; const EpiResid e{XB, SSA(3 * l + 2)}; GEMM(EpiResid, g, e); }
        PH_END;
        if (PH_ON) { PH_PTRS
            for (int t = vcu * 8 + wave; t < T; t += G * 8)
                d_route((size_t)t, lane, XB, SSA(3 * l + 2), in.norm_ffn_g + (size_t)l * D, in.w_gr + (size_t)l * D * NG, in.b_gr + (size_t)l * NG, in.w_er + (size_t)l * D * NE, in.b_er + (size_t)l * NE, SELE, SELW);
        }
        PH_END;
        if (PH_ON) { PH_PTRS
            const size_t eoff = (size_t)l * NE * D * EF;
            LAS float* sm = (LAS float*)lds + (tid >> 8) * 1296;
            for (int base = vcu * 2; base < T; base += G * 2)
                d_moe((size_t)(base + (tid >> 8)), tid & 255, sm, XB, SSA(3 * l + 2), in.norm_ffn_g + (size_t)l * D, in.w_eg + eoff, in.w_eu + eoff, in.w_ed + eoff, SELE, SELW, SSA(3 * l + 3));
        }
        PH_END;
    }
    if (PH_ON) { PH_PTRS for (int t = vcu * 2 + (tid >> 8); t < T; t += G * 2) d_final((size_t)t, tid & 255, XB, SSA(6), in.final_g, (float*)dout); }
    PH_END;
#undef PH_ON
#undef PH_PTRS
#undef PH_END
#undef GEMM
#undef SS
#undef XB
#undef AQ
#undef AK
#undef AV
#undef BQ
#undef BK
#undef BV
#undef BRS
#undef GA
#undef GB
#undef MG
#undef Q
#undef MEMN
#undef KVB
#undef LOGA
#undef OAB
#undef RAW
#undef TMP
#undef SELE
#undef SELW
#undef WD
#undef SSA
#undef MK_EP
}

extern "C" void kernel_launch(void* const* d_in, const int* in_sizes, int n_in, void* d_out, int out_size, void* d_ws, size_t ws_size, hipStream_t stream) {
    static int grid = 0;
    if (grid == 0) {
        int dev = 0, cus = 0;
        if (hipGetDevice(&dev) != hipSuccess || hipDeviceGetAttribute(&cus, hipDeviceAttributeMultiprocessorCount, dev) != hipSuccess || cus <= 0) cus = 256;
        grid = cus;
        if (hipFuncSetAttribute((const void*)mk_fwd, hipFuncAttributeMaxDynamicSharedMemorySize, LDS_BYTES) != hipSuccess) fprintf(stderr, "kernel_launch: hipFuncSetAttribute failed\n");
        int per_cu = 0;
        if (hipOccupancyMaxActiveBlocksPerMultiprocessor(&per_cu, (const void*)mk_fwd, 512, LDS_BYTES) != hipSuccess || per_cu < 1) fprintf(stderr, "kernel_launch: occupancy query says %d blocks per CU\n", per_cu);
        (void)hipGetLastError();
        if (ws_size < WS_END || n_in != 24) fprintf(stderr, "kernel_launch: unexpected ws_size %zu / n_in %d\n", ws_size, n_in);
    }
    MKArgs a{};
    { const float** p = (const float**)&a.in; for (int i = 0; i < 24; ++i) p[i] = (const float*)d_in[i]; }
    a.ws = (unsigned char*)d_ws; a.dout = (unsigned char*)d_out;
    (void)hipMemsetAsync((unsigned char*)d_ws + WS_CTL, 0, CTL_ZERO_BYTES, stream);
#if MK_LAUNCHES == 1
    a.ph_lo = 0; a.ph_hi = N_PHASES;
    hipLaunchKernelGGL(mk_fwd, dim3(grid), dim3(512), LDS_BYTES, stream, a);
#else
    for (int p = 0; p < N_PHASES; ++p) { a.ph_lo = p; a.ph_hi = p + 1; hipLaunchKernelGGL(mk_fwd, dim3(grid), dim3(512), LDS_BYTES, stream, a); }
#endif
}
```

```cpp
#include <hip/hip_runtime.h>
#include <cstdint>
#include <cstdio>
#include <cmath>

namespace cfg {
constexpr int D = 1024, NB = 2, L = 8192, T = NB * L, DEPTH = 2;
constexpr int CH = 64, NMEM = 256, NCH = L / CH;
constexpr int AH = 8, AW = 512, ALC = 8, ABAND = 576, AMAXREL = 256, RELW = 2 * AMAXREL + 1;
constexpr int BH = 4, BKW = 256, BVW = 512, BR = 16;
constexpr int INW = 5136;
constexpr int XH = 4, XD = 256;
constexpr int NG = 4, EPG = 8, NE = NG * EPG, EF = 256;
constexpr float EPS = 1e-6f;
constexpr int NPROJ = 5376;
constexpr int NPROJ_A = 9 * 256, NPROJ_V = 4 * 256, NPROJ_B = 8 * 256;

constexpr size_t MiB = 1u << 20;
constexpr size_t WS_CTL = 0, CTL_BYTES = 2 * MiB;
constexpr size_t WS_WDENSE = 2 * MiB, WDENSE_STRIDE = 23 * MiB;
constexpr size_t WD_WIN = 0, WD_WB = 11 * MiB, WD_WMO = 13 * MiB, WD_WXQ = 15 * MiB, WD_WXKV = 17 * MiB, WD_WXO = 21 * MiB;
constexpr size_t WS_WEXP = 48 * MiB, WEXP_STRIDE = 48 * MiB;
constexpr size_t WS_XB = 144 * MiB;
constexpr size_t WS_XN = 176 * MiB;
constexpr size_t WS_MIX = 208 * MiB;
constexpr size_t WS_AQ = WS_MIX, WS_AK = WS_MIX + 16 * MiB, WS_AVT = WS_MIX + 32 * MiB, WS_BVT = WS_MIX + 48 * MiB, WS_BQ = WS_MIX + 64 * MiB, WS_BK = WS_MIX + 72 * MiB,
                 WS_BRS = WS_MIX + 80 * MiB, WS_LOGA = WS_MIX + 96 * MiB;
constexpr size_t WS_SB = WS_AQ;
constexpr size_t WS_GA = WS_MIX + 16 * MiB, WS_TMP = WS_MIX + 48 * MiB, WS_MG = WS_MIX + 80 * MiB;
constexpr size_t WS_Q = WS_MIX;
constexpr size_t WS_XG = WS_MIX, WS_HID = WS_MIX + 80 * MiB;
constexpr size_t WS_MEMN = 320 * MiB, WS_KVB = 321 * MiB;
constexpr size_t WS_SEL = 325 * MiB;
constexpr size_t WS_SSP = 326 * MiB;
constexpr size_t WS_DEC = 333 * MiB + 512 * 1024;
constexpr size_t WS_WR = 333 * MiB;
constexpr size_t WS_END = 334 * MiB;
constexpr size_t DO_OAB = 0, DO_ST = 32 * MiB, DO_GB = 32 * MiB;
}
using namespace cfg;

#define LAS __attribute__((address_space(3)))
typedef unsigned short bf16_t;
typedef float f32x4 __attribute__((ext_vector_type(4)));
typedef unsigned u32x4 __attribute__((ext_vector_type(4)));
typedef unsigned u32x2 __attribute__((ext_vector_type(2)));

__device__ __forceinline__ float bf2f(unsigned short b) { return __uint_as_float((unsigned)b << 16); }
__device__ __forceinline__ float bflo(unsigned w) { return __uint_as_float(w << 16); }
__device__ __forceinline__ float bfhi(unsigned w) { return __uint_as_float(w & 0xffff0000u); }
__device__ __forceinline__ unsigned pkbf(float lo, float hi) { unsigned r; asm volatile("v_cvt_pk_bf16_f32 %0, %1, %2" : "=v"(r) : "v"(lo), "v"(hi)); return r; }
__device__ __forceinline__ unsigned short f2bf(float f) { return (unsigned short)(pkbf(f, 0.f) & 0xffffu); }
__device__ __forceinline__ float fsigmoid(float x) { return __builtin_amdgcn_rcpf(1.0f + __expf(-x)); }
__device__ __forceinline__ float fsilu(float x) { return x * fsigmoid(x); }
__device__ __forceinline__ float flogsigmoid(float x) { return fminf(x, 0.f) - __logf(1.0f + __expf(-fabsf(x))); }
template <int MASK> __device__ __forceinline__ float swz_xor(float v) { return __int_as_float(__builtin_amdgcn_ds_swizzle(__float_as_int(v), (MASK << 10) | 0x1f)); }
__device__ __forceinline__ float add_xor32(float v) { const auto r = __builtin_amdgcn_permlane32_swap(__float_as_uint(v), __float_as_uint(v), false, false); return __uint_as_float(r[0]) + __uint_as_float(r[1]); }
__device__ __forceinline__ float max_xor32(float v) { const auto r = __builtin_amdgcn_permlane32_swap(__float_as_uint(v), __float_as_uint(v), false, false); return fmaxf(__uint_as_float(r[0]), __uint_as_float(r[1])); }
__device__ __forceinline__ float add_xor16(float v) { return v + swz_xor<16>(v); }
__device__ __forceinline__ float wave_sum(float v) { v += swz_xor<1>(v); v += swz_xor<2>(v); v += swz_xor<4>(v); v += swz_xor<8>(v); v += swz_xor<16>(v); return add_xor32(v); }
__device__ __forceinline__ float wave_max(float v) { v = fmaxf(v, swz_xor<1>(v)); v = fmaxf(v, swz_xor<2>(v)); v = fmaxf(v, swz_xor<4>(v)); v = fmaxf(v, swz_xor<8>(v)); v = fmaxf(v, swz_xor<16>(v)); return max_xor32(v); }
__device__ __forceinline__ int shfl_idx(int v, int src_lane) { return __builtin_amdgcn_ds_bpermute(src_lane << 2, v); }
__device__ __forceinline__ unsigned char* opaque_ptr(unsigned char* p) { asm volatile("" : "+s"(p)); return p; }
__device__ __forceinline__ int lane_now() { unsigned z; asm volatile("v_mov_b32 %0, 0" : "=v"(z)); return (int)__builtin_amdgcn_mbcnt_hi(~0u, __builtin_amdgcn_mbcnt_lo(~0u, z)); }
__device__ __forceinline__ int opaque_int(int v) { asm volatile("" : "+s"(v)); return v; }
__device__ __forceinline__ int tid_of(int wv) { return (wv << 6) | lane_now(); }
namespace pg8 {
#define PG8_LAS __attribute__((address_space(3)))
typedef unsigned short bf16_t;
typedef short bf16x8 __attribute__((ext_vector_type(8)));
typedef float f32x4 __attribute__((ext_vector_type(4)));
typedef unsigned u32x4 __attribute__((ext_vector_type(4)));
constexpr int BM = 256, BK = 64, HALF = 128, HTB = HALF * BK * 2  , STAGE_BYTES = 8 * HTB, NXCD = 8, WGM = 8;

__host__ __device__ __forceinline__ int lds_byte(int r, int c) { const int st = (r >> 4) * 2 + (c >> 5), rr = r & 15, cc = c & 31, ob = rr * 64 + cc * 2; return st * 1024 + (ob ^ (((ob >> 9) & 1) << 5)); }
__host__ __device__ __forceinline__ void stage_rc(int b, int& R, int& C) { const int st = b / 1024, sb = b % 1024, swz = sb ^ (((sb >> 9) & 1) << 5); R = (st >> 1) * 16 + swz / 64; C = (st & 1) * 32 + (swz % 64) / 2; }
__host__ __device__ __forceinline__ int perm32(int rho) { const int n = rho >> 4, i = rho & 15; return 8 * (i >> 2) + 4 * n + (i & 3); }

struct Unit { int pm, pn; };
struct Gemm { const bf16_t* A; const bf16_t* Bt; int M, N, K, lda, ldb, pad; };

struct StaticOrder {
    int nM, nN, nwg, G, c;
    __host__ __device__ __forceinline__ void init(int M, int N, int G_, int c_) { nM = M / BM; nN = N / BM; nwg = nM * nN; G = G_; c = c_; }
    __host__ __device__ __forceinline__ bool next(int i, Unit& u) const {
        const long L = (long)i * G + c; if (L >= nwg) return false;
        int wgid = (int)L; { const int q = nwg / NXCD, r = nwg % NXCD, xcd = wgid % NXCD, off = wgid / NXCD; wgid = (xcd < r ? xcd * (q + 1) : r * (q + 1) + (xcd - r) * q) + off; }
        const int nig = WGM * nN, gid = wgid / nig, fm = gid * WGM, gsz = (nM - fm) < WGM ? (nM - fm) : WGM;
        u.pm = fm + ((wgid % nig) % gsz); u.pn = (wgid % nig) / gsz; return true;
    }
    __device__ __forceinline__ void a_ready(const Unit&) const {}
    __device__ __forceinline__ void done(const Unit&) const {}
};


template <class Epi, class Sched, bool ALIGN_EPI = false, bool SP2 = false>
__device__ __forceinline__ void gemm_phase(PG8_LAS unsigned char* lds, const Gemm g, const Sched& S, const Epi& E, const int wv  ) {
    const int tid = tid_of(wv), wid = wv, lane = tid & 63, wr = wid >> 2, wc = wid & 3, fr = lane & 15, fq = lane >> 4;
    const int K = g.K, nt = K / BK;
    unsigned voffA[2], voffB[2];
#pragma unroll
    for (int i = 0; i < 2; ++i) { int R, C; stage_rc(tid * 16 + i * 8192, R, C); const int Rb = Epi::PERM ? ((R & ~31) + perm32(R & 31)) : R;
        voffA[i] = (unsigned)(R * g.lda + C) * 2u; voffB[i] = (unsigned)(Rb * g.ldb + C) * 2u; }
    const size_t kstep = (size_t)(BK * 2);
    const size_t hstepA = (size_t)HALF * g.lda * 2, hstepB = (size_t)HALF * g.ldb * 2;
    const size_t tstepA = 2 * hstepA, tstepB = 2 * hstepB;
    const unsigned ldsw = (unsigned)wid * 1024u;
    const int aoff = lds_byte(wr * 64 + fr, fq * 8), boff = lds_byte(wc * 32 + fr, fq * 8);
#define PG8_SA(b, h) (((b) * 2 + (h)) * HTB)
#define PG8_SB(b, h) ((4 + (b) * 2 + (h)) * HTB)
#define PG8_STAGE(bufoff, gbase, voff) do { _Pragma("unroll") for (int _i = 0; _i < 2; ++_i) \
        __builtin_amdgcn_global_load_lds((const unsigned*)((const char*)(gbase) + (voff)[_i]), (PG8_LAS unsigned*)(lds + (bufoff) + ldsw + _i * 8192), 16, 0, 0); } while (0)
#define PG8_LDA(dst, b, h) do { _Pragma("unroll") for (int m = 0; m < 4; ++m) _Pragma("unroll") for (int k = 0; k < 2; ++k) dst[m][k] = *(const PG8_LAS bf16x8*)(lds + PG8_SA(b, h) + aoff + m * 2048 + k * 1024); } while (0)
#define PG8_LDB(dst, b, h) do { _Pragma("unroll") for (int n = 0; n < 2; ++n) _Pragma("unroll") for (int k = 0; k < 2; ++k) dst[n][k] = *(const PG8_LAS bf16x8*)(lds + PG8_SB(b, h) + boff + n * 2048 + k * 1024); } while (0)
#define PG8_MMA(ai, bj, At, Bt) do { __builtin_amdgcn_s_setprio(1); _Pragma("unroll") for (int m = 0; m < 4; ++m) _Pragma("unroll") for (int n = 0; n < 2; ++n) _Pragma("unroll") for (int k = 0; k < 2; ++k) \
        acc[ai][bj][m][n] = __builtin_amdgcn_mfma_f32_16x16x32_bf16(Bt[n][k], At[m][k], acc[ai][bj][m][n], 0, 0, 0); __builtin_amdgcn_s_setprio(0); } while (0)
#define PG8_WAIT_V(n) asm volatile("s_waitcnt vmcnt(" #n ")" ::: "memory")
#define PG8_WAIT_L(n) asm volatile("s_waitcnt lgkmcnt(" #n ")" ::: "memory")
#define PG8_BAR __builtin_amdgcn_s_barrier()
#define PG8_SCHED __builtin_amdgcn_sched_barrier(0)
    Unit cur, nxt; int ui = 0;
    if (!S.next(0, cur)) return;
    f32x4 acc[2][2][4][2];
#pragma unroll
    for (int a = 0; a < 2; ++a)
#pragma unroll
        for (int b = 0; b < 2; ++b)
#pragma unroll
            for (int m = 0; m < 4; ++m)
#pragma unroll
                for (int n = 0; n < 2; ++n) acc[a][b][m][n] = (f32x4){0.f, 0.f, 0.f, 0.f};
    bf16x8 At[4][2], B0[2][2], B1[2][2];
    const char* cA = (const char*)g.A + (size_t)cur.pm * tstepA; const char* cB = (const char*)g.Bt + (size_t)cur.pn * tstepB;
    S.a_ready(cur);
    if constexpr (SP2) {
        PG8_STAGE(PG8_SB(0, 0), cB, voffB); PG8_STAGE(PG8_SB(0, 1), cB + hstepB, voffB); PG8_STAGE(PG8_SA(0, 0), cA, voffA); PG8_STAGE(PG8_SA(0, 1), cA + hstepA, voffA);
        if (wr == 1) PG8_BAR;
        PG8_WAIT_V(2); PG8_BAR;
        PG8_STAGE(PG8_SB(1, 0), cB + kstep, voffB); PG8_STAGE(PG8_SA(1, 0), cA + kstep, voffA); PG8_STAGE(PG8_SB(1, 1), cB + hstepB + kstep, voffB);
        PG8_WAIT_V(6); PG8_BAR;
    } else {
        PG8_STAGE(PG8_SB(0, 0), cB, voffB); PG8_STAGE(PG8_SA(0, 0), cA, voffA); PG8_STAGE(PG8_SB(0, 1), cB + hstepB, voffB); PG8_STAGE(PG8_SA(0, 1), cA + hstepA, voffA);
        if (wr == 1) PG8_BAR;
        PG8_WAIT_V(4); PG8_BAR;
        PG8_STAGE(PG8_SB(1, 0), cB + kstep, voffB); PG8_STAGE(PG8_SA(1, 0), cA + kstep, voffA); PG8_STAGE(PG8_SB(1, 1), cB + hstepB + kstep, voffB);
        PG8_WAIT_V(6); PG8_BAR;
    }
    for (;;) {
        const bool has_next = S.next(ui + 1, nxt);
        const char* nA = has_next ? (const char*)g.A + (size_t)nxt.pm * tstepA : cA; const char* nB = has_next ? (const char*)g.Bt + (size_t)nxt.pn * tstepB : cB;
        for (int t = 0; t < nt; t += 2) {
            const bool last = (t == nt - 2);
            const char* a1 = cA + (size_t)(t + 1) * kstep;
            const char* a2 = last ? nA : cA + (size_t)(t + 2) * kstep; const char* b2 = last ? nB : cB + (size_t)(t + 2) * kstep;
            const char* a3 = a2 + kstep; const char* b3 = b2 + kstep;
            if (last && has_next) S.a_ready(nxt);
            if constexpr (SP2) {
            PG8_LDB(B0, 0, 0); PG8_LDB(B1, 0, 1); PG8_SCHED; PG8_LDA(At, 0, 0); PG8_STAGE(PG8_SA(1, 1), a1 + hstepA, voffA);
            PG8_WAIT_V(8); PG8_WAIT_L(0); PG8_BAR; PG8_MMA(0, 0, At, B0); PG8_MMA(0, 1, At, B1); PG8_BAR; PG8_SCHED;
            PG8_LDA(At, 0, 1); PG8_STAGE(PG8_SB(0, 0), b2, voffB); PG8_STAGE(PG8_SB(0, 1), b2 + hstepB, voffB); PG8_STAGE(PG8_SA(0, 0), a2, voffA);
            PG8_WAIT_V(8); PG8_WAIT_L(0); PG8_BAR; PG8_MMA(1, 0, At, B0); PG8_MMA(1, 1, At, B1); PG8_BAR; PG8_SCHED;
            PG8_LDB(B0, 1, 0); PG8_LDB(B1, 1, 1); PG8_SCHED; PG8_LDA(At, 1, 0); PG8_STAGE(PG8_SA(0, 1), a2 + hstepA, voffA);
            PG8_WAIT_V(8); PG8_WAIT_L(0); PG8_BAR; PG8_MMA(0, 0, At, B0); PG8_MMA(0, 1, At, B1); PG8_BAR; PG8_SCHED;
            PG8_LDA(At, 1, 1); PG8_STAGE(PG8_SB(1, 0), b3, voffB); PG8_STAGE(PG8_SB(1, 1), b3 + hstepB, voffB); PG8_STAGE(PG8_SA(1, 0), a3, voffA);
            PG8_WAIT_V(8); PG8_WAIT_L(0); PG8_BAR; PG8_MMA(1, 0, At, B0); PG8_MMA(1, 1, At, B1); PG8_BAR; PG8_SCHED;
            } else {
            PG8_LDB(B0, 0, 0); PG8_SCHED; PG8_LDA(At, 0, 0); PG8_STAGE(PG8_SA(1, 1), a1 + hstepA, voffA);
            PG8_WAIT_L(8); PG8_BAR; PG8_WAIT_L(0); PG8_MMA(0, 0, At, B0); PG8_BAR; PG8_SCHED;
            PG8_LDB(B1, 0, 1); PG8_STAGE(PG8_SB(0, 0), b2, voffB);
            PG8_BAR; PG8_WAIT_L(0); PG8_MMA(0, 1, At, B1); PG8_BAR;
            PG8_LDA(At, 0, 1); PG8_STAGE(PG8_SA(0, 0), a2, voffA);
            PG8_BAR; PG8_WAIT_L(0); PG8_MMA(1, 0, At, B0); PG8_BAR; PG8_SCHED;
            PG8_STAGE(PG8_SB(0, 1), b2 + hstepB, voffB);
            PG8_WAIT_V(6); PG8_BAR; PG8_MMA(1, 1, At, B1); PG8_BAR;
            PG8_LDB(B0, 1, 0); PG8_SCHED; PG8_LDA(At, 1, 0); PG8_STAGE(PG8_SA(0, 1), a2 + hstepA, voffA);
            PG8_WAIT_L(8); PG8_BAR; PG8_WAIT_L(0); PG8_MMA(0, 0, At, B0); PG8_BAR; PG8_SCHED;
            PG8_LDB(B1, 1, 1); PG8_STAGE(PG8_SB(1, 0), b3, voffB);
            PG8_BAR; PG8_WAIT_L(0); PG8_MMA(0, 1, At, B1); PG8_BAR;
            PG8_LDA(At, 1, 1); PG8_STAGE(PG8_SA(1, 0), a3, voffA);
            PG8_BAR; PG8_WAIT_L(0); PG8_MMA(1, 0, At, B0); PG8_BAR; PG8_SCHED;
            PG8_STAGE(PG8_SB(1, 1), b3 + hstepB, voffB);
            PG8_WAIT_V(6); PG8_BAR; PG8_MMA(1, 1, At, B1); PG8_BAR;
            }
        }
        if constexpr (ALIGN_EPI) { if (wr == 0) PG8_BAR; }
        if constexpr (!Epi::AFTER_DRAIN) { const int le_ = lane_now(); E(acc, cur, wr, wc, le_ & 15, le_ >> 4); S.done(cur); }
        if (!has_next) break;
#pragma unroll
        for (int a = 0; a < 2; ++a)
#pragma unroll
            for (int b = 0; b < 2; ++b)
#pragma unroll
                for (int m = 0; m < 4; ++m)
#pragma unroll
                    for (int n = 0; n < 2; ++n) acc[a][b][m][n] = (f32x4){0.f, 0.f, 0.f, 0.f};
        cur = nxt; cA = nA; cB = nB; ++ui;
        if constexpr (ALIGN_EPI) { if (wr == 1) PG8_BAR; }
    }
    PG8_WAIT_V(0);
    if constexpr (!ALIGN_EPI) { if (wr == 0) PG8_BAR; }
    PG8_BAR;
    if constexpr (Epi::AFTER_DRAIN) { const int le_ = lane_now(); E.fused(acc, cur, wr, wc, le_ & 15, le_ >> 4, lds, wid, le_); S.done(cur); }
#undef PG8_SA
#undef PG8_SB
#undef PG8_STAGE
#undef PG8_LDA
#undef PG8_LDB
#undef PG8_MMA
#undef PG8_WAIT_V
#undef PG8_WAIT_L
#undef PG8_BAR
#undef PG8_SCHED
}
}
#define XB_TMO      128
#define XB_XCNT(j)  (256  + 64 * (j))
#define XB_XSUB(j)  (1280 + 64 * (j))
#define XB_XGEN(j)  (2304 + 64 * (j))
#define XB_TOP      3328
#define XB_TOPGEN   3392
#define XCD_BAR_WORDS 3456
#define XB_SPIN_CAP (1u << 18)

__device__ __forceinline__ unsigned xb_ld(unsigned* p)              { return __hip_atomic_load(p, __ATOMIC_RELAXED, __HIP_MEMORY_SCOPE_AGENT); }
__device__ __forceinline__ unsigned xb_add(unsigned* p, unsigned v) { return __hip_atomic_fetch_add(p, v, __ATOMIC_RELAXED, __HIP_MEMORY_SCOPE_AGENT); }
__device__ __forceinline__ unsigned xb_xcc_id() { return (unsigned)__builtin_amdgcn_s_getreg((3 << 11) | 20) & 0xFu; }
#define XB_SPIN(cond, bar) do { unsigned _sp = 0; while (cond) { __builtin_amdgcn_s_sleep(1); \
    if ((++_sp & 255u) == 0u) { if (xb_ld(&(bar)[XB_TMO])) break; if (_sp > XB_SPIN_CAP) { atomicAdd(&(bar)[XB_TMO], 1u); break; } } } } while (0)

struct XcdBarrier {
    unsigned* bar; unsigned x;
    volatile LAS unsigned* st;
};

__device__ __forceinline__ XcdBarrier xcd_barrier_post(unsigned* bar, volatile LAS unsigned* st) {
    XcdBarrier b; b.bar = bar; b.x = xb_xcc_id(); b.st = st;
    if (threadIdx.x == 0) (void)xb_add(&bar[XB_XCNT(b.x)], 1u);
    return b;
}
__device__ __forceinline__ void xcd_barrier_complete(unsigned* bar, unsigned x, unsigned& nloc, unsigned& nx) {
    const unsigned G = gridDim.x * gridDim.y * gridDim.z;
    unsigned sum, cnt, mine, sp = 0u;
    for (;;) {
        sum = 0u; cnt = 0u; mine = 0u;
#pragma unroll
        for (unsigned j = 0; j < 16; ++j) { const unsigned c = xb_ld(&bar[XB_XCNT(j)]); sum += c; cnt += (c > 0u) ? 1u : 0u; }
        if (sum == G) { mine = xb_ld(&bar[XB_XCNT(x)]); break; }
        __builtin_amdgcn_s_sleep(1);
        if ((++sp & 255u) == 0u) { if (xb_ld(&bar[XB_TMO])) break; if (sp > XB_SPIN_CAP) { atomicAdd(&bar[XB_TMO], 1u); break; } }
    }
    nloc = mine > 0u ? mine : 1u; nx = cnt > 0u ? cnt : 1u;
}

__device__ __forceinline__ void xcd_barrier(const XcdBarrier& b, const bool t0  ) {
    asm volatile("s_waitcnt vmcnt(0)" ::: "memory");
    __syncthreads();
    if (t0) {
        unsigned* bar = (unsigned*)opaque_ptr((unsigned char*)b.bar);
        __builtin_amdgcn_s_waitcnt(0);
        unsigned nloc = b.st[0], nx = b.st[1];
        if (nloc == 0u) { xcd_barrier_complete(bar, b.x, nloc, nx); b.st[0] = nloc; b.st[1] = nx; }
        const unsigned old = xb_add(&bar[XB_XSUB(b.x)], 1u);
        const unsigned gen = old / nloc;
        if (old + 1u == (gen + 1u) * nloc) {
            __builtin_amdgcn_fence(__ATOMIC_RELEASE, "agent");
            asm volatile("s_waitcnt vmcnt(0)" ::: "memory");
            const unsigned og = xb_add(&bar[XB_TOP], 1u);
            const unsigned tg = og / nx;
            if (og + 1u == (tg + 1u) * nx) xb_add(&bar[XB_TOPGEN], 1u);
            else XB_SPIN(xb_ld(&bar[XB_TOPGEN]) == tg, bar);
            __builtin_amdgcn_fence(__ATOMIC_ACQUIRE, "agent");
            xb_add(&bar[XB_XGEN(b.x)], 1u);
            asm volatile("s_waitcnt vmcnt(0)" ::: "memory");
        } else {
            XB_SPIN(xb_ld(&bar[XB_XGEN(b.x)]) == gen, bar);
            __builtin_amdgcn_fence(__ATOMIC_ACQUIRE, "agent");
            asm volatile("s_waitcnt vmcnt(0)" ::: "memory");
        }
    }
    __syncthreads();
}
typedef pg8::f32x4 A4;
#define EPI_ROWS_BEGIN _Pragma("unroll") for (int ai = 0; ai < 2; ++ai) _Pragma("unroll") for (int m = 0; m < 4; ++m) { const int row = u.pm * 256 + ai * 128 + wr * 64 + m * 16 + fr;
#define EPI_ROWS_END }
__device__ __forceinline__ float rstd_of(const float* ss, int row, int fq) {
    if (!ss) return 1.0f;
    const f32x4 p = *(const f32x4*)(ss + (size_t)row * 16 + fq * 4);
    float s = (p[0] + p[1]) + (p[2] + p[3]);
    s = add_xor32(add_xor16(s));
    return rsqrtf(s * (1.0f / D) + EPS);
}
__device__ __forceinline__ float rstd_row(const float* ss, size_t row) {
    const f32x4* p = (const f32x4*)(ss + row * 16); float s = 0.f;
#pragma unroll
    for (int i = 0; i < 4; ++i) { const f32x4 v = p[i]; s += (v[0] + v[1]) + (v[2] + v[3]); }
    return rsqrtf(s * (1.0f / D) + EPS);
}
__device__ __forceinline__ u32x4 pack8(const A4& a, const A4& b) { u32x4 w; w.x = pkbf(a[0], a[1]); w.y = pkbf(a[2], a[3]); w.z = pkbf(b[0], b[1]); w.w = pkbf(b[2], b[3]); return w; }
__device__ __forceinline__ void unpack8(const u32x4& w, A4& a, A4& b) { a[0] = bflo(w.x); a[1] = bfhi(w.x); a[2] = bflo(w.y); a[3] = bfhi(w.y); b[0] = bflo(w.z); b[1] = bfhi(w.z); b[2] = bflo(w.w); b[3] = bfhi(w.w); }

struct EpiScale {
    static constexpr bool PERM = true, AFTER_DRAIN = false;
    bf16_t* O; const float* ss; int ld; float scale;
    __device__ __forceinline__ void operator()(const A4 (&acc)[2][2][4][2], const pg8::Unit& u, int wr, int wc, int fr, int fq) const {
        const int col0 = u.pn * 256 + wc * 32 + 8 * fq;
        EPI_ROWS_BEGIN
            const float s = rstd_of(ss, row, fq) * scale;
#pragma unroll
            for (int bj = 0; bj < 2; ++bj) *(u32x4*)(O + (size_t)row * ld + col0 + bj * 128) = pack8(acc[ai][bj][m][0] * s, acc[ai][bj][m][1] * s);
        EPI_ROWS_END
    }
};

struct EpiProj {
    static constexpr bool PERM = true, AFTER_DRAIN = false;
    bf16_t *AQ, *AK, *BQ, *BK, *BRS, *GA, *GB; float* LOGA; const float* balpha; int tile0, pad;
    __device__ __forceinline__ void operator()(const A4 (&acc)[2][2][4][2], const pg8::Unit& u, int wr, int wc, int fr, int fq) const {
        const int tile = u.pn + tile0;
        bf16_t* dst; int ld, c0, mode = 0; float sc = 1.f;
        if (tile < 2) { dst = AQ; ld = 512; c0 = tile * 256; sc = 0.125f; }
        else if (tile < 4) { dst = AK; ld = 512; c0 = (tile - 2) * 256; }
        else if (tile == 4) { dst = BQ; ld = 256; c0 = 0; sc = 0.125f; }
        else if (tile == 5) { dst = BK; ld = 256; c0 = 0; }
        else if (tile < 8) { dst = BRS; ld = 512; c0 = (tile - 6) * 256; mode = 1; }
        else if (tile == 8) { dst = nullptr; ld = 256; c0 = 0; mode = 3; }
        else if (tile < 13) { dst = GA; ld = 1024; c0 = (tile - 9) * 256; mode = 2; }
        else { dst = GB; ld = 1024; c0 = (tile - 13) * 256; mode = 2; }
        const int cl = wc * 32 + 8 * fq;
        EPI_ROWS_BEGIN
#pragma unroll
            for (int bj = 0; bj < 2; ++bj) {
                A4 v0 = acc[ai][bj][m][0] * sc, v1 = acc[ai][bj][m][1] * sc;
                const int c = cl + bj * 128;
                if (mode == 3) {
                    const A4 b0 = *(const A4*)(balpha + c), b1 = *(const A4*)(balpha + c + 4);
#pragma unroll
                    for (int i = 0; i < 4; ++i) { v0[i] = flogsigmoid(v0[i] + b0[i]) * 0.0625f; v1[i] = flogsigmoid(v1[i] + b1[i]) * 0.0625f; }
                    float* o = LOGA + (size_t)row * 256 + c; *(A4*)o = v0; *(A4*)(o + 4) = v1;
                } else {
                    if (mode == 1) {
#pragma unroll
                        for (int i = 0; i < 4; ++i) { v0[i] = fsilu(v0[i]); v1[i] = fsilu(v1[i]); }
                    } else if (mode == 2) {
#pragma unroll
                        for (int i = 0; i < 4; ++i) { v0[i] = fsigmoid(v0[i]); v1[i] = fsigmoid(v1[i]); }
                    }
                    *(u32x4*)(dst + (size_t)row * ld + c0 + c) = pack8(v0, v1);
                }
            }
        EPI_ROWS_END
    }
};

struct EpiGate {
    static constexpr bool PERM = true, AFTER_DRAIN = false;
    const bf16_t* G; const bf16_t* ADD; bf16_t* O;
    __device__ __forceinline__ void operator()(const A4 (&acc)[2][2][4][2], const pg8::Unit& u, int wr, int wc, int fr, int fq) const {
        const int col0 = u.pn * 256 + wc * 32 + 8 * fq;
        EPI_ROWS_BEGIN
#pragma unroll
            for (int bj = 0; bj < 2; ++bj) {
                const size_t off = (size_t)row * D + col0 + bj * 128;
                A4 g0, g1; unpack8(*(const u32x4*)(G + off), g0, g1);
                A4 v0 = acc[ai][bj][m][0] * g0, v1 = acc[ai][bj][m][1] * g1;
                if (ADD) { A4 a0, a1; unpack8(*(const u32x4*)(ADD + off), a0, a1); v0 += a0; v1 += a1; }
                *(u32x4*)(O + off) = pack8(v0, v1);
            }
        EPI_ROWS_END
    }
};

struct EpiResid {
    static constexpr bool PERM = true, AFTER_DRAIN = false;
    bf16_t* X; float* ss_out;
    __device__ __forceinline__ void operator()(const A4 (&acc)[2][2][4][2], const pg8::Unit& u, int wr, int wc, int fr, int fq) const {
        const int col0 = u.pn * 256 + wc * 32 + 8 * fq;
        EPI_ROWS_BEGIN
            float q = 0.f;
#pragma unroll
            for (int bj = 0; bj < 2; ++bj) {
                const size_t off = (size_t)row * D + col0 + bj * 128;
                A4 x0, x1; unpack8(*(const u32x4*)(X + off), x0, x1);
                x0 += acc[ai][bj][m][0]; x1 += acc[ai][bj][m][1];
                q += (x0[0] * x0[0] + x0[1] * x0[1]) + (x0[2] * x0[2] + x0[3] * x0[3]) + (x1[0] * x1[0] + x1[1] * x1[1]) + (x1[2] * x1[2] + x1[3] * x1[3]);
                *(u32x4*)(X + off) = pack8(x0, x1);
            }
            q = add_xor32(add_xor16(q));
            if (fq == 0) ss_out[(size_t)row * 16 + u.pn * 4 + wc] = q;
        EPI_ROWS_END
    }
};

__device__ __forceinline__ void conv_item(const float* __restrict__ W, int ldw, const float* __restrict__ gk, bf16_t* __restrict__ WT, int ldt, int k0, int n0, LAS float* scr, int lane) {
    float4 v[8];
#pragma unroll
    for (int i = 0; i < 8; ++i) { const int kk = (lane >> 3) + 8 * i; v[i] = *(const float4*)(W + (size_t)(k0 + kk) * ldw + n0 + (lane & 7) * 4); }
#pragma unroll
    for (int i = 0; i < 8; ++i) { const int kk = (lane >> 3) + 8 * i; const float s = gk ? gk[k0 + kk] : 1.0f; LAS float* p = scr + kk * 33 + (lane & 7) * 4;
        p[0] = v[i].x * s; p[1] = v[i].y * s; p[2] = v[i].z * s; p[3] = v[i].w * s; }
    asm volatile("s_waitcnt lgkmcnt(0)" ::: "memory");
    const int c = lane & 7;
#pragma unroll
    for (int j = 0; j < 4; ++j) { const int n = (lane >> 3) + 8 * j; const LAS float* s = scr + (8 * c) * 33 + n;
        u32x4 o; o.x = pkbf(s[0 * 33], s[1 * 33]); o.y = pkbf(s[2 * 33], s[3 * 33]); o.z = pkbf(s[4 * 33], s[5 * 33]); o.w = pkbf(s[6 * 33], s[7 * 33]);
        *(u32x4*)(WT + (size_t)(n0 + n) * ldt + k0 + 8 * c) = o; }
    asm volatile("s_waitcnt lgkmcnt(0)" ::: "memory");
}

struct InPtrs {
    const float *x, *mem, *norm_mix_g, *w_in, *rel_bias, *gla_w_alpha, *gla_b_alpha, *gla_norm_g, *w_branch, *w_mix_out, *norm_x_g, *mem_norm_g, *w_xq, *w_xkv, *w_xo,
                *norm_ffn_g, *w_gr, *b_gr, *w_er, *b_er, *w_eg, *w_eu, *w_ed, *final_g;
};

struct ConvJob { const float* W; const float* gk; bf16_t* WT; int ldw, ldt, K, N; };
__device__ __forceinline__ ConvJob dense_job(const InPtrs& in, unsigned char* ws, int l, int j) {
    unsigned char* wd = ws + WS_WDENSE + (size_t)l * WDENSE_STRIDE;
    const float* Win = in.w_in + (size_t)l * D * INW; bf16_t* WIN_T = (bf16_t*)(wd + WD_WIN);
    const float* gm = in.norm_mix_g + l * D;
    ConvJob J;
    switch (j) {
    case 0: J = {Win + 0, gm, WIN_T + (size_t)0 * D, INW, D, D, 1024}; break;
    case 1: J = {Win + 1024, gm, WIN_T + (size_t)2304 * D, INW, D, D, 512}; break;
    case 2: J = {Win + 1536, gm, WIN_T + (size_t)1024 * D, INW, D, D, 512}; break;
    case 3: J = {Win + 2048, gm, WIN_T + (size_t)2816 * D, INW, D, D, 512}; break;
    case 4: J = {Win + 3088, gm, WIN_T + (size_t)3328 * D, INW, D, D, 2048}; break;
    case 11: J = {Win + 2576, gm, WIN_T + (size_t)1536 * D, INW, D, D, 512}; break;
    case 5: J = {in.w_branch + (size_t)(l * 2 + 0) * 512 * D, nullptr, (bf16_t*)(wd + WD_WB), D, D, 512, D}; break;
    case 6: J = {in.w_branch + (size_t)(l * 2 + 1) * 512 * D, nullptr, (bf16_t*)(wd + WD_WB) + 512, D, D, 512, D}; break;
    case 7: J = {in.w_mix_out + (size_t)l * D * D, nullptr, (bf16_t*)(wd + WD_WMO), D, D, D, D}; break;
    case 8: J = {in.w_xq + (size_t)l * D * D, in.norm_x_g + l * D, (bf16_t*)(wd + WD_WXQ), D, D, D, D}; break;
    case 9: J = {in.w_xkv + (size_t)l * D * 2 * D, nullptr, (bf16_t*)(wd + WD_WXKV), 2 * D, D, D, 2 * D}; break;
    default: J = {in.w_xo + (size_t)l * D * D, nullptr, (bf16_t*)(wd + WD_WXO), D, D, D, D}; break;
    }
    return J;
}

__device__ __forceinline__ void ph_prologue(const InPtrs& in, unsigned char* ws, LAS unsigned char* lds, int vcu, int G, int wv) {
    const int tid = tid_of(wv), lane = tid & 63, wave = wv;
    LAS float* scr = (LAS float*)(lds + wave * 16384);
    const int gw = vcu * 8 + wave, NGW = G * 8;
#pragma nounroll
    for (int lj = 0; lj < DEPTH * 12; ++lj) {
            const int l = lj / 12, j = lj % 12;
            const ConvJob J = dense_job(in, ws, l, j);
            const int nnb = J.N / 32, nit = (J.K / 64) * nnb;
#pragma nounroll
            for (int it = gw; it < nit; it += NGW) conv_item(J.W, J.ldw, J.gk, J.WT, J.ldt, (it / nnb) * 64, (it % nnb) * 32, scr, lane);
        }
#pragma nounroll
    for (int l = 0; l < DEPTH; ++l) {
        bf16_t* WIN_T = (bf16_t*)(ws + WS_WDENSE + (size_t)l * WDENSE_STRIDE + WD_WIN);
        const float* Win = in.w_in + (size_t)l * D * INW; const float* Wa = in.gla_w_alpha + (size_t)l * BR * BKW; const float* gm = in.norm_mix_g + l * D;
        for (int i = vcu * 512 + tid; i < 256 * D; i += G * 512) {
            const int c = i >> 10, k = i & 1023; float s = 0.f;
#pragma unroll
            for (int r = 0; r < BR; ++r) s += Win[(size_t)k * INW + 2560 + r] * Wa[r * BKW + c];
            WIN_T[(size_t)(2048 + c) * D + k] = f2bf(s * gm[k]);
        }
    }
    bf16_t* XB = (bf16_t*)(ws + WS_XB); bf16_t* XN = (bf16_t*)(ws + WS_XN);
    for (int r = gw; r < T; r += NGW) {
        const float4* xr = (const float4*)(in.x + (size_t)r * D) + lane; float4 v[4]; float s = 0.f;
#pragma unroll
        for (int j = 0; j < 4; ++j) { v[j] = xr[64 * j]; s += v[j].x * v[j].x + v[j].y * v[j].y + v[j].z * v[j].z + v[j].w * v[j].w;
            u32x2 o; o.x = pkbf(v[j].x, v[j].y); o.y = pkbf(v[j].z, v[j].w); *(u32x2*)(XB + (size_t)r * D + (lane + 64 * j) * 4) = o; }
        const float rs = rsqrtf(wave_sum(s) * (1.0f / D) + EPS);
#pragma unroll
        for (int j = 0; j < 4; ++j) { u32x2 o; o.x = pkbf(v[j].x * rs, v[j].y * rs); o.y = pkbf(v[j].z * rs, v[j].w * rs); *(u32x2*)(XN + (size_t)r * D + (lane + 64 * j) * 4) = o; }
    }
    bf16_t* MEMN = (bf16_t*)(ws + WS_MEMN);
    for (int r = gw; r < NB * NMEM; r += NGW) {
        const float4* xr = (const float4*)(in.mem + (size_t)r * D) + lane; float4 v[4]; float s = 0.f;
#pragma unroll
        for (int j = 0; j < 4; ++j) { v[j] = xr[64 * j]; s += v[j].x * v[j].x + v[j].y * v[j].y + v[j].z * v[j].z + v[j].w * v[j].w; }
        const float rs = rsqrtf(wave_sum(s) * (1.0f / D) + EPS);
#pragma unroll
        for (int j = 0; j < 4; ++j) { const float4 g = ((const float4*)in.mem_norm_g)[lane + 64 * j];
            u32x2 o; o.x = pkbf(v[j].x * rs * g.x, v[j].y * rs * g.y); o.y = pkbf(v[j].z * rs * g.z, v[j].w * rs * g.w); *(u32x2*)(MEMN + (size_t)r * D + (lane + 64 * j) * 4) = o; }
    }
}

__device__ __forceinline__ void d_band_attn(int blk, int qi, const bf16_t* __restrict__ AQ, const bf16_t* __restrict__ AK, const bf16_t* __restrict__ AV, const float* __restrict__ rel, bf16_t* __restrict__ OAB) {
    const int n = blk % NCH, h = (blk / NCH) % AH, b = blk / (NCH * AH);
    const size_t qrow = (size_t)(b * L + n * CH + qi);
    float q[64], acc[64];
#pragma unroll
    for (int d = 0; d < 64; d += 8) { const u32x4 w = *(const u32x4*)(AQ + qrow * AW + h * 64 + d);
        q[d] = bflo(w.x); q[d + 1] = bfhi(w.x); q[d + 2] = bflo(w.y); q[d + 3] = bfhi(w.y); q[d + 4] = bflo(w.z); q[d + 5] = bfhi(w.z); q[d + 6] = bflo(w.w); q[d + 7] = bfhi(w.w); }
#pragma unroll
    for (int d = 0; d < 64; ++d) acc[d] = 0.f;
    float m = -INFINITY, l = 0.f;
    for (int j = 0; j < ABAND; ++j) {
        const int kc = n + (j >> 6) - ALC; if (kc < 0) continue;
        const size_t krow = (size_t)(b * L + kc * CH + (j & 63));
        const bf16_t* kp = AK + krow * AW + h * 64; const bf16_t* vp = AV + krow * AW + h * 64;
        float s = 0.f;
#pragma unroll
        for (int d = 0; d < 64; d += 8) { const u32x4 w = *(const u32x4*)(kp + d);
            s += q[d] * bflo(w.x) + q[d + 1] * bfhi(w.x) + q[d + 2] * bflo(w.y) + q[d + 3] * bfhi(w.y) + q[d + 4] * bflo(w.z) + q[d + 5] * bfhi(w.z) + q[d + 6] * bflo(w.w) + q[d + 7] * bfhi(w.w); }
        int relp = (ALC * CH + qi) - j; relp = relp < -AMAXREL ? -AMAXREL : (relp > AMAXREL ? AMAXREL : relp);
        s = s + rel[h * RELW + relp + AMAXREL];
        const float mn = fmaxf(m, s), corr = __expf(m - mn), p = __expf(s - mn);
        l = l * corr + p; m = mn;
#pragma unroll
        for (int d = 0; d < 64; d += 8) { const u32x4 w = *(const u32x4*)(vp + d);
            acc[d] = acc[d] * corr + p * bflo(w.x); acc[d + 1] = acc[d + 1] * corr + p * bfhi(w.x); acc[d + 2] = acc[d + 2] * corr + p * bflo(w.y); acc[d + 3] = acc[d + 3] * corr + p * bfhi(w.y);
            acc[d + 4] = acc[d + 4] * corr + p * bflo(w.z); acc[d + 5] = acc[d + 5] * corr + p * bfhi(w.z); acc[d + 6] = acc[d + 6] * corr + p * bflo(w.w); acc[d + 7] = acc[d + 7] * corr + p * bfhi(w.w); }
    }
    const float inv = 1.0f / l;
#pragma unroll
    for (int d = 0; d < 64; d += 8) { u32x4 o; o.x = pkbf(acc[d] * inv, acc[d + 1] * inv); o.y = pkbf(acc[d + 2] * inv, acc[d + 3] * inv); o.z = pkbf(acc[d + 4] * inv, acc[d + 5] * inv); o.w = pkbf(acc[d + 6] * inv, acc[d + 7] * inv);
        *(u32x4*)(OAB + qrow * D + h * 64 + d) = o; }
}

__device__ __forceinline__ void d_gla(int wv, int item, LAS float* sm  , const bf16_t* __restrict__ BQ, const bf16_t* __restrict__ BK, const bf16_t* __restrict__ BV, const float* __restrict__ LOGA, float* __restrict__ raw) {
    LAS float* sq = sm; LAS float* sk = sm + 128; LAS float* sa = sm + 256;
    const int b = item / BH, h = item % BH, v = tid_of(wv);
    float S[64];
#pragma unroll
    for (int k = 0; k < 64; ++k) S[k] = 0.f;
    for (int t = 0; t < L; ++t) {
        const size_t row = (size_t)(b * L + t); const int bf = (t & 1) * 64;
        float vv = 0.f;
        if (v < 64) { sq[bf + v] = bf2f(BQ[row * BKW + h * 64 + v]); sa[bf + v] = __expf(LOGA[row * BKW + h * 64 + v]); }
        else if (v < 128) { sk[bf + v - 64] = bf2f(BK[row * BKW + h * 64 + (v - 64)]); }
        if (v < 128) vv = bf2f(BV[(size_t)(h * 128 + v) * T + row]);
        __syncthreads();
        if (v < 128) {
            float o = 0.f;
#pragma unroll
            for (int k = 0; k < 64; ++k) { S[k] = sa[bf + k] * S[k] + sk[bf + k] * vv; o += sq[bf + k] * S[k]; }
            raw[row * BVW + h * 128 + v] = o;
        }
    }
}
__device__ __forceinline__ void d_gla_post(int w, int lane, const float* __restrict__ raw, const bf16_t* __restrict__ BRS, const float* __restrict__ g, bf16_t* __restrict__ OAB) {
    const size_t t = w / BH; const int h = w % BH;
    const float* p = raw + t * BVW + h * 128;
    const float a = p[lane], c = p[lane + 64];
    const float rs = rsqrtf(wave_sum(a * a + c * c) * (1.0f / 128.0f) + EPS);
    const bf16_t* br = BRS + t * BVW + h * 128;
    bf16_t* o = OAB + t * D + 512 + h * 128;
    o[lane] = f2bf(a * rs * g[lane] * bf2f(br[lane])); o[lane + 64] = f2bf(c * rs * g[lane + 64] * bf2f(br[lane + 64]));
}

__device__ __forceinline__ void d_xattn(int item, int j, LAS float* sm, bf16_t* QO, const bf16_t* __restrict__ kv) {
    LAS float* qs = sm; LAS float* ps = sm + 256; LAS float* red = sm + 512;
    const size_t t = item / XH; const int h = item % XH, b = (int)(t / L);
    qs[j] = bf2f(QO[t * D + h * XD + j]);
    __syncthreads();
    const bf16_t* kp = kv + (size_t)(b * NMEM + j) * 2048 + h * XD;
    float s = 0.f;
    for (int d = 0; d < XD; d += 8) { const u32x4 w = *(const u32x4*)(kp + d);
        s += qs[d] * bflo(w.x) + qs[d + 1] * bfhi(w.x) + qs[d + 2] * bflo(w.y) + qs[d + 3] * bfhi(w.y) + qs[d + 4] * bflo(w.z) + qs[d + 5] * bfhi(w.z) + qs[d + 6] * bflo(w.w) + qs[d + 7] * bfhi(w.w); }
    float m = wave_max(s);
    if ((j & 63) == 0) red[j >> 6] = m;
    __syncthreads();
    m = fmaxf(fmaxf(red[0], red[1]), fmaxf(red[2], red[3]));
    __syncthreads();
    const float p = __expf(s - m);
    float l = wave_sum(p);
    if ((j & 63) == 0) red[j >> 6] = l;
    ps[j] = p;
    __syncthreads();
    l = red[0] + red[1] + red[2] + red[3];
    const bf16_t* vp = kv + (size_t)(b * NMEM) * 2048 + 1024 + h * XD + j;
    float o = 0.f;
    for (int jj = 0; jj < NMEM; ++jj) o += ps[jj] * bf2f(vp[(size_t)jj * 2048]);
    QO[t * D + h * XD + j] = f2bf(o / l);
    __syncthreads();
}

__device__ __forceinline__ void d_route(size_t t, int lane, const bf16_t* __restrict__ XB, const float* __restrict__ ss, const float* __restrict__ g, const float* __restrict__ wgr, const float* __restrict__ bgr,
                                        const float* __restrict__ wer, const float* __restrict__ ber, int* __restrict__ sel_e, float* __restrict__ sel_w) {
    const float rs = rstd_row(ss, t);
    float gl[4], el[32];
#pragma unroll
    for (int i = 0; i < 4; ++i) gl[i] = 0.f;
#pragma unroll
    for (int i = 0; i < 32; ++i) el[i] = 0.f;
    for (int i = 0; i < 16; ++i) { const int d = lane + 64 * i; const float hv = bf2f(XB[t * D + d]) * rs * g[d];
#pragma unroll
        for (int o = 0; o < 4; ++o) gl[o] += hv * wgr[d * NG + o];
#pragma unroll
        for (int o = 0; o < 32; ++o) el[o] += hv * wer[d * NE + o]; }
#pragma unroll
    for (int i = 0; i < 4; ++i) gl[i] = wave_sum(gl[i]) + bgr[i];
#pragma unroll
    for (int i = 0; i < 32; ++i) el[i] = wave_sum(el[i]) + ber[i];
    float gm = gl[0]; int gi = 0;
#pragma unroll
    for (int i = 1; i < 4; ++i) if (gl[i] > gm) { gm = gl[i]; gi = i; }
    float gs = 0.f;
#pragma unroll
    for (int i = 0; i < 4; ++i) gs += __expf(gl[i] - gm);
    const float gw = 1.0f / gs;
    float v0 = -INFINITY, v1 = -INFINITY; int i0 = 0, i1 = 0;
#pragma unroll
    for (int gg = 0; gg < 4; ++gg)
#pragma unroll
        for (int e = 0; e < EPG; ++e) if (gg == gi) { const float x = el[gg * EPG + e];
            if (x > v0) { v1 = v0; i1 = i0; v0 = x; i0 = e; } else if (x > v1) { v1 = x; i1 = e; } }
    const float e1 = __expf(v1 - v0), den = 1.0f + e1;
    if (lane == 0) { sel_e[t * 2] = gi * EPG + i0; sel_e[t * 2 + 1] = gi * EPG + i1; sel_w[t * 2] = gw / den; sel_w[t * 2 + 1] = gw * e1 / den; }
}

__device__ __forceinline__ void d_moe(size_t t, int f, LAS float* sm, bf16_t* XB, const float* __restrict__ ss, const float* __restrict__ g, const float* __restrict__ Wg, const float* __restrict__ Wu, const float* __restrict__ Wd,
                                      const int* __restrict__ sel_e, const float* __restrict__ sel_w, float* __restrict__ ss_next) {
    LAS float* hs = sm; LAS float* hid = sm + 1024; LAS float* red = sm + 1280;
    const float rs = rstd_row(ss, t);
    for (int i = f; i < D; i += 256) hs[i] = bf2f(XB[t * D + i]) * rs * g[i];
    float y0 = 0.f, y1 = 0.f, y2 = 0.f, y3 = 0.f;
    for (int s = 0; s < 2; ++s) {
        const int e = sel_e[t * 2 + s]; const float w = sel_w[t * 2 + s];
        __syncthreads();
        const float* wg = Wg + (size_t)e * D * EF + f; const float* wu = Wu + (size_t)e * D * EF + f;
        float ga = 0.f, up = 0.f;
        for (int d = 0; d < D; ++d) { ga += hs[d] * wg[(size_t)d * EF]; up += hs[d] * wu[(size_t)d * EF]; }
        hid[f] = ga / (1.0f + __expf(-ga)) * up * w;
        __syncthreads();
        const float* wd = Wd + (size_t)e * EF * D + f;
        for (int ff = 0; ff < EF; ++ff) { const float hv = hid[ff]; const float* r = wd + (size_t)ff * D; y0 += hv * r[0]; y1 += hv * r[256]; y2 += hv * r[512]; y3 += hv * r[768]; }
    }
    bf16_t* xr = XB + t * D + f;
    const float x0 = bf2f(xr[0]) + y0, x1 = bf2f(xr[256]) + y1, x2 = bf2f(xr[512]) + y2, x3 = bf2f(xr[768]) + y3;
    xr[0] = f2bf(x0); xr[256] = f2bf(x1); xr[512] = f2bf(x2); xr[768] = f2bf(x3);
    const float q = wave_sum(x0 * x0 + x1 * x1 + x2 * x2 + x3 * x3);
    __syncthreads();
    if ((f & 63) == 0) red[f >> 6] = q;
    __syncthreads();
    if (f < 16) ss_next[t * 16 + f] = f == 0 ? (red[0] + red[1]) + (red[2] + red[3]) : 0.f;
    __syncthreads();
}

__device__ __forceinline__ void d_final(size_t t, int i, const bf16_t* __restrict__ XB, const float* __restrict__ ss, const float* __restrict__ g, float* __restrict__ out) {
    const float rs = rstd_row(ss, t);
    const u32x2 w = *(const u32x2*)(XB + t * D + i * 4); const float4 gg = ((const float4*)g)[i];
    float4 o; o.x = bflo(w.x) * rs * gg.x; o.y = bfhi(w.x) * rs * gg.y; o.z = bflo(w.y) * rs * gg.z; o.w = bfhi(w.y) * rs * gg.w;
    ((float4*)(out + t * D))[i] = o;
}
typedef short bf16x8_t __attribute__((ext_vector_type(8)));
constexpr int NRMAX = 40960;
constexpr int NTMAX = NRMAX / 256;
constexpr int CW_CNT = 256;
constexpr size_t SEL_SELE = 0, SEL_SELW = 128 * 1024, SEL_LPOS = 256 * 1024, SEL_POS = 384 * 1024, SEL_GW = 512 * 1024, SEL_TILE = 768 * 1024, SEL_NT = 768 * 1024 + 4096;

__device__ __forceinline__ void conv_expert_item(const InPtrs& in, unsigned char* ws, int it, LAS float* scr, int lane) {
    const int le = it / 384, r = it % 384, l = le >> 5, e = le & 31;
    bf16_t* WGU = (bf16_t*)(ws + WS_WEXP + (size_t)l * WEXP_STRIDE) + (size_t)e * 512 * D;
    bf16_t* WDT = (bf16_t*)(ws + WS_WEXP + (size_t)l * WEXP_STRIDE + 32 * MiB) + (size_t)e * D * EF;
    const size_t eo = ((size_t)l * NE + e) * D * EF;
    if (r < 256) {
        const int p = r >> 6, q = r & 63, kb = q >> 2, nb = q & 3;
        const float* W = ((p & 1) ? in.w_eu : in.w_eg) + eo + (p >> 1) * 128;
        conv_item(W, EF, in.norm_ffn_g + l * D, WGU + (size_t)(p * 128) * D, D, kb * 64, nb * 32, scr, lane);
    } else {
        const int q = r - 256, kb = q >> 5, nb = q & 31;
        conv_item(in.w_ed + eo, D, nullptr, WDT, EF, kb * 64, nb * 32, scr, lane);
    }
}
__device__ __forceinline__ void conv_router(const InPtrs& in, unsigned char* ws, int vcu, int G, int tid) {
    for (int i = vcu * 512 + tid; i < DEPTH * 48 * D; i += G * 512) {
        const int l = i / (48 * D), r = (i / D) % 48, k = i % D; float v = 0.f;
        if (r < NG) v = in.w_gr[((size_t)l * D + k) * NG + r]; else if (r < NG + NE) v = in.w_er[((size_t)l * D + k) * NE + (r - NG)];
        ((bf16_t*)(ws + WS_WR))[i] = f2bf(v * in.norm_ffn_g[l * D + k]);
    }
}

__device__ __forceinline__ void ph_route(const InPtrs& in, unsigned char* ws, LAS unsigned char* lds, int l, int vcu, int G, int wv) {
    const int tid = tid_of(wv), lane = tid & 63, wave = wv;
    const bf16_t* XB = (const bf16_t*)(ws + WS_XB); const bf16_t* WR = (const bf16_t*)(ws + WS_WR) + (size_t)l * 48 * D;
    const float* ss = (const float*)(ws + WS_SSP) + (size_t)(3 * l + 2) * T * 16;
    int* SELE = (int*)(ws + WS_SEL + SEL_SELE); float* SELW = (float*)(ws + WS_SEL + SEL_SELW); int* LPOS = (int*)(ws + WS_SEL + SEL_LPOS);
    unsigned* CNT = (unsigned*)(ws + WS_CTL) + CW_CNT + 32 * l;
    LAS float* lg = (LAS float*)lds + wave * (16 * 49);
    LAS unsigned* hist = (LAS unsigned*)(lds + 16384); LAS unsigned* gbase = hist + 32;
    for (int t0 = vcu * 64; t0 < T; t0 += G * 64) {
        if (tid < 32) hist[tid] = 0u;
        int e0 = 0, e1 = 0; unsigned r0 = 0, r1 = 0;
        if (wave < 4) {
            const int tw = t0 + wave * 16;
            f32x4 acc[3];
#pragma unroll
            for (int nb = 0; nb < 3; ++nb) acc[nb] = (f32x4){0.f, 0.f, 0.f, 0.f};
            const bf16_t* ap = XB + (size_t)(tw + (lane & 15)) * D + 8 * (lane >> 4);
            const bf16_t* bp = WR + (size_t)(lane & 15) * D + 8 * (lane >> 4);
#pragma unroll 4
            for (int kk = 0; kk < D / 32; ++kk) {
                const bf16x8_t a = *(const bf16x8_t*)(ap + kk * 32);
#pragma unroll
                for (int nb = 0; nb < 3; ++nb) { const bf16x8_t b = *(const bf16x8_t*)(bp + (size_t)nb * 16 * D + kk * 32); acc[nb] = __builtin_amdgcn_mfma_f32_16x16x32_bf16(a, b, acc[nb], 0, 0, 0); }
            }
#pragma unroll
            for (int nb = 0; nb < 3; ++nb)
#pragma unroll
                for (int r = 0; r < 4; ++r) lg[((lane >> 4) * 4 + r) * 49 + nb * 16 + (lane & 15)] = acc[nb][r];
        }
        __syncthreads();
        if (wave < 4 && lane < 16) {
            const int t = t0 + wave * 16 + lane; const float rs = rstd_row(ss, (size_t)t);
            const LAS float* p = lg + lane * 49;
            float gm = -INFINITY; int gi = 0;
#pragma unroll
            for (int i = 0; i < NG; ++i) { const float x = p[i] * rs + in.b_gr[l * NG + i]; if (x > gm) { gm = x; gi = i; } }
            float gs = 0.f;
#pragma unroll
            for (int i = 0; i < NG; ++i) gs += __expf(p[i] * rs + in.b_gr[l * NG + i] - gm);
            const float gw = 1.0f / gs;
            float v0 = -INFINITY, v1 = -INFINITY; int i0 = 0, i1 = 0;
#pragma unroll
            for (int e = 0; e < EPG; ++e) { const float x = p[NG + gi * EPG + e] * rs + in.b_er[l * NE + gi * EPG + e];
                if (x > v0) { v1 = v0; i1 = i0; v0 = x; i0 = e; } else if (x > v1) { v1 = x; i1 = e; } }
            const float ex = __expf(v1 - v0), den = 1.0f + ex;
            e0 = gi * EPG + i0; e1 = gi * EPG + i1;
            SELE[t * 2] = e0; SELE[t * 2 + 1] = e1; SELW[t * 2] = gw / den; SELW[t * 2 + 1] = gw * ex / den;
            r0 = __hip_atomic_fetch_add(&hist[e0], 1u, __ATOMIC_RELAXED, __HIP_MEMORY_SCOPE_WORKGROUP); r1 = __hip_atomic_fetch_add(&hist[e1], 1u, __ATOMIC_RELAXED, __HIP_MEMORY_SCOPE_WORKGROUP);
        }
        __syncthreads();
        if (tid < 32) gbase[tid] = hist[tid] ? atomicAdd(&CNT[tid], hist[tid]) : 0u;
        __syncthreads();
        if (wave < 4 && lane < 16) { const int t = t0 + wave * 16 + lane; LPOS[t * 2] = (int)(gbase[e0] + r0); LPOS[t * 2 + 1] = (int)(gbase[e1] + r1); }
        __syncthreads();
    }
}

__device__ __forceinline__ void ph_gather(unsigned char* ws, int l, int vcu, int G, int wv) {
    const int tid = tid_of(wv), lane = tid & 63, wave = wv; (void)tid;
    const unsigned* CNT = (const unsigned*)(ws + WS_CTL) + CW_CNT + 32 * l;
    const int cnt = (lane < 32) ? (int)__hip_atomic_load(CNT + (lane & 31), __ATOMIC_RELAXED, __HIP_MEMORY_SCOPE_AGENT) : 0;
    const int pad = (cnt + 255) & ~255;
    int incl = pad;
#pragma unroll
    for (int o = 1; o < 32; o <<= 1) { const int y = shfl_idx(incl, (lane - o) & 63); if ((lane & 31) >= o) incl += y; }
    const int base_l = incl - pad;
    if (vcu == 0 && wave == 0) {
        int* TILE_E = (int*)(ws + WS_SEL + SEL_TILE);
        if (lane < 32) for (int r = base_l >> 8; r < (incl >> 8); ++r) TILE_E[r] = lane;
        if (lane == 31) *(int*)(ws + WS_SEL + SEL_NT) = incl >> 8;
    }
    const bf16_t* XB = (const bf16_t*)(ws + WS_XB); bf16_t* XG = (bf16_t*)(ws + WS_XG);
    const float* ss = (const float*)(ws + WS_SSP) + (size_t)(3 * l + 2) * T * 16;
    const int* SELE = (const int*)(ws + WS_SEL + SEL_SELE); const float* SELW = (const float*)(ws + WS_SEL + SEL_SELW); const int* LPOS = (const int*)(ws + WS_SEL + SEL_LPOS);
    int* POS = (int*)(ws + WS_SEL + SEL_POS); float* GW = (float*)(ws + WS_SEL + SEL_GW);
    for (int s = vcu * 8 + wave; s < 2 * T; s += G * 8) {
        const int t = s >> 1, e = SELE[s];
        const int pos = shfl_idx(base_l, e) + LPOS[s];
        const float rs = rstd_row(ss, (size_t)t);
        if (lane == 0) { POS[s] = pos; GW[pos] = SELW[s]; }
        const u32x4* src = (const u32x4*)(XB + (size_t)t * D) + lane; u32x4* dst = (u32x4*)(XG + (size_t)pos * D) + lane;
#pragma unroll
        for (int j = 0; j < 2; ++j) { const u32x4 w = src[64 * j]; u32x4 o;
            o.x = pkbf(bflo(w.x) * rs, bfhi(w.x) * rs); o.y = pkbf(bflo(w.y) * rs, bfhi(w.y) * rs); o.z = pkbf(bflo(w.z) * rs, bfhi(w.z) * rs); o.w = pkbf(bflo(w.w) * rs, bfhi(w.w) * rs);
            dst[64 * j] = o; }
    }
}

template <int NJ> struct GroupedOrder {
    const int* tile_e; int nunits, G, c;
    __device__ __forceinline__ void init(const int* te, int nt, int G_, int c_) { tile_e = te; nunits = nt * NJ; G = G_; c = c_; }
    __device__ __forceinline__ bool next(int i, pg8::Unit& u) const {
        const int L = i * G + c; if (L >= nunits) return false;
        const int rt = L / NJ, j = L % NJ;
        u.pm = rt; u.pn = __builtin_amdgcn_readfirstlane(tile_e[rt]) * NJ + j; return true;
    }
    __device__ __forceinline__ void a_ready(const pg8::Unit&) const {}
    __device__ __forceinline__ void done(const pg8::Unit&) const {}
};
struct EpiHid {
    static constexpr bool PERM = true, AFTER_DRAIN = false;
    bf16_t* HID; const float* GW;
    __device__ __forceinline__ void operator()(const A4 (&acc)[2][2][4][2], const pg8::Unit& u, int wr, int wc, int fr, int fq) const {
        const int f0 = (u.pn & 1) * 128 + wc * 32 + 8 * fq;
        EPI_ROWS_BEGIN
            const float w = GW[row];
            A4 h0, h1;
#pragma unroll
            for (int i = 0; i < 4; ++i) { h0[i] = fsilu(acc[ai][0][m][0][i]) * acc[ai][1][m][0][i] * w; h1[i] = fsilu(acc[ai][0][m][1][i]) * acc[ai][1][m][1][i] * w; }
            *(u32x4*)(HID + (size_t)row * EF + f0) = pack8(h0, h1);
        EPI_ROWS_END
    }
};
struct EpiY {
    static constexpr bool PERM = true, AFTER_DRAIN = false;
    bf16_t* Y;
    __device__ __forceinline__ void operator()(const A4 (&acc)[2][2][4][2], const pg8::Unit& u, int wr, int wc, int fr, int fq) const {
        const int col0 = (u.pn & 3) * 256 + wc * 32 + 8 * fq;
        EPI_ROWS_BEGIN
#pragma unroll
            for (int bj = 0; bj < 2; ++bj) *(u32x4*)(Y + (size_t)row * D + col0 + bj * 128) = pack8(acc[ai][bj][m][0], acc[ai][bj][m][1]);
        EPI_ROWS_END
    }
};

__device__ __forceinline__ void ph_combine(unsigned char* ws, int l, int vcu, int G, bf16_t* XN, int wv) {
    const int tid = tid_of(wv), lane = tid & 63, wave = wv; (void)tid;
    bf16_t* XB = (bf16_t*)(ws + WS_XB); const bf16_t* Y = (const bf16_t*)(ws + WS_XG);
    const int* POS = (const int*)(ws + WS_SEL + SEL_POS); float* ssn = (float*)(ws + WS_SSP) + (size_t)(3 * l + 3) * T * 16;
    for (int t = vcu * 8 + wave; t < T; t += G * 8) {
        const int p0 = POS[2 * t], p1 = POS[2 * t + 1];
        u32x4* xr = (u32x4*)(XB + (size_t)t * D) + lane; const u32x4* y0 = (const u32x4*)(Y + (size_t)p0 * D) + lane; const u32x4* y1 = (const u32x4*)(Y + (size_t)p1 * D) + lane;
        A4 v[4]; float q = 0.f;
#pragma unroll
        for (int j = 0; j < 2; ++j) { A4 a0, a1, b0, b1, c0, c1; unpack8(xr[64 * j], a0, a1); unpack8(y0[64 * j], b0, b1); unpack8(y1[64 * j], c0, c1);
            a0 += b0 + c0; a1 += b1 + c1; v[2 * j] = a0; v[2 * j + 1] = a1;
            q += (a0[0] * a0[0] + a0[1] * a0[1]) + (a0[2] * a0[2] + a0[3] * a0[3]) + (a1[0] * a1[0] + a1[1] * a1[1]) + (a1[2] * a1[2] + a1[3] * a1[3]);
            xr[64 * j] = pack8(a0, a1); }
        q = wave_sum(q);
        if (lane < 16) ssn[(size_t)t * 16 + lane] = lane == 0 ? q : 0.f;
        if (XN) { const float rs = rsqrtf(q * (1.0f / D) + EPS); u32x4* xn = (u32x4*)(XN + (size_t)t * D) + lane;
#pragma unroll
            for (int j = 0; j < 2; ++j) xn[64 * j] = pack8(v[2 * j] * rs, v[2 * j + 1] * rs); }
    }
}
struct FixedOrder {
    int pm, pn;
    __device__ __forceinline__ bool next(int i, pg8::Unit& u) const { if (i != 0) return false; u.pm = pm; u.pn = pn; return true; }
    __device__ __forceinline__ void a_ready(const pg8::Unit&) const {}
    __device__ __forceinline__ void done(const pg8::Unit&) const {}
};
struct EpiSoftmax {
    static constexpr bool PERM = true, AFTER_DRAIN = true;
    bf16_t* P; int ld, pad;
    __device__ __forceinline__ void fused(A4 (&acc)[2][2][4][2], const pg8::Unit& u, int wr, int wc, int fr, int fq, PG8_LAS unsigned char* lds, int wid, int lane) const {
        typedef float f32x2v __attribute__((ext_vector_type(2)));
        PG8_LAS f32x2v* X = (PG8_LAS f32x2v*)lds;
        float mw[2][4];
#pragma unroll
        for (int ai = 0; ai < 2; ++ai)
#pragma unroll
            for (int m = 0; m < 4; ++m) {
                float mx = -INFINITY;
#pragma unroll
                for (int bj = 0; bj < 2; ++bj)
#pragma unroll
                    for (int i = 0; i < 4; ++i) mx = fmaxf(mx, fmaxf(acc[ai][bj][m][0][i], acc[ai][bj][m][1][i]));
                mx = fmaxf(mx, swz_xor<16>(mx)); mx = max_xor32(mx);
                float s = 0.f;
#pragma unroll
                for (int bj = 0; bj < 2; ++bj)
#pragma unroll
                    for (int n = 0; n < 2; ++n)
#pragma unroll
                        for (int i = 0; i < 4; ++i) { const float e = __expf(acc[ai][bj][m][n][i] - mx); acc[ai][bj][m][n][i] = e; s += e; }
                s = add_xor32(add_xor16(s));
                mw[ai][m] = mx;
                if (fq == 0) X[(ai * 128 + wr * 64 + m * 16 + fr) * 4 + wc] = (f32x2v){mx, s};
            }
        asm volatile("s_waitcnt lgkmcnt(0)" ::: "memory"); __builtin_amdgcn_s_barrier(); asm volatile("" ::: "memory");
#pragma unroll
        for (int ai = 0; ai < 2; ++ai)
#pragma unroll
            for (int m = 0; m < 4; ++m) {
                const int r = ai * 128 + wr * 64 + m * 16 + fr;
                const f32x2v a = X[r * 4 + 0], b = X[r * 4 + 1], c = X[r * 4 + 2], d = X[r * 4 + 3];
                const float M = fmaxf(fmaxf(a.x, b.x), fmaxf(c.x, d.x));
                const float S = (a.y * __expf(a.x - M) + b.y * __expf(b.x - M)) + (c.y * __expf(c.x - M) + d.y * __expf(d.x - M));
                const float f = __expf(mw[ai][m] - M) * __builtin_amdgcn_rcpf(S);
#pragma unroll
                for (int bj = 0; bj < 2; ++bj) *(u32x4*)(P + (size_t)(u.pm * 256 + r) * ld + bj * 128 + wc * 32 + 8 * fq) = pack8(acc[ai][bj][m][0] * f, acc[ai][bj][m][1] * f);
            }
    }
};
typedef float f32x16 __attribute__((ext_vector_type(16)));
constexpr int RTAB = 640;
__device__ __forceinline__ bf16x8_t as_bf16x8(const u32x4 w) { return __builtin_bit_cast(bf16x8_t, w); }
__device__ __forceinline__ void band_tables(const float* __restrict__ rel  , LAS float* Rt, int tid) {
    for (int i = tid; i < AH * RTAB; i += 512) { const int h = i / RTAB, k = i % RTAB; int r = 575 - k; r = r < -AMAXREL ? -AMAXREL : (r > AMAXREL ? AMAXREL : r); Rt[i] = rel[h * RELW + r + AMAXREL]; }
}
__device__ __forceinline__ void band_item(int item, int lane, const bf16_t* __restrict__ AQ, const bf16_t* __restrict__ AK, const bf16_t* __restrict__ AVT, const LAS float* Rt, bf16_t* __restrict__ OAB) {
    const int n = item % NCH, h = (item / NCH) % AH, b = item / (NCH * AH);
    const int ql = lane & 31, hh = lane >> 5;
    const size_t tok0 = (size_t)b * L + (size_t)n * CH;
    bf16x8_t Qf[2][4];
#pragma unroll
    for (int qb = 0; qb < 2; ++qb)
#pragma unroll
        for (int s = 0; s < 4; ++s) Qf[qb][s] = *(const bf16x8_t*)(AQ + (tok0 + 32 * qb + ql) * AW + h * 64 + 16 * s + 8 * hh);
    f32x16 O[2][2];
#pragma unroll
    for (int db = 0; db < 2; ++db)
#pragma unroll
        for (int qb = 0; qb < 2; ++qb)
#pragma unroll
            for (int r = 0; r < 16; ++r) O[db][qb][r] = 0.f;
    float mrun[2] = {-INFINITY, -INFINITY}, lrun[2] = {0.f, 0.f};
    const LAS float* Rh = Rt + h * RTAB + (31 - ql + 4 * hh);
    const bf16_t* vbase = AVT + (size_t)(h * 64 + ql) * T + 4 * hh;
#pragma nounroll
    for (int c = (n < ALC ? ALC - n : 0); c <= ALC; ++c) {
        const size_t key0 = (size_t)b * L + (size_t)(n - ALC + c) * CH;
        bf16x8_t Kf[2][4], Vf[2][2][2];
#pragma unroll
        for (int kb = 0; kb < 2; ++kb)
#pragma unroll
            for (int s = 0; s < 4; ++s) Kf[kb][s] = *(const bf16x8_t*)(AK + (key0 + 32 * kb + ql) * AW + h * 64 + 16 * s + 8 * hh);
#pragma unroll
        for (int db = 0; db < 2; ++db)
#pragma unroll
            for (int kb = 0; kb < 2; ++kb)
#pragma unroll
                for (int s = 0; s < 2; ++s) { const bf16_t* p = vbase + (size_t)(32 * db) * T + key0 + 32 * kb + 16 * s;
                    const u32x2 a = *(const u32x2*)p, c2 = *(const u32x2*)(p + 8); Vf[db][kb][s] = as_bf16x8((u32x4){a.x, a.y, c2.x, c2.y}); }
        const LAS float* Rc = Rh + c * 64;
#pragma unroll
        for (int qb = 0; qb < 2; ++qb) {
            f32x16 S[2];
#pragma unroll
            for (int kb = 0; kb < 2; ++kb) {
#pragma unroll
                for (int r = 0; r < 16; ++r) S[kb][r] = Rc[32 + 32 * kb - 32 * qb + (r & 3) + 8 * (r >> 2)];
#pragma unroll
                for (int s = 0; s < 4; ++s) S[kb] = __builtin_amdgcn_mfma_f32_32x32x16_bf16(Kf[kb][s], Qf[qb][s], S[kb], 0, 0, 0);
            }
            float mx = S[0][0];
#pragma unroll
            for (int r = 0; r < 16; ++r) mx = fmaxf(mx, fmaxf(S[0][r], S[1][r]));
            mx = max_xor32(mx);
            const float mn = fmaxf(mrun[qb], mx), alpha = __expf(mrun[qb] - mn);
            mrun[qb] = mn;
            float sum = 0.f;
#pragma unroll
            for (int kb = 0; kb < 2; ++kb)
#pragma unroll
                for (int r = 0; r < 16; ++r) { const float p = __expf(S[kb][r] - mn); S[kb][r] = p; sum += p; }
            lrun[qb] = lrun[qb] * alpha + add_xor32(sum);
#pragma unroll
            for (int db = 0; db < 2; ++db)
#pragma unroll
                for (int r = 0; r < 16; ++r) O[db][qb][r] *= alpha;
#pragma unroll
            for (int kb = 0; kb < 2; ++kb)
#pragma unroll
                for (int s = 0; s < 2; ++s) {
                    u32x4 w; w.x = pkbf(S[kb][8 * s + 0], S[kb][8 * s + 1]); w.y = pkbf(S[kb][8 * s + 2], S[kb][8 * s + 3]); w.z = pkbf(S[kb][8 * s + 4], S[kb][8 * s + 5]); w.w = pkbf(S[kb][8 * s + 6], S[kb][8 * s + 7]);
                    const bf16x8_t Pf = as_bf16x8(w);
#pragma unroll
                    for (int db = 0; db < 2; ++db) O[db][qb] = __builtin_amdgcn_mfma_f32_32x32x16_bf16(Vf[db][kb][s], Pf, O[db][qb], 0, 0, 0);
                }
        }
    }
#pragma unroll
    for (int qb = 0; qb < 2; ++qb) {
        const float inv = 1.0f / lrun[qb];
        bf16_t* orow = OAB + (tok0 + 32 * qb + ql) * D + h * 64 + 4 * hh;
#pragma unroll
        for (int db = 0; db < 2; ++db)
#pragma unroll
            for (int g = 0; g < 4; ++g) { u32x2 o; o.x = pkbf(O[db][qb][4 * g] * inv, O[db][qb][4 * g + 1] * inv); o.y = pkbf(O[db][qb][4 * g + 2] * inv, O[db][qb][4 * g + 3] * inv);
                *(u32x2*)(orow + 32 * db + 8 * g) = o; }
    }
}
constexpr size_t DS_ITEM = 128 * 64;
__device__ __forceinline__ int rowmap32(int r, int hh) { return (r & 3) + 8 * (r >> 2) + 4 * hh; }

__device__ __forceinline__ float gla_scan_tile(const float* __restrict__ LOGA, size_t tok0, int h, int lane, LAS float* Gt) {
    const float* p = LOGA + tok0 * BKW + h * 64 + lane;
    float cum = 0.f;
#pragma unroll
    for (int t0 = 0; t0 < 64; t0 += 16) {
        float la[16];
#pragma unroll
        for (int i = 0; i < 16; ++i) la[i] = p[(size_t)(t0 + i) * BKW];
#pragma unroll
        for (int i = 0; i < 16; ++i) { cum += la[i]; Gt[(t0 + i) * 64 + lane] = cum; }
    }
    asm volatile("s_waitcnt lgkmcnt(0)" ::: "memory");
    return cum;
}

__device__ __forceinline__ void gla1_item(int idx, int lane, LAS float* Gt, const bf16_t* __restrict__ BK, const bf16_t* __restrict__ BVT, const float* __restrict__ LOGA, float* __restrict__ DS, float* __restrict__ DEC) {
    const int c = idx & 127, h = (idx >> 7) & 3, b = idx >> 9;
    const size_t tok0 = (size_t)b * L + (size_t)c * CH;
    const int ql = lane & 31, hh = lane >> 5;
    const float last = gla_scan_tile(LOGA, tok0, h, lane, Gt);
    DEC[(size_t)idx * 64 + lane] = __expf(last);
    bf16x8_t Xf[2][2][2];
#pragma unroll
    for (int kb = 0; kb < 2; ++kb) {
        const float lk = __int_as_float(shfl_idx(__float_as_int(last), 32 * kb + ql));
#pragma unroll
        for (int tb = 0; tb < 2; ++tb) {
            float x[16];
#pragma unroll
            for (int r = 0; r < 16; ++r) { const int t = 32 * tb + rowmap32(r, hh);
                x[r] = bf2f(BK[(tok0 + t) * BKW + h * 64 + 32 * kb + ql]) * __expf(lk - Gt[t * 64 + 32 * kb + ql]); }
#pragma unroll
            for (int s = 0; s < 2; ++s) { u32x4 w; w.x = pkbf(x[8 * s], x[8 * s + 1]); w.y = pkbf(x[8 * s + 2], x[8 * s + 3]); w.z = pkbf(x[8 * s + 4], x[8 * s + 5]); w.w = pkbf(x[8 * s + 6], x[8 * s + 7]); Xf[tb][kb][s] = as_bf16x8(w); }
        }
    }
    const bf16_t* vbase = BVT + (size_t)(h * 128 + ql) * T + tok0 + 4 * hh;
    float* dsb = DS + (size_t)idx * DS_ITEM;
#pragma unroll
    for (int vb = 0; vb < 4; ++vb) {
        bf16x8_t Vf[2][2];
#pragma unroll
        for (int tb = 0; tb < 2; ++tb)
#pragma unroll
            for (int s = 0; s < 2; ++s) { const bf16_t* p = vbase + (size_t)(32 * vb) * T + 32 * tb + 16 * s; const u32x2 a = *(const u32x2*)p, c2 = *(const u32x2*)(p + 8); Vf[tb][s] = as_bf16x8((u32x4){a.x, a.y, c2.x, c2.y}); }
#pragma unroll
        for (int kb = 0; kb < 2; ++kb) {
            f32x16 acc;
#pragma unroll
            for (int r = 0; r < 16; ++r) acc[r] = 0.f;
#pragma unroll
            for (int tb = 0; tb < 2; ++tb)
#pragma unroll
                for (int s = 0; s < 2; ++s) acc = __builtin_amdgcn_mfma_f32_32x32x16_bf16(Vf[tb][s], Xf[tb][kb][s], acc, 0, 0, 0);
#pragma unroll
            for (int r = 0; r < 16; ++r) dsb[(size_t)(32 * vb + rowmap32(r, hh)) * 64 + 32 * kb + ql] = acc[r];
        }
    }
}

__device__ __forceinline__ void gla2_scan(int e, const float* __restrict__ DS, const float* __restrict__ DEC, bf16_t* __restrict__ SB) {
    const int k = e & 63, v = (e >> 6) & 127, bh = e >> 13;
    const size_t base = (size_t)bh * 128;
    float S = 0.f;
#pragma unroll 1
    for (int c0 = 0; c0 < 128; c0 += 8) {
        float d[8], a[8];
#pragma unroll
        for (int i = 0; i < 8; ++i) { d[i] = DS[(base + c0 + i) * DS_ITEM + (size_t)v * 64 + k]; a[i] = DEC[(base + c0 + i) * 64 + k]; }
#pragma unroll
        for (int i = 0; i < 8; ++i) { SB[(base + c0 + i) * DS_ITEM + (size_t)v * 64 + k] = f2bf(S); S = a[i] * S + d[i]; }
    }
}

__device__ __forceinline__ void gla3_unit(int unit, int lane, LAS float* Gt, const bf16_t* __restrict__ BQ, const bf16_t* __restrict__ BK, const bf16_t* __restrict__ BVT, const float* __restrict__ LOGA,
                                          const bf16_t* __restrict__ SB, const bf16_t* __restrict__ BRS, const float* __restrict__ gnorm, bf16_t* __restrict__ OAB) {
    const int tb = unit & 1, idx = unit >> 1;
    const int c = idx & 127, h = (idx >> 7) & 3, b = idx >> 9;
    const size_t tok0 = (size_t)b * L + (size_t)c * CH;
    const int ql = lane & 31, hh = lane >> 5;
    (void)gla_scan_tile(LOGA, tok0, h, lane, Gt);
    bf16x8_t Qf[4];
    {
        const int t = 32 * tb + ql;
#pragma unroll
        for (int s = 0; s < 4; ++s) {
            const u32x4 q = *(const u32x4*)(BQ + (tok0 + t) * BKW + h * 64 + 16 * s + 8 * hh);
            const f32x4 g0 = *(const LAS f32x4*)(Gt + t * 64 + 16 * s + 8 * hh), g1 = *(const LAS f32x4*)(Gt + t * 64 + 16 * s + 8 * hh + 4);
            u32x4 w; w.x = pkbf(bflo(q.x) * __expf(g0[0]), bfhi(q.x) * __expf(g0[1])); w.y = pkbf(bflo(q.y) * __expf(g0[2]), bfhi(q.y) * __expf(g0[3]));
            w.z = pkbf(bflo(q.z) * __expf(g1[0]), bfhi(q.z) * __expf(g1[1])); w.w = pkbf(bflo(q.w) * __expf(g1[2]), bfhi(q.w) * __expf(g1[3]));
            Qf[s] = as_bf16x8(w);
        }
    }
    bf16x8_t Pf[2][2];
#pragma unroll
    for (int sb = 0; sb < 2; ++sb) {
        if (sb <= tb) {
            const int srow = 32 * sb + ql;
            f32x16 A;
#pragma unroll
            for (int r = 0; r < 16; ++r) A[r] = 0.f;
#pragma unroll
            for (int s = 0; s < 4; ++s) {
                const u32x4 kx = *(const u32x4*)(BK + (tok0 + srow) * BKW + h * 64 + 16 * s + 8 * hh);
                const f32x4 g0 = *(const LAS f32x4*)(Gt + srow * 64 + 16 * s + 8 * hh), g1 = *(const LAS f32x4*)(Gt + srow * 64 + 16 * s + 8 * hh + 4);
                u32x4 w; w.x = pkbf(bflo(kx.x) * __expf(-g0[0]), bfhi(kx.x) * __expf(-g0[1])); w.y = pkbf(bflo(kx.y) * __expf(-g0[2]), bfhi(kx.y) * __expf(-g0[3]));
                w.z = pkbf(bflo(kx.z) * __expf(-g1[0]), bfhi(kx.z) * __expf(-g1[1])); w.w = pkbf(bflo(kx.w) * __expf(-g1[2]), bfhi(kx.w) * __expf(-g1[3]));
                A = __builtin_amdgcn_mfma_f32_32x32x16_bf16(as_bf16x8(w), Qf[s], A, 0, 0, 0);
            }
            if (sb == tb) {
#pragma unroll
                for (int r = 0; r < 16; ++r) A[r] = (rowmap32(r, hh) <= ql) ? A[r] : 0.f;
            }
#pragma unroll
            for (int s2 = 0; s2 < 2; ++s2) { u32x4 w; w.x = pkbf(A[8 * s2], A[8 * s2 + 1]); w.y = pkbf(A[8 * s2 + 2], A[8 * s2 + 3]); w.z = pkbf(A[8 * s2 + 4], A[8 * s2 + 5]); w.w = pkbf(A[8 * s2 + 6], A[8 * s2 + 7]); Pf[sb][s2] = as_bf16x8(w); }
        }
    }
    f32x16 O[4];
    const bf16_t* vbase = BVT + (size_t)(h * 128 + ql) * T + tok0 + 4 * hh;
    const bf16_t* sbase = SB + (size_t)idx * DS_ITEM + (size_t)ql * 64 + 8 * hh;
#pragma unroll
    for (int vb = 0; vb < 4; ++vb) {
#pragma unroll
        for (int r = 0; r < 16; ++r) O[vb][r] = 0.f;
#pragma unroll
        for (int s = 0; s < 4; ++s) { const bf16x8_t Sf = *(const bf16x8_t*)(sbase + (size_t)(32 * vb) * 64 + 16 * s); O[vb] = __builtin_amdgcn_mfma_f32_32x32x16_bf16(Sf, Qf[s], O[vb], 0, 0, 0); }
#pragma unroll
        for (int sb = 0; sb < 2; ++sb) {
            if (sb <= tb) {
#pragma unroll
                for (int s2 = 0; s2 < 2; ++s2) { const bf16_t* p = vbase + (size_t)(32 * vb) * T + 32 * sb + 16 * s2; const u32x2 a = *(const u32x2*)p, c2 = *(const u32x2*)(p + 8);
                    O[vb] = __builtin_amdgcn_mfma_f32_32x32x16_bf16(as_bf16x8((u32x4){a.x, a.y, c2.x, c2.y}), Pf[sb][s2], O[vb], 0, 0, 0); }
            }
        }
    }
    float q = 0.f;
#pragma unroll
    for (int vb = 0; vb < 4; ++vb)
#pragma unroll
        for (int r = 0; r < 16; ++r) q += O[vb][r] * O[vb][r];
    const float rs = rsqrtf(add_xor32(q) * (1.0f / 128.0f) + EPS);
    const size_t trow = tok0 + 32 * tb + ql;
    const bf16_t* br = BRS + trow * BVW + h * 128 + 4 * hh; bf16_t* orow = OAB + trow * D + 512 + h * 128 + 4 * hh; const float* gn = gnorm + 4 * hh;
#pragma unroll
    for (int vb = 0; vb < 4; ++vb)
#pragma unroll
        for (int g = 0; g < 4; ++g) {
            const int vo = 32 * vb + 8 * g;
            const u32x2 bw = *(const u32x2*)(br + vo); const f32x4 gv = *(const f32x4*)(gn + vo);
            u32x2 o; o.x = pkbf(O[vb][4 * g] * rs * gv[0] * bflo(bw.x), O[vb][4 * g + 1] * rs * gv[1] * bfhi(bw.x)); o.y = pkbf(O[vb][4 * g + 2] * rs * gv[2] * bflo(bw.y), O[vb][4 * g + 3] * rs * gv[3] * bfhi(bw.y));
            *(u32x2*)(orow + vo) = o;
        }
}
#ifndef MK_LAUNCHES
#define MK_LAUNCHES 1
#endif
constexpr int RING_BYTES = 131072, MISC_OFF = RING_BYTES + 512, LDS_BYTES = 147456;
constexpr int CW_BAR = 1024;
constexpr size_t CTL_ZERO_BYTES = 64 * 1024;
static_assert((CW_BAR + XCD_BAR_WORDS) * 4 <= (int)CTL_ZERO_BYTES, "barrier words inside the memset region");
constexpr int N_PHASES = 2 + 14 * DEPTH;

struct MKArgs { InPtrs in; unsigned char* ws; unsigned char* dout; int ph_lo, ph_hi; };

__global__ void __launch_bounds__(512, 2) mk_fwd(MKArgs a) {
    extern __shared__ __attribute__((aligned(16))) unsigned char lds_raw[];
    LAS unsigned char* lds = (LAS unsigned char*)lds_raw;
    const int G0 = (int)gridDim.x, vcu0 = (int)blockIdx.x;
    const int wv0 = __builtin_amdgcn_readfirstlane((int)threadIdx.x >> 6);
    volatile LAS unsigned* MISC = (volatile LAS unsigned*)(lds + MISC_OFF);
    if (threadIdx.x < 16) MISC[threadIdx.x] = 0u;
    __syncthreads();
    const bool one_launch = (a.ph_hi - a.ph_lo) > 1;
    XcdBarrier bar; bar.bar = (unsigned*)(a.ws + WS_CTL) + CW_BAR; bar.x = 0; bar.st = MISC + 8;
    if (one_launch) bar = xcd_barrier_post((unsigned*)(a.ws + WS_CTL) + CW_BAR, MISC + 8);

    const InPtrs& in = a.in;
#define SS ((float*)(ws + WS_SSP))
#define XB ((bf16_t*)(ws + WS_XB))
#define AQ ((bf16_t*)(ws + WS_AQ))
#define AK ((bf16_t*)(ws + WS_AK))
#define AVT ((bf16_t*)(ws + WS_AVT))
#define XN ((bf16_t*)(ws + WS_XN))
#define BQ ((bf16_t*)(ws + WS_BQ))
#define BK ((bf16_t*)(ws + WS_BK))
#define BVT ((bf16_t*)(ws + WS_BVT))
#define BRS ((bf16_t*)(ws + WS_BRS))
#define GA ((bf16_t*)(ws + WS_GA))
#define GB ((bf16_t*)(dout + DO_GB))
#define MG ((bf16_t*)(ws + WS_MG))
#define Q ((bf16_t*)(ws + WS_Q))
#define MEMN ((bf16_t*)(ws + WS_MEMN))
#define KVB ((bf16_t*)(ws + WS_KVB))
#define LOGA ((float*)(ws + WS_LOGA))
#define OAB ((bf16_t*)(dout + DO_OAB))
#define DSF ((float*)(dout + DO_ST))
#define DEC ((float*)(ws + WS_DEC))
#define SBB ((bf16_t*)(ws + WS_SB))
#define TMP ((bf16_t*)(ws + WS_TMP))
#define SELE ((int*)(ws + WS_SEL))
#define SELW ((float*)(ws + WS_SEL + (size_t)T * 2 * 4))
#define WD(l) (ws + WS_WDENSE + (size_t)(l) * WDENSE_STRIDE)
#define SSA(i) (SS + (size_t)(i) * T * 16)
#define MK_EP(l, t0) EpiProj{AQ, AK, BQ, BK, BRS, GA, GB, LOGA, in.gla_b_alpha + (size_t)(l) * BKW, (t0), 0}
    int ph = 0;
#define PH_ON (ph >= a.ph_lo && ph < a.ph_hi)
#define PH_PTRS const int G = opaque_int(G0), vcu = opaque_int(vcu0), wv = opaque_int(wv0); (void)G; (void)vcu; unsigned char* ws = opaque_ptr(a.ws); unsigned char* dout = opaque_ptr(a.dout); (void)ws; (void)dout; const int tid = tid_of(wv), lane = tid & 63, wave = wv; (void)lane; (void)wave;
#define PH_END do { if (PH_ON && ph + 1 < a.ph_hi) xcd_barrier(bar, tid_of(opaque_int(wv0)) == 0); ++ph; } while (0)
#define GEMM(EpiT, gm, ep) do { pg8::StaticOrder S_; S_.init((gm).M, (gm).N, G, vcu); pg8::gemm_phase<EpiT, pg8::StaticOrder, true, true>(lds, gm, S_, ep, wv); } while (0)

    if (PH_ON) { PH_PTRS ph_prologue(in, ws, lds, vcu, G, wv);
        LAS float* scr = (LAS float*)(lds + wave * 16384);
#pragma nounroll
        for (int it = vcu * 8 + wave; it < DEPTH * NE * 384; it += G * 8) conv_expert_item(in, ws, it, scr, lane);
        conv_router(in, ws, vcu, G, tid); }
    PH_END;

#pragma nounroll
    for (int l = 0; l < DEPTH; ++l) {
        if (PH_ON) { PH_PTRS
            if (l == 0) {
#pragma nounroll
                for (int l2 = 0; l2 < DEPTH; ++l2) {
                    const bf16_t* Wkv = (const bf16_t*)(WD(l2) + WD_WXKV);
                    { const pg8::Gemm g{MEMN, Wkv, NB * NMEM, D, D, D, D, 0}; const EpiScale e{KVB + (size_t)l2 * 2 * NB * NMEM * D, nullptr, D, 1.0f}; GEMM(EpiScale, g, e); }
                    { const pg8::Gemm g{Wkv + (size_t)D * D, MEMN, D, NB * NMEM, D, D, D, 0}; const EpiScale e{KVB + (size_t)l2 * 2 * NB * NMEM * D + (size_t)NB * NMEM * D, nullptr, NB * NMEM, 1.0f}; GEMM(EpiScale, g, e); }
                }
            }
            { const pg8::Gemm g{XN, (const bf16_t*)(WD(l) + WD_WIN), T, NPROJ_A, D, D, D, 0}; const EpiProj e = MK_EP(l, 0); GEMM(EpiProj, g, e); }
            { const pg8::Gemm g{(const bf16_t*)(WD(l) + WD_WIN) + (size_t)NPROJ_A * D, XN, NPROJ_V, T, D, D, D, 0}; const EpiScale e{AVT, nullptr, T, 1.0f}; GEMM(EpiScale, g, e); }
        }
        PH_END;
        if (PH_ON) { PH_PTRS
            LAS float* Rt = (LAS float*)lds;
            band_tables(in.rel_bias + (size_t)l * AH * RELW, Rt, tid);
            __syncthreads();
            if (wave < 4) {
                LAS float* Gt = (LAS float*)(lds + 32768 + wave * 16384);
#pragma nounroll
                for (int it = vcu * 4 + wave; it < NB * BH * NCH; it += G * 4) gla1_item(it, lane, Gt, BK, BVT, LOGA, DSF, DEC);
            }
#pragma nounroll
            for (int it = vcu * 8 + wave; it < NB * AH * NCH; it += G * 8) band_item(it, lane, AQ, AK, AVT, Rt, OAB);
        }
        PH_END;
        if (PH_ON) { PH_PTRS
            for (int e2 = vcu * 512 + tid; e2 < NB * BH * 128 * 64; e2 += G * 512) gla2_scan(e2, DSF, DEC, SBB);
        }
        PH_END;
        if (PH_ON) { PH_PTRS
            LAS float* Gt = (LAS float*)(lds + wave * 16384);
#pragma nounroll
            for (int un = vcu * 8 + wave; un < 2 * NB * BH * NCH; un += G * 8) gla3_unit(un, lane, Gt, BQ, BK, BVT, LOGA, SBB, BRS, in.gla_norm_g + (size_t)l * 128, OAB);
        }
        PH_END;
        if (PH_ON) { PH_PTRS
            const pg8::Gemm g{XN, (const bf16_t*)(WD(l) + WD_WIN) + (size_t)(NPROJ_A + NPROJ_V) * D, T, NPROJ_B, D, D, D, 0}; const EpiProj e = MK_EP(l, 9);
            GEMM(EpiProj, g, e);
        }
        PH_END;
        if (PH_ON) { PH_PTRS
            { const pg8::Gemm g{OAB, (const bf16_t*)(WD(l) + WD_WB), T, D, 512, D, D, 0}; const EpiGate e{GA, nullptr, TMP}; GEMM(EpiGate, g, e); }
            { const pg8::Gemm g{OAB + 512, (const bf16_t*)(WD(l) + WD_WB) + 512, T, D, 512, D, D, 0}; const EpiGate e{GB, TMP, MG}; GEMM(EpiGate, g, e); }
        }
        PH_END;
        if (PH_ON) { PH_PTRS const pg8::Gemm g{MG, (const bf16_t*)(WD(l) + WD_WMO), T, D, D, D, D, 0}; const EpiResid e{XB, SSA(3 * l + 1)}; GEMM(EpiResid, g, e); }
        PH_END;
        if (PH_ON) { PH_PTRS
            pg8::StaticOrder S0; S0.init(T, D, G, vcu); pg8::Unit u;
            const bf16_t* KBl = KVB + (size_t)l * 2 * NB * NMEM * D; const bf16_t* VTl = KBl + (size_t)NB * NMEM * D;
#pragma nounroll
            for (int i = 0; S0.next(i, u); ++i) {
                const int h = u.pn, b = u.pm >> 5; bf16_t* Qh = Q + h * XD;
                { const pg8::Gemm g{XB, (const bf16_t*)(WD(l) + WD_WXQ), T, D, D, D, D, 0}; const FixedOrder F{u.pm, u.pn}; const EpiScale e{Q, SSA(3 * l + 1), D, 0.0625f};
                  pg8::gemm_phase<EpiScale, FixedOrder, true, true>(lds, g, F, e, wv); }
                { const pg8::Gemm g{Qh, KBl + (size_t)(b * NMEM) * D + h * XD, T, XD, XD, D, D, 0}; const FixedOrder F{u.pm, 0}; const EpiSoftmax e{Qh, D, 0};
                  pg8::gemm_phase<EpiSoftmax, FixedOrder, false, true>(lds, g, F, e, wv); }
                asm volatile("s_waitcnt vmcnt(0)" ::: "memory"); __syncthreads();
                { const pg8::Gemm g{Qh, VTl + (size_t)(h * XD) * (NB * NMEM) + b * NMEM, T, XD, XD, D, NB * NMEM, 0}; const FixedOrder F{u.pm, 0}; const EpiScale e{Qh, nullptr, D, 1.0f};
                  pg8::gemm_phase<EpiScale, FixedOrder, true, true>(lds, g, F, e, wv); }
            }
        }
        PH_END;
        if (PH_ON) { PH_PTRS const pg8::Gemm g{Q, (const bf16_t*)(WD(l) + WD_WXO), T, D, D, D, D, 0}; const EpiResid e{XB, SSA(3 * l + 2)}; GEMM(EpiResid, g, e); }
        PH_END;
        if (PH_ON) { PH_PTRS ph_route(in, ws, lds, l, vcu, G, wv); }
        PH_END;
        if (PH_ON) { PH_PTRS ph_gather(ws, l, vcu, G, wv); }
        PH_END;
        if (PH_ON) { PH_PTRS
            const int nt = __builtin_amdgcn_readfirstlane(*(const int*)(ws + WS_SEL + SEL_NT));
            const pg8::Gemm g{(const bf16_t*)(ws + WS_XG), (const bf16_t*)(ws + WS_WEXP + (size_t)l * WEXP_STRIDE), nt * 256, 512, D, D, D, 0};
            GroupedOrder<2> S_; S_.init((const int*)(ws + WS_SEL + SEL_TILE), nt, G, vcu);
            const EpiHid e{(bf16_t*)(ws + WS_HID), (const float*)(ws + WS_SEL + SEL_GW)};
            pg8::gemm_phase<EpiHid, GroupedOrder<2>, true, true>(lds, g, S_, e, wv);
        }
        PH_END;
        if (PH_ON) { PH_PTRS
            const int nt = __builtin_amdgcn_readfirstlane(*(const int*)(ws + WS_SEL + SEL_NT));
            const pg8::Gemm g{(const bf16_t*)(ws + WS_HID), (const bf16_t*)(ws + WS_WEXP + (size_t)l * WEXP_STRIDE + 32 * MiB), nt * 256, D, EF, EF, EF, 0};
            GroupedOrder<4> S_; S_.init((const int*)(ws + WS_SEL + SEL_TILE), nt, G, vcu);
            const EpiY e{(bf16_t*)(ws + WS_XG)};
            pg8::gemm_phase<EpiY, GroupedOrder<4>, true, true>(lds, g, S_, e, wv);
        }
        PH_END;
        if (PH_ON) { PH_PTRS ph_combine(ws, l, vcu, G, (l + 1 < DEPTH) ? XN : nullptr, wv); }
        PH_END;
    }
    if (PH_ON) { PH_PTRS for (int t = vcu * 2 + (tid >> 8); t < T; t += G * 2) d_final((size_t)t, tid & 255, XB, SSA(6), in.final_g, (float*)dout); }
    PH_END;
#undef PH_ON
#undef PH_PTRS
#undef PH_END
#undef GEMM
#undef SS
#undef XB
#undef AQ
#undef AK
#undef AVT
#undef XN
#undef BQ
#undef BK
#undef BVT
#undef BRS
#undef GA
#undef GB
#undef MG
#undef Q
#undef MEMN
#undef KVB
#undef LOGA
#undef OAB
#undef DSF
#undef DEC
#undef SBB
#undef TMP
#undef SELE
#undef SELW
#undef WD
#undef SSA
#undef MK_EP
}

extern "C" void kernel_launch(void* const* d_in, const int* in_sizes, int n_in, void* d_out, int out_size, void* d_ws, size_t ws_size, hipStream_t stream) {
    static int grid = 0;
    if (grid == 0) {
        int dev = 0, cus = 0;
        if (hipGetDevice(&dev) != hipSuccess || hipDeviceGetAttribute(&cus, hipDeviceAttributeMultiprocessorCount, dev) != hipSuccess || cus <= 0) cus = 256;
        grid = cus;
        if (hipFuncSetAttribute((const void*)mk_fwd, hipFuncAttributeMaxDynamicSharedMemorySize, LDS_BYTES) != hipSuccess) fprintf(stderr, "kernel_launch: hipFuncSetAttribute failed\n");
        int per_cu = 0;
        if (hipOccupancyMaxActiveBlocksPerMultiprocessor(&per_cu, (const void*)mk_fwd, 512, LDS_BYTES) != hipSuccess || per_cu < 1) fprintf(stderr, "kernel_launch: occupancy query says %d blocks per CU\n", per_cu);
        (void)hipGetLastError();
        if (ws_size < WS_END || n_in != 24) fprintf(stderr, "kernel_launch: unexpected ws_size %zu / n_in %d\n", ws_size, n_in);
    }
    MKArgs a{};
    { const float** p = (const float**)&a.in; for (int i = 0; i < 24; ++i) p[i] = (const float*)d_in[i]; }
    a.ws = (unsigned char*)d_ws; a.dout = (unsigned char*)d_out;
    (void)hipMemsetAsync((unsigned char*)d_ws + WS_CTL, 0, CTL_ZERO_BYTES, stream);
#if MK_LAUNCHES == 1
    a.ph_lo = 0; a.ph_hi = N_PHASES;
    hipLaunchKernelGGL(mk_fwd, dim3(grid), dim3(512), LDS_BYTES, stream, a);
#else
    for (int p = 0; p < N_PHASES; ++p) { a.ph_lo = p; a.ph_hi = p + 1; hipLaunchKernelGGL(mk_fwd, dim3(grid), dim3(512), LDS_BYTES, stream, a); }
#endif
}
```

```cpp
#include <hip/hip_runtime.h>
#include <cstdint>
#include <cstdio>
#include <cmath>

namespace cfg {
constexpr int D = 1024, NB = 2, L = 8192, T = NB * L, DEPTH = 2;
constexpr int CH = 64, NMEM = 256, NCH = L / CH;
constexpr int AH = 8, AW = 512, ALC = 8, ABAND = 576, AMAXREL = 256, RELW = 2 * AMAXREL + 1;
constexpr int BH = 4, BKW = 256, BVW = 512, BR = 16;
constexpr int INW = 5136;
constexpr int XH = 4, XD = 256;
constexpr int NG = 4, EPG = 8, NE = NG * EPG, EF = 256;
constexpr float EPS = 1e-6f;
constexpr int NPROJ = 5376;
constexpr int NPROJ_A = 9 * 256, NPROJ_V = 4 * 256, NPROJ_B = 8 * 256;

constexpr size_t MiB = 1u << 20;
constexpr size_t WS_CTL = 0, CTL_BYTES = 2 * MiB;
constexpr size_t WS_WDENSE = 2 * MiB, WDENSE_STRIDE = 23 * MiB;
constexpr size_t WD_WIN = 0, WD_WB = 11 * MiB, WD_WMO = 13 * MiB, WD_WXQ = 15 * MiB, WD_WXKV = 17 * MiB, WD_WXO = 21 * MiB;
constexpr size_t WS_WEXP = 48 * MiB, WEXP_STRIDE = 48 * MiB;
constexpr size_t WS_XB = 144 * MiB;
constexpr size_t WS_XN = 176 * MiB;
constexpr size_t WS_MIX = 208 * MiB;
constexpr size_t WS_AQ = WS_MIX, WS_AK = WS_MIX + 16 * MiB, WS_AVT = WS_MIX + 32 * MiB, WS_BVT = WS_MIX + 48 * MiB, WS_BQ = WS_MIX + 64 * MiB, WS_BK = WS_MIX + 72 * MiB,
                 WS_BRS = WS_MIX + 80 * MiB, WS_LOGA = WS_MIX + 96 * MiB;
constexpr size_t WS_SB = WS_AQ;
constexpr size_t WS_GA = WS_MIX + 16 * MiB, WS_TMP = WS_MIX + 48 * MiB, WS_MG = WS_MIX + 80 * MiB;
constexpr size_t WS_Q = WS_MIX;
constexpr size_t WS_XG = WS_MIX, WS_HID = WS_MIX + 80 * MiB;
constexpr size_t WS_MEMN = 320 * MiB, WS_KVB = 321 * MiB;
constexpr size_t WS_SEL = 325 * MiB;
constexpr size_t WS_SSP = 326 * MiB;
constexpr size_t WS_DEC = 333 * MiB + 512 * 1024;
constexpr size_t WS_WR = 333 * MiB;
constexpr size_t WS_END = 334 * MiB;
constexpr size_t DO_OAB = 0, DO_ST = 32 * MiB, DO_GB = 32 * MiB;
}
using namespace cfg;

#define LAS __attribute__((address_space(3)))
typedef unsigned short bf16_t;
typedef float f32x4 __attribute__((ext_vector_type(4)));
typedef unsigned u32x4 __attribute__((ext_vector_type(4)));
typedef unsigned u32x2 __attribute__((ext_vector_type(2)));

__device__ __forceinline__ float bf2f(unsigned short b) { return __uint_as_float((unsigned)b << 16); }
__device__ __forceinline__ float bflo(unsigned w) { return __uint_as_float(w << 16); }
__device__ __forceinline__ float bfhi(unsigned w) { return __uint_as_float(w & 0xffff0000u); }
__device__ __forceinline__ unsigned pkbf(float lo, float hi) { unsigned r; asm volatile("v_cvt_pk_bf16_f32 %0, %1, %2" : "=v"(r) : "v"(lo), "v"(hi)); return r; }
__device__ __forceinline__ unsigned short f2bf(float f) { return (unsigned short)(pkbf(f, 0.f) & 0xffffu); }
__device__ __forceinline__ float fsigmoid(float x) { return __builtin_amdgcn_rcpf(1.0f + __expf(-x)); }
__device__ __forceinline__ float fsilu(float x) { return x * fsigmoid(x); }
__device__ __forceinline__ float flogsigmoid(float x) { return fminf(x, 0.f) - __logf(1.0f + __expf(-fabsf(x))); }
template <int MASK> __device__ __forceinline__ float swz_xor(float v) { return __int_as_float(__builtin_amdgcn_ds_swizzle(__float_as_int(v), (MASK << 10) | 0x1f)); }
__device__ __forceinline__ float add_xor32(float v) { const auto r = __builtin_amdgcn_permlane32_swap(__float_as_uint(v), __float_as_uint(v), false, false); return __uint_as_float(r[0]) + __uint_as_float(r[1]); }
__device__ __forceinline__ float max_xor32(float v) { const auto r = __builtin_amdgcn_permlane32_swap(__float_as_uint(v), __float_as_uint(v), false, false); return fmaxf(__uint_as_float(r[0]), __uint_as_float(r[1])); }
__device__ __forceinline__ float add_xor16(float v) { return v + swz_xor<16>(v); }
__device__ __forceinline__ float wave_sum(float v) { v += swz_xor<1>(v); v += swz_xor<2>(v); v += swz_xor<4>(v); v += swz_xor<8>(v); v += swz_xor<16>(v); return add_xor32(v); }
__device__ __forceinline__ float wave_max(float v) { v = fmaxf(v, swz_xor<1>(v)); v = fmaxf(v, swz_xor<2>(v)); v = fmaxf(v, swz_xor<4>(v)); v = fmaxf(v, swz_xor<8>(v)); v = fmaxf(v, swz_xor<16>(v)); return max_xor32(v); }
__device__ __forceinline__ int shfl_idx(int v, int src_lane) { return __builtin_amdgcn_ds_bpermute(src_lane << 2, v); }
__device__ __forceinline__ unsigned char* opaque_ptr(unsigned char* p) { asm volatile("" : "+s"(p)); return p; }
__device__ __forceinline__ int lane_now() { unsigned z; asm volatile("v_mov_b32 %0, 0" : "=v"(z)); return (int)__builtin_amdgcn_mbcnt_hi(~0u, __builtin_amdgcn_mbcnt_lo(~0u, z)); }
__device__ __forceinline__ int opaque_int(int v) { asm volatile("" : "+s"(v)); return v; }
__device__ __forceinline__ int tid_of(int wv) { return (wv << 6) | lane_now(); }
__device__ __forceinline__ void st16_wt(void* p, const u32x4 v) { asm volatile("global_store_dwordx4 %0, %1, off sc1\n\ts_nop 1" :: "v"(p), "v"(v) : "memory"); }
#ifndef MK_WT
#define MK_WT 0
#endif
#if MK_WT
#define ST16_OUT(p, v) st16_wt((void*)(p), (v))
#else
#define ST16_OUT(p, v) (*(u32x4*)(p) = (v))
#endif
namespace pg8 {
#define PG8_LAS __attribute__((address_space(3)))
typedef unsigned short bf16_t;
typedef short bf16x8 __attribute__((ext_vector_type(8)));
typedef float f32x4 __attribute__((ext_vector_type(4)));
typedef unsigned u32x4 __attribute__((ext_vector_type(4)));
constexpr int BM = 256, BK = 64, HALF = 128, HTB = HALF * BK * 2  , STAGE_BYTES = 8 * HTB, NXCD = 8, WGM = 8;

__host__ __device__ __forceinline__ int lds_byte(int r, int c) { const int st = (r >> 4) * 2 + (c >> 5), rr = r & 15, cc = c & 31, ob = rr * 64 + cc * 2; return st * 1024 + (ob ^ (((ob >> 9) & 1) << 5)); }
__host__ __device__ __forceinline__ void stage_rc(int b, int& R, int& C) { const int st = b / 1024, sb = b % 1024, swz = sb ^ (((sb >> 9) & 1) << 5); R = (st >> 1) * 16 + swz / 64; C = (st & 1) * 32 + (swz % 64) / 2; }
__host__ __device__ __forceinline__ int perm32(int rho) { const int n = rho >> 4, i = rho & 15; return 8 * (i >> 2) + 4 * n + (i & 3); }

struct Unit { int pm, pn; };
struct Gemm { const bf16_t* A; const bf16_t* Bt; int M, N, K, lda, ldb, pad; };

struct StaticOrder {
    int nM, nN, nwg, G, c;
    __host__ __device__ __forceinline__ void init(int M, int N, int G_, int c_) { nM = M / BM; nN = N / BM; nwg = nM * nN; G = G_; c = c_; }
    __host__ __device__ __forceinline__ bool next(int i, Unit& u) const {
        const long L = (long)i * G + c; if (L >= nwg) return false;
        int wgid = (int)L; { const int q = nwg / NXCD, r = nwg % NXCD, xcd = wgid % NXCD, off = wgid / NXCD; wgid = (xcd < r ? xcd * (q + 1) : r * (q + 1) + (xcd - r) * q) + off; }
        const int nig = WGM * nN, gid = wgid / nig, fm = gid * WGM, gsz = (nM - fm) < WGM ? (nM - fm) : WGM;
        u.pm = fm + ((wgid % nig) % gsz); u.pn = (wgid % nig) / gsz; return true;
    }
    __device__ __forceinline__ void a_ready(const Unit&) const {}
    __device__ __forceinline__ void done(const Unit&) const {}
};


template <class Epi, class Sched, bool ALIGN_EPI = false, bool SP2 = false>
__device__ __forceinline__ void gemm_phase(PG8_LAS unsigned char* lds, const Gemm g, const Sched& S, const Epi& E, const int wv  ) {
    const int tid = tid_of(wv), wid = wv, lane = tid & 63, wr = wid >> 2, wc = wid & 3, fr = lane & 15, fq = lane >> 4;
    const int K = g.K, nt = K / BK;
    unsigned voffA[2], voffB[2];
#pragma unroll
    for (int i = 0; i < 2; ++i) { int R, C; stage_rc(tid * 16 + i * 8192, R, C); const int Rb = Epi::PERM ? ((R & ~31) + perm32(R & 31)) : R;
        voffA[i] = (unsigned)(R * g.lda + C) * 2u; voffB[i] = (unsigned)(Rb * g.ldb + C) * 2u; }
    const size_t kstep = (size_t)(BK * 2);
    const size_t hstepA = (size_t)HALF * g.lda * 2, hstepB = (size_t)HALF * g.ldb * 2;
    const size_t tstepA = 2 * hstepA, tstepB = 2 * hstepB;
    const unsigned ldsw = (unsigned)wid * 1024u;
    const int aoff = lds_byte(wr * 64 + fr, fq * 8), boff = lds_byte(wc * 32 + fr, fq * 8);
#define PG8_SA(b, h) (((b) * 2 + (h)) * HTB)
#define PG8_SB(b, h) ((4 + (b) * 2 + (h)) * HTB)
#define PG8_STAGE(bufoff, gbase, voff) do { _Pragma("unroll") for (int _i = 0; _i < 2; ++_i) \
        __builtin_amdgcn_global_load_lds((const unsigned*)((const char*)(gbase) + (voff)[_i]), (PG8_LAS unsigned*)(lds + (bufoff) + ldsw + _i * 8192), 16, 0, 0); } while (0)
#define PG8_LDA(dst, b, h) do { _Pragma("unroll") for (int m = 0; m < 4; ++m) _Pragma("unroll") for (int k = 0; k < 2; ++k) dst[m][k] = *(const PG8_LAS bf16x8*)(lds + PG8_SA(b, h) + aoff + m * 2048 + k * 1024); } while (0)
#define PG8_LDB(dst, b, h) do { _Pragma("unroll") for (int n = 0; n < 2; ++n) _Pragma("unroll") for (int k = 0; k < 2; ++k) dst[n][k] = *(const PG8_LAS bf16x8*)(lds + PG8_SB(b, h) + boff + n * 2048 + k * 1024); } while (0)
#define PG8_MMA(ai, bj, At, Bt) do { __builtin_amdgcn_s_setprio(1); _Pragma("unroll") for (int m = 0; m < 4; ++m) _Pragma("unroll") for (int n = 0; n < 2; ++n) _Pragma("unroll") for (int k = 0; k < 2; ++k) \
        acc[ai][bj][m][n] = __builtin_amdgcn_mfma_f32_16x16x32_bf16(Bt[n][k], At[m][k], acc[ai][bj][m][n], 0, 0, 0); __builtin_amdgcn_s_setprio(0); } while (0)
#define PG8_WAIT_V(n) asm volatile("s_waitcnt vmcnt(" #n ")" ::: "memory")
#define PG8_WAIT_L(n) asm volatile("s_waitcnt lgkmcnt(" #n ")" ::: "memory")
#define PG8_BAR __builtin_amdgcn_s_barrier()
#define PG8_SCHED __builtin_amdgcn_sched_barrier(0)
    Unit cur, nxt; int ui = 0;
    if (!S.next(0, cur)) return;
    f32x4 acc[2][2][4][2];
#pragma unroll
    for (int a = 0; a < 2; ++a)
#pragma unroll
        for (int b = 0; b < 2; ++b)
#pragma unroll
            for (int m = 0; m < 4; ++m)
#pragma unroll
                for (int n = 0; n < 2; ++n) acc[a][b][m][n] = (f32x4){0.f, 0.f, 0.f, 0.f};
    bf16x8 At[4][2], B0[2][2], B1[2][2];
    const char* cA = (const char*)g.A + (size_t)cur.pm * tstepA; const char* cB = (const char*)g.Bt + (size_t)cur.pn * tstepB;
    S.a_ready(cur);
    if constexpr (SP2) {
        PG8_STAGE(PG8_SB(0, 0), cB, voffB); PG8_STAGE(PG8_SB(0, 1), cB + hstepB, voffB); PG8_STAGE(PG8_SA(0, 0), cA, voffA); PG8_STAGE(PG8_SA(0, 1), cA + hstepA, voffA);
        if (wr == 1) PG8_BAR;
        PG8_WAIT_V(2); PG8_BAR;
        PG8_STAGE(PG8_SB(1, 0), cB + kstep, voffB); PG8_STAGE(PG8_SA(1, 0), cA + kstep, voffA); PG8_STAGE(PG8_SB(1, 1), cB + hstepB + kstep, voffB);
        PG8_WAIT_V(6); PG8_BAR;
    } else {
        PG8_STAGE(PG8_SB(0, 0), cB, voffB); PG8_STAGE(PG8_SA(0, 0), cA, voffA); PG8_STAGE(PG8_SB(0, 1), cB + hstepB, voffB); PG8_STAGE(PG8_SA(0, 1), cA + hstepA, voffA);
        if (wr == 1) PG8_BAR;
        PG8_WAIT_V(4); PG8_BAR;
        PG8_STAGE(PG8_SB(1, 0), cB + kstep, voffB); PG8_STAGE(PG8_SA(1, 0), cA + kstep, voffA); PG8_STAGE(PG8_SB(1, 1), cB + hstepB + kstep, voffB);
        PG8_WAIT_V(6); PG8_BAR;
    }
    for (;;) {
        const bool has_next = S.next(ui + 1, nxt);
        const char* nA = has_next ? (const char*)g.A + (size_t)nxt.pm * tstepA : cA; const char* nB = has_next ? (const char*)g.Bt + (size_t)nxt.pn * tstepB : cB;
        for (int t = 0; t < nt; t += 2) {
            const bool last = (t == nt - 2);
            const char* a1 = cA + (size_t)(t + 1) * kstep;
            const char* a2 = last ? nA : cA + (size_t)(t + 2) * kstep; const char* b2 = last ? nB : cB + (size_t)(t + 2) * kstep;
            const char* a3 = a2 + kstep; const char* b3 = b2 + kstep;
            if (last && has_next) S.a_ready(nxt);
            if constexpr (SP2) {
            PG8_LDB(B0, 0, 0); PG8_LDB(B1, 0, 1); PG8_SCHED; PG8_LDA(At, 0, 0); PG8_STAGE(PG8_SA(1, 1), a1 + hstepA, voffA);
            PG8_WAIT_V(8); PG8_WAIT_L(0); PG8_BAR; PG8_MMA(0, 0, At, B0); PG8_MMA(0, 1, At, B1); PG8_BAR; PG8_SCHED;
            PG8_LDA(At, 0, 1); PG8_STAGE(PG8_SB(0, 0), b2, voffB); PG8_STAGE(PG8_SB(0, 1), b2 + hstepB, voffB); PG8_STAGE(PG8_SA(0, 0), a2, voffA);
            PG8_WAIT_V(8); PG8_WAIT_L(0); PG8_BAR; PG8_MMA(1, 0, At, B0); PG8_MMA(1, 1, At, B1); PG8_BAR; PG8_SCHED;
            PG8_LDB(B0, 1, 0); PG8_LDB(B1, 1, 1); PG8_SCHED; PG8_LDA(At, 1, 0); PG8_STAGE(PG8_SA(0, 1), a2 + hstepA, voffA);
            PG8_WAIT_V(8); PG8_WAIT_L(0); PG8_BAR; PG8_MMA(0, 0, At, B0); PG8_MMA(0, 1, At, B1); PG8_BAR; PG8_SCHED;
            PG8_LDA(At, 1, 1); PG8_STAGE(PG8_SB(1, 0), b3, voffB); PG8_STAGE(PG8_SB(1, 1), b3 + hstepB, voffB); PG8_STAGE(PG8_SA(1, 0), a3, voffA);
            PG8_WAIT_V(8); PG8_WAIT_L(0); PG8_BAR; PG8_MMA(1, 0, At, B0); PG8_MMA(1, 1, At, B1); PG8_BAR; PG8_SCHED;
            } else {
            PG8_LDB(B0, 0, 0); PG8_SCHED; PG8_LDA(At, 0, 0); PG8_STAGE(PG8_SA(1, 1), a1 + hstepA, voffA);
            PG8_WAIT_L(8); PG8_BAR; PG8_WAIT_L(0); PG8_MMA(0, 0, At, B0); PG8_BAR; PG8_SCHED;
            PG8_LDB(B1, 0, 1); PG8_STAGE(PG8_SB(0, 0), b2, voffB);
            PG8_BAR; PG8_WAIT_L(0); PG8_MMA(0, 1, At, B1); PG8_BAR;
            PG8_LDA(At, 0, 1); PG8_STAGE(PG8_SA(0, 0), a2, voffA);
            PG8_BAR; PG8_WAIT_L(0); PG8_MMA(1, 0, At, B0); PG8_BAR; PG8_SCHED;
            PG8_STAGE(PG8_SB(0, 1), b2 + hstepB, voffB);
            PG8_WAIT_V(6); PG8_BAR; PG8_MMA(1, 1, At, B1); PG8_BAR;
            PG8_LDB(B0, 1, 0); PG8_SCHED; PG8_LDA(At, 1, 0); PG8_STAGE(PG8_SA(0, 1), a2 + hstepA, voffA);
            PG8_WAIT_L(8); PG8_BAR; PG8_WAIT_L(0); PG8_MMA(0, 0, At, B0); PG8_BAR; PG8_SCHED;
            PG8_LDB(B1, 1, 1); PG8_STAGE(PG8_SB(1, 0), b3, voffB);
            PG8_BAR; PG8_WAIT_L(0); PG8_MMA(0, 1, At, B1); PG8_BAR;
            PG8_LDA(At, 1, 1); PG8_STAGE(PG8_SA(1, 0), a3, voffA);
            PG8_BAR; PG8_WAIT_L(0); PG8_MMA(1, 0, At, B0); PG8_BAR; PG8_SCHED;
            PG8_STAGE(PG8_SB(1, 1), b3 + hstepB, voffB);
            PG8_WAIT_V(6); PG8_BAR; PG8_MMA(1, 1, At, B1); PG8_BAR;
            }
        }
        if constexpr (ALIGN_EPI) { if (wr == 0) PG8_BAR; }
        if constexpr (!Epi::AFTER_DRAIN) { const int le_ = lane_now(); E(acc, cur, wr, wc, le_ & 15, le_ >> 4); S.done(cur); }
        if (!has_next) break;
#pragma unroll
        for (int a = 0; a < 2; ++a)
#pragma unroll
            for (int b = 0; b < 2; ++b)
#pragma unroll
                for (int m = 0; m < 4; ++m)
#pragma unroll
                    for (int n = 0; n < 2; ++n) acc[a][b][m][n] = (f32x4){0.f, 0.f, 0.f, 0.f};
        cur = nxt; cA = nA; cB = nB; ++ui;
        if constexpr (ALIGN_EPI) { if (wr == 1) PG8_BAR; }
    }
    PG8_WAIT_V(0);
    if constexpr (!ALIGN_EPI) { if (wr == 0) PG8_BAR; }
    PG8_BAR;
    if constexpr (Epi::AFTER_DRAIN) { const int le_ = lane_now(); E.fused(acc, cur, wr, wc, le_ & 15, le_ >> 4, lds, wid, le_); S.done(cur); }
#undef PG8_SA
#undef PG8_SB
#undef PG8_STAGE
#undef PG8_LDA
#undef PG8_LDB
#undef PG8_MMA
#undef PG8_WAIT_V
#undef PG8_WAIT_L
#undef PG8_BAR
#undef PG8_SCHED
}
}
#define XB_TMO      128
#define XB_XCNT(j)  (256  + 64 * (j))
#define XB_XSUB(j)  (1280 + 64 * (j))
#define XB_XGEN(j)  (2304 + 64 * (j))
#define XB_TOP      3328
#define XB_TOPGEN   3392
#define XCD_BAR_WORDS 3456
#define XB_SPIN_CAP (1u << 18)

__device__ __forceinline__ unsigned xb_ld(unsigned* p)              { return __hip_atomic_load(p, __ATOMIC_RELAXED, __HIP_MEMORY_SCOPE_AGENT); }
__device__ __forceinline__ unsigned xb_add(unsigned* p, unsigned v) { return __hip_atomic_fetch_add(p, v, __ATOMIC_RELAXED, __HIP_MEMORY_SCOPE_AGENT); }
__device__ __forceinline__ unsigned xb_xcc_id() { return (unsigned)__builtin_amdgcn_s_getreg((3 << 11) | 20) & 0xFu; }
#define XB_SPIN(cond, bar) do { unsigned _sp = 0; while (cond) { __builtin_amdgcn_s_sleep(1); \
    if ((++_sp & 255u) == 0u) { if (xb_ld(&(bar)[XB_TMO])) break; if (_sp > XB_SPIN_CAP) { atomicAdd(&(bar)[XB_TMO], 1u); break; } } } } while (0)

struct XcdBarrier {
    unsigned* bar; unsigned x;
    volatile LAS unsigned* st;
};

__device__ __forceinline__ XcdBarrier xcd_barrier_post(unsigned* bar, volatile LAS unsigned* st) {
    XcdBarrier b; b.bar = bar; b.x = xb_xcc_id(); b.st = st;
    if (threadIdx.x == 0) (void)xb_add(&bar[XB_XCNT(b.x)], 1u);
    return b;
}
__device__ __forceinline__ void xcd_barrier_complete(unsigned* bar, unsigned x, unsigned& nloc, unsigned& nx) {
    const unsigned G = gridDim.x * gridDim.y * gridDim.z;
    unsigned sum, cnt, mine, sp = 0u;
    for (;;) {
        sum = 0u; cnt = 0u; mine = 0u;
#pragma unroll
        for (unsigned j = 0; j < 16; ++j) { const unsigned c = xb_ld(&bar[XB_XCNT(j)]); sum += c; cnt += (c > 0u) ? 1u : 0u; }
        if (sum == G) { mine = xb_ld(&bar[XB_XCNT(x)]); break; }
        __builtin_amdgcn_s_sleep(1);
        if ((++sp & 255u) == 0u) { if (xb_ld(&bar[XB_TMO])) break; if (sp > XB_SPIN_CAP) { atomicAdd(&bar[XB_TMO], 1u); break; } }
    }
    nloc = mine > 0u ? mine : 1u; nx = cnt > 0u ? cnt : 1u;
}

__device__ __forceinline__ void xcd_barrier(const XcdBarrier& b, const bool t0  ) {
    asm volatile("s_waitcnt vmcnt(0)" ::: "memory");
    __syncthreads();
    if (t0) {
        unsigned* bar = (unsigned*)opaque_ptr((unsigned char*)b.bar);
        __builtin_amdgcn_s_waitcnt(0);
        unsigned nloc = b.st[0], nx = b.st[1];
        if (nloc == 0u) { xcd_barrier_complete(bar, b.x, nloc, nx); b.st[0] = nloc; b.st[1] = nx; }
        const unsigned old = xb_add(&bar[XB_XSUB(b.x)], 1u);
        const unsigned gen = old / nloc;
        if (old + 1u == (gen + 1u) * nloc) {
            __builtin_amdgcn_fence(__ATOMIC_RELEASE, "agent");
            asm volatile("s_waitcnt vmcnt(0)" ::: "memory");
            const unsigned og = xb_add(&bar[XB_TOP], 1u);
            const unsigned tg = og / nx;
            if (og + 1u == (tg + 1u) * nx) xb_add(&bar[XB_TOPGEN], 1u);
            else XB_SPIN(xb_ld(&bar[XB_TOPGEN]) == tg, bar);
            __builtin_amdgcn_fence(__ATOMIC_ACQUIRE, "agent");
            xb_add(&bar[XB_XGEN(b.x)], 1u);
            asm volatile("s_waitcnt vmcnt(0)" ::: "memory");
        } else {
            XB_SPIN(xb_ld(&bar[XB_XGEN(b.x)]) == gen, bar);
            __builtin_amdgcn_fence(__ATOMIC_ACQUIRE, "agent");
            asm volatile("s_waitcnt vmcnt(0)" ::: "memory");
        }
    }
    __syncthreads();
}

__device__ __forceinline__ void panel_sync(unsigned* cnt, unsigned target, const bool t0) {
    asm volatile("s_waitcnt vmcnt(0)" ::: "memory");
    __syncthreads();
    if (t0) {
        __builtin_amdgcn_s_waitcnt(0);
#if !MK_WT
        __builtin_amdgcn_fence(__ATOMIC_RELEASE, "agent");
        asm volatile("s_waitcnt vmcnt(0)" ::: "memory");
#endif
        (void)xb_add(cnt, 1u);
        unsigned sp = 0;
        while (xb_ld(cnt) < target) { __builtin_amdgcn_s_sleep(1); if (++sp > (1u << 20)) break; }
        __builtin_amdgcn_fence(__ATOMIC_ACQUIRE, "agent");
        asm volatile("s_waitcnt vmcnt(0)" ::: "memory");
    }
    __syncthreads();
}
typedef pg8::f32x4 A4;
#define EPI_ROWS_BEGIN _Pragma("unroll") for (int ai = 0; ai < 2; ++ai) _Pragma("unroll") for (int m = 0; m < 4; ++m) { const int row = u.pm * 256 + ai * 128 + wr * 64 + m * 16 + fr;
#define EPI_ROWS_END }
__device__ __forceinline__ float rstd_of(const float* ss, int row, int fq) {
    if (!ss) return 1.0f;
    const f32x4 p = *(const f32x4*)(ss + (size_t)row * 16 + fq * 4);
    float s = (p[0] + p[1]) + (p[2] + p[3]);
    s = add_xor32(add_xor16(s));
    return rsqrtf(s * (1.0f / D) + EPS);
}
__device__ __forceinline__ float rstd_row(const float* ss, size_t row) {
    const f32x4* p = (const f32x4*)(ss + row * 16); float s = 0.f;
#pragma unroll
    for (int i = 0; i < 4; ++i) { const f32x4 v = p[i]; s += (v[0] + v[1]) + (v[2] + v[3]); }
    return rsqrtf(s * (1.0f / D) + EPS);
}
__device__ __forceinline__ u32x4 pack8(const A4& a, const A4& b) { u32x4 w; w.x = pkbf(a[0], a[1]); w.y = pkbf(a[2], a[3]); w.z = pkbf(b[0], b[1]); w.w = pkbf(b[2], b[3]); return w; }
__device__ __forceinline__ void unpack8(const u32x4& w, A4& a, A4& b) { a[0] = bflo(w.x); a[1] = bfhi(w.x); a[2] = bflo(w.y); a[3] = bfhi(w.y); b[0] = bflo(w.z); b[1] = bfhi(w.z); b[2] = bflo(w.w); b[3] = bfhi(w.w); }

struct EpiScale {
    static constexpr bool PERM = true, AFTER_DRAIN = false;
    bf16_t* O; const float* ss; int ld; float scale; int wt, pad;
    __device__ __forceinline__ void operator()(const A4 (&acc)[2][2][4][2], const pg8::Unit& u, int wr, int wc, int fr, int fq) const {
        const int col0 = u.pn * 256 + wc * 32 + 8 * fq;
        EPI_ROWS_BEGIN
            const float s = rstd_of(ss, row, fq) * scale;
#pragma unroll
            for (int bj = 0; bj < 2; ++bj) { const u32x4 w = pack8(acc[ai][bj][m][0] * s, acc[ai][bj][m][1] * s); bf16_t* p = O + (size_t)row * ld + col0 + bj * 128; if (wt) ST16_OUT(p, w); else *(u32x4*)p = w; }
        EPI_ROWS_END
    }
};

struct EpiProj {
    static constexpr bool PERM = true, AFTER_DRAIN = false;
    bf16_t *AQ, *AK, *BQ, *BK, *BRS, *GA, *GB; float* LOGA; const float* balpha; int tile0, pad;
    __device__ __forceinline__ void operator()(const A4 (&acc)[2][2][4][2], const pg8::Unit& u, int wr, int wc, int fr, int fq) const {
        const int tile = u.pn + tile0;
        bf16_t* dst; int ld, c0, mode = 0; float sc = 1.f;
        if (tile < 2) { dst = AQ; ld = 512; c0 = tile * 256; sc = 0.125f * 1.4426950408889634f; }
        else if (tile < 4) { dst = AK; ld = 512; c0 = (tile - 2) * 256; }
        else if (tile == 4) { dst = BQ; ld = 256; c0 = 0; sc = 0.125f; }
        else if (tile == 5) { dst = BK; ld = 256; c0 = 0; }
        else if (tile < 8) { dst = BRS; ld = 512; c0 = (tile - 6) * 256; mode = 1; }
        else if (tile == 8) { dst = nullptr; ld = 256; c0 = 0; mode = 3; }
        else if (tile < 13) { dst = GA; ld = 1024; c0 = (tile - 9) * 256; mode = 2; }
        else { dst = GB; ld = 1024; c0 = (tile - 13) * 256; mode = 2; }
        const int cl = wc * 32 + 8 * fq;
        EPI_ROWS_BEGIN
#pragma unroll
            for (int bj = 0; bj < 2; ++bj) {
                A4 v0 = acc[ai][bj][m][0] * sc, v1 = acc[ai][bj][m][1] * sc;
                const int c = cl + bj * 128;
                if (mode == 3) {
                    const A4 b0 = *(const A4*)(balpha + c), b1 = *(const A4*)(balpha + c + 4);
#pragma unroll
                    for (int i = 0; i < 4; ++i) { v0[i] = flogsigmoid(v0[i] + b0[i]) * 0.0625f; v1[i] = flogsigmoid(v1[i] + b1[i]) * 0.0625f; }
                    float* o = LOGA + (size_t)row * 256 + c; *(A4*)o = v0; *(A4*)(o + 4) = v1;
                } else {
                    if (mode == 1) {
#pragma unroll
                        for (int i = 0; i < 4; ++i) { v0[i] = fsilu(v0[i]); v1[i] = fsilu(v1[i]); }
                    } else if (mode == 2) {
#pragma unroll
                        for (int i = 0; i < 4; ++i) { v0[i] = fsigmoid(v0[i]); v1[i] = fsigmoid(v1[i]); }
                    }
                    { const u32x4 w = pack8(v0, v1); bf16_t* p = dst + (size_t)row * ld + c0 + c; if (mode == 2) *(u32x4*)p = w; else ST16_OUT(p, w); }
                }
            }
        EPI_ROWS_END
    }
};

struct EpiGate {
    static constexpr bool PERM = true, AFTER_DRAIN = false;
    const bf16_t* G; const bf16_t* ADD; bf16_t* O;
    __device__ __forceinline__ void operator()(const A4 (&acc)[2][2][4][2], const pg8::Unit& u, int wr, int wc, int fr, int fq) const {
        const int col0 = u.pn * 256 + wc * 32 + 8 * fq;
        EPI_ROWS_BEGIN
#pragma unroll
            for (int bj = 0; bj < 2; ++bj) {
                const size_t off = (size_t)row * D + col0 + bj * 128;
                A4 g0, g1; unpack8(*(const u32x4*)(G + off), g0, g1);
                A4 v0 = acc[ai][bj][m][0] * g0, v1 = acc[ai][bj][m][1] * g1;
                if (ADD) { A4 a0, a1; unpack8(*(const u32x4*)(ADD + off), a0, a1); v0 += a0; v1 += a1; }
                { const u32x4 w = pack8(v0, v1); if (ADD) ST16_OUT(O + off, w); else *(u32x4*)(O + off) = w; }
            }
        EPI_ROWS_END
    }
};

struct EpiResid {
    static constexpr bool PERM = true, AFTER_DRAIN = false;
    bf16_t* Xo; const bf16_t* X; float* ss_out;
    __device__ __forceinline__ void operator()(const A4 (&acc)[2][2][4][2], const pg8::Unit& u, int wr, int wc, int fr, int fq) const {
        const int col0 = u.pn * 256 + wc * 32 + 8 * fq;
        EPI_ROWS_BEGIN
            float q = 0.f;
#pragma unroll
            for (int bj = 0; bj < 2; ++bj) {
                const size_t off = (size_t)row * D + col0 + bj * 128;
                A4 x0, x1; unpack8(*(const u32x4*)(X + off), x0, x1);
                x0 += acc[ai][bj][m][0]; x1 += acc[ai][bj][m][1];
                q += (x0[0] * x0[0] + x0[1] * x0[1]) + (x0[2] * x0[2] + x0[3] * x0[3]) + (x1[0] * x1[0] + x1[1] * x1[1]) + (x1[2] * x1[2] + x1[3] * x1[3]);
                ST16_OUT(Xo + off, pack8(x0, x1));
            }
            q = add_xor32(add_xor16(q));
            if (fq == 0) __hip_atomic_store(ss_out + (size_t)row * 16 + u.pn * 4 + wc, q, __ATOMIC_RELAXED, __HIP_MEMORY_SCOPE_AGENT);
        EPI_ROWS_END
    }
};

struct ConvRegs { f32x4 v[8]; };
__device__ __forceinline__ void conv_load(ConvRegs& R, const float* __restrict__ W, int ldw, int k0, int n0, int lane) {
#pragma unroll
    for (int i = 0; i < 8; ++i) { const int kk = (lane >> 3) + 8 * i; R.v[i] = __builtin_nontemporal_load((const f32x4*)(W + (size_t)(k0 + kk) * ldw + n0 + (lane & 7) * 4)); }
}
__device__ __forceinline__ void conv_store(const ConvRegs& R, const float* __restrict__ gk, bf16_t* __restrict__ WT, int ldt, int k0, int n0, LAS float* scr, int lane) {
#pragma unroll
    for (int i = 0; i < 8; ++i) { const int kk = (lane >> 3) + 8 * i; const float s = gk ? gk[k0 + kk] : 1.0f; LAS float* p = scr + kk * 33 + (lane & 7) * 4;
        p[0] = R.v[i][0] * s; p[1] = R.v[i][1] * s; p[2] = R.v[i][2] * s; p[3] = R.v[i][3] * s; }
    asm volatile("s_waitcnt lgkmcnt(0)" ::: "memory");
    const int c = lane & 7;
#pragma unroll
    for (int j = 0; j < 4; ++j) { const int n = (lane >> 3) + 8 * j; const LAS float* s = scr + (8 * c) * 33 + n;
        u32x4 o; o.x = pkbf(s[0 * 33], s[1 * 33]); o.y = pkbf(s[2 * 33], s[3 * 33]); o.z = pkbf(s[4 * 33], s[5 * 33]); o.w = pkbf(s[6 * 33], s[7 * 33]);
        *(u32x4*)(WT + (size_t)(n0 + n) * ldt + k0 + 8 * c) = o; }
    asm volatile("s_waitcnt lgkmcnt(0)" ::: "memory");
}
__device__ __forceinline__ void conv_item(const float* __restrict__ W, int ldw, const float* __restrict__ gk, bf16_t* __restrict__ WT, int ldt, int k0, int n0, LAS float* scr, int lane) {
    ConvRegs R; conv_load(R, W, ldw, k0, n0, lane); conv_store(R, gk, WT, ldt, k0, n0, scr, lane);
}

struct InPtrs {
    const float *x, *mem, *norm_mix_g, *w_in, *rel_bias, *gla_w_alpha, *gla_b_alpha, *gla_norm_g, *w_branch, *w_mix_out, *norm_x_g, *mem_norm_g, *w_xq, *w_xkv, *w_xo,
                *norm_ffn_g, *w_gr, *b_gr, *w_er, *b_er, *w_eg, *w_eu, *w_ed, *final_g;
};

struct ConvJob { const float* W; const float* gk; bf16_t* WT; int ldw, ldt, K, N; };
__device__ __forceinline__ ConvJob dense_job(const InPtrs& in, unsigned char* ws, int l, int j) {
    unsigned char* wd = ws + WS_WDENSE + (size_t)l * WDENSE_STRIDE;
    const float* Win = in.w_in + (size_t)l * D * INW; bf16_t* WIN_T = (bf16_t*)(wd + WD_WIN);
    const float* gm = in.norm_mix_g + l * D;
    ConvJob J;
    switch (j) {
    case 0: J = {Win + 0, gm, WIN_T + (size_t)0 * D, INW, D, D, 1024}; break;
    case 1: J = {Win + 1024, gm, WIN_T + (size_t)2304 * D, INW, D, D, 512}; break;
    case 2: J = {Win + 1536, gm, WIN_T + (size_t)1024 * D, INW, D, D, 512}; break;
    case 3: J = {Win + 2048, gm, WIN_T + (size_t)2816 * D, INW, D, D, 512}; break;
    case 4: J = {Win + 3088, gm, WIN_T + (size_t)3328 * D, INW, D, D, 2048}; break;
    case 11: J = {Win + 2576, gm, WIN_T + (size_t)1536 * D, INW, D, D, 512}; break;
    case 5: J = {in.w_branch + (size_t)(l * 2 + 0) * 512 * D, nullptr, (bf16_t*)(wd + WD_WB), D, D, 512, D}; break;
    case 6: J = {in.w_branch + (size_t)(l * 2 + 1) * 512 * D, nullptr, (bf16_t*)(wd + WD_WB) + 512, D, D, 512, D}; break;
    case 7: J = {in.w_mix_out + (size_t)l * D * D, nullptr, (bf16_t*)(wd + WD_WMO), D, D, D, D}; break;
    case 8: J = {in.w_xq + (size_t)l * D * D, in.norm_x_g + l * D, (bf16_t*)(wd + WD_WXQ), D, D, D, D}; break;
    case 9: J = {in.w_xkv + (size_t)l * D * 2 * D, nullptr, (bf16_t*)(wd + WD_WXKV), 2 * D, D, D, 2 * D}; break;
    default: J = {in.w_xo + (size_t)l * D * D, nullptr, (bf16_t*)(wd + WD_WXO), D, D, D, D}; break;
    }
    return J;
}

__device__ __forceinline__ void ph_prologue(const InPtrs& in, unsigned char* ws, LAS unsigned char* lds, int vcu, int G, int wv) {
    const int tid = tid_of(wv), lane = tid & 63, wave = wv;
    LAS float* scr = (LAS float*)(lds + wave * 16384);
    const int gw = vcu * 8 + wave, NGW = G * 8;
#pragma nounroll
    for (int lj = 0; lj < DEPTH * 12; ++lj) {
            const int l = lj / 12, j = lj % 12;
            const ConvJob J = dense_job(in, ws, l, j);
            const int nnb = J.N / 32, nit = (J.K / 64) * nnb;
#pragma nounroll
            for (int it = gw; it < nit; it += 2 * NGW) {
                const int it2 = it + NGW; ConvRegs R0, R1;
                conv_load(R0, J.W, J.ldw, (it / nnb) * 64, (it % nnb) * 32, lane);
                if (it2 < nit) conv_load(R1, J.W, J.ldw, (it2 / nnb) * 64, (it2 % nnb) * 32, lane);
                conv_store(R0, J.gk, J.WT, J.ldt, (it / nnb) * 64, (it % nnb) * 32, scr, lane);
                if (it2 < nit) conv_store(R1, J.gk, J.WT, J.ldt, (it2 / nnb) * 64, (it2 % nnb) * 32, scr, lane);
            }
        }
#pragma nounroll
    for (int l = 0; l < DEPTH; ++l) {
        bf16_t* WIN_T = (bf16_t*)(ws + WS_WDENSE + (size_t)l * WDENSE_STRIDE + WD_WIN);
        const float* Win = in.w_in + (size_t)l * D * INW; const float* Wa = in.gla_w_alpha + (size_t)l * BR * BKW; const float* gm = in.norm_mix_g + l * D;
        for (int i = vcu * 512 + tid; i < 256 * D; i += G * 512) {
            const int c = i >> 10, k = i & 1023; float s = 0.f;
#pragma unroll
            for (int r = 0; r < BR; ++r) s += Win[(size_t)k * INW + 2560 + r] * Wa[r * BKW + c];
            WIN_T[(size_t)(2048 + c) * D + k] = f2bf(s * gm[k]);
        }
    }
    bf16_t* XB = (bf16_t*)(ws + WS_XB); bf16_t* XN = (bf16_t*)(ws + WS_XN);
    for (int r = gw; r < T; r += NGW) {
        const float4* xr = (const float4*)(in.x + (size_t)r * D) + lane; float4 v[4]; float s = 0.f;
#pragma unroll
        for (int j = 0; j < 4; ++j) { v[j] = xr[64 * j]; s += v[j].x * v[j].x + v[j].y * v[j].y + v[j].z * v[j].z + v[j].w * v[j].w;
            u32x2 o; o.x = pkbf(v[j].x, v[j].y); o.y = pkbf(v[j].z, v[j].w); *(u32x2*)(XB + (size_t)r * D + (lane + 64 * j) * 4) = o; }
        const float rs = rsqrtf(wave_sum(s) * (1.0f / D) + EPS);
#pragma unroll
        for (int j = 0; j < 4; ++j) { u32x2 o; o.x = pkbf(v[j].x * rs, v[j].y * rs); o.y = pkbf(v[j].z * rs, v[j].w * rs); *(u32x2*)(XN + (size_t)r * D + (lane + 64 * j) * 4) = o; }
    }
    bf16_t* MEMN = (bf16_t*)(ws + WS_MEMN);
    for (int r = gw; r < NB * NMEM; r += NGW) {
        const float4* xr = (const float4*)(in.mem + (size_t)r * D) + lane; float4 v[4]; float s = 0.f;
#pragma unroll
        for (int j = 0; j < 4; ++j) { v[j] = xr[64 * j]; s += v[j].x * v[j].x + v[j].y * v[j].y + v[j].z * v[j].z + v[j].w * v[j].w; }
        const float rs = rsqrtf(wave_sum(s) * (1.0f / D) + EPS);
#pragma unroll
        for (int j = 0; j < 4; ++j) { const float4 g = ((const float4*)in.mem_norm_g)[lane + 64 * j];
            u32x2 o; o.x = pkbf(v[j].x * rs * g.x, v[j].y * rs * g.y); o.y = pkbf(v[j].z * rs * g.z, v[j].w * rs * g.w); *(u32x2*)(MEMN + (size_t)r * D + (lane + 64 * j) * 4) = o; }
    }
}

__device__ __forceinline__ void d_band_attn(int blk, int qi, const bf16_t* __restrict__ AQ, const bf16_t* __restrict__ AK, const bf16_t* __restrict__ AV, const float* __restrict__ rel, bf16_t* __restrict__ OAB) {
    const int n = blk % NCH, h = (blk / NCH) % AH, b = blk / (NCH * AH);
    const size_t qrow = (size_t)(b * L + n * CH + qi);
    float q[64], acc[64];
#pragma unroll
    for (int d = 0; d < 64; d += 8) { const u32x4 w = *(const u32x4*)(AQ + qrow * AW + h * 64 + d);
        q[d] = bflo(w.x); q[d + 1] = bfhi(w.x); q[d + 2] = bflo(w.y); q[d + 3] = bfhi(w.y); q[d + 4] = bflo(w.z); q[d + 5] = bfhi(w.z); q[d + 6] = bflo(w.w); q[d + 7] = bfhi(w.w); }
#pragma unroll
    for (int d = 0; d < 64; ++d) acc[d] = 0.f;
    float m = -INFINITY, l = 0.f;
    for (int j = 0; j < ABAND; ++j) {
        const int kc = n + (j >> 6) - ALC; if (kc < 0) continue;
        const size_t krow = (size_t)(b * L + kc * CH + (j & 63));
        const bf16_t* kp = AK + krow * AW + h * 64; const bf16_t* vp = AV + krow * AW + h * 64;
        float s = 0.f;
#pragma unroll
        for (int d = 0; d < 64; d += 8) { const u32x4 w = *(const u32x4*)(kp + d);
            s += q[d] * bflo(w.x) + q[d + 1] * bfhi(w.x) + q[d + 2] * bflo(w.y) + q[d + 3] * bfhi(w.y) + q[d + 4] * bflo(w.z) + q[d + 5] * bfhi(w.z) + q[d + 6] * bflo(w.w) + q[d + 7] * bfhi(w.w); }
        int relp = (ALC * CH + qi) - j; relp = relp < -AMAXREL ? -AMAXREL : (relp > AMAXREL ? AMAXREL : relp);
        s = s + rel[h * RELW + relp + AMAXREL];
        const float mn = fmaxf(m, s), corr = __expf(m - mn), p = __expf(s - mn);
        l = l * corr + p; m = mn;
#pragma unroll
        for (int d = 0; d < 64; d += 8) { const u32x4 w = *(const u32x4*)(vp + d);
            acc[d] = acc[d] * corr + p * bflo(w.x); acc[d + 1] = acc[d + 1] * corr + p * bfhi(w.x); acc[d + 2] = acc[d + 2] * corr + p * bflo(w.y); acc[d + 3] = acc[d + 3] * corr + p * bfhi(w.y);
            acc[d + 4] = acc[d + 4] * corr + p * bflo(w.z); acc[d + 5] = acc[d + 5] * corr + p * bfhi(w.z); acc[d + 6] = acc[d + 6] * corr + p * bflo(w.w); acc[d + 7] = acc[d + 7] * corr + p * bfhi(w.w); }
    }
    const float inv = 1.0f / l;
#pragma unroll
    for (int d = 0; d < 64; d += 8) { u32x4 o; o.x = pkbf(acc[d] * inv, acc[d + 1] * inv); o.y = pkbf(acc[d + 2] * inv, acc[d + 3] * inv); o.z = pkbf(acc[d + 4] * inv, acc[d + 5] * inv); o.w = pkbf(acc[d + 6] * inv, acc[d + 7] * inv);
        *(u32x4*)(OAB + qrow * D + h * 64 + d) = o; }
}

__device__ __forceinline__ void d_gla(int wv, int item, LAS float* sm  , const bf16_t* __restrict__ BQ, const bf16_t* __restrict__ BK, const bf16_t* __restrict__ BV, const float* __restrict__ LOGA, float* __restrict__ raw) {
    LAS float* sq = sm; LAS float* sk = sm + 128; LAS float* sa = sm + 256;
    const int b = item / BH, h = item % BH, v = tid_of(wv);
    float S[64];
#pragma unroll
    for (int k = 0; k < 64; ++k) S[k] = 0.f;
    for (int t = 0; t < L; ++t) {
        const size_t row = (size_t)(b * L + t); const int bf = (t & 1) * 64;
        float vv = 0.f;
        if (v < 64) { sq[bf + v] = bf2f(BQ[row * BKW + h * 64 + v]); sa[bf + v] = __expf(LOGA[row * BKW + h * 64 + v]); }
        else if (v < 128) { sk[bf + v - 64] = bf2f(BK[row * BKW + h * 64 + (v - 64)]); }
        if (v < 128) vv = bf2f(BV[(size_t)(h * 128 + v) * T + row]);
        __syncthreads();
        if (v < 128) {
            float o = 0.f;
#pragma unroll
            for (int k = 0; k < 64; ++k) { S[k] = sa[bf + k] * S[k] + sk[bf + k] * vv; o += sq[bf + k] * S[k]; }
            raw[row * BVW + h * 128 + v] = o;
        }
    }
}
__device__ __forceinline__ void d_gla_post(int w, int lane, const float* __restrict__ raw, const bf16_t* __restrict__ BRS, const float* __restrict__ g, bf16_t* __restrict__ OAB) {
    const size_t t = w / BH; const int h = w % BH;
    const float* p = raw + t * BVW + h * 128;
    const float a = p[lane], c = p[lane + 64];
    const float rs = rsqrtf(wave_sum(a * a + c * c) * (1.0f / 128.0f) + EPS);
    const bf16_t* br = BRS + t * BVW + h * 128;
    bf16_t* o = OAB + t * D + 512 + h * 128;
    o[lane] = f2bf(a * rs * g[lane] * bf2f(br[lane])); o[lane + 64] = f2bf(c * rs * g[lane + 64] * bf2f(br[lane + 64]));
}

__device__ __forceinline__ void d_xattn(int item, int j, LAS float* sm, bf16_t* QO, const bf16_t* __restrict__ kv) {
    LAS float* qs = sm; LAS float* ps = sm + 256; LAS float* red = sm + 512;
    const size_t t = item / XH; const int h = item % XH, b = (int)(t / L);
    qs[j] = bf2f(QO[t * D + h * XD + j]);
    __syncthreads();
    const bf16_t* kp = kv + (size_t)(b * NMEM + j) * 2048 + h * XD;
    float s = 0.f;
    for (int d = 0; d < XD; d += 8) { const u32x4 w = *(const u32x4*)(kp + d);
        s += qs[d] * bflo(w.x) + qs[d + 1] * bfhi(w.x) + qs[d + 2] * bflo(w.y) + qs[d + 3] * bfhi(w.y) + qs[d + 4] * bflo(w.z) + qs[d + 5] * bfhi(w.z) + qs[d + 6] * bflo(w.w) + qs[d + 7] * bfhi(w.w); }
    float m = wave_max(s);
    if ((j & 63) == 0) red[j >> 6] = m;
    __syncthreads();
    m = fmaxf(fmaxf(red[0], red[1]), fmaxf(red[2], red[3]));
    __syncthreads();
    const float p = __expf(s - m);
    float l = wave_sum(p);
    if ((j & 63) == 0) red[j >> 6] = l;
    ps[j] = p;
    __syncthreads();
    l = red[0] + red[1] + red[2] + red[3];
    const bf16_t* vp = kv + (size_t)(b * NMEM) * 2048 + 1024 + h * XD + j;
    float o = 0.f;
    for (int jj = 0; jj < NMEM; ++jj) o += ps[jj] * bf2f(vp[(size_t)jj * 2048]);
    QO[t * D + h * XD + j] = f2bf(o / l);
    __syncthreads();
}

__device__ __forceinline__ void d_route(size_t t, int lane, const bf16_t* __restrict__ XB, const float* __restrict__ ss, const float* __restrict__ g, const float* __restrict__ wgr, const float* __restrict__ bgr,
                                        const float* __restrict__ wer, const float* __restrict__ ber, int* __restrict__ sel_e, float* __restrict__ sel_w) {
    const float rs = rstd_row(ss, t);
    float gl[4], el[32];
#pragma unroll
    for (int i = 0; i < 4; ++i) gl[i] = 0.f;
#pragma unroll
    for (int i = 0; i < 32; ++i) el[i] = 0.f;
    for (int i = 0; i < 16; ++i) { const int d = lane + 64 * i; const float hv = bf2f(XB[t * D + d]) * rs * g[d];
#pragma unroll
        for (int o = 0; o < 4; ++o) gl[o] += hv * wgr[d * NG + o];
#pragma unroll
        for (int o = 0; o < 32; ++o) el[o] += hv * wer[d * NE + o]; }
#pragma unroll
    for (int i = 0; i < 4; ++i) gl[i] = wave_sum(gl[i]) + bgr[i];
#pragma unroll
    for (int i = 0; i < 32; ++i) el[i] = wave_sum(el[i]) + ber[i];
    float gm = gl[0]; int gi = 0;
#pragma unroll
    for (int i = 1; i < 4; ++i) if (gl[i] > gm) { gm = gl[i]; gi = i; }
    float gs = 0.f;
#pragma unroll
    for (int i = 0; i < 4; ++i) gs += __expf(gl[i] - gm);
    const float gw = 1.0f / gs;
    float v0 = -INFINITY, v1 = -INFINITY; int i0 = 0, i1 = 0;
#pragma unroll
    for (int gg = 0; gg < 4; ++gg)
#pragma unroll
        for (int e = 0; e < EPG; ++e) if (gg == gi) { const float x = el[gg * EPG + e];
            if (x > v0) { v1 = v0; i1 = i0; v0 = x; i0 = e; } else if (x > v1) { v1 = x; i1 = e; } }
    const float e1 = __expf(v1 - v0), den = 1.0f + e1;
    if (lane == 0) { sel_e[t * 2] = gi * EPG + i0; sel_e[t * 2 + 1] = gi * EPG + i1; sel_w[t * 2] = gw / den; sel_w[t * 2 + 1] = gw * e1 / den; }
}

__device__ __forceinline__ void d_moe(size_t t, int f, LAS float* sm, bf16_t* XB, const float* __restrict__ ss, const float* __restrict__ g, const float* __restrict__ Wg, const float* __restrict__ Wu, const float* __restrict__ Wd,
                                      const int* __restrict__ sel_e, const float* __restrict__ sel_w, float* __restrict__ ss_next) {
    LAS float* hs = sm; LAS float* hid = sm + 1024; LAS float* red = sm + 1280;
    const float rs = rstd_row(ss, t);
    for (int i = f; i < D; i += 256) hs[i] = bf2f(XB[t * D + i]) * rs * g[i];
    float y0 = 0.f, y1 = 0.f, y2 = 0.f, y3 = 0.f;
    for (int s = 0; s < 2; ++s) {
        const int e = sel_e[t * 2 + s]; const float w = sel_w[t * 2 + s];
        __syncthreads();
        const float* wg = Wg + (size_t)e * D * EF + f; const float* wu = Wu + (size_t)e * D * EF + f;
        float ga = 0.f, up = 0.f;
        for (int d = 0; d < D; ++d) { ga += hs[d] * wg[(size_t)d * EF]; up += hs[d] * wu[(size_t)d * EF]; }
        hid[f] = ga / (1.0f + __expf(-ga)) * up * w;
        __syncthreads();
        const float* wd = Wd + (size_t)e * EF * D + f;
        for (int ff = 0; ff < EF; ++ff) { const float hv = hid[ff]; const float* r = wd + (size_t)ff * D; y0 += hv * r[0]; y1 += hv * r[256]; y2 += hv * r[512]; y3 += hv * r[768]; }
    }
    bf16_t* xr = XB + t * D + f;
    const float x0 = bf2f(xr[0]) + y0, x1 = bf2f(xr[256]) + y1, x2 = bf2f(xr[512]) + y2, x3 = bf2f(xr[768]) + y3;
    xr[0] = f2bf(x0); xr[256] = f2bf(x1); xr[512] = f2bf(x2); xr[768] = f2bf(x3);
    const float q = wave_sum(x0 * x0 + x1 * x1 + x2 * x2 + x3 * x3);
    __syncthreads();
    if ((f & 63) == 0) red[f >> 6] = q;
    __syncthreads();
    if (f < 16) ss_next[t * 16 + f] = f == 0 ? (red[0] + red[1]) + (red[2] + red[3]) : 0.f;
    __syncthreads();
}

__device__ __forceinline__ void d_final(size_t t, int i, const bf16_t* __restrict__ XB, const float* __restrict__ ss, const float* __restrict__ g, float* __restrict__ out) {
    const float rs = rstd_row(ss, t);
    const u32x2 w = *(const u32x2*)(XB + t * D + i * 4); const float4 gg = ((const float4*)g)[i];
    float4 o; o.x = bflo(w.x) * rs * gg.x; o.y = bfhi(w.x) * rs * gg.y; o.z = bflo(w.y) * rs * gg.z; o.w = bfhi(w.y) * rs * gg.w;
    ((float4*)(out + t * D))[i] = o;
}
typedef short bf16x8_t __attribute__((ext_vector_type(8)));
constexpr int NRMAX = 40960;
constexpr int NTMAX = NRMAX / 256;
constexpr int CW_CNT = 256;
constexpr size_t SEL_SELE = 0, SEL_SELW = 128 * 1024, SEL_LPOS = 256 * 1024, SEL_POS = 384 * 1024, SEL_GW = 512 * 1024, SEL_TILE = 768 * 1024, SEL_NT = 768 * 1024 + 4096;

struct ExpItem { const float* W; const float* gk; bf16_t* WT; int ldw, ldt, k0, n0; };
__device__ __forceinline__ ExpItem expert_item(const InPtrs& in, unsigned char* ws, int it) {
    const int le = it / 384, r = it % 384, l = le >> 5, e = le & 31;
    bf16_t* WGU = (bf16_t*)(ws + WS_WEXP + (size_t)l * WEXP_STRIDE) + (size_t)e * 512 * D;
    bf16_t* WDT = (bf16_t*)(ws + WS_WEXP + (size_t)l * WEXP_STRIDE + 32 * MiB) + (size_t)e * D * EF;
    const size_t eo = ((size_t)l * NE + e) * D * EF;
    ExpItem I;
    if (r < 256) { const int p = r >> 6, q = r & 63; I = {((p & 1) ? in.w_eu : in.w_eg) + eo + (p >> 1) * 128, in.norm_ffn_g + l * D, WGU + (size_t)(p * 128) * D, EF, D, (q >> 2) * 64, (q & 3) * 32}; }
    else { const int q = r - 256; I = {in.w_ed + eo, nullptr, WDT, D, EF, (q >> 5) * 64, (q & 31) * 32}; }
    return I;
}
__device__ __forceinline__ void conv_expert_items(const InPtrs& in, unsigned char* ws, int gw, int NGW, LAS float* scr, int lane) {
#pragma nounroll
    for (int it = gw; it < DEPTH * NE * 384; it += 2 * NGW) {
        const int it2 = it + NGW; ConvRegs R0, R1;
        const ExpItem A = expert_item(in, ws, it); conv_load(R0, A.W, A.ldw, A.k0, A.n0, lane);
        ExpItem B = A; if (it2 < DEPTH * NE * 384) { B = expert_item(in, ws, it2); conv_load(R1, B.W, B.ldw, B.k0, B.n0, lane); }
        conv_store(R0, A.gk, A.WT, A.ldt, A.k0, A.n0, scr, lane);
        if (it2 < DEPTH * NE * 384) conv_store(R1, B.gk, B.WT, B.ldt, B.k0, B.n0, scr, lane);
    }
}
__device__ __forceinline__ void conv_router(const InPtrs& in, unsigned char* ws, int vcu, int G, int tid) {
    for (int i = vcu * 512 + tid; i < DEPTH * 48 * D; i += G * 512) {
        const int l = i / (48 * D), r = (i / D) % 48, k = i % D; float v = 0.f;
        if (r < NG) v = in.w_gr[((size_t)l * D + k) * NG + r]; else if (r < NG + NE) v = in.w_er[((size_t)l * D + k) * NE + (r - NG)];
        ((bf16_t*)(ws + WS_WR))[i] = f2bf(v * in.norm_ffn_g[l * D + k]);
    }
}

__device__ __forceinline__ void ph_route(const InPtrs& in, unsigned char* ws, LAS unsigned char* lds, int l, int vcu, int G, int wv, bool dummy_cnt) {
    const int tid = tid_of(wv), lane = tid & 63, wave = wv;
    const bf16_t* XB = (const bf16_t*)(ws + WS_XB); const bf16_t* WR = (const bf16_t*)(ws + WS_WR) + (size_t)l * 48 * D;
    const float* ss = (const float*)(ws + WS_SSP) + (size_t)(3 * l + 2) * T * 16;
    int* SELE = (int*)(ws + WS_SEL + SEL_SELE); float* SELW = (float*)(ws + WS_SEL + SEL_SELW); int* LPOS = (int*)(ws + WS_SEL + SEL_LPOS);
    unsigned* CNT = (unsigned*)(ws + WS_CTL) + CW_CNT + 32 * l + (dummy_cnt ? 128 : 0);
    LAS float* lg = (LAS float*)lds + wave * (16 * 49);
    LAS unsigned* hist = (LAS unsigned*)(lds + 32768); LAS unsigned* gbase = hist + 32;
    for (int t0 = vcu * 64; t0 < T; t0 += G * 64) {
        if (tid < 32) hist[tid] = 0u;
        int e0 = 0, e1 = 0; unsigned r0 = 0, r1 = 0;
        {
            const int tw = t0 + (wave & 3) * 16, kh = (wave >> 2) * (D / 2);
            f32x4 acc[3];
#pragma unroll
            for (int nb = 0; nb < 3; ++nb) acc[nb] = (f32x4){0.f, 0.f, 0.f, 0.f};
            const bf16_t* ap = XB + (size_t)(tw + (lane & 15)) * D + kh + 8 * (lane >> 4);
            const bf16_t* bp = WR + (size_t)(lane & 15) * D + kh + 8 * (lane >> 4);
#pragma unroll
            for (int k0 = 0; k0 < D / 64; k0 += 8) {
                bf16x8_t a[8], b[8][3];
#pragma unroll
                for (int kk = 0; kk < 8; ++kk) { a[kk] = *(const bf16x8_t*)(ap + (k0 + kk) * 32);
#pragma unroll
                    for (int nb = 0; nb < 3; ++nb) b[kk][nb] = *(const bf16x8_t*)(bp + (size_t)nb * 16 * D + (k0 + kk) * 32); }
#pragma unroll
                for (int kk = 0; kk < 8; ++kk)
#pragma unroll
                    for (int nb = 0; nb < 3; ++nb) acc[nb] = __builtin_amdgcn_mfma_f32_16x16x32_bf16(a[kk], b[kk][nb], acc[nb], 0, 0, 0);
            }
#pragma unroll
            for (int nb = 0; nb < 3; ++nb)
#pragma unroll
                for (int r = 0; r < 4; ++r) lg[((lane >> 4) * 4 + r) * 49 + nb * 16 + (lane & 15)] = acc[nb][r];
        }
        __syncthreads();
        if (wave < 4 && lane < 16) {
            const int t = t0 + wave * 16 + lane; const float rs = rstd_row(ss, (size_t)t);
            const LAS float* p = lg + lane * 49; const LAS float* p2 = p + 4 * (16 * 49);
            float gm = -INFINITY; int gi = 0;
#pragma unroll
            for (int i = 0; i < NG; ++i) { const float x = (p[i] + p2[i]) * rs + in.b_gr[l * NG + i]; if (x > gm) { gm = x; gi = i; } }
            float gs = 0.f;
#pragma unroll
            for (int i = 0; i < NG; ++i) gs += __expf((p[i] + p2[i]) * rs + in.b_gr[l * NG + i] - gm);
            const float gw = 1.0f / gs;
            float v0 = -INFINITY, v1 = -INFINITY; int i0 = 0, i1 = 0;
#pragma unroll
            for (int e = 0; e < EPG; ++e) { const float x = (p[NG + gi * EPG + e] + p2[NG + gi * EPG + e]) * rs + in.b_er[l * NE + gi * EPG + e];
                if (x > v0) { v1 = v0; i1 = i0; v0 = x; i0 = e; } else if (x > v1) { v1 = x; i1 = e; } }
            const float ex = __expf(v1 - v0), den = 1.0f + ex;
            e0 = gi * EPG + i0; e1 = gi * EPG + i1;
            SELE[t * 2] = e0; SELE[t * 2 + 1] = e1; SELW[t * 2] = gw / den; SELW[t * 2 + 1] = gw * ex / den;
            r0 = __hip_atomic_fetch_add(&hist[e0], 1u, __ATOMIC_RELAXED, __HIP_MEMORY_SCOPE_WORKGROUP); r1 = __hip_atomic_fetch_add(&hist[e1], 1u, __ATOMIC_RELAXED, __HIP_MEMORY_SCOPE_WORKGROUP);
        }
        __syncthreads();
        if (tid < 32) gbase[tid] = hist[tid] ? atomicAdd(&CNT[tid], hist[tid]) : 0u;
        __syncthreads();
        if (wave < 4 && lane < 16) { const int t = t0 + wave * 16 + lane; LPOS[t * 2] = (int)(gbase[e0] + r0); LPOS[t * 2 + 1] = (int)(gbase[e1] + r1); }
        __syncthreads();
    }
}

__device__ __forceinline__ void ph_gather(unsigned char* ws, int l, int vcu, int G, int wv) {
    const int tid = tid_of(wv), lane = tid & 63, wave = wv; (void)tid;
    const unsigned* CNT = (const unsigned*)(ws + WS_CTL) + CW_CNT + 32 * l;
    const int cnt = (lane < 32) ? (int)__hip_atomic_load(CNT + (lane & 31), __ATOMIC_RELAXED, __HIP_MEMORY_SCOPE_AGENT) : 0;
    const int pad = (cnt + 255) & ~255;
    int incl = pad;
#pragma unroll
    for (int o = 1; o < 32; o <<= 1) { const int y = shfl_idx(incl, (lane - o) & 63); if ((lane & 31) >= o) incl += y; }
    const int base_l = incl - pad;
    if (vcu == 0 && wave == 0) {
        int* TILE_E = (int*)(ws + WS_SEL + SEL_TILE);
        if (lane < 32) for (int r = base_l >> 8; r < (incl >> 8); ++r) TILE_E[r] = lane;
        if (lane == 31) *(int*)(ws + WS_SEL + SEL_NT) = incl >> 8;
    }
    const bf16_t* XB = (const bf16_t*)(ws + WS_XB); bf16_t* XG = (bf16_t*)(ws + WS_XG);
    const float* ss = (const float*)(ws + WS_SSP) + (size_t)(3 * l + 2) * T * 16;
    const int* SELE = (const int*)(ws + WS_SEL + SEL_SELE); const float* SELW = (const float*)(ws + WS_SEL + SEL_SELW); const int* LPOS = (const int*)(ws + WS_SEL + SEL_LPOS);
    int* POS = (int*)(ws + WS_SEL + SEL_POS); float* GW = (float*)(ws + WS_SEL + SEL_GW);
    for (int s = vcu * 8 + wave; s < 2 * T; s += G * 8) {
        const int t = s >> 1, e = SELE[s];
        const int pos = shfl_idx(base_l, e) + LPOS[s];
        const float rs = rstd_row(ss, (size_t)t);
        if (lane == 0) { POS[s] = pos; GW[pos] = SELW[s]; }
        const u32x4* src = (const u32x4*)(XB + (size_t)t * D) + lane; u32x4* dst = (u32x4*)(XG + (size_t)pos * D) + lane;
#pragma unroll
        for (int j = 0; j < 2; ++j) { const u32x4 w = src[64 * j]; u32x4 o;
            o.x = pkbf(bflo(w.x) * rs, bfhi(w.x) * rs); o.y = pkbf(bflo(w.y) * rs, bfhi(w.y) * rs); o.z = pkbf(bflo(w.z) * rs, bfhi(w.z) * rs); o.w = pkbf(bflo(w.w) * rs, bfhi(w.w) * rs);
            ST16_OUT(dst + 64 * j, o); }
    }
}

template <int NJ> struct GroupedOrder {
    const int* tile_e; int nunits, G, c;
    __device__ __forceinline__ void init(const int* te, int nt, int G_, int c_) { tile_e = te; nunits = nt * NJ; G = G_; c = c_; }
    __device__ __forceinline__ bool next(int i, pg8::Unit& u) const {
        const int L = i * G + c; if (L >= nunits) return false;
        const int rt = L / NJ, j = L % NJ;
        u.pm = rt; u.pn = __builtin_amdgcn_readfirstlane(tile_e[rt]) * NJ + j; return true;
    }
    __device__ __forceinline__ void a_ready(const pg8::Unit&) const {}
    __device__ __forceinline__ void done(const pg8::Unit&) const {}
};
struct EpiHid {
    static constexpr bool PERM = true, AFTER_DRAIN = false;
    bf16_t* HID; const float* GW;
    __device__ __forceinline__ void operator()(const A4 (&acc)[2][2][4][2], const pg8::Unit& u, int wr, int wc, int fr, int fq) const {
        const int f0 = (u.pn & 1) * 128 + wc * 32 + 8 * fq;
        EPI_ROWS_BEGIN
            const float w = GW[row];
            A4 h0, h1;
#pragma unroll
            for (int i = 0; i < 4; ++i) { h0[i] = fsilu(acc[ai][0][m][0][i]) * acc[ai][1][m][0][i] * w; h1[i] = fsilu(acc[ai][0][m][1][i]) * acc[ai][1][m][1][i] * w; }
            ST16_OUT(HID + (size_t)row * EF + f0, pack8(h0, h1));
        EPI_ROWS_END
    }
};
struct EpiY {
    static constexpr bool PERM = true, AFTER_DRAIN = false;
    bf16_t* Y;
    __device__ __forceinline__ void operator()(const A4 (&acc)[2][2][4][2], const pg8::Unit& u, int wr, int wc, int fr, int fq) const {
        const int col0 = (u.pn & 3) * 256 + wc * 32 + 8 * fq;
        EPI_ROWS_BEGIN
#pragma unroll
            for (int bj = 0; bj < 2; ++bj) ST16_OUT(Y + (size_t)row * D + col0 + bj * 128, pack8(acc[ai][bj][m][0], acc[ai][bj][m][1]));
        EPI_ROWS_END
    }
};

__device__ __forceinline__ void ph_combine(unsigned char* ws, int l, int vcu, int G, bf16_t* XN, float* OUT, const float* __restrict__ fg, int wv, bf16_t* XBo) {
    const int tid = tid_of(wv), lane = tid & 63, wave = wv; (void)tid;
    const bf16_t* XB = (const bf16_t*)(ws + WS_XB); const bf16_t* Y = (const bf16_t*)(ws + WS_XG);
    const int* POS = (const int*)(ws + WS_SEL + SEL_POS); float* ssn = (float*)(ws + WS_SSP) + (size_t)(3 * l + 3) * T * 16;
    for (int t = vcu * 8 + wave; t < T; t += G * 8) {
        const int p0 = POS[2 * t], p1 = POS[2 * t + 1];
        const u32x4* xr = (const u32x4*)(XB + (size_t)t * D) + lane; u32x4* xo = (u32x4*)(XBo + (size_t)t * D) + lane; const u32x4* y0 = (const u32x4*)(Y + (size_t)p0 * D) + lane; const u32x4* y1 = (const u32x4*)(Y + (size_t)p1 * D) + lane;
        A4 v[4]; float q = 0.f;
#pragma unroll
        for (int j = 0; j < 2; ++j) { A4 a0, a1, b0, b1, c0, c1; unpack8(xr[64 * j], a0, a1); unpack8(y0[64 * j], b0, b1); unpack8(y1[64 * j], c0, c1);
            a0 += b0 + c0; a1 += b1 + c1; v[2 * j] = a0; v[2 * j + 1] = a1;
            q += (a0[0] * a0[0] + a0[1] * a0[1]) + (a0[2] * a0[2] + a0[3] * a0[3]) + (a1[0] * a1[0] + a1[1] * a1[1]) + (a1[2] * a1[2] + a1[3] * a1[3]);
            ST16_OUT(xo + 64 * j, pack8(a0, a1)); }
        q = wave_sum(q);
        if (lane < 16) ssn[(size_t)t * 16 + lane] = lane == 0 ? q : 0.f;
        const float rs = rsqrtf(q * (1.0f / D) + EPS);
        if (XN) { u32x4* xn = (u32x4*)(XN + (size_t)t * D) + lane;
#pragma unroll
            for (int j = 0; j < 2; ++j) ST16_OUT(xn + 64 * j, pack8(v[2 * j] * rs, v[2 * j + 1] * rs)); }
        if (OUT) {
#pragma unroll
            for (int j = 0; j < 2; ++j) { const int c0 = 8 * lane + 512 * j; const A4 g0 = *(const A4*)(fg + c0), g1 = *(const A4*)(fg + c0 + 4);
                float* o = OUT + (size_t)t * D + c0; *(A4*)o = v[2 * j] * rs * g0; *(A4*)(o + 4) = v[2 * j + 1] * rs * g1; }
        }
    }
}
struct FixedOrder {
    int pm, pn;
    __device__ __forceinline__ bool next(int i, pg8::Unit& u) const { if (i != 0) return false; u.pm = pm; u.pn = pn; return true; }
    __device__ __forceinline__ void a_ready(const pg8::Unit&) const {}
    __device__ __forceinline__ void done(const pg8::Unit&) const {}
};
struct PairOrder {
    int pm, pn0, pn1;
    __device__ __forceinline__ bool next(int i, pg8::Unit& u) const { if (i > 1) return false; u.pm = pm; u.pn = i ? pn1 : pn0; return true; }
    __device__ __forceinline__ void a_ready(const pg8::Unit&) const {}
    __device__ __forceinline__ void done(const pg8::Unit&) const {}
};
struct EpiSoftmax {
    static constexpr bool PERM = true, AFTER_DRAIN = true;
    bf16_t* P; int ld, pad;
    __device__ __forceinline__ void fused(A4 (&acc)[2][2][4][2], const pg8::Unit& u, int wr, int wc, int fr, int fq, PG8_LAS unsigned char* lds, int wid, int lane) const {
        typedef float f32x2v __attribute__((ext_vector_type(2)));
        PG8_LAS f32x2v* X = (PG8_LAS f32x2v*)lds;
        float mw[2][4];
#pragma unroll
        for (int ai = 0; ai < 2; ++ai)
#pragma unroll
            for (int m = 0; m < 4; ++m) {
                float mx = -INFINITY;
#pragma unroll
                for (int bj = 0; bj < 2; ++bj)
#pragma unroll
                    for (int i = 0; i < 4; ++i) mx = fmaxf(mx, fmaxf(acc[ai][bj][m][0][i], acc[ai][bj][m][1][i]));
                mx = fmaxf(mx, swz_xor<16>(mx)); mx = max_xor32(mx);
                float s = 0.f;
#pragma unroll
                for (int bj = 0; bj < 2; ++bj)
#pragma unroll
                    for (int n = 0; n < 2; ++n)
#pragma unroll
                        for (int i = 0; i < 4; ++i) { const float e = __expf(acc[ai][bj][m][n][i] - mx); acc[ai][bj][m][n][i] = e; s += e; }
                s = add_xor32(add_xor16(s));
                mw[ai][m] = mx;
                if (fq == 0) X[(ai * 128 + wr * 64 + m * 16 + fr) * 4 + wc] = (f32x2v){mx, s};
            }
        asm volatile("s_waitcnt lgkmcnt(0)" ::: "memory"); __builtin_amdgcn_s_barrier(); asm volatile("" ::: "memory");
#pragma unroll
        for (int ai = 0; ai < 2; ++ai)
#pragma unroll
            for (int m = 0; m < 4; ++m) {
                const int r = ai * 128 + wr * 64 + m * 16 + fr;
                const f32x2v a = X[r * 4 + 0], b = X[r * 4 + 1], c = X[r * 4 + 2], d = X[r * 4 + 3];
                const float M = fmaxf(fmaxf(a.x, b.x), fmaxf(c.x, d.x));
                const float S = (a.y * __expf(a.x - M) + b.y * __expf(b.x - M)) + (c.y * __expf(c.x - M) + d.y * __expf(d.x - M));
                const float f = __expf(mw[ai][m] - M) * __builtin_amdgcn_rcpf(S);
#pragma unroll
                for (int bj = 0; bj < 2; ++bj) *(u32x4*)(P + (size_t)(u.pm * 256 + r) * ld + bj * 128 + wc * 32 + 8 * fq) = pack8(acc[ai][bj][m][0] * f, acc[ai][bj][m][1] * f);
            }
    }
};
typedef float f32x16 __attribute__((ext_vector_type(16)));
constexpr int RTAB = 640;
__device__ __forceinline__ bf16x8_t as_bf16x8(const u32x4 w) { return __builtin_bit_cast(bf16x8_t, w); }
constexpr float LOG2E = 1.4426950408889634f;
__device__ __forceinline__ void band_tables(const float* __restrict__ rel  , LAS float* Rt, int tid) {
    for (int i = tid; i < AH * RTAB; i += 512) { const int h = i / RTAB, k = i % RTAB; int r = 575 - k; r = r < -AMAXREL ? -AMAXREL : (r > AMAXREL ? AMAXREL : r); Rt[i] = rel[h * RELW + r + AMAXREL] * LOG2E; }
}
__device__ __forceinline__ void band_load_k(bf16x8_t (&Kf)[4], const bf16_t* __restrict__ AK, size_t key0, int h, int ql, int hh) {
#pragma unroll
    for (int s = 0; s < 4; ++s) Kf[s] = *(const bf16x8_t*)(AK + (key0 + ql) * AW + h * 64 + 16 * s + 8 * hh);
}
__device__ __forceinline__ void band_load_v(bf16x8_t (&Vf)[2][2], const bf16_t* vbase, size_t key0) {
#pragma unroll
    for (int db = 0; db < 2; ++db)
#pragma unroll
        for (int s = 0; s < 2; ++s) { const bf16_t* p = vbase + (size_t)(32 * db) * T + key0 + 16 * s;
            const u32x2 a = *(const u32x2*)p, c2 = *(const u32x2*)(p + 8); Vf[db][s] = as_bf16x8((u32x4){a.x, a.y, c2.x, c2.y}); }
}
__device__ __forceinline__ void band_item(int item, int lane, const bf16_t* __restrict__ AQ, const bf16_t* __restrict__ AK, const bf16_t* __restrict__ AVT, const LAS float* Rt, bf16_t* __restrict__ OAB) {
    const int n = item % NCH, h = (item / NCH) % AH, b = item / (NCH * AH);
    const int ql = lane & 31, hh = lane >> 5;
    const size_t tok0 = (size_t)b * L + (size_t)n * CH;
    bf16x8_t Qf[2][4];
#pragma unroll
    for (int qb = 0; qb < 2; ++qb)
#pragma unroll
        for (int s = 0; s < 4; ++s) Qf[qb][s] = *(const bf16x8_t*)(AQ + (tok0 + 32 * qb + ql) * AW + h * 64 + 16 * s + 8 * hh);
    f32x16 O[2][2];
#pragma unroll
    for (int db = 0; db < 2; ++db)
#pragma unroll
        for (int qb = 0; qb < 2; ++qb)
#pragma unroll
            for (int r = 0; r < 16; ++r) O[db][qb][r] = 0.f;
    float mrun[2] = {-INFINITY, -INFINITY}, lrun[2] = {0.f, 0.f};
    const LAS float* Rh = Rt + h * RTAB + (31 - ql + 4 * hh);
    const float bias_far = Rt[h * RTAB];
    const bf16_t* vbase = AVT + (size_t)(h * 64 + ql) * T + 4 * hh;
    const int j_lo = (n < ALC ? 2 * (ALC - n) : 0), j_hi = 2 * ALC + 1;
    const size_t keyb = (size_t)b * L + (size_t)(n - ALC) * CH;
    bf16x8_t Kf[4], Vf[2][2];
    f32x16 S[2];
    band_load_k(Kf, AK, keyb + (size_t)j_lo * 32, h, ql, hh);
    band_load_v(Vf, vbase, keyb + (size_t)j_lo * 32);
#define BAND_SCORES(jj) do { const LAS float* Rc_ = Rh + (jj) * 32; \
        _Pragma("unroll") for (int qb = 0; qb < 2; ++qb) { \
            if ((jj) < 8) { _Pragma("unroll") for (int r = 0; r < 16; ++r) S[qb][r] = bias_far; } \
            else { _Pragma("unroll") for (int r = 0; r < 16; ++r) S[qb][r] = Rc_[32 - 32 * qb + (r & 3) + 8 * (r >> 2)]; } \
            _Pragma("unroll") for (int s = 0; s < 4; ++s) S[qb] = __builtin_amdgcn_mfma_f32_32x32x16_bf16(Kf[s], Qf[qb][s], S[qb], 0, 0, 0); } } while (0)
    BAND_SCORES(j_lo);
    band_load_k(Kf, AK, keyb + (size_t)(j_lo < j_hi ? j_lo + 1 : j_lo) * 32, h, ql, hh);
#pragma nounroll
    for (int j = j_lo; j <= j_hi; ++j) {
#pragma unroll
        for (int qb = 0; qb < 2; ++qb) {
            float mx = S[qb][0];
#pragma unroll
            for (int r = 1; r < 16; ++r) mx = fmaxf(mx, S[qb][r]);
            mx = max_xor32(mx);
            const float mn = fmaxf(mrun[qb], mx), alpha = __builtin_amdgcn_exp2f(mrun[qb] - mn);
            mrun[qb] = mn;
            float sum = 0.f;
#pragma unroll
            for (int r = 0; r < 16; ++r) { const float p = __builtin_amdgcn_exp2f(S[qb][r] - mn); S[qb][r] = p; sum += p; }
            lrun[qb] = lrun[qb] * alpha + add_xor32(sum);
#pragma unroll
            for (int db = 0; db < 2; ++db)
#pragma unroll
                for (int r = 0; r < 16; ++r) O[db][qb][r] *= alpha;
#pragma unroll
            for (int s = 0; s < 2; ++s) {
                u32x4 w; w.x = pkbf(S[qb][8 * s + 0], S[qb][8 * s + 1]); w.y = pkbf(S[qb][8 * s + 2], S[qb][8 * s + 3]); w.z = pkbf(S[qb][8 * s + 4], S[qb][8 * s + 5]); w.w = pkbf(S[qb][8 * s + 6], S[qb][8 * s + 7]);
                const bf16x8_t Pf = as_bf16x8(w);
#pragma unroll
                for (int db = 0; db < 2; ++db) O[db][qb] = __builtin_amdgcn_mfma_f32_32x32x16_bf16(Vf[db][s], Pf, O[db][qb], 0, 0, 0);
            }
        }
        if (j < j_hi) {
            band_load_v(Vf, vbase, keyb + (size_t)(j + 1) * 32);
            BAND_SCORES(j + 1);
            band_load_k(Kf, AK, keyb + (size_t)(j + 2 <= j_hi ? j + 2 : j_hi) * 32, h, ql, hh);
        }
    }
#undef BAND_SCORES
#pragma unroll
    for (int qb = 0; qb < 2; ++qb) {
        const float inv = 1.0f / lrun[qb];
        bf16_t* orow = OAB + (tok0 + 32 * qb + ql) * D + h * 64 + 4 * hh;
#pragma unroll
        for (int db = 0; db < 2; ++db)
#pragma unroll
            for (int g = 0; g < 4; ++g) { u32x2 o; o.x = pkbf(O[db][qb][4 * g] * inv, O[db][qb][4 * g + 1] * inv); o.y = pkbf(O[db][qb][4 * g + 2] * inv, O[db][qb][4 * g + 3] * inv);
                *(u32x2*)(orow + 32 * db + 8 * g) = o; }
    }
}
constexpr size_t DS_ITEM = 128 * 64;
__device__ __forceinline__ int rowmap32(int r, int hh) { return (r & 3) + 8 * (r >> 2) + 4 * hh; }

__device__ __forceinline__ float gla_scan_tile(const float* __restrict__ LOGA, size_t tok0, int h, int lane, LAS float* Gt) {
    const float* p = LOGA + tok0 * BKW + h * 64 + lane;
    float cum = 0.f;
#pragma unroll
    for (int t0 = 0; t0 < 64; t0 += 16) {
        float la[16];
#pragma unroll
        for (int i = 0; i < 16; ++i) la[i] = p[(size_t)(t0 + i) * BKW];
#pragma unroll
        for (int i = 0; i < 16; ++i) { cum += la[i]; Gt[(t0 + i) * 64 + lane] = cum; }
    }
    asm volatile("s_waitcnt lgkmcnt(0)" ::: "memory");
    return cum;
}

__device__ __forceinline__ void gla1_item(int idx, int lane, LAS float* Gt, const bf16_t* __restrict__ BK, const bf16_t* __restrict__ BVT, const float* __restrict__ LOGA, float* __restrict__ DS, float* __restrict__ DEC) {
    const int c = idx & 127, h = (idx >> 7) & 3, b = idx >> 9;
    const size_t tok0 = (size_t)b * L + (size_t)c * CH;
    const int ql = lane & 31, hh = lane >> 5;
    LAS bf16_t* Kt = (LAS bf16_t*)(Gt + 64 * 64);
    {
        u32x4 kr[8];
#pragma unroll
        for (int i = 0; i < 8; ++i) kr[i] = *(const u32x4*)(BK + (tok0 + 8 * i + (lane >> 3)) * BKW + h * 64 + (lane & 7) * 8);
#pragma unroll
        for (int i = 0; i < 8; ++i) *(LAS u32x4*)(Kt + (8 * i + (lane >> 3)) * 64 + (lane & 7) * 8) = kr[i];
    }
    const float last = gla_scan_tile(LOGA, tok0, h, lane, Gt);
    DEC[(size_t)idx * 64 + lane] = __expf(last);
    bf16x8_t Xf[2][2][2];
#pragma unroll
    for (int kb = 0; kb < 2; ++kb) {
        const float lk = __int_as_float(shfl_idx(__float_as_int(last), 32 * kb + ql));
#pragma unroll
        for (int tb = 0; tb < 2; ++tb) {
            float x[16];
#pragma unroll
            for (int r = 0; r < 16; ++r) { const int t = 32 * tb + rowmap32(r, hh);
                x[r] = bf2f(Kt[t * 64 + 32 * kb + ql]) * __expf(lk - Gt[t * 64 + 32 * kb + ql]); }
#pragma unroll
            for (int s = 0; s < 2; ++s) { u32x4 w; w.x = pkbf(x[8 * s], x[8 * s + 1]); w.y = pkbf(x[8 * s + 2], x[8 * s + 3]); w.z = pkbf(x[8 * s + 4], x[8 * s + 5]); w.w = pkbf(x[8 * s + 6], x[8 * s + 7]); Xf[tb][kb][s] = as_bf16x8(w); }
        }
    }
    const bf16_t* vbase = BVT + (size_t)(h * 128 + ql) * T + tok0 + 4 * hh;
    float* dsb = DS + (size_t)idx * DS_ITEM;
#pragma unroll
    for (int vb = 0; vb < 4; ++vb) {
        bf16x8_t Vf[2][2];
#pragma unroll
        for (int tb = 0; tb < 2; ++tb)
#pragma unroll
            for (int s = 0; s < 2; ++s) { const bf16_t* p = vbase + (size_t)(32 * vb) * T + 32 * tb + 16 * s; const u32x2 a = *(const u32x2*)p, c2 = *(const u32x2*)(p + 8); Vf[tb][s] = as_bf16x8((u32x4){a.x, a.y, c2.x, c2.y}); }
#pragma unroll
        for (int kb = 0; kb < 2; ++kb) {
            f32x16 acc;
#pragma unroll
            for (int r = 0; r < 16; ++r) acc[r] = 0.f;
#pragma unroll
            for (int tb = 0; tb < 2; ++tb)
#pragma unroll
                for (int s = 0; s < 2; ++s) acc = __builtin_amdgcn_mfma_f32_32x32x16_bf16(Vf[tb][s], Xf[tb][kb][s], acc, 0, 0, 0);
#pragma unroll
            for (int r = 0; r < 16; ++r) dsb[(size_t)(32 * vb + rowmap32(r, hh)) * 64 + 32 * kb + ql] = acc[r];
        }
    }
}

__device__ __forceinline__ void gla2_scan(int e, const float* __restrict__ DS, const float* __restrict__ DEC, bf16_t* __restrict__ SB) {
    const int k = e & 63, v = (e >> 6) & 127, bh = e >> 13;
    const size_t base = (size_t)bh * 128;
    float S = 0.f;
#pragma unroll 1
    for (int c0 = 0; c0 < 128; c0 += 8) {
        float d[8], a[8];
#pragma unroll
        for (int i = 0; i < 8; ++i) { d[i] = DS[(base + c0 + i) * DS_ITEM + (size_t)v * 64 + k]; a[i] = DEC[(base + c0 + i) * 64 + k]; }
#pragma unroll
        for (int i = 0; i < 8; ++i) { SB[(base + c0 + i) * DS_ITEM + (size_t)v * 64 + k] = f2bf(S); S = a[i] * S + d[i]; }
    }
}

__device__ __forceinline__ void gla3_unit(int unit, int lane, LAS float* Gt, const bf16_t* __restrict__ BQ, const bf16_t* __restrict__ BK, const bf16_t* __restrict__ BVT, const float* __restrict__ LOGA,
                                          const bf16_t* __restrict__ SB, const bf16_t* __restrict__ BRS, const float* __restrict__ gnorm, bf16_t* __restrict__ OAB) {
    const int tb = unit & 1, idx = unit >> 1;
    const int c = idx & 127, h = (idx >> 7) & 3, b = idx >> 9;
    const size_t tok0 = (size_t)b * L + (size_t)c * CH;
    const int ql = lane & 31, hh = lane >> 5;
    (void)gla_scan_tile(LOGA, tok0, h, lane, Gt);
    bf16x8_t Qf[4];
    {
        const int t = 32 * tb + ql;
#pragma unroll
        for (int s = 0; s < 4; ++s) {
            const u32x4 q = *(const u32x4*)(BQ + (tok0 + t) * BKW + h * 64 + 16 * s + 8 * hh);
            const f32x4 g0 = *(const LAS f32x4*)(Gt + t * 64 + 16 * s + 8 * hh), g1 = *(const LAS f32x4*)(Gt + t * 64 + 16 * s + 8 * hh + 4);
            u32x4 w; w.x = pkbf(bflo(q.x) * __expf(g0[0]), bfhi(q.x) * __expf(g0[1])); w.y = pkbf(bflo(q.y) * __expf(g0[2]), bfhi(q.y) * __expf(g0[3]));
            w.z = pkbf(bflo(q.z) * __expf(g1[0]), bfhi(q.z) * __expf(g1[1])); w.w = pkbf(bflo(q.w) * __expf(g1[2]), bfhi(q.w) * __expf(g1[3]));
            Qf[s] = as_bf16x8(w);
        }
    }
    bf16x8_t Pf[2][2];
#pragma unroll
    for (int sb = 0; sb < 2; ++sb) {
        if (sb <= tb) {
            const int srow = 32 * sb + ql;
            f32x16 A;
#pragma unroll
            for (int r = 0; r < 16; ++r) A[r] = 0.f;
#pragma unroll
            for (int s = 0; s < 4; ++s) {
                const u32x4 kx = *(const u32x4*)(BK + (tok0 + srow) * BKW + h * 64 + 16 * s + 8 * hh);
                const f32x4 g0 = *(const LAS f32x4*)(Gt + srow * 64 + 16 * s + 8 * hh), g1 = *(const LAS f32x4*)(Gt + srow * 64 + 16 * s + 8 * hh + 4);
                u32x4 w; w.x = pkbf(bflo(kx.x) * __expf(-g0[0]), bfhi(kx.x) * __expf(-g0[1])); w.y = pkbf(bflo(kx.y) * __expf(-g0[2]), bfhi(kx.y) * __expf(-g0[3]));
                w.z = pkbf(bflo(kx.z) * __expf(-g1[0]), bfhi(kx.z) * __expf(-g1[1])); w.w = pkbf(bflo(kx.w) * __expf(-g1[2]), bfhi(kx.w) * __expf(-g1[3]));
                A = __builtin_amdgcn_mfma_f32_32x32x16_bf16(as_bf16x8(w), Qf[s], A, 0, 0, 0);
            }
            if (sb == tb) {
#pragma unroll
                for (int r = 0; r < 16; ++r) A[r] = (rowmap32(r, hh) <= ql) ? A[r] : 0.f;
            }
#pragma unroll
            for (int s2 = 0; s2 < 2; ++s2) { u32x4 w; w.x = pkbf(A[8 * s2], A[8 * s2 + 1]); w.y = pkbf(A[8 * s2 + 2], A[8 * s2 + 3]); w.z = pkbf(A[8 * s2 + 4], A[8 * s2 + 5]); w.w = pkbf(A[8 * s2 + 6], A[8 * s2 + 7]); Pf[sb][s2] = as_bf16x8(w); }
        }
    }
    f32x16 O[4];
    const bf16_t* vbase = BVT + (size_t)(h * 128 + ql) * T + tok0 + 4 * hh;
    const bf16_t* sbase = SB + (size_t)idx * DS_ITEM + (size_t)ql * 64 + 8 * hh;
#pragma unroll
    for (int vb = 0; vb < 4; ++vb) {
#pragma unroll
        for (int r = 0; r < 16; ++r) O[vb][r] = 0.f;
#pragma unroll
        for (int s = 0; s < 4; ++s) { const bf16x8_t Sf = *(const bf16x8_t*)(sbase + (size_t)(32 * vb) * 64 + 16 * s); O[vb] = __builtin_amdgcn_mfma_f32_32x32x16_bf16(Sf, Qf[s], O[vb], 0, 0, 0); }
#pragma unroll
        for (int sb = 0; sb < 2; ++sb) {
            if (sb <= tb) {
#pragma unroll
                for (int s2 = 0; s2 < 2; ++s2) { const bf16_t* p = vbase + (size_t)(32 * vb) * T + 32 * sb + 16 * s2; const u32x2 a = *(const u32x2*)p, c2 = *(const u32x2*)(p + 8);
                    O[vb] = __builtin_amdgcn_mfma_f32_32x32x16_bf16(as_bf16x8((u32x4){a.x, a.y, c2.x, c2.y}), Pf[sb][s2], O[vb], 0, 0, 0); }
            }
        }
    }
    float q = 0.f;
#pragma unroll
    for (int vb = 0; vb < 4; ++vb)
#pragma unroll
        for (int r = 0; r < 16; ++r) q += O[vb][r] * O[vb][r];
    const float rs = rsqrtf(add_xor32(q) * (1.0f / 128.0f) + EPS);
    const size_t trow = tok0 + 32 * tb + ql;
    const bf16_t* br = BRS + trow * BVW + h * 128 + 4 * hh; bf16_t* orow = OAB + trow * D + 512 + h * 128 + 4 * hh; const float* gn = gnorm + 4 * hh;
#pragma unroll
    for (int vb = 0; vb < 4; ++vb)
#pragma unroll
        for (int g = 0; g < 4; ++g) {
            const int vo = 32 * vb + 8 * g;
            const u32x2 bw = *(const u32x2*)(br + vo); const f32x4 gv = *(const f32x4*)(gn + vo);
            u32x2 o; o.x = pkbf(O[vb][4 * g] * rs * gv[0] * bflo(bw.x), O[vb][4 * g + 1] * rs * gv[1] * bfhi(bw.x)); o.y = pkbf(O[vb][4 * g + 2] * rs * gv[2] * bflo(bw.y), O[vb][4 * g + 3] * rs * gv[3] * bfhi(bw.y));
            *(u32x2*)(orow + vo) = o;
        }
}
#ifndef MK_REP_PHASE
#define MK_REP_PHASE (-1)
#define MK_REP_N 1
#endif
#ifndef MK_PANEL_TEST
#define MK_PANEL_TEST 0
#endif
#ifndef MK_LAUNCHES
#define MK_LAUNCHES 1
#endif
constexpr int RING_BYTES = 131072, MISC_OFF = RING_BYTES + 512, LDS_BYTES = 147456;
constexpr int CW_BAR = 1024;
constexpr size_t CTL_ZERO_BYTES = 64 * 1024;
constexpr int CW_PANEL = 8192;
static_assert((CW_BAR + XCD_BAR_WORDS) * 4 <= (int)CTL_ZERO_BYTES, "barrier words inside the memset region");
constexpr int N_PHASES = 1 + 13 * DEPTH;

struct MKArgs { InPtrs in; unsigned char* ws; unsigned char* dout; int ph_lo, ph_hi, rep_phase, rep_n; };

__global__ void __launch_bounds__(512, 2) mk_fwd(MKArgs a) {
    extern __shared__ __attribute__((aligned(16))) unsigned char lds_raw[];
    LAS unsigned char* lds = (LAS unsigned char*)lds_raw;
    const int G0 = (int)gridDim.x, vcu0 = (int)blockIdx.x;
    const int wv0 = __builtin_amdgcn_readfirstlane((int)threadIdx.x >> 6);
    volatile LAS unsigned* MISC = (volatile LAS unsigned*)(lds + MISC_OFF);
    if (threadIdx.x < 16) MISC[threadIdx.x] = 0u;
    __syncthreads();
    const bool one_launch = (a.ph_hi - a.ph_lo) > 1;
    XcdBarrier bar; bar.bar = (unsigned*)(a.ws + WS_CTL) + CW_BAR; bar.x = 0; bar.st = MISC + 8;
    if (one_launch) bar = xcd_barrier_post((unsigned*)(a.ws + WS_CTL) + CW_BAR, MISC + 8);

    const InPtrs& in = a.in;
#define SS ((float*)(ws + WS_SSP))
#define XB ((bf16_t*)(ws + WS_XB))
#define AQ ((bf16_t*)(ws + WS_AQ))
#define AK ((bf16_t*)(ws + WS_AK))
#define AVT ((bf16_t*)(ws + WS_AVT))
#define XN ((bf16_t*)(ws + WS_XN))
#define BQ ((bf16_t*)(ws + WS_BQ))
#define BK ((bf16_t*)(ws + WS_BK))
#define BVT ((bf16_t*)(ws + WS_BVT))
#define BRS ((bf16_t*)(ws + WS_BRS))
#define GA ((bf16_t*)(ws + WS_GA))
#define GB ((bf16_t*)(dout + DO_GB))
#define MG ((bf16_t*)(ws + WS_MG))
#define Q ((bf16_t*)(ws + WS_Q))
#define MEMN ((bf16_t*)(ws + WS_MEMN))
#define KVB ((bf16_t*)(ws + WS_KVB))
#define LOGA ((float*)(ws + WS_LOGA))
#define OAB ((bf16_t*)(dout + DO_OAB))
#define DSF ((float*)(dout + DO_ST))
#define DEC ((float*)(ws + WS_DEC))
#define SBB ((bf16_t*)(ws + WS_SB))
#define TMP ((bf16_t*)(ws + WS_TMP))
#define SELE ((int*)(ws + WS_SEL))
#define SELW ((float*)(ws + WS_SEL + (size_t)T * 2 * 4))
#define WD(l) (ws + WS_WDENSE + (size_t)(l) * WDENSE_STRIDE)
#define SSA(i) (SS + (size_t)(i) * T * 16)
#define MK_EP(l, t0) EpiProj{AQ, AK, BQ, BK, BRS, GA, GB, LOGA, in.gla_b_alpha + (size_t)(l) * BKW, (t0), 0}
    int ph = 0;
#define PH_ON (ph >= a.ph_lo && ph < a.ph_hi)
#define PH_RUN for (int rep_ = (PH_ON ? (ph == a.rep_phase ? a.rep_n : 1) : 0); rep_ > 0; --rep_)
#define PH_PTRS const int G = opaque_int(G0), vcu = opaque_int(vcu0), wv = opaque_int(wv0); (void)G; (void)vcu; unsigned char* ws = opaque_ptr(a.ws); unsigned char* dout = opaque_ptr(a.dout); (void)ws; (void)dout; const int tid = tid_of(wv), lane = tid & 63, wave = wv; (void)lane; (void)wave;
#define PH_END do { if (PH_ON && ph + 1 < a.ph_hi) xcd_barrier(bar, tid_of(opaque_int(wv0)) == 0); ++ph; } while (0)
#define GEMM_AT(EpiT, gm, ep, cc) do { pg8::StaticOrder S_; S_.init((gm).M, (gm).N, G, (cc)); pg8::gemm_phase<EpiT, pg8::StaticOrder, true, true>(lds, gm, S_, ep, wv); } while (0)
#define GEMM(EpiT, gm, ep) do { pg8::StaticOrder S_; S_.init((gm).M, (gm).N, G, vcu); pg8::gemm_phase<EpiT, pg8::StaticOrder, true, true>(lds, gm, S_, ep, wv); } while (0)

    PH_RUN { PH_PTRS ph_prologue(in, ws, lds, vcu, G, wv);
        LAS float* scr = (LAS float*)(lds + wave * 16384);
        conv_expert_items(in, ws, vcu * 8 + wave, G * 8, scr, lane);
        conv_router(in, ws, vcu, G, tid); }
    PH_END;

#pragma nounroll
    for (int l = 0; l < DEPTH; ++l) {
        PH_RUN { PH_PTRS
            if (l == 0) {
#pragma nounroll
                for (int l2 = 0; l2 < DEPTH; ++l2) {
                    const bf16_t* Wkv = (const bf16_t*)(WD(l2) + WD_WXKV);
                    { const pg8::Gemm g{MEMN, Wkv, NB * NMEM, D, D, D, D, 0}; const EpiScale e{KVB + (size_t)l2 * 2 * NB * NMEM * D, nullptr, D, 1.0f, 1, 0}; GEMM_AT(EpiScale, g, e, (vcu + G - (G > 128 ? 64 + 16 * l2 : 0)) % G); }
                    { const pg8::Gemm g{Wkv + (size_t)D * D, MEMN, D, NB * NMEM, D, D, D, 0}; const EpiScale e{KVB + (size_t)l2 * 2 * NB * NMEM * D + (size_t)NB * NMEM * D, nullptr, NB * NMEM, 1.0f, 1, 0}; GEMM_AT(EpiScale, g, e, (vcu + G - (G > 128 ? 72 + 16 * l2 : 0)) % G); }
                }
            }
            { const pg8::Gemm g{XN, (const bf16_t*)(WD(l) + WD_WIN), T, NPROJ_A, D, D, D, 0}; const EpiProj e = MK_EP(l, 0); GEMM(EpiProj, g, e); }
            { const pg8::Gemm g{(const bf16_t*)(WD(l) + WD_WIN) + (size_t)NPROJ_A * D, XN, NPROJ_V, T, D, D, D, 0}; const EpiScale e{AVT, nullptr, T, 1.0f, 1, 0}; GEMM(EpiScale, g, e); }
        }
        PH_END;
        PH_RUN { PH_PTRS
            LAS float* Rt = (LAS float*)lds;
            band_tables(in.rel_bias + (size_t)l * AH * RELW, Rt, tid);
            __syncthreads();
            if (wave < 4) {
                LAS float* Gt = (LAS float*)(lds + 32768 + wave * 24576);
#pragma nounroll
                for (int it = vcu * 4 + wave; it < NB * BH * NCH; it += G * 4) gla1_item(it, lane, Gt, BK, BVT, LOGA, DSF, DEC);
            }
#pragma nounroll
            for (int it = vcu * 8 + wave; it < NB * AH * NCH; it += G * 8) band_item(it, lane, AQ, AK, AVT, Rt, OAB);
        }
        PH_END;
        PH_RUN { PH_PTRS
            for (int e2 = vcu * 512 + tid; e2 < NB * BH * 128 * 64; e2 += G * 512) gla2_scan(e2, DSF, DEC, SBB);
        }
        PH_END;
        PH_RUN { PH_PTRS
            LAS float* Gt = (LAS float*)(lds + wave * 16384);
#pragma nounroll
            for (int un = vcu * 8 + wave; un < 2 * NB * BH * NCH; un += G * 8) gla3_unit(un, lane, Gt, BQ, BK, BVT, LOGA, SBB, BRS, in.gla_norm_g + (size_t)l * 128, OAB);
        }
        PH_END;
        PH_RUN { PH_PTRS
            pg8::StaticOrder S0; S0.init(T, D, G, vcu); pg8::Unit u;
            const bf16_t* Wg = (const bf16_t*)(WD(l) + WD_WIN) + (size_t)(NPROJ_A + NPROJ_V) * D;
#pragma nounroll
            for (int i = 0; S0.next(i, u); ++i) {
                { const pg8::Gemm g{XN, Wg, T, NPROJ_B, D, D, D, 0}; const PairOrder F{u.pm, u.pn, 4 + u.pn}; const EpiProj e = MK_EP(l, 9); pg8::gemm_phase<EpiProj, PairOrder, true, true>(lds, g, F, e, wv); }
                { const pg8::Gemm g{OAB, (const bf16_t*)(WD(l) + WD_WB), T, D, 512, D, D, 0}; const FixedOrder F{u.pm, u.pn}; const EpiGate e{GA, nullptr, TMP}; pg8::gemm_phase<EpiGate, FixedOrder, true, true>(lds, g, F, e, wv); }
                { const pg8::Gemm g{OAB + 512, (const bf16_t*)(WD(l) + WD_WB) + 512, T, D, 512, D, D, 0}; const FixedOrder F{u.pm, u.pn}; const EpiGate e{GB, TMP, MG}; pg8::gemm_phase<EpiGate, FixedOrder, true, true>(lds, g, F, e, wv); }
            }
        }
        PH_END;
        PH_RUN { PH_PTRS const pg8::Gemm g{MG, (const bf16_t*)(WD(l) + WD_WMO), T, D, D, D, D, 0}; const EpiResid e{rep_ > 1 ? TMP : XB, XB, SSA(3 * l + 1)}; GEMM(EpiResid, g, e);
            if (MK_PANEL_TEST && one_launch && G == 256) { pg8::StaticOrder S0; S0.init(T, D, G, vcu); pg8::Unit u; S0.next(0, u);
                panel_sync((unsigned*)(ws + WS_CTL) + CW_PANEL + 64 * (l * 64 + u.pm), 4u, tid_of(wv) == 0); } }
        if (MK_PANEL_TEST && one_launch && G0 == 256) ++ph; else PH_END;
        PH_RUN { PH_PTRS
            pg8::StaticOrder S0; S0.init(T, D, G, vcu); pg8::Unit u;
            const bf16_t* KBl = KVB + (size_t)l * 2 * NB * NMEM * D; const bf16_t* VTl = KBl + (size_t)NB * NMEM * D;
#pragma nounroll
            for (int i = 0; S0.next(i, u); ++i) {
                const int h = u.pn, b = u.pm >> 5; bf16_t* Qh = Q + h * XD;
                { const pg8::Gemm g{XB, (const bf16_t*)(WD(l) + WD_WXQ), T, D, D, D, D, 0}; const FixedOrder F{u.pm, u.pn}; const EpiScale e{Q, SSA(3 * l + 1), D, 0.0625f, 0, 0};
                  pg8::gemm_phase<EpiScale, FixedOrder, true, true>(lds, g, F, e, wv); }
                { const pg8::Gemm g{Qh, KBl + (size_t)(b * NMEM) * D + h * XD, T, XD, XD, D, D, 0}; const FixedOrder F{u.pm, 0}; const EpiSoftmax e{Qh, D, 0};
                  pg8::gemm_phase<EpiSoftmax, FixedOrder, false, true>(lds, g, F, e, wv); }
                asm volatile("s_waitcnt vmcnt(0)" ::: "memory"); __syncthreads();
                { const pg8::Gemm g{Qh, VTl + (size_t)(h * XD) * (NB * NMEM) + b * NMEM, T, XD, XD, D, NB * NMEM, 0}; const FixedOrder F{u.pm, 0}; const EpiScale e{Qh, nullptr, D, 1.0f, 1, 0};
                  pg8::gemm_phase<EpiScale, FixedOrder, true, true>(lds, g, F, e, wv); }
            }
        }
        PH_END;
        PH_RUN { PH_PTRS const pg8::Gemm g{Q, (const bf16_t*)(WD(l) + WD_WXO), T, D, D, D, D, 0}; const EpiResid e{rep_ > 1 ? TMP : XB, XB, SSA(3 * l + 2)}; GEMM(EpiResid, g, e); }
        PH_END;
        PH_RUN { PH_PTRS ph_route(in, ws, lds, l, vcu, G, wv, rep_ > 1); }
        PH_END;
        PH_RUN { PH_PTRS ph_gather(ws, l, vcu, G, wv); }
        PH_END;
        PH_RUN { PH_PTRS
            const int nt = __builtin_amdgcn_readfirstlane(*(const int*)(ws + WS_SEL + SEL_NT));
            const pg8::Gemm g{(const bf16_t*)(ws + WS_XG), (const bf16_t*)(ws + WS_WEXP + (size_t)l * WEXP_STRIDE), nt * 256, 512, D, D, D, 0};
            GroupedOrder<2> S_; S_.init((const int*)(ws + WS_SEL + SEL_TILE), nt, G, vcu);
            const EpiHid e{(bf16_t*)(ws + WS_HID), (const float*)(ws + WS_SEL + SEL_GW)};
            pg8::gemm_phase<EpiHid, GroupedOrder<2>, true, true>(lds, g, S_, e, wv);
        }
        PH_END;
        PH_RUN { PH_PTRS
            const int nt = __builtin_amdgcn_readfirstlane(*(const int*)(ws + WS_SEL + SEL_NT));
            const pg8::Gemm g{(const bf16_t*)(ws + WS_HID), (const bf16_t*)(ws + WS_WEXP + (size_t)l * WEXP_STRIDE + 32 * MiB), nt * 256, D, EF, EF, EF, 0};
            GroupedOrder<4> S_; S_.init((const int*)(ws + WS_SEL + SEL_TILE), nt, G, vcu);
            const EpiY e{(bf16_t*)(ws + WS_XG)};
            pg8::gemm_phase<EpiY, GroupedOrder<4>, true, true>(lds, g, S_, e, wv);
        }
        PH_END;
        PH_RUN { PH_PTRS ph_combine(ws, l, vcu, G, (l + 1 < DEPTH) ? XN : nullptr, (l + 1 < DEPTH) ? nullptr : (float*)dout, in.final_g, wv, rep_ > 1 ? (bf16_t*)dout : XB); }
        PH_END;
    }
#undef PH_ON
#undef PH_RUN
#undef PH_PTRS
#undef PH_END
#undef GEMM
#undef GEMM_AT
#undef SS
#undef XB
#undef AQ
#undef AK
#undef AVT
#undef XN
#undef BQ
#undef BK
#undef BVT
#undef BRS
#undef GA
#undef GB
#undef MG
#undef Q
#undef MEMN
#undef KVB
#undef LOGA
#undef OAB
#undef DSF
#undef DEC
#undef SBB
#undef TMP
#undef SELE
#undef SELW
#undef WD
#undef SSA
#undef MK_EP
}

extern "C" void kernel_launch(void* const* d_in, const int* in_sizes, int n_in, void* d_out, int out_size, void* d_ws, size_t ws_size, hipStream_t stream) {
    static int grid = 0;
    if (grid == 0) {
        int dev = 0, cus = 0;
        if (hipGetDevice(&dev) != hipSuccess || hipDeviceGetAttribute(&cus, hipDeviceAttributeMultiprocessorCount, dev) != hipSuccess || cus <= 0) cus = 256;
        grid = cus;
        if (hipFuncSetAttribute((const void*)mk_fwd, hipFuncAttributeMaxDynamicSharedMemorySize, LDS_BYTES) != hipSuccess) fprintf(stderr, "kernel_launch: hipFuncSetAttribute failed\n");
        int per_cu = 0;
        if (hipOccupancyMaxActiveBlocksPerMultiprocessor(&per_cu, (const void*)mk_fwd, 512, LDS_BYTES) != hipSuccess || per_cu < 1) fprintf(stderr, "kernel_launch: occupancy query says %d blocks per CU\n", per_cu);
        (void)hipGetLastError();
        if (ws_size < WS_END || n_in != 24) fprintf(stderr, "kernel_launch: unexpected ws_size %zu / n_in %d\n", ws_size, n_in);
    }
    MKArgs a{};
    { const float** p = (const float**)&a.in; for (int i = 0; i < 24; ++i) p[i] = (const float*)d_in[i]; }
    a.ws = (unsigned char*)d_ws; a.dout = (unsigned char*)d_out;
    (void)hipMemsetAsync((unsigned char*)d_ws + WS_CTL, 0, CTL_ZERO_BYTES, stream);
#if MK_LAUNCHES == 1
    a.ph_lo = 0; a.ph_hi = N_PHASES; a.rep_phase = MK_REP_PHASE; a.rep_n = MK_REP_N;
    hipLaunchKernelGGL(mk_fwd, dim3(grid), dim3(512), LDS_BYTES, stream, a);
#else
    for (int p = 0; p < N_PHASES; ++p) { a.ph_lo = p; a.ph_hi = p + 1; a.rep_phase = -1; a.rep_n = 1; hipLaunchKernelGGL(mk_fwd, dim3(grid), dim3(512), LDS_BYTES, stream, a); }
#endif
}
```

```cpp
#include <hip/hip_runtime.h>
#include <cstdint>
#include <cstdio>
#include <cmath>

namespace cfg {
constexpr int D = 1024, NB = 2, L = 8192, T = NB * L, DEPTH = 2;
constexpr int CH = 64, NMEM = 256, NCH = L / CH;
constexpr int AH = 8, AW = 512, ALC = 8, ABAND = 576, AMAXREL = 256, RELW = 2 * AMAXREL + 1;
constexpr int BH = 4, BKW = 256, BVW = 512, BR = 16;
constexpr int INW = 5136;
constexpr int XH = 4, XD = 256;
constexpr int NG = 4, EPG = 8, NE = NG * EPG, EF = 256;
constexpr float EPS = 1e-6f;
constexpr int NPROJ = 5376;
constexpr int NPROJ_A = 9 * 256, NPROJ_V = 4 * 256, NPROJ_B = 8 * 256;

constexpr size_t MiB = 1u << 20;
constexpr size_t WS_CTL = 0, CTL_BYTES = 2 * MiB;
constexpr size_t WS_WDENSE = 2 * MiB, WDENSE_STRIDE = 23 * MiB;
constexpr size_t WD_WIN = 0, WD_WB = 11 * MiB, WD_WMO = 13 * MiB, WD_WXQ = 15 * MiB, WD_WXKV = 17 * MiB, WD_WXO = 21 * MiB;
constexpr size_t WS_WEXP = 48 * MiB, WEXP_STRIDE = 48 * MiB;
constexpr size_t WS_XB = 144 * MiB;
constexpr size_t WS_XN = 176 * MiB;
constexpr size_t WS_MIX = 208 * MiB;
constexpr size_t WS_AQ = WS_MIX, WS_AK = WS_MIX + 16 * MiB, WS_AVT = WS_MIX + 32 * MiB, WS_BVT = WS_MIX + 48 * MiB, WS_BQ = WS_MIX + 64 * MiB, WS_BK = WS_MIX + 72 * MiB,
                 WS_BRS = WS_MIX + 80 * MiB, WS_LOGA = WS_MIX + 96 * MiB;
constexpr size_t WS_SB = WS_AQ;
constexpr size_t WS_GA = WS_MIX + 16 * MiB, WS_TMP = WS_MIX + 48 * MiB, WS_MG = WS_XN;
constexpr size_t WS_Q = WS_MIX;
constexpr size_t WS_XG = WS_MIX, WS_HID = WS_MIX + 80 * MiB;
constexpr size_t WS_MEMN = 320 * MiB, WS_KVB = 321 * MiB;
constexpr size_t WS_SEL = 325 * MiB;
constexpr size_t WS_SSP = 326 * MiB;
constexpr size_t WS_DEC = 333 * MiB + 512 * 1024;
constexpr size_t WS_WR = 333 * MiB;
constexpr size_t WS_TOK = 334 * MiB;
constexpr size_t WS_END = 336 * MiB;
constexpr size_t DO_OAB = 0, DO_ST = 32 * MiB, DO_GB = 32 * MiB;
}
using namespace cfg;

#define LAS __attribute__((address_space(3)))
typedef unsigned short bf16_t;
typedef float f32x4 __attribute__((ext_vector_type(4)));
typedef unsigned u32x4 __attribute__((ext_vector_type(4)));
typedef unsigned u32x2 __attribute__((ext_vector_type(2)));

__device__ __forceinline__ float bf2f(unsigned short b) { return __uint_as_float((unsigned)b << 16); }
__device__ __forceinline__ float bflo(unsigned w) { return __uint_as_float(w << 16); }
__device__ __forceinline__ float bfhi(unsigned w) { return __uint_as_float(w & 0xffff0000u); }
__device__ __forceinline__ unsigned pkbf(float lo, float hi) { unsigned r; asm volatile("v_cvt_pk_bf16_f32 %0, %1, %2" : "=v"(r) : "v"(lo), "v"(hi)); return r; }
__device__ __forceinline__ unsigned short f2bf(float f) { return (unsigned short)(pkbf(f, 0.f) & 0xffffu); }
__device__ __forceinline__ float fsigmoid(float x) { return __builtin_amdgcn_rcpf(1.0f + __expf(-x)); }
__device__ __forceinline__ float fsilu(float x) { return x * fsigmoid(x); }
__device__ __forceinline__ float flogsigmoid(float x) { return fminf(x, 0.f) - __logf(1.0f + __expf(-fabsf(x))); }
template <int MASK> __device__ __forceinline__ float swz_xor(float v) { return __int_as_float(__builtin_amdgcn_ds_swizzle(__float_as_int(v), (MASK << 10) | 0x1f)); }
__device__ __forceinline__ float add_xor32(float v) { const auto r = __builtin_amdgcn_permlane32_swap(__float_as_uint(v), __float_as_uint(v), false, false); return __uint_as_float(r[0]) + __uint_as_float(r[1]); }
__device__ __forceinline__ float max_xor32(float v) { const auto r = __builtin_amdgcn_permlane32_swap(__float_as_uint(v), __float_as_uint(v), false, false); return fmaxf(__uint_as_float(r[0]), __uint_as_float(r[1])); }
__device__ __forceinline__ float add_xor16(float v) { return v + swz_xor<16>(v); }
__device__ __forceinline__ float wave_sum(float v) { v += swz_xor<1>(v); v += swz_xor<2>(v); v += swz_xor<4>(v); v += swz_xor<8>(v); v += swz_xor<16>(v); return add_xor32(v); }
__device__ __forceinline__ float wave_max(float v) { v = fmaxf(v, swz_xor<1>(v)); v = fmaxf(v, swz_xor<2>(v)); v = fmaxf(v, swz_xor<4>(v)); v = fmaxf(v, swz_xor<8>(v)); v = fmaxf(v, swz_xor<16>(v)); return max_xor32(v); }
__device__ __forceinline__ int shfl_idx(int v, int src_lane) { return __builtin_amdgcn_ds_bpermute(src_lane << 2, v); }
__device__ __forceinline__ unsigned char* opaque_ptr(unsigned char* p) { asm volatile("" : "+s"(p)); return p; }
__device__ __forceinline__ int lane_now() { unsigned z; asm volatile("v_mov_b32 %0, 0" : "=v"(z)); return (int)__builtin_amdgcn_mbcnt_hi(~0u, __builtin_amdgcn_mbcnt_lo(~0u, z)); }
__device__ __forceinline__ int opaque_int(int v) { asm volatile("" : "+s"(v)); return v; }
__device__ __forceinline__ int tid_of(int wv) { return (wv << 6) | lane_now(); }
__device__ __forceinline__ void st16_wt(void* p, const u32x4 v) { asm volatile("global_store_dwordx4 %0, %1, off sc1\n\ts_nop 1" :: "v"(p), "v"(v) : "memory"); }
#ifndef MK_WT
#define MK_WT 1
#endif
#if MK_WT
#define ST16_OUT(p, v) st16_wt((void*)(p), (v))
#else
#define ST16_OUT(p, v) (*(u32x4*)(p) = (v))
#endif
namespace pg8 {
#define PG8_LAS __attribute__((address_space(3)))
typedef unsigned short bf16_t;
typedef short bf16x8 __attribute__((ext_vector_type(8)));
typedef float f32x4 __attribute__((ext_vector_type(4)));
typedef unsigned u32x4 __attribute__((ext_vector_type(4)));
constexpr int BM = 256, BK = 64, HALF = 128, HTB = HALF * BK * 2  , STAGE_BYTES = 8 * HTB, NXCD = 8, WGM = 8;

__host__ __device__ __forceinline__ int lds_byte(int r, int c) { const int st = (r >> 4) * 2 + (c >> 5), rr = r & 15, cc = c & 31, ob = rr * 64 + cc * 2; return st * 1024 + (ob ^ (((ob >> 9) & 1) << 5)); }
__host__ __device__ __forceinline__ void stage_rc(int b, int& R, int& C) { const int st = b / 1024, sb = b % 1024, swz = sb ^ (((sb >> 9) & 1) << 5); R = (st >> 1) * 16 + swz / 64; C = (st & 1) * 32 + (swz % 64) / 2; }
__host__ __device__ __forceinline__ int perm32(int rho) { const int n = rho >> 4, i = rho & 15; return 8 * (i >> 2) + 4 * n + (i & 3); }

struct Unit { int pm, pn; };
struct Gemm { const bf16_t* A; const bf16_t* Bt; int M, N, K, lda, ldb, pad; };

struct StaticOrder {
    static constexpr bool GATHER = false;
    int nM, nN, nwg, G, c;
    __host__ __device__ __forceinline__ void init(int M, int N, int G_, int c_) { nM = M / BM; nN = N / BM; nwg = nM * nN; G = G_; c = c_; }
    __host__ __device__ __forceinline__ bool next(int i, Unit& u) const {
        const long L = (long)i * G + c; if (L >= nwg) return false;
        int wgid = (int)L; { const int q = nwg / NXCD, r = nwg % NXCD, xcd = wgid % NXCD, off = wgid / NXCD; wgid = (xcd < r ? xcd * (q + 1) : r * (q + 1) + (xcd - r) * q) + off; }
        const int nig = WGM * nN, gid = wgid / nig, fm = gid * WGM, gsz = (nM - fm) < WGM ? (nM - fm) : WGM;
        u.pm = fm + ((wgid % nig) % gsz); u.pn = (wgid % nig) / gsz; return true;
    }
    __device__ __forceinline__ void a_ready(const Unit&) const {}
    __device__ __forceinline__ void done(const Unit&) const {}
};


template <class Epi, class Sched, bool ALIGN_EPI = false, bool SP2 = false>
__device__ __forceinline__ void gemm_phase(PG8_LAS unsigned char* lds, const Gemm g, const Sched& S, const Epi& E, const int wv  ) {
    const int tid = tid_of(wv), wid = wv, lane = tid & 63, wr = wid >> 2, wc = wid & 3, fr = lane & 15, fq = lane >> 4;
    const int K = g.K, nt = K / BK;
    unsigned voffA[2], voffA1[2], voffB[2];
#pragma unroll
    for (int i = 0; i < 2; ++i) { int R, C; stage_rc(tid * 16 + i * 8192, R, C); const int Rb = Epi::PERM ? ((R & ~31) + perm32(R & 31)) : R;
        voffA[i] = (unsigned)(R * g.lda + C) * 2u; voffA1[i] = voffA[i]; voffB[i] = (unsigned)(Rb * g.ldb + C) * 2u; }
    const size_t kstep = (size_t)(BK * 2);
    const size_t hstepA = Sched::GATHER ? 0 : (size_t)HALF * g.lda * 2, hstepB = (size_t)HALF * g.ldb * 2;
    const size_t tstepA = 2 * hstepA, tstepB = 2 * hstepB;
    const unsigned ldsw = (unsigned)wid * 1024u;
    const int aoff = lds_byte(wr * 64 + fr, fq * 8), boff = lds_byte(wc * 32 + fr, fq * 8);
#define PG8_SA(b, h) (((b) * 2 + (h)) * HTB)
#define PG8_SB(b, h) ((4 + (b) * 2 + (h)) * HTB)
#define PG8_STAGE(bufoff, gbase, voff) do { _Pragma("unroll") for (int _i = 0; _i < 2; ++_i) \
        __builtin_amdgcn_global_load_lds((const unsigned*)((const char*)(gbase) + (voff)[_i]), (PG8_LAS unsigned*)(lds + (bufoff) + ldsw + _i * 8192), 16, 0, 0); } while (0)
#define PG8_LDA(dst, b, h) do { _Pragma("unroll") for (int m = 0; m < 4; ++m) _Pragma("unroll") for (int k = 0; k < 2; ++k) dst[m][k] = *(const PG8_LAS bf16x8*)(lds + PG8_SA(b, h) + aoff + m * 2048 + k * 1024); } while (0)
#define PG8_LDB(dst, b, h) do { _Pragma("unroll") for (int n = 0; n < 2; ++n) _Pragma("unroll") for (int k = 0; k < 2; ++k) dst[n][k] = *(const PG8_LAS bf16x8*)(lds + PG8_SB(b, h) + boff + n * 2048 + k * 1024); } while (0)
#define PG8_MMA(ai, bj, At, Bt) do { __builtin_amdgcn_s_setprio(1); _Pragma("unroll") for (int m = 0; m < 4; ++m) _Pragma("unroll") for (int n = 0; n < 2; ++n) _Pragma("unroll") for (int k = 0; k < 2; ++k) \
        acc[ai][bj][m][n] = __builtin_amdgcn_mfma_f32_16x16x32_bf16(Bt[n][k], At[m][k], acc[ai][bj][m][n], 0, 0, 0); __builtin_amdgcn_s_setprio(0); } while (0)
#define PG8_WAIT_V(n) asm volatile("s_waitcnt vmcnt(" #n ")" ::: "memory")
#define PG8_WAIT_L(n) asm volatile("s_waitcnt lgkmcnt(" #n ")" ::: "memory")
#define PG8_BAR __builtin_amdgcn_s_barrier()
#define PG8_SCHED __builtin_amdgcn_sched_barrier(0)
    Unit cur, nxt; int ui = 0;
    if (!S.next(0, cur)) return;
    if constexpr (Sched::GATHER) {
#pragma unroll
        for (int i = 0; i < 2; ++i) { int R, C; stage_rc(tid * 16 + i * 8192, R, C);
            voffA[i] = (unsigned)(S.arow(R) * g.lda + C) * 2u; voffA1[i] = (unsigned)(S.arow(R + HALF) * g.lda + C) * 2u; }
    }
    f32x4 acc[2][2][4][2];
#pragma unroll
    for (int a = 0; a < 2; ++a)
#pragma unroll
        for (int b = 0; b < 2; ++b)
#pragma unroll
            for (int m = 0; m < 4; ++m)
#pragma unroll
                for (int n = 0; n < 2; ++n) acc[a][b][m][n] = (f32x4){0.f, 0.f, 0.f, 0.f};
    bf16x8 At[4][2], B0[2][2], B1[2][2];
    const char* cA = (const char*)g.A + (size_t)cur.pm * tstepA; const char* cB = (const char*)g.Bt + (size_t)cur.pn * tstepB;
    S.a_ready(cur);
    if constexpr (SP2) {
        PG8_STAGE(PG8_SB(0, 0), cB, voffB); PG8_STAGE(PG8_SB(0, 1), cB + hstepB, voffB); PG8_STAGE(PG8_SA(0, 0), cA, voffA); PG8_STAGE(PG8_SA(0, 1), cA + hstepA, voffA1);
        if (wr == 1) PG8_BAR;
        PG8_WAIT_V(2); PG8_BAR;
        PG8_STAGE(PG8_SB(1, 0), cB + kstep, voffB); PG8_STAGE(PG8_SA(1, 0), cA + kstep, voffA); PG8_STAGE(PG8_SB(1, 1), cB + hstepB + kstep, voffB);
        PG8_WAIT_V(6); PG8_BAR;
    } else {
        PG8_STAGE(PG8_SB(0, 0), cB, voffB); PG8_STAGE(PG8_SA(0, 0), cA, voffA); PG8_STAGE(PG8_SB(0, 1), cB + hstepB, voffB); PG8_STAGE(PG8_SA(0, 1), cA + hstepA, voffA1);
        if (wr == 1) PG8_BAR;
        PG8_WAIT_V(4); PG8_BAR;
        PG8_STAGE(PG8_SB(1, 0), cB + kstep, voffB); PG8_STAGE(PG8_SA(1, 0), cA + kstep, voffA); PG8_STAGE(PG8_SB(1, 1), cB + hstepB + kstep, voffB);
        PG8_WAIT_V(6); PG8_BAR;
    }
    for (;;) {
        const bool has_next = S.next(ui + 1, nxt);
        const char* nA = has_next ? (const char*)g.A + (size_t)nxt.pm * tstepA : cA; const char* nB = has_next ? (const char*)g.Bt + (size_t)nxt.pn * tstepB : cB;
        for (int t = 0; t < nt; t += 2) {
            const bool last = (t == nt - 2);
            const char* a1 = cA + (size_t)(t + 1) * kstep;
            const char* a2 = last ? nA : cA + (size_t)(t + 2) * kstep; const char* b2 = last ? nB : cB + (size_t)(t + 2) * kstep;
            const char* a3 = a2 + kstep; const char* b3 = b2 + kstep;
            if (last && has_next) S.a_ready(nxt);
            if constexpr (SP2) {
            PG8_LDB(B0, 0, 0); PG8_LDB(B1, 0, 1); PG8_SCHED; PG8_LDA(At, 0, 0); PG8_STAGE(PG8_SA(1, 1), a1 + hstepA, voffA1);
            PG8_WAIT_V(8); PG8_WAIT_L(0); PG8_BAR; PG8_MMA(0, 0, At, B0); PG8_MMA(0, 1, At, B1); PG8_BAR; PG8_SCHED;
            PG8_LDA(At, 0, 1); PG8_STAGE(PG8_SB(0, 0), b2, voffB); PG8_STAGE(PG8_SB(0, 1), b2 + hstepB, voffB); PG8_STAGE(PG8_SA(0, 0), a2, voffA);
            PG8_WAIT_V(8); PG8_WAIT_L(0); PG8_BAR; PG8_MMA(1, 0, At, B0); PG8_MMA(1, 1, At, B1); PG8_BAR; PG8_SCHED;
            PG8_LDB(B0, 1, 0); PG8_LDB(B1, 1, 1); PG8_SCHED; PG8_LDA(At, 1, 0); PG8_STAGE(PG8_SA(0, 1), a2 + hstepA, voffA1);
            PG8_WAIT_V(8); PG8_WAIT_L(0); PG8_BAR; PG8_MMA(0, 0, At, B0); PG8_MMA(0, 1, At, B1); PG8_BAR; PG8_SCHED;
            PG8_LDA(At, 1, 1); PG8_STAGE(PG8_SB(1, 0), b3, voffB); PG8_STAGE(PG8_SB(1, 1), b3 + hstepB, voffB); PG8_STAGE(PG8_SA(1, 0), a3, voffA);
            PG8_WAIT_V(8); PG8_WAIT_L(0); PG8_BAR; PG8_MMA(1, 0, At, B0); PG8_MMA(1, 1, At, B1); PG8_BAR; PG8_SCHED;
            } else {
            PG8_LDB(B0, 0, 0); PG8_SCHED; PG8_LDA(At, 0, 0); PG8_STAGE(PG8_SA(1, 1), a1 + hstepA, voffA1);
            PG8_WAIT_L(8); PG8_BAR; PG8_WAIT_L(0); PG8_MMA(0, 0, At, B0); PG8_BAR; PG8_SCHED;
            PG8_LDB(B1, 0, 1); PG8_STAGE(PG8_SB(0, 0), b2, voffB);
            PG8_BAR; PG8_WAIT_L(0); PG8_MMA(0, 1, At, B1); PG8_BAR;
            PG8_LDA(At, 0, 1); PG8_STAGE(PG8_SA(0, 0), a2, voffA);
            PG8_BAR; PG8_WAIT_L(0); PG8_MMA(1, 0, At, B0); PG8_BAR; PG8_SCHED;
            PG8_STAGE(PG8_SB(0, 1), b2 + hstepB, voffB);
            PG8_WAIT_V(6); PG8_BAR; PG8_MMA(1, 1, At, B1); PG8_BAR;
            PG8_LDB(B0, 1, 0); PG8_SCHED; PG8_LDA(At, 1, 0); PG8_STAGE(PG8_SA(0, 1), a2 + hstepA, voffA1);
            PG8_WAIT_L(8); PG8_BAR; PG8_WAIT_L(0); PG8_MMA(0, 0, At, B0); PG8_BAR; PG8_SCHED;
            PG8_LDB(B1, 1, 1); PG8_STAGE(PG8_SB(1, 0), b3, voffB);
            PG8_BAR; PG8_WAIT_L(0); PG8_MMA(0, 1, At, B1); PG8_BAR;
            PG8_LDA(At, 1, 1); PG8_STAGE(PG8_SA(1, 0), a3, voffA);
            PG8_BAR; PG8_WAIT_L(0); PG8_MMA(1, 0, At, B0); PG8_BAR; PG8_SCHED;
            PG8_STAGE(PG8_SB(1, 1), b3 + hstepB, voffB);
            PG8_WAIT_V(6); PG8_BAR; PG8_MMA(1, 1, At, B1); PG8_BAR;
            }
        }
        if constexpr (ALIGN_EPI) { if (wr == 0) PG8_BAR; }
        if constexpr (!Epi::AFTER_DRAIN) { const int le_ = lane_now(); E(acc, cur, wr, wc, le_ & 15, le_ >> 4); S.done(cur); }
        if (!has_next) break;
#pragma unroll
        for (int a = 0; a < 2; ++a)
#pragma unroll
            for (int b = 0; b < 2; ++b)
#pragma unroll
                for (int m = 0; m < 4; ++m)
#pragma unroll
                    for (int n = 0; n < 2; ++n) acc[a][b][m][n] = (f32x4){0.f, 0.f, 0.f, 0.f};
        cur = nxt; cA = nA; cB = nB; ++ui;
        if constexpr (ALIGN_EPI) { if (wr == 1) PG8_BAR; }
    }
    PG8_WAIT_V(0);
    if constexpr (!ALIGN_EPI) { if (wr == 0) PG8_BAR; }
    PG8_BAR;
    if constexpr (Epi::AFTER_DRAIN) { const int le_ = lane_now(); E.fused(acc, cur, wr, wc, le_ & 15, le_ >> 4, lds, wid, le_); S.done(cur); }
#undef PG8_SA
#undef PG8_SB
#undef PG8_STAGE
#undef PG8_LDA
#undef PG8_LDB
#undef PG8_MMA
#undef PG8_WAIT_V
#undef PG8_WAIT_L
#undef PG8_BAR
#undef PG8_SCHED
}
}
#define XB_TMO      128
#define XB_XCNT(j)  (256  + 64 * (j))
#define XB_XSUB(j)  (1280 + 64 * (j))
#define XB_XGEN(j)  (2304 + 64 * (j))
#define XB_TOP      3328
#define XB_TOPGEN   3392
#define XCD_BAR_WORDS 3456
#define XB_SPIN_CAP (1u << 18)

__device__ __forceinline__ unsigned xb_ld(unsigned* p)              { return __hip_atomic_load(p, __ATOMIC_RELAXED, __HIP_MEMORY_SCOPE_AGENT); }
__device__ __forceinline__ unsigned xb_add(unsigned* p, unsigned v) { return __hip_atomic_fetch_add(p, v, __ATOMIC_RELAXED, __HIP_MEMORY_SCOPE_AGENT); }
__device__ __forceinline__ unsigned xb_xcc_id() { return (unsigned)__builtin_amdgcn_s_getreg((3 << 11) | 20) & 0xFu; }
#define XB_SPIN(cond, bar) do { unsigned _sp = 0; while (cond) { __builtin_amdgcn_s_sleep(1); \
    if ((++_sp & 255u) == 0u) { if (xb_ld(&(bar)[XB_TMO])) break; if (_sp > XB_SPIN_CAP) { atomicAdd(&(bar)[XB_TMO], 1u); break; } } } } while (0)

struct XcdBarrier {
    unsigned* bar; unsigned x;
    volatile LAS unsigned* st;
};

__device__ __forceinline__ XcdBarrier xcd_barrier_post(unsigned* bar, volatile LAS unsigned* st) {
    XcdBarrier b; b.bar = bar; b.x = xb_xcc_id(); b.st = st;
    if (threadIdx.x == 0) (void)xb_add(&bar[XB_XCNT(b.x)], 1u);
    return b;
}
__device__ __forceinline__ void xcd_barrier_complete(unsigned* bar, unsigned x, unsigned& nloc, unsigned& nx) {
    const unsigned G = gridDim.x * gridDim.y * gridDim.z;
    unsigned sum, cnt, mine, sp = 0u;
    for (;;) {
        sum = 0u; cnt = 0u; mine = 0u;
#pragma unroll
        for (unsigned j = 0; j < 16; ++j) { const unsigned c = xb_ld(&bar[XB_XCNT(j)]); sum += c; cnt += (c > 0u) ? 1u : 0u; }
        if (sum == G) { mine = xb_ld(&bar[XB_XCNT(x)]); break; }
        __builtin_amdgcn_s_sleep(1);
        if ((++sp & 255u) == 0u) { if (xb_ld(&bar[XB_TMO])) break; if (sp > XB_SPIN_CAP) { atomicAdd(&bar[XB_TMO], 1u); break; } }
    }
    nloc = mine > 0u ? mine : 1u; nx = cnt > 0u ? cnt : 1u;
}

__device__ __forceinline__ void xcd_barrier(const XcdBarrier& b, const bool t0  ) {
    asm volatile("s_waitcnt vmcnt(0)" ::: "memory");
    __syncthreads();
    if (t0) {
        unsigned* bar = (unsigned*)opaque_ptr((unsigned char*)b.bar);
        __builtin_amdgcn_s_waitcnt(0);
        unsigned nloc = b.st[0], nx = b.st[1];
        if (nloc == 0u) { xcd_barrier_complete(bar, b.x, nloc, nx); b.st[0] = nloc; b.st[1] = nx; }
        const unsigned old = xb_add(&bar[XB_XSUB(b.x)], 1u);
        const unsigned gen = old / nloc;
        if (old + 1u == (gen + 1u) * nloc) {
            __builtin_amdgcn_fence(__ATOMIC_RELEASE, "agent");
            asm volatile("s_waitcnt vmcnt(0)" ::: "memory");
            const unsigned og = xb_add(&bar[XB_TOP], 1u);
            const unsigned tg = og / nx;
            if (og + 1u == (tg + 1u) * nx) xb_add(&bar[XB_TOPGEN], 1u);
            else XB_SPIN(xb_ld(&bar[XB_TOPGEN]) == tg, bar);
            __builtin_amdgcn_fence(__ATOMIC_ACQUIRE, "agent");
            xb_add(&bar[XB_XGEN(b.x)], 1u);
            asm volatile("s_waitcnt vmcnt(0)" ::: "memory");
        } else {
            XB_SPIN(xb_ld(&bar[XB_XGEN(b.x)]) == gen, bar);
            __builtin_amdgcn_fence(__ATOMIC_ACQUIRE, "agent");
            asm volatile("s_waitcnt vmcnt(0)" ::: "memory");
        }
    }
    __syncthreads();
}

__device__ __forceinline__ void panel_sync(unsigned* cnt, unsigned target, const bool t0) {
    asm volatile("s_waitcnt vmcnt(0)" ::: "memory");
    __syncthreads();
    if (t0) {
        __builtin_amdgcn_s_waitcnt(0);
#if !MK_WT
        __builtin_amdgcn_fence(__ATOMIC_RELEASE, "agent");
        asm volatile("s_waitcnt vmcnt(0)" ::: "memory");
#endif
        (void)xb_add(cnt, 1u);
        unsigned sp = 0;
        while (xb_ld(cnt) < target) { __builtin_amdgcn_s_sleep(1); if (++sp > (1u << 20)) break; }
        __builtin_amdgcn_fence(__ATOMIC_ACQUIRE, "agent");
        asm volatile("s_waitcnt vmcnt(0)" ::: "memory");
    }
    __syncthreads();
}
typedef pg8::f32x4 A4;
#define EPI_ROWS_BEGIN _Pragma("unroll") for (int ai = 0; ai < 2; ++ai) _Pragma("unroll") for (int m = 0; m < 4; ++m) { const int row = u.pm * 256 + ai * 128 + wr * 64 + m * 16 + fr;
#define EPI_ROWS_END }
__device__ __forceinline__ float rstd_of(const float* ss, int row, int fq) {
    if (!ss) return 1.0f;
    const f32x4 p = *(const f32x4*)(ss + (size_t)row * 16 + fq * 4);
    float s = (p[0] + p[1]) + (p[2] + p[3]);
    s = add_xor32(add_xor16(s));
    return rsqrtf(s * (1.0f / D) + EPS);
}
__device__ __forceinline__ float rstd_row(const float* ss, size_t row) {
    const f32x4* p = (const f32x4*)(ss + row * 16); float s = 0.f;
#pragma unroll
    for (int i = 0; i < 4; ++i) { const f32x4 v = p[i]; s += (v[0] + v[1]) + (v[2] + v[3]); }
    return rsqrtf(s * (1.0f / D) + EPS);
}
__device__ __forceinline__ u32x4 pack8(const A4& a, const A4& b) { u32x4 w; w.x = pkbf(a[0], a[1]); w.y = pkbf(a[2], a[3]); w.z = pkbf(b[0], b[1]); w.w = pkbf(b[2], b[3]); return w; }
__device__ __forceinline__ void unpack8(const u32x4& w, A4& a, A4& b) { a[0] = bflo(w.x); a[1] = bfhi(w.x); a[2] = bflo(w.y); a[3] = bfhi(w.y); b[0] = bflo(w.z); b[1] = bfhi(w.z); b[2] = bflo(w.w); b[3] = bfhi(w.w); }

struct EpiScale {
    static constexpr bool PERM = true, AFTER_DRAIN = false;
    bf16_t* O; const float* ss; int ld; float scale; int wt, pad;
    __device__ __forceinline__ void operator()(const A4 (&acc)[2][2][4][2], const pg8::Unit& u, int wr, int wc, int fr, int fq) const {
        const int col0 = u.pn * 256 + wc * 32 + 8 * fq;
        EPI_ROWS_BEGIN
            const float s = rstd_of(ss, row, fq) * scale;
#pragma unroll
            for (int bj = 0; bj < 2; ++bj) { const u32x4 w = pack8(acc[ai][bj][m][0] * s, acc[ai][bj][m][1] * s); bf16_t* p = O + (size_t)row * ld + col0 + bj * 128; if (wt) ST16_OUT(p, w); else *(u32x4*)p = w; }
        EPI_ROWS_END
    }
};

struct EpiProj {
    static constexpr bool PERM = true, AFTER_DRAIN = false;
    bf16_t *AQ, *AK, *BQ, *BK, *BRS, *GA, *GB; float* LOGA; const float* balpha; int tile0, pad;
    __device__ __forceinline__ void operator()(const A4 (&acc)[2][2][4][2], const pg8::Unit& u, int wr, int wc, int fr, int fq) const {
        const int tile = u.pn + tile0;
        bf16_t* dst; int ld, c0, mode = 0; float sc = 1.f;
        if (tile < 2) { dst = AQ; ld = 512; c0 = tile * 256; sc = 0.125f * 1.4426950408889634f; }
        else if (tile < 4) { dst = AK; ld = 512; c0 = (tile - 2) * 256; }
        else if (tile == 4) { dst = BQ; ld = 256; c0 = 0; sc = 0.125f; }
        else if (tile == 5) { dst = BK; ld = 256; c0 = 0; }
        else if (tile < 8) { dst = BRS; ld = 512; c0 = (tile - 6) * 256; mode = 1; }
        else if (tile == 8) { dst = nullptr; ld = 256; c0 = 0; mode = 3; }
        else if (tile < 13) { dst = GA; ld = 1024; c0 = (tile - 9) * 256; mode = 2; }
        else { dst = GB; ld = 1024; c0 = (tile - 13) * 256; mode = 2; }
        const int cl = wc * 32 + 8 * fq;
        EPI_ROWS_BEGIN
#pragma unroll
            for (int bj = 0; bj < 2; ++bj) {
                A4 v0 = acc[ai][bj][m][0] * sc, v1 = acc[ai][bj][m][1] * sc;
                const int c = cl + bj * 128;
                if (mode == 3) {
                    const A4 b0 = *(const A4*)(balpha + c), b1 = *(const A4*)(balpha + c + 4);
#pragma unroll
                    for (int i = 0; i < 4; ++i) { v0[i] = flogsigmoid(v0[i] + b0[i]) * 0.0625f; v1[i] = flogsigmoid(v1[i] + b1[i]) * 0.0625f; }
                    float* o = LOGA + (size_t)row * 256 + c; *(A4*)o = v0; *(A4*)(o + 4) = v1;
                } else {
                    if (mode == 1) {
#pragma unroll
                        for (int i = 0; i < 4; ++i) { v0[i] = fsilu(v0[i]); v1[i] = fsilu(v1[i]); }
                    } else if (mode == 2) {
#pragma unroll
                        for (int i = 0; i < 4; ++i) { v0[i] = fsigmoid(v0[i]); v1[i] = fsigmoid(v1[i]); }
                    }
                    { const u32x4 w = pack8(v0, v1); bf16_t* p = dst + (size_t)row * ld + c0 + c; if (mode == 2) *(u32x4*)p = w; else ST16_OUT(p, w); }
                }
            }
        EPI_ROWS_END
    }
};

struct EpiGate {
    static constexpr bool PERM = true, AFTER_DRAIN = false;
    const bf16_t* G; const bf16_t* ADD; bf16_t* O;
    __device__ __forceinline__ void operator()(const A4 (&acc)[2][2][4][2], const pg8::Unit& u, int wr, int wc, int fr, int fq) const {
        const int col0 = u.pn * 256 + wc * 32 + 8 * fq;
        EPI_ROWS_BEGIN
#pragma unroll
            for (int bj = 0; bj < 2; ++bj) {
                const size_t off = (size_t)row * D + col0 + bj * 128;
                A4 g0, g1; unpack8(*(const u32x4*)(G + off), g0, g1);
                A4 v0 = acc[ai][bj][m][0] * g0, v1 = acc[ai][bj][m][1] * g1;
                if (ADD) { A4 a0, a1; unpack8(*(const u32x4*)(ADD + off), a0, a1); v0 += a0; v1 += a1; }
                { const u32x4 w = pack8(v0, v1); if (ADD) ST16_OUT(O + off, w); else *(u32x4*)(O + off) = w; }
            }
        EPI_ROWS_END
    }
};

struct EpiResid {
    static constexpr bool PERM = true, AFTER_DRAIN = false;
    bf16_t* Xo; const bf16_t* X; float* ss_out;
    __device__ __forceinline__ void operator()(const A4 (&acc)[2][2][4][2], const pg8::Unit& u, int wr, int wc, int fr, int fq) const {
        const int col0 = u.pn * 256 + wc * 32 + 8 * fq;
        EPI_ROWS_BEGIN
            float q = 0.f;
#pragma unroll
            for (int bj = 0; bj < 2; ++bj) {
                const size_t off = (size_t)row * D + col0 + bj * 128;
                A4 x0, x1; unpack8(*(const u32x4*)(X + off), x0, x1);
                x0 += acc[ai][bj][m][0]; x1 += acc[ai][bj][m][1];
                q += (x0[0] * x0[0] + x0[1] * x0[1]) + (x0[2] * x0[2] + x0[3] * x0[3]) + (x1[0] * x1[0] + x1[1] * x1[1]) + (x1[2] * x1[2] + x1[3] * x1[3]);
                ST16_OUT(Xo + off, pack8(x0, x1));
            }
            q = add_xor32(add_xor16(q));
            if (fq == 0) __hip_atomic_store(ss_out + (size_t)row * 16 + u.pn * 4 + wc, q, __ATOMIC_RELAXED, __HIP_MEMORY_SCOPE_AGENT);
        EPI_ROWS_END
    }
};

struct ConvRegs { f32x4 v[8]; };
__device__ __forceinline__ void conv_load(ConvRegs& R, const float* __restrict__ W, int ldw, int k0, int n0, int lane) {
#pragma unroll
    for (int i = 0; i < 8; ++i) { const int kk = (lane >> 3) + 8 * i; R.v[i] = __builtin_nontemporal_load((const f32x4*)(W + (size_t)(k0 + kk) * ldw + n0 + (lane & 7) * 4)); }
}
__device__ __forceinline__ void conv_store(const ConvRegs& R, const float* __restrict__ gk, bf16_t* __restrict__ WT, int ldt, int k0, int n0, LAS float* scr, int lane) {
#pragma unroll
    for (int i = 0; i < 8; ++i) { const int kk = (lane >> 3) + 8 * i; const float s = gk ? gk[k0 + kk] : 1.0f; LAS float* p = scr + kk * 33 + (lane & 7) * 4;
        p[0] = R.v[i][0] * s; p[1] = R.v[i][1] * s; p[2] = R.v[i][2] * s; p[3] = R.v[i][3] * s; }
    asm volatile("s_waitcnt lgkmcnt(0)" ::: "memory");
    const int c = lane & 7;
#pragma unroll
    for (int j = 0; j < 4; ++j) { const int n = (lane >> 3) + 8 * j; const LAS float* s = scr + (8 * c) * 33 + n;
        u32x4 o; o.x = pkbf(s[0 * 33], s[1 * 33]); o.y = pkbf(s[2 * 33], s[3 * 33]); o.z = pkbf(s[4 * 33], s[5 * 33]); o.w = pkbf(s[6 * 33], s[7 * 33]);
        *(u32x4*)(WT + (size_t)(n0 + n) * ldt + k0 + 8 * c) = o; }
    asm volatile("s_waitcnt lgkmcnt(0)" ::: "memory");
}
__device__ __forceinline__ void conv_item(const float* __restrict__ W, int ldw, const float* __restrict__ gk, bf16_t* __restrict__ WT, int ldt, int k0, int n0, LAS float* scr, int lane) {
    ConvRegs R; conv_load(R, W, ldw, k0, n0, lane); conv_store(R, gk, WT, ldt, k0, n0, scr, lane);
}

struct InPtrs {
    const float *x, *mem, *norm_mix_g, *w_in, *rel_bias, *gla_w_alpha, *gla_b_alpha, *gla_norm_g, *w_branch, *w_mix_out, *norm_x_g, *mem_norm_g, *w_xq, *w_xkv, *w_xo,
                *norm_ffn_g, *w_gr, *b_gr, *w_er, *b_er, *w_eg, *w_eu, *w_ed, *final_g;
};

struct ConvJob { const float* W; const float* gk; bf16_t* WT; int ldw, ldt, K, N; };
__device__ __forceinline__ ConvJob dense_job(const InPtrs& in, unsigned char* ws, int l, int j) {
    unsigned char* wd = ws + WS_WDENSE + (size_t)l * WDENSE_STRIDE;
    const float* Win = in.w_in + (size_t)l * D * INW; bf16_t* WIN_T = (bf16_t*)(wd + WD_WIN);
    const float* gm = in.norm_mix_g + l * D;
    ConvJob J;
    switch (j) {
    case 0: J = {Win + 0, gm, WIN_T + (size_t)0 * D, INW, D, D, 1024}; break;
    case 1: J = {Win + 1024, gm, WIN_T + (size_t)2304 * D, INW, D, D, 512}; break;
    case 2: J = {Win + 1536, gm, WIN_T + (size_t)1024 * D, INW, D, D, 512}; break;
    case 3: J = {Win + 2048, gm, WIN_T + (size_t)2816 * D, INW, D, D, 512}; break;
    case 4: J = {Win + 3088, gm, WIN_T + (size_t)3328 * D, INW, D, D, 2048}; break;
    case 11: J = {Win + 2576, gm, WIN_T + (size_t)1536 * D, INW, D, D, 512}; break;
    case 5: J = {in.w_branch + (size_t)(l * 2 + 0) * 512 * D, nullptr, (bf16_t*)(wd + WD_WB), D, D, 512, D}; break;
    case 6: J = {in.w_branch + (size_t)(l * 2 + 1) * 512 * D, nullptr, (bf16_t*)(wd + WD_WB) + 512, D, D, 512, D}; break;
    case 7: J = {in.w_mix_out + (size_t)l * D * D, nullptr, (bf16_t*)(wd + WD_WMO), D, D, D, D}; break;
    case 8: J = {in.w_xq + (size_t)l * D * D, in.norm_x_g + l * D, (bf16_t*)(wd + WD_WXQ), D, D, D, D}; break;
    case 9: J = {in.w_xkv + (size_t)l * D * 2 * D, nullptr, (bf16_t*)(wd + WD_WXKV), 2 * D, D, D, 2 * D}; break;
    default: J = {in.w_xo + (size_t)l * D * D, nullptr, (bf16_t*)(wd + WD_WXO), D, D, D, D}; break;
    }
    return J;
}

__device__ __forceinline__ void conv_dense_layer(const InPtrs& in, unsigned char* ws, int l, int gw, int NGW, int gt, int NGT, LAS float* scr, int lane) {
#pragma nounroll
    for (int j = 0; j < 12; ++j) {
            const ConvJob J = dense_job(in, ws, l, j);
            const int nnb = J.N / 32, nit = (J.K / 64) * nnb;
#pragma nounroll
            for (int it = gw; it < nit; it += 2 * NGW) {
                const int it2 = it + NGW; ConvRegs R0, R1;
                conv_load(R0, J.W, J.ldw, (it / nnb) * 64, (it % nnb) * 32, lane);
                if (it2 < nit) conv_load(R1, J.W, J.ldw, (it2 / nnb) * 64, (it2 % nnb) * 32, lane);
                conv_store(R0, J.gk, J.WT, J.ldt, (it / nnb) * 64, (it % nnb) * 32, scr, lane);
                if (it2 < nit) conv_store(R1, J.gk, J.WT, J.ldt, (it2 / nnb) * 64, (it2 % nnb) * 32, scr, lane);
            }
        }
    {
        bf16_t* WIN_T = (bf16_t*)(ws + WS_WDENSE + (size_t)l * WDENSE_STRIDE + WD_WIN);
        const float* Win = in.w_in + (size_t)l * D * INW; const float* Wa = in.gla_w_alpha + (size_t)l * BR * BKW; const float* gm = in.norm_mix_g + l * D;
        for (int i = gt; i < 256 * D; i += NGT) {
            const int c = i >> 10, k = i & 1023; float s = 0.f;
#pragma unroll
            for (int r = 0; r < BR; ++r) s += Win[(size_t)k * INW + 2560 + r] * Wa[r * BKW + c];
            WIN_T[(size_t)(2048 + c) * D + k] = f2bf(s * gm[k]);
        }
    }
}
__device__ __forceinline__ void ph_prologue(const InPtrs& in, unsigned char* ws, LAS unsigned char* lds, int vcu, int G, int wv) {
    const int tid = tid_of(wv), lane = tid & 63, wave = wv;
    LAS float* scr = (LAS float*)(lds + wave * 16384);
    const int gw = vcu * 8 + wave, NGW = G * 8;
    conv_dense_layer(in, ws, 0, gw, NGW, vcu * 512 + tid, G * 512, scr, lane);
    bf16_t* XB = (bf16_t*)(ws + WS_XB); bf16_t* XN = (bf16_t*)(ws + WS_XN);
    for (int r = gw; r < T; r += NGW) {
        const float4* xr = (const float4*)(in.x + (size_t)r * D) + lane; float4 v[4]; float s = 0.f;
#pragma unroll
        for (int j = 0; j < 4; ++j) { v[j] = xr[64 * j]; s += v[j].x * v[j].x + v[j].y * v[j].y + v[j].z * v[j].z + v[j].w * v[j].w;
            u32x2 o; o.x = pkbf(v[j].x, v[j].y); o.y = pkbf(v[j].z, v[j].w); *(u32x2*)(XB + (size_t)r * D + (lane + 64 * j) * 4) = o; }
        const float rs = rsqrtf(wave_sum(s) * (1.0f / D) + EPS);
#pragma unroll
        for (int j = 0; j < 4; ++j) { u32x2 o; o.x = pkbf(v[j].x * rs, v[j].y * rs); o.y = pkbf(v[j].z * rs, v[j].w * rs); *(u32x2*)(XN + (size_t)r * D + (lane + 64 * j) * 4) = o; }
    }
    bf16_t* MEMN = (bf16_t*)(ws + WS_MEMN);
    for (int r = gw; r < NB * NMEM; r += NGW) {
        const float4* xr = (const float4*)(in.mem + (size_t)r * D) + lane; float4 v[4]; float s = 0.f;
#pragma unroll
        for (int j = 0; j < 4; ++j) { v[j] = xr[64 * j]; s += v[j].x * v[j].x + v[j].y * v[j].y + v[j].z * v[j].z + v[j].w * v[j].w; }
        const float rs = rsqrtf(wave_sum(s) * (1.0f / D) + EPS);
#pragma unroll
        for (int j = 0; j < 4; ++j) { const float4 g = ((const float4*)in.mem_norm_g)[lane + 64 * j];
            u32x2 o; o.x = pkbf(v[j].x * rs * g.x, v[j].y * rs * g.y); o.y = pkbf(v[j].z * rs * g.z, v[j].w * rs * g.w); *(u32x2*)(MEMN + (size_t)r * D + (lane + 64 * j) * 4) = o; }
    }
}

__device__ __forceinline__ void d_band_attn(int blk, int qi, const bf16_t* __restrict__ AQ, const bf16_t* __restrict__ AK, const bf16_t* __restrict__ AV, const float* __restrict__ rel, bf16_t* __restrict__ OAB) {
    const int n = blk % NCH, h = (blk / NCH) % AH, b = blk / (NCH * AH);
    const size_t qrow = (size_t)(b * L + n * CH + qi);
    float q[64], acc[64];
#pragma unroll
    for (int d = 0; d < 64; d += 8) { const u32x4 w = *(const u32x4*)(AQ + qrow * AW + h * 64 + d);
        q[d] = bflo(w.x); q[d + 1] = bfhi(w.x); q[d + 2] = bflo(w.y); q[d + 3] = bfhi(w.y); q[d + 4] = bflo(w.z); q[d + 5] = bfhi(w.z); q[d + 6] = bflo(w.w); q[d + 7] = bfhi(w.w); }
#pragma unroll
    for (int d = 0; d < 64; ++d) acc[d] = 0.f;
    float m = -INFINITY, l = 0.f;
    for (int j = 0; j < ABAND; ++j) {
        const int kc = n + (j >> 6) - ALC; if (kc < 0) continue;
        const size_t krow = (size_t)(b * L + kc * CH + (j & 63));
        const bf16_t* kp = AK + krow * AW + h * 64; const bf16_t* vp = AV + krow * AW + h * 64;
        float s = 0.f;
#pragma unroll
        for (int d = 0; d < 64; d += 8) { const u32x4 w = *(const u32x4*)(kp + d);
            s += q[d] * bflo(w.x) + q[d + 1] * bfhi(w.x) + q[d + 2] * bflo(w.y) + q[d + 3] * bfhi(w.y) + q[d + 4] * bflo(w.z) + q[d + 5] * bfhi(w.z) + q[d + 6] * bflo(w.w) + q[d + 7] * bfhi(w.w); }
        int relp = (ALC * CH + qi) - j; relp = relp < -AMAXREL ? -AMAXREL : (relp > AMAXREL ? AMAXREL : relp);
        s = s + rel[h * RELW + relp + AMAXREL];
        const float mn = fmaxf(m, s), corr = __expf(m - mn), p = __expf(s - mn);
        l = l * corr + p; m = mn;
#pragma unroll
        for (int d = 0; d < 64; d += 8) { const u32x4 w = *(const u32x4*)(vp + d);
            acc[d] = acc[d] * corr + p * bflo(w.x); acc[d + 1] = acc[d + 1] * corr + p * bfhi(w.x); acc[d + 2] = acc[d + 2] * corr + p * bflo(w.y); acc[d + 3] = acc[d + 3] * corr + p * bfhi(w.y);
            acc[d + 4] = acc[d + 4] * corr + p * bflo(w.z); acc[d + 5] = acc[d + 5] * corr + p * bfhi(w.z); acc[d + 6] = acc[d + 6] * corr + p * bflo(w.w); acc[d + 7] = acc[d + 7] * corr + p * bfhi(w.w); }
    }
    const float inv = 1.0f / l;
#pragma unroll
    for (int d = 0; d < 64; d += 8) { u32x4 o; o.x = pkbf(acc[d] * inv, acc[d + 1] * inv); o.y = pkbf(acc[d + 2] * inv, acc[d + 3] * inv); o.z = pkbf(acc[d + 4] * inv, acc[d + 5] * inv); o.w = pkbf(acc[d + 6] * inv, acc[d + 7] * inv);
        *(u32x4*)(OAB + qrow * D + h * 64 + d) = o; }
}

__device__ __forceinline__ void d_gla(int wv, int item, LAS float* sm  , const bf16_t* __restrict__ BQ, const bf16_t* __restrict__ BK, const bf16_t* __restrict__ BV, const float* __restrict__ LOGA, float* __restrict__ raw) {
    LAS float* sq = sm; LAS float* sk = sm + 128; LAS float* sa = sm + 256;
    const int b = item / BH, h = item % BH, v = tid_of(wv);
    float S[64];
#pragma unroll
    for (int k = 0; k < 64; ++k) S[k] = 0.f;
    for (int t = 0; t < L; ++t) {
        const size_t row = (size_t)(b * L + t); const int bf = (t & 1) * 64;
        float vv = 0.f;
        if (v < 64) { sq[bf + v] = bf2f(BQ[row * BKW + h * 64 + v]); sa[bf + v] = __expf(LOGA[row * BKW + h * 64 + v]); }
        else if (v < 128) { sk[bf + v - 64] = bf2f(BK[row * BKW + h * 64 + (v - 64)]); }
        if (v < 128) vv = bf2f(BV[(size_t)(h * 128 + v) * T + row]);
        __syncthreads();
        if (v < 128) {
            float o = 0.f;
#pragma unroll
            for (int k = 0; k < 64; ++k) { S[k] = sa[bf + k] * S[k] + sk[bf + k] * vv; o += sq[bf + k] * S[k]; }
            raw[row * BVW + h * 128 + v] = o;
        }
    }
}
__device__ __forceinline__ void d_gla_post(int w, int lane, const float* __restrict__ raw, const bf16_t* __restrict__ BRS, const float* __restrict__ g, bf16_t* __restrict__ OAB) {
    const size_t t = w / BH; const int h = w % BH;
    const float* p = raw + t * BVW + h * 128;
    const float a = p[lane], c = p[lane + 64];
    const float rs = rsqrtf(wave_sum(a * a + c * c) * (1.0f / 128.0f) + EPS);
    const bf16_t* br = BRS + t * BVW + h * 128;
    bf16_t* o = OAB + t * D + 512 + h * 128;
    o[lane] = f2bf(a * rs * g[lane] * bf2f(br[lane])); o[lane + 64] = f2bf(c * rs * g[lane + 64] * bf2f(br[lane + 64]));
}

__device__ __forceinline__ void d_xattn(int item, int j, LAS float* sm, bf16_t* QO, const bf16_t* __restrict__ kv) {
    LAS float* qs = sm; LAS float* ps = sm + 256; LAS float* red = sm + 512;
    const size_t t = item / XH; const int h = item % XH, b = (int)(t / L);
    qs[j] = bf2f(QO[t * D + h * XD + j]);
    __syncthreads();
    const bf16_t* kp = kv + (size_t)(b * NMEM + j) * 2048 + h * XD;
    float s = 0.f;
    for (int d = 0; d < XD; d += 8) { const u32x4 w = *(const u32x4*)(kp + d);
        s += qs[d] * bflo(w.x) + qs[d + 1] * bfhi(w.x) + qs[d + 2] * bflo(w.y) + qs[d + 3] * bfhi(w.y) + qs[d + 4] * bflo(w.z) + qs[d + 5] * bfhi(w.z) + qs[d + 6] * bflo(w.w) + qs[d + 7] * bfhi(w.w); }
    float m = wave_max(s);
    if ((j & 63) == 0) red[j >> 6] = m;
    __syncthreads();
    m = fmaxf(fmaxf(red[0], red[1]), fmaxf(red[2], red[3]));
    __syncthreads();
    const float p = __expf(s - m);
    float l = wave_sum(p);
    if ((j & 63) == 0) red[j >> 6] = l;
    ps[j] = p;
    __syncthreads();
    l = red[0] + red[1] + red[2] + red[3];
    const bf16_t* vp = kv + (size_t)(b * NMEM) * 2048 + 1024 + h * XD + j;
    float o = 0.f;
    for (int jj = 0; jj < NMEM; ++jj) o += ps[jj] * bf2f(vp[(size_t)jj * 2048]);
    QO[t * D + h * XD + j] = f2bf(o / l);
    __syncthreads();
}

__device__ __forceinline__ void d_route(size_t t, int lane, const bf16_t* __restrict__ XB, const float* __restrict__ ss, const float* __restrict__ g, const float* __restrict__ wgr, const float* __restrict__ bgr,
                                        const float* __restrict__ wer, const float* __restrict__ ber, int* __restrict__ sel_e, float* __restrict__ sel_w) {
    const float rs = rstd_row(ss, t);
    float gl[4], el[32];
#pragma unroll
    for (int i = 0; i < 4; ++i) gl[i] = 0.f;
#pragma unroll
    for (int i = 0; i < 32; ++i) el[i] = 0.f;
    for (int i = 0; i < 16; ++i) { const int d = lane + 64 * i; const float hv = bf2f(XB[t * D + d]) * rs * g[d];
#pragma unroll
        for (int o = 0; o < 4; ++o) gl[o] += hv * wgr[d * NG + o];
#pragma unroll
        for (int o = 0; o < 32; ++o) el[o] += hv * wer[d * NE + o]; }
#pragma unroll
    for (int i = 0; i < 4; ++i) gl[i] = wave_sum(gl[i]) + bgr[i];
#pragma unroll
    for (int i = 0; i < 32; ++i) el[i] = wave_sum(el[i]) + ber[i];
    float gm = gl[0]; int gi = 0;
#pragma unroll
    for (int i = 1; i < 4; ++i) if (gl[i] > gm) { gm = gl[i]; gi = i; }
    float gs = 0.f;
#pragma unroll
    for (int i = 0; i < 4; ++i) gs += __expf(gl[i] - gm);
    const float gw = 1.0f / gs;
    float v0 = -INFINITY, v1 = -INFINITY; int i0 = 0, i1 = 0;
#pragma unroll
    for (int gg = 0; gg < 4; ++gg)
#pragma unroll
        for (int e = 0; e < EPG; ++e) if (gg == gi) { const float x = el[gg * EPG + e];
            if (x > v0) { v1 = v0; i1 = i0; v0 = x; i0 = e; } else if (x > v1) { v1 = x; i1 = e; } }
    const float e1 = __expf(v1 - v0), den = 1.0f + e1;
    if (lane == 0) { sel_e[t * 2] = gi * EPG + i0; sel_e[t * 2 + 1] = gi * EPG + i1; sel_w[t * 2] = gw / den; sel_w[t * 2 + 1] = gw * e1 / den; }
}

__device__ __forceinline__ void d_moe(size_t t, int f, LAS float* sm, bf16_t* XB, const float* __restrict__ ss, const float* __restrict__ g, const float* __restrict__ Wg, const float* __restrict__ Wu, const float* __restrict__ Wd,
                                      const int* __restrict__ sel_e, const float* __restrict__ sel_w, float* __restrict__ ss_next) {
    LAS float* hs = sm; LAS float* hid = sm + 1024; LAS float* red = sm + 1280;
    const float rs = rstd_row(ss, t);
    for (int i = f; i < D; i += 256) hs[i] = bf2f(XB[t * D + i]) * rs * g[i];
    float y0 = 0.f, y1 = 0.f, y2 = 0.f, y3 = 0.f;
    for (int s = 0; s < 2; ++s) {
        const int e = sel_e[t * 2 + s]; const float w = sel_w[t * 2 + s];
        __syncthreads();
        const float* wg = Wg + (size_t)e * D * EF + f; const float* wu = Wu + (size_t)e * D * EF + f;
        float ga = 0.f, up = 0.f;
        for (int d = 0; d < D; ++d) { ga += hs[d] * wg[(size_t)d * EF]; up += hs[d] * wu[(size_t)d * EF]; }
        hid[f] = ga / (1.0f + __expf(-ga)) * up * w;
        __syncthreads();
        const float* wd = Wd + (size_t)e * EF * D + f;
        for (int ff = 0; ff < EF; ++ff) { const float hv = hid[ff]; const float* r = wd + (size_t)ff * D; y0 += hv * r[0]; y1 += hv * r[256]; y2 += hv * r[512]; y3 += hv * r[768]; }
    }
    bf16_t* xr = XB + t * D + f;
    const float x0 = bf2f(xr[0]) + y0, x1 = bf2f(xr[256]) + y1, x2 = bf2f(xr[512]) + y2, x3 = bf2f(xr[768]) + y3;
    xr[0] = f2bf(x0); xr[256] = f2bf(x1); xr[512] = f2bf(x2); xr[768] = f2bf(x3);
    const float q = wave_sum(x0 * x0 + x1 * x1 + x2 * x2 + x3 * x3);
    __syncthreads();
    if ((f & 63) == 0) red[f >> 6] = q;
    __syncthreads();
    if (f < 16) ss_next[t * 16 + f] = f == 0 ? (red[0] + red[1]) + (red[2] + red[3]) : 0.f;
    __syncthreads();
}

__device__ __forceinline__ void d_final(size_t t, int i, const bf16_t* __restrict__ XB, const float* __restrict__ ss, const float* __restrict__ g, float* __restrict__ out) {
    const float rs = rstd_row(ss, t);
    const u32x2 w = *(const u32x2*)(XB + t * D + i * 4); const float4 gg = ((const float4*)g)[i];
    float4 o; o.x = bflo(w.x) * rs * gg.x; o.y = bfhi(w.x) * rs * gg.y; o.z = bflo(w.y) * rs * gg.z; o.w = bfhi(w.y) * rs * gg.w;
    ((float4*)(out + t * D))[i] = o;
}
typedef short bf16x8_t __attribute__((ext_vector_type(8)));
constexpr int NRMAX = 40960;
constexpr int NTMAX = NRMAX / 256;
constexpr int CW_CNT = 256;
constexpr size_t SEL_SELE = 0, SEL_SELW = 128 * 1024, SEL_LPOS = 256 * 1024, SEL_POS = 384 * 1024, SEL_GW = 512 * 1024, SEL_TILE = 768 * 1024, SEL_NT = 768 * 1024 + 4096, SEL_RS = 896 * 1024;

struct ExpItem { const float* W; const float* gk; bf16_t* WT; int ldw, ldt, k0, n0; };
__device__ __forceinline__ ExpItem expert_item(const InPtrs& in, unsigned char* ws, int it) {
    const int le = it / 384, r = it % 384, l = le >> 5, e = le & 31;
    bf16_t* WGU = (bf16_t*)(ws + WS_WEXP + (size_t)l * WEXP_STRIDE) + (size_t)e * 512 * D;
    bf16_t* WDT = (bf16_t*)(ws + WS_WEXP + (size_t)l * WEXP_STRIDE + 32 * MiB) + (size_t)e * D * EF;
    const size_t eo = ((size_t)l * NE + e) * D * EF;
    ExpItem I;
    if (r < 256) { const int p = r >> 6, q = r & 63; I = {((p & 1) ? in.w_eu : in.w_eg) + eo + (p >> 1) * 128, in.norm_ffn_g + l * D, WGU + (size_t)(p * 128) * D, EF, D, (q >> 2) * 64, (q & 3) * 32}; }
    else { const int q = r - 256; I = {in.w_ed + eo, nullptr, WDT, D, EF, (q >> 5) * 64, (q & 31) * 32}; }
    return I;
}
__device__ __forceinline__ void conv_expert_items(const InPtrs& in, unsigned char* ws, int it_lo, int it_hi, int gw, int NGW, LAS float* scr, int lane) {
#pragma nounroll
    for (int it = it_lo + gw; it < it_hi; it += 2 * NGW) {
        const int it2 = it + NGW; ConvRegs R0, R1;
        const ExpItem A = expert_item(in, ws, it); conv_load(R0, A.W, A.ldw, A.k0, A.n0, lane);
        ExpItem B = A; if (it2 < it_hi) { B = expert_item(in, ws, it2); conv_load(R1, B.W, B.ldw, B.k0, B.n0, lane); }
        conv_store(R0, A.gk, A.WT, A.ldt, A.k0, A.n0, scr, lane);
        if (it2 < it_hi) conv_store(R1, B.gk, B.WT, B.ldt, B.k0, B.n0, scr, lane);
    }
}
__device__ __forceinline__ void conv_router(const InPtrs& in, unsigned char* ws, int vcu, int G, int tid) {
    for (int i = vcu * 512 + tid; i < DEPTH * 48 * D; i += G * 512) {
        const int l = i / (48 * D), r = (i / D) % 48, k = i % D; float v = 0.f;
        if (r < NG) v = in.w_gr[((size_t)l * D + k) * NG + r]; else if (r < NG + NE) v = in.w_er[((size_t)l * D + k) * NE + (r - NG)];
        ((bf16_t*)(ws + WS_WR))[i] = f2bf(v * in.norm_ffn_g[l * D + k]);
    }
}

__device__ __forceinline__ void ph_route(const InPtrs& in, unsigned char* ws, LAS unsigned char* lds, int l, int t0  , int wv, bool dummy_cnt) {
    const int tid = tid_of(wv), lane = tid & 63, wave = wv;
    const bf16_t* XB = (const bf16_t*)(ws + WS_XB); const bf16_t* WR = (const bf16_t*)(ws + WS_WR) + (size_t)l * 48 * D;
    const float* ss = (const float*)(ws + WS_SSP) + (size_t)(3 * l + 2) * T * 16;
    int* SELE = (int*)(ws + WS_SEL + SEL_SELE); float* SELW = (float*)(ws + WS_SEL + SEL_SELW); int* LPOS = (int*)(ws + WS_SEL + SEL_LPOS);
    float* RSTD = (float*)(ws + WS_SEL + SEL_RS); int* TOKS = (int*)(ws + WS_TOK);
    unsigned* CNT = (unsigned*)(ws + WS_CTL) + CW_CNT + 32 * l + (dummy_cnt ? 128 : 0);
    LAS float* lg = (LAS float*)lds + wave * (16 * 49);
    LAS unsigned* hist = (LAS unsigned*)(lds + 32768); LAS unsigned* gbase = hist + 32;
    {
        if (tid < 32) hist[tid] = 0u;
        int e0 = 0, e1 = 0; unsigned r0 = 0, r1 = 0;
        {
            const int tw = t0 + (wave & 3) * 16, kh = (wave >> 2) * (D / 2);
            f32x4 acc[3];
#pragma unroll
            for (int nb = 0; nb < 3; ++nb) acc[nb] = (f32x4){0.f, 0.f, 0.f, 0.f};
            const bf16_t* ap = XB + (size_t)(tw + (lane & 15)) * D + kh + 8 * (lane >> 4);
            const bf16_t* bp = WR + (size_t)(lane & 15) * D + kh + 8 * (lane >> 4);
#pragma unroll
            for (int k0 = 0; k0 < D / 64; k0 += 8) {
                bf16x8_t a[8], b[8][3];
#pragma unroll
                for (int kk = 0; kk < 8; ++kk) { a[kk] = *(const bf16x8_t*)(ap + (k0 + kk) * 32);
#pragma unroll
                    for (int nb = 0; nb < 3; ++nb) b[kk][nb] = *(const bf16x8_t*)(bp + (size_t)nb * 16 * D + (k0 + kk) * 32); }
#pragma unroll
                for (int kk = 0; kk < 8; ++kk)
#pragma unroll
                    for (int nb = 0; nb < 3; ++nb) acc[nb] = __builtin_amdgcn_mfma_f32_16x16x32_bf16(a[kk], b[kk][nb], acc[nb], 0, 0, 0);
            }
#pragma unroll
            for (int nb = 0; nb < 3; ++nb)
#pragma unroll
                for (int r = 0; r < 4; ++r) lg[((lane >> 4) * 4 + r) * 49 + nb * 16 + (lane & 15)] = acc[nb][r];
        }
        __syncthreads();
        if (wave < 4 && lane < 16) {
            const int t = t0 + wave * 16 + lane; const float rs = rstd_row(ss, (size_t)t);
            const LAS float* p = lg + lane * 49; const LAS float* p2 = p + 4 * (16 * 49);
            float gm = -INFINITY; int gi = 0;
#pragma unroll
            for (int i = 0; i < NG; ++i) { const float x = (p[i] + p2[i]) * rs + in.b_gr[l * NG + i]; if (x > gm) { gm = x; gi = i; } }
            float gs = 0.f;
#pragma unroll
            for (int i = 0; i < NG; ++i) gs += __expf((p[i] + p2[i]) * rs + in.b_gr[l * NG + i] - gm);
            const float gw = 1.0f / gs;
            float v0 = -INFINITY, v1 = -INFINITY; int i0 = 0, i1 = 0;
#pragma unroll
            for (int e = 0; e < EPG; ++e) { const float x = (p[NG + gi * EPG + e] + p2[NG + gi * EPG + e]) * rs + in.b_er[l * NE + gi * EPG + e];
                if (x > v0) { v1 = v0; i1 = i0; v0 = x; i0 = e; } else if (x > v1) { v1 = x; i1 = e; } }
            const float ex = __expf(v1 - v0), den = 1.0f + ex;
            e0 = gi * EPG + i0; e1 = gi * EPG + i1;
            SELE[t * 2] = e0; SELE[t * 2 + 1] = e1; SELW[t * 2] = gw / den; SELW[t * 2 + 1] = gw * ex / den; RSTD[t] = rs;
            r0 = __hip_atomic_fetch_add(&hist[e0], 1u, __ATOMIC_RELAXED, __HIP_MEMORY_SCOPE_WORKGROUP); r1 = __hip_atomic_fetch_add(&hist[e1], 1u, __ATOMIC_RELAXED, __HIP_MEMORY_SCOPE_WORKGROUP);
        }
        __syncthreads();
        if (tid < 32) gbase[tid] = hist[tid] ? atomicAdd(&CNT[tid], hist[tid]) : 0u;
        __syncthreads();
        if (wave < 4 && lane < 16) { const int t = t0 + wave * 16 + lane; const int p0 = (int)(gbase[e0] + r0), p1 = (int)(gbase[e1] + r1);
            LPOS[t * 2] = p0; LPOS[t * 2 + 1] = p1; TOKS[(size_t)e0 * T + p0] = 2 * t; TOKS[(size_t)e1 * T + p1] = 2 * t + 1; }
        __syncthreads();
    }
}

__device__ __forceinline__ int moe_prefix(const unsigned* CNT, int lane, int& cnt, int& tile0, int& ntile) {
    cnt = (lane < 32) ? (int)__hip_atomic_load(CNT + (lane & 31), __ATOMIC_RELAXED, __HIP_MEMORY_SCOPE_AGENT) : 0;
    ntile = (cnt + 255) >> 8;
    int incl = ntile;
#pragma unroll
    for (int o = 1; o < 32; o <<= 1) { const int y = shfl_idx(incl, (lane - o) & 63); if ((lane & 31) >= o) incl += y; }
    tile0 = incl - ntile;
    return shfl_idx(incl, 31);
}
__device__ __forceinline__ void moe_tables(unsigned char* ws, int l, LAS int* tb, int vcu, int wave, int lane) {
    if (wave == 0) {
        int cnt, t0, nt_e; const int nt = moe_prefix((const unsigned*)(ws + WS_CTL) + CW_CNT + 32 * l, lane, cnt, t0, nt_e);
        if (lane < 32) { tb[lane] = cnt; tb[32 + lane] = t0; for (int r = t0; r < t0 + nt_e; ++r) tb[96 + r] = lane; }
        if (lane == 0) tb[64] = nt;
        if (vcu == 0) {
            int* TILE_E = (int*)(ws + WS_SEL + SEL_TILE);
            if (lane < 32) for (int r = t0; r < t0 + nt_e; ++r) TILE_E[r] = lane;
            if (lane == 0) *(int*)(ws + WS_SEL + SEL_NT) = nt;
        }
    }
    asm volatile("s_waitcnt lgkmcnt(0)" ::: "memory");
    __syncthreads();
}
struct GatherOrder {
    static constexpr bool GATHER = true;
    int pm, pn; const int* toks; int tl, cnt;
    __device__ __forceinline__ bool next(int i, pg8::Unit& u) const { if (i != 0) return false; u.pm = pm; u.pn = pn; return true; }
    __device__ __forceinline__ int arow(int R) const { const int p = tl * 256 + R; return p < cnt ? (toks[p] >> 1) : 0; }
    __device__ __forceinline__ void a_ready(const pg8::Unit&) const {}
    __device__ __forceinline__ void done(const pg8::Unit&) const {}
};
template <int NJ> struct GroupedOrder {
    static constexpr bool GATHER = false;
    const int* tile_e; int nunits, G, c;
    __device__ __forceinline__ void init(const int* te, int nt, int G_, int c_) { tile_e = te; nunits = nt * NJ; G = G_; c = c_; }
    __device__ __forceinline__ bool next(int i, pg8::Unit& u) const {
        const int L = i * G + c; if (L >= nunits) return false;
        const int rt = L / NJ, j = L % NJ;
        u.pm = rt; u.pn = __builtin_amdgcn_readfirstlane(tile_e[rt]) * NJ + j; return true;
    }
    __device__ __forceinline__ void a_ready(const pg8::Unit&) const {}
    __device__ __forceinline__ void done(const pg8::Unit&) const {}
};
struct QuadOrder {
    static constexpr bool GATHER = false;
    int pm, pn0, n;
    __device__ __forceinline__ bool next(int i, pg8::Unit& u) const { if (i >= n) return false; u.pm = pm; u.pn = pn0 + i; return true; }
    __device__ __forceinline__ void a_ready(const pg8::Unit&) const {}
    __device__ __forceinline__ void done(const pg8::Unit&) const {}
};
constexpr int CW_READY = 24576;
struct EpiHid {
    static constexpr bool PERM = true, AFTER_DRAIN = false;
    bf16_t* HID; const int* toks; const float* RSTD; const float* SELW; int tl, cnt;
    __device__ __forceinline__ void operator()(const A4 (&acc)[2][2][4][2], const pg8::Unit& u, int wr, int wc, int fr, int fq) const {
        const int f0 = (u.pn & 1) * 128 + wc * 32 + 8 * fq;
        EPI_ROWS_BEGIN
            const int p = tl * 256 + (row - u.pm * 256);
            const int slot = p < cnt ? toks[p] : 0;
            const float rs = RSTD[slot >> 1], w = SELW[slot];
            A4 h0, h1;
#pragma unroll
            for (int i = 0; i < 4; ++i) { h0[i] = fsilu(acc[ai][0][m][0][i] * rs) * (acc[ai][1][m][0][i] * rs) * w; h1[i] = fsilu(acc[ai][0][m][1][i] * rs) * (acc[ai][1][m][1][i] * rs) * w; }
            st16_wt(HID + (size_t)row * EF + f0, pack8(h0, h1));
        EPI_ROWS_END
    }
};
struct EpiY {
    static constexpr bool PERM = true, AFTER_DRAIN = false;
    bf16_t* Y;
    __device__ __forceinline__ void operator()(const A4 (&acc)[2][2][4][2], const pg8::Unit& u, int wr, int wc, int fr, int fq) const {
        const int col0 = (u.pn & 3) * 256 + wc * 32 + 8 * fq;
        EPI_ROWS_BEGIN
#pragma unroll
            for (int bj = 0; bj < 2; ++bj) ST16_OUT(Y + (size_t)row * D + col0 + bj * 128, pack8(acc[ai][bj][m][0], acc[ai][bj][m][1]));
        EPI_ROWS_END
    }
};

__device__ __forceinline__ void ph_combine(unsigned char* ws, int l, int vcu, int G, bf16_t* XN, float* OUT, const float* __restrict__ fg, int wv, bf16_t* XBo) {
    const int tid = tid_of(wv), lane = tid & 63, wave = wv; (void)tid;
    const bf16_t* XB = (const bf16_t*)(ws + WS_XB); const bf16_t* Y = (const bf16_t*)(ws + WS_XG);
    const int* SELE = (const int*)(ws + WS_SEL + SEL_SELE); const int* LPOS = (const int*)(ws + WS_SEL + SEL_LPOS); float* ssn = (float*)(ws + WS_SSP) + (size_t)(3 * l + 3) * T * 16;
    int cnt_, tile0_, ntile_; (void)moe_prefix((const unsigned*)(ws + WS_CTL) + CW_CNT + 32 * l, lane, cnt_, tile0_, ntile_);
    for (int t = vcu * 8 + wave; t < T; t += G * 8) {
        const int p0 = shfl_idx(tile0_, SELE[2 * t]) * 256 + LPOS[2 * t], p1 = shfl_idx(tile0_, SELE[2 * t + 1]) * 256 + LPOS[2 * t + 1];
        const u32x4* xr = (const u32x4*)(XB + (size_t)t * D) + lane; u32x4* xo = (u32x4*)(XBo + (size_t)t * D) + lane; const u32x4* y0 = (const u32x4*)(Y + (size_t)p0 * D) + lane; const u32x4* y1 = (const u32x4*)(Y + (size_t)p1 * D) + lane;
        A4 v[4]; float q = 0.f;
#pragma unroll
        for (int j = 0; j < 2; ++j) { A4 a0, a1, b0, b1, c0, c1; unpack8(xr[64 * j], a0, a1); unpack8(y0[64 * j], b0, b1); unpack8(y1[64 * j], c0, c1);
            a0 += b0 + c0; a1 += b1 + c1; v[2 * j] = a0; v[2 * j + 1] = a1;
            q += (a0[0] * a0[0] + a0[1] * a0[1]) + (a0[2] * a0[2] + a0[3] * a0[3]) + (a1[0] * a1[0] + a1[1] * a1[1]) + (a1[2] * a1[2] + a1[3] * a1[3]);
            ST16_OUT(xo + 64 * j, pack8(a0, a1)); }
        q = wave_sum(q);
        if (lane < 16) ssn[(size_t)t * 16 + lane] = lane == 0 ? q : 0.f;
        const float rs = rsqrtf(q * (1.0f / D) + EPS);
        if (XN) { u32x4* xn = (u32x4*)(XN + (size_t)t * D) + lane;
#pragma unroll
            for (int j = 0; j < 2; ++j) ST16_OUT(xn + 64 * j, pack8(v[2 * j] * rs, v[2 * j + 1] * rs)); }
        if (OUT) {
#pragma unroll
            for (int j = 0; j < 2; ++j) { const int c0 = 8 * lane + 512 * j; const A4 g0 = *(const A4*)(fg + c0), g1 = *(const A4*)(fg + c0 + 4);
                float* o = OUT + (size_t)t * D + c0; *(A4*)o = v[2 * j] * rs * g0; *(A4*)(o + 4) = v[2 * j + 1] * rs * g1; }
        }
    }
}
struct FixedOrder {
    static constexpr bool GATHER = false;
    int pm, pn;
    __device__ __forceinline__ bool next(int i, pg8::Unit& u) const { if (i != 0) return false; u.pm = pm; u.pn = pn; return true; }
    __device__ __forceinline__ void a_ready(const pg8::Unit&) const {}
    __device__ __forceinline__ void done(const pg8::Unit&) const {}
};
struct PairOrder {
    static constexpr bool GATHER = false;
    int pm, pn0, pn1;
    __device__ __forceinline__ bool next(int i, pg8::Unit& u) const { if (i > 1) return false; u.pm = pm; u.pn = i ? pn1 : pn0; return true; }
    __device__ __forceinline__ void a_ready(const pg8::Unit&) const {}
    __device__ __forceinline__ void done(const pg8::Unit&) const {}
};
struct EpiSoftmax {
    static constexpr bool PERM = true, AFTER_DRAIN = true;
    bf16_t* P; int ld, pad;
    __device__ __forceinline__ void fused(A4 (&acc)[2][2][4][2], const pg8::Unit& u, int wr, int wc, int fr, int fq, PG8_LAS unsigned char* lds, int wid, int lane) const {
        typedef float f32x2v __attribute__((ext_vector_type(2)));
        PG8_LAS f32x2v* X = (PG8_LAS f32x2v*)lds;
        float mw[2][4];
#pragma unroll
        for (int ai = 0; ai < 2; ++ai)
#pragma unroll
            for (int m = 0; m < 4; ++m) {
                float mx = -INFINITY;
#pragma unroll
                for (int bj = 0; bj < 2; ++bj)
#pragma unroll
                    for (int i = 0; i < 4; ++i) mx = fmaxf(mx, fmaxf(acc[ai][bj][m][0][i], acc[ai][bj][m][1][i]));
                mx = fmaxf(mx, swz_xor<16>(mx)); mx = max_xor32(mx);
                float s = 0.f;
#pragma unroll
                for (int bj = 0; bj < 2; ++bj)
#pragma unroll
                    for (int n = 0; n < 2; ++n)
#pragma unroll
                        for (int i = 0; i < 4; ++i) { const float e = __expf(acc[ai][bj][m][n][i] - mx); acc[ai][bj][m][n][i] = e; s += e; }
                s = add_xor32(add_xor16(s));
                mw[ai][m] = mx;
                if (fq == 0) X[(ai * 128 + wr * 64 + m * 16 + fr) * 4 + wc] = (f32x2v){mx, s};
            }
        asm volatile("s_waitcnt lgkmcnt(0)" ::: "memory"); __builtin_amdgcn_s_barrier(); asm volatile("" ::: "memory");
#pragma unroll
        for (int ai = 0; ai < 2; ++ai)
#pragma unroll
            for (int m = 0; m < 4; ++m) {
                const int r = ai * 128 + wr * 64 + m * 16 + fr;
                const f32x2v a = X[r * 4 + 0], b = X[r * 4 + 1], c = X[r * 4 + 2], d = X[r * 4 + 3];
                const float M = fmaxf(fmaxf(a.x, b.x), fmaxf(c.x, d.x));
                const float S = (a.y * __expf(a.x - M) + b.y * __expf(b.x - M)) + (c.y * __expf(c.x - M) + d.y * __expf(d.x - M));
                const float f = __expf(mw[ai][m] - M) * __builtin_amdgcn_rcpf(S);
#pragma unroll
                for (int bj = 0; bj < 2; ++bj) *(u32x4*)(P + (size_t)(u.pm * 256 + r) * ld + bj * 128 + wc * 32 + 8 * fq) = pack8(acc[ai][bj][m][0] * f, acc[ai][bj][m][1] * f);
            }
    }
};
typedef float f32x16 __attribute__((ext_vector_type(16)));
constexpr int RTAB = 640;
__device__ __forceinline__ bf16x8_t as_bf16x8(const u32x4 w) { return __builtin_bit_cast(bf16x8_t, w); }
constexpr float LOG2E = 1.4426950408889634f;
__device__ __forceinline__ void band_tables(const float* __restrict__ rel  , LAS float* Rt, int tid) {
    for (int i = tid; i < AH * RTAB; i += 512) { const int h = i / RTAB, k = i % RTAB; int r = 575 - k; r = r < -AMAXREL ? -AMAXREL : (r > AMAXREL ? AMAXREL : r); Rt[i] = rel[h * RELW + r + AMAXREL] * LOG2E; }
}
__device__ __forceinline__ void band_load_k(bf16x8_t (&Kf)[4], const bf16_t* __restrict__ AK, size_t key0, int h, int ql, int hh) {
#pragma unroll
    for (int s = 0; s < 4; ++s) Kf[s] = *(const bf16x8_t*)(AK + (key0 + ql) * AW + h * 64 + 16 * s + 8 * hh);
}
__device__ __forceinline__ void band_load_v(bf16x8_t (&Vf)[2][2], const bf16_t* vbase, size_t key0) {
#pragma unroll
    for (int db = 0; db < 2; ++db)
#pragma unroll
        for (int s = 0; s < 2; ++s) { const bf16_t* p = vbase + (size_t)(32 * db) * T + key0 + 16 * s;
            const u32x2 a = *(const u32x2*)p, c2 = *(const u32x2*)(p + 8); Vf[db][s] = as_bf16x8((u32x4){a.x, a.y, c2.x, c2.y}); }
}
__device__ __forceinline__ void band_item(int item, int lane, const bf16_t* __restrict__ AQ, const bf16_t* __restrict__ AK, const bf16_t* __restrict__ AVT, const LAS float* Rt, bf16_t* __restrict__ OAB) {
    const int n = item % NCH, h = (item / NCH) % AH, b = item / (NCH * AH);
    const int ql = lane & 31, hh = lane >> 5;
    const size_t tok0 = (size_t)b * L + (size_t)n * CH;
    bf16x8_t Qf[2][4];
#pragma unroll
    for (int qb = 0; qb < 2; ++qb)
#pragma unroll
        for (int s = 0; s < 4; ++s) Qf[qb][s] = *(const bf16x8_t*)(AQ + (tok0 + 32 * qb + ql) * AW + h * 64 + 16 * s + 8 * hh);
    f32x16 O[2][2];
#pragma unroll
    for (int db = 0; db < 2; ++db)
#pragma unroll
        for (int qb = 0; qb < 2; ++qb)
#pragma unroll
            for (int r = 0; r < 16; ++r) O[db][qb][r] = 0.f;
    float mrun[2] = {-INFINITY, -INFINITY}, lrun[2] = {0.f, 0.f};
    const LAS float* Rh = Rt + h * RTAB + (31 - ql + 4 * hh);
    const float bias_far = Rt[h * RTAB];
    const bf16_t* vbase = AVT + (size_t)(h * 64 + ql) * T + 4 * hh;
    const int j_lo = (n < ALC ? 2 * (ALC - n) : 0), j_hi = 2 * ALC + 1;
    const size_t keyb = (size_t)b * L + (size_t)(n - ALC) * CH;
    bf16x8_t Kf[4], Vf[2][2];
    f32x16 S[2];
    band_load_k(Kf, AK, keyb + (size_t)j_lo * 32, h, ql, hh);
    band_load_v(Vf, vbase, keyb + (size_t)j_lo * 32);
#define BAND_SCORES(jj) do { const LAS float* Rc_ = Rh + (jj) * 32; \
        _Pragma("unroll") for (int qb = 0; qb < 2; ++qb) { \
            if ((jj) < 8) { _Pragma("unroll") for (int r = 0; r < 16; ++r) S[qb][r] = bias_far; } \
            else { _Pragma("unroll") for (int r = 0; r < 16; ++r) S[qb][r] = Rc_[32 - 32 * qb + (r & 3) + 8 * (r >> 2)]; } \
            _Pragma("unroll") for (int s = 0; s < 4; ++s) S[qb] = __builtin_amdgcn_mfma_f32_32x32x16_bf16(Kf[s], Qf[qb][s], S[qb], 0, 0, 0); } } while (0)
    BAND_SCORES(j_lo);
    band_load_k(Kf, AK, keyb + (size_t)(j_lo < j_hi ? j_lo + 1 : j_lo) * 32, h, ql, hh);
#pragma nounroll
    for (int j = j_lo; j <= j_hi; ++j) {
#pragma unroll
        for (int qb = 0; qb < 2; ++qb) {
            float mx = S[qb][0];
#pragma unroll
            for (int r = 1; r < 16; ++r) mx = fmaxf(mx, S[qb][r]);
            mx = max_xor32(mx);
            const float mn = fmaxf(mrun[qb], mx), alpha = __builtin_amdgcn_exp2f(mrun[qb] - mn);
            mrun[qb] = mn;
            float sum = 0.f;
#pragma unroll
            for (int r = 0; r < 16; ++r) { const float p = __builtin_amdgcn_exp2f(S[qb][r] - mn); S[qb][r] = p; sum += p; }
            lrun[qb] = lrun[qb] * alpha + add_xor32(sum);
#pragma unroll
            for (int db = 0; db < 2; ++db)
#pragma unroll
                for (int r = 0; r < 16; ++r) O[db][qb][r] *= alpha;
#pragma unroll
            for (int s = 0; s < 2; ++s) {
                u32x4 w; w.x = pkbf(S[qb][8 * s + 0], S[qb][8 * s + 1]); w.y = pkbf(S[qb][8 * s + 2], S[qb][8 * s + 3]); w.z = pkbf(S[qb][8 * s + 4], S[qb][8 * s + 5]); w.w = pkbf(S[qb][8 * s + 6], S[qb][8 * s + 7]);
                const bf16x8_t Pf = as_bf16x8(w);
#pragma unroll
                for (int db = 0; db < 2; ++db) O[db][qb] = __builtin_amdgcn_mfma_f32_32x32x16_bf16(Vf[db][s], Pf, O[db][qb], 0, 0, 0);
            }
        }
        if (j < j_hi) {
            band_load_v(Vf, vbase, keyb + (size_t)(j + 1) * 32);
            BAND_SCORES(j + 1);
            band_load_k(Kf, AK, keyb + (size_t)(j + 2 <= j_hi ? j + 2 : j_hi) * 32, h, ql, hh);
        }
    }
#undef BAND_SCORES
#pragma unroll
    for (int qb = 0; qb < 2; ++qb) {
        const float inv = 1.0f / lrun[qb];
        bf16_t* orow = OAB + (tok0 + 32 * qb + ql) * D + h * 64 + 4 * hh;
#pragma unroll
        for (int db = 0; db < 2; ++db)
#pragma unroll
            for (int g = 0; g < 4; ++g) { u32x2 o; o.x = pkbf(O[db][qb][4 * g] * inv, O[db][qb][4 * g + 1] * inv); o.y = pkbf(O[db][qb][4 * g + 2] * inv, O[db][qb][4 * g + 3] * inv);
                *(u32x2*)(orow + 32 * db + 8 * g) = o; }
    }
}
constexpr size_t DS_ITEM = 128 * 64;
__device__ __forceinline__ int rowmap32(int r, int hh) { return (r & 3) + 8 * (r >> 2) + 4 * hh; }

__device__ __forceinline__ float gla_scan_tile(const float* __restrict__ LOGA, size_t tok0, int h, int lane, LAS float* Gt) {
    const float* p = LOGA + tok0 * BKW + h * 64 + lane;
    float cum = 0.f;
#pragma unroll
    for (int t0 = 0; t0 < 64; t0 += 16) {
        float la[16];
#pragma unroll
        for (int i = 0; i < 16; ++i) la[i] = p[(size_t)(t0 + i) * BKW];
#pragma unroll
        for (int i = 0; i < 16; ++i) { cum += la[i]; Gt[(t0 + i) * 64 + lane] = cum; }
    }
    asm volatile("s_waitcnt lgkmcnt(0)" ::: "memory");
    return cum;
}

__device__ __forceinline__ void gla1_item(int idx, int lane, LAS float* Gt, const bf16_t* __restrict__ BK, const bf16_t* __restrict__ BVT, const float* __restrict__ LOGA, float* __restrict__ DS, float* __restrict__ DEC) {
    const int c = idx & 127, h = (idx >> 7) & 3, b = idx >> 9;
    const size_t tok0 = (size_t)b * L + (size_t)c * CH;
    const int ql = lane & 31, hh = lane >> 5;
    LAS bf16_t* Kt = (LAS bf16_t*)(Gt + 64 * 64);
    {
        u32x4 kr[8];
#pragma unroll
        for (int i = 0; i < 8; ++i) kr[i] = *(const u32x4*)(BK + (tok0 + 8 * i + (lane >> 3)) * BKW + h * 64 + (lane & 7) * 8);
#pragma unroll
        for (int i = 0; i < 8; ++i) *(LAS u32x4*)(Kt + (8 * i + (lane >> 3)) * 64 + (lane & 7) * 8) = kr[i];
    }
    const float last = gla_scan_tile(LOGA, tok0, h, lane, Gt);
    DEC[(size_t)idx * 64 + lane] = __expf(last);
    bf16x8_t Xf[2][2][2];
#pragma unroll
    for (int kb = 0; kb < 2; ++kb) {
        const float lk = __int_as_float(shfl_idx(__float_as_int(last), 32 * kb + ql));
#pragma unroll
        for (int tb = 0; tb < 2; ++tb) {
            float x[16];
#pragma unroll
            for (int r = 0; r < 16; ++r) { const int t = 32 * tb + rowmap32(r, hh);
                x[r] = bf2f(Kt[t * 64 + 32 * kb + ql]) * __expf(lk - Gt[t * 64 + 32 * kb + ql]); }
#pragma unroll
            for (int s = 0; s < 2; ++s) { u32x4 w; w.x = pkbf(x[8 * s], x[8 * s + 1]); w.y = pkbf(x[8 * s + 2], x[8 * s + 3]); w.z = pkbf(x[8 * s + 4], x[8 * s + 5]); w.w = pkbf(x[8 * s + 6], x[8 * s + 7]); Xf[tb][kb][s] = as_bf16x8(w); }
        }
    }
    const bf16_t* vbase = BVT + (size_t)(h * 128 + ql) * T + tok0 + 4 * hh;
    float* dsb = DS + (size_t)idx * DS_ITEM;
#pragma unroll
    for (int vb = 0; vb < 4; ++vb) {
        bf16x8_t Vf[2][2];
#pragma unroll
        for (int tb = 0; tb < 2; ++tb)
#pragma unroll
            for (int s = 0; s < 2; ++s) { const bf16_t* p = vbase + (size_t)(32 * vb) * T + 32 * tb + 16 * s; const u32x2 a = *(const u32x2*)p, c2 = *(const u32x2*)(p + 8); Vf[tb][s] = as_bf16x8((u32x4){a.x, a.y, c2.x, c2.y}); }
#pragma unroll
        for (int kb = 0; kb < 2; ++kb) {
            f32x16 acc;
#pragma unroll
            for (int r = 0; r < 16; ++r) acc[r] = 0.f;
#pragma unroll
            for (int tb = 0; tb < 2; ++tb)
#pragma unroll
                for (int s = 0; s < 2; ++s) acc = __builtin_amdgcn_mfma_f32_32x32x16_bf16(Vf[tb][s], Xf[tb][kb][s], acc, 0, 0, 0);
#pragma unroll
            for (int r = 0; r < 16; ++r) dsb[(size_t)(32 * vb + rowmap32(r, hh)) * 64 + 32 * kb + ql] = acc[r];
        }
    }
}

__device__ __forceinline__ void gla2_scan(int e, const float* __restrict__ DS, const float* __restrict__ DEC, bf16_t* __restrict__ SB) {
    const int k = e & 63, v = (e >> 6) & 127, bh = e >> 13;
    const size_t base = (size_t)bh * 128;
    float S = 0.f;
#pragma unroll 1
    for (int c0 = 0; c0 < 128; c0 += 8) {
        float d[8], a[8];
#pragma unroll
        for (int i = 0; i < 8; ++i) { d[i] = DS[(base + c0 + i) * DS_ITEM + (size_t)v * 64 + k]; a[i] = DEC[(base + c0 + i) * 64 + k]; }
#pragma unroll
        for (int i = 0; i < 8; ++i) { SB[(base + c0 + i) * DS_ITEM + (size_t)v * 64 + k] = f2bf(S); S = a[i] * S + d[i]; }
    }
}

__device__ __forceinline__ void gla3_unit(int unit, int lane, LAS float* Gt, const bf16_t* __restrict__ BQ, const bf16_t* __restrict__ BK, const bf16_t* __restrict__ BVT, const float* __restrict__ LOGA,
                                          const bf16_t* __restrict__ SB, const bf16_t* __restrict__ BRS, const float* __restrict__ gnorm, bf16_t* __restrict__ OAB) {
    const int tb = unit & 1, idx = unit >> 1;
    const int c = idx & 127, h = (idx >> 7) & 3, b = idx >> 9;
    const size_t tok0 = (size_t)b * L + (size_t)c * CH;
    const int ql = lane & 31, hh = lane >> 5;
    (void)gla_scan_tile(LOGA, tok0, h, lane, Gt);
    bf16x8_t Qf[4];
    {
        const int t = 32 * tb + ql;
#pragma unroll
        for (int s = 0; s < 4; ++s) {
            const u32x4 q = *(const u32x4*)(BQ + (tok0 + t) * BKW + h * 64 + 16 * s + 8 * hh);
            const f32x4 g0 = *(const LAS f32x4*)(Gt + t * 64 + 16 * s + 8 * hh), g1 = *(const LAS f32x4*)(Gt + t * 64 + 16 * s + 8 * hh + 4);
            u32x4 w; w.x = pkbf(bflo(q.x) * __expf(g0[0]), bfhi(q.x) * __expf(g0[1])); w.y = pkbf(bflo(q.y) * __expf(g0[2]), bfhi(q.y) * __expf(g0[3]));
            w.z = pkbf(bflo(q.z) * __expf(g1[0]), bfhi(q.z) * __expf(g1[1])); w.w = pkbf(bflo(q.w) * __expf(g1[2]), bfhi(q.w) * __expf(g1[3]));
            Qf[s] = as_bf16x8(w);
        }
    }
    bf16x8_t Pf[2][2];
#pragma unroll
    for (int sb = 0; sb < 2; ++sb) {
        if (sb <= tb) {
            const int srow = 32 * sb + ql;
            f32x16 A;
#pragma unroll
            for (int r = 0; r < 16; ++r) A[r] = 0.f;
#pragma unroll
            for (int s = 0; s < 4; ++s) {
                const u32x4 kx = *(const u32x4*)(BK + (tok0 + srow) * BKW + h * 64 + 16 * s + 8 * hh);
                const f32x4 g0 = *(const LAS f32x4*)(Gt + srow * 64 + 16 * s + 8 * hh), g1 = *(const LAS f32x4*)(Gt + srow * 64 + 16 * s + 8 * hh + 4);
                u32x4 w; w.x = pkbf(bflo(kx.x) * __expf(-g0[0]), bfhi(kx.x) * __expf(-g0[1])); w.y = pkbf(bflo(kx.y) * __expf(-g0[2]), bfhi(kx.y) * __expf(-g0[3]));
                w.z = pkbf(bflo(kx.z) * __expf(-g1[0]), bfhi(kx.z) * __expf(-g1[1])); w.w = pkbf(bflo(kx.w) * __expf(-g1[2]), bfhi(kx.w) * __expf(-g1[3]));
                A = __builtin_amdgcn_mfma_f32_32x32x16_bf16(as_bf16x8(w), Qf[s], A, 0, 0, 0);
            }
            if (sb == tb) {
#pragma unroll
                for (int r = 0; r < 16; ++r) A[r] = (rowmap32(r, hh) <= ql) ? A[r] : 0.f;
            }
#pragma unroll
            for (int s2 = 0; s2 < 2; ++s2) { u32x4 w; w.x = pkbf(A[8 * s2], A[8 * s2 + 1]); w.y = pkbf(A[8 * s2 + 2], A[8 * s2 + 3]); w.z = pkbf(A[8 * s2 + 4], A[8 * s2 + 5]); w.w = pkbf(A[8 * s2 + 6], A[8 * s2 + 7]); Pf[sb][s2] = as_bf16x8(w); }
        }
    }
    f32x16 O[4];
    const bf16_t* vbase = BVT + (size_t)(h * 128 + ql) * T + tok0 + 4 * hh;
    const bf16_t* sbase = SB + (size_t)idx * DS_ITEM + (size_t)ql * 64 + 8 * hh;
#pragma unroll
    for (int vb = 0; vb < 4; ++vb) {
#pragma unroll
        for (int r = 0; r < 16; ++r) O[vb][r] = 0.f;
#pragma unroll
        for (int s = 0; s < 4; ++s) { const bf16x8_t Sf = *(const bf16x8_t*)(sbase + (size_t)(32 * vb) * 64 + 16 * s); O[vb] = __builtin_amdgcn_mfma_f32_32x32x16_bf16(Sf, Qf[s], O[vb], 0, 0, 0); }
#pragma unroll
        for (int sb = 0; sb < 2; ++sb) {
            if (sb <= tb) {
#pragma unroll
                for (int s2 = 0; s2 < 2; ++s2) { const bf16_t* p = vbase + (size_t)(32 * vb) * T + 32 * sb + 16 * s2; const u32x2 a = *(const u32x2*)p, c2 = *(const u32x2*)(p + 8);
                    O[vb] = __builtin_amdgcn_mfma_f32_32x32x16_bf16(as_bf16x8((u32x4){a.x, a.y, c2.x, c2.y}), Pf[sb][s2], O[vb], 0, 0, 0); }
            }
        }
    }
    float q = 0.f;
#pragma unroll
    for (int vb = 0; vb < 4; ++vb)
#pragma unroll
        for (int r = 0; r < 16; ++r) q += O[vb][r] * O[vb][r];
    const float rs = rsqrtf(add_xor32(q) * (1.0f / 128.0f) + EPS);
    const size_t trow = tok0 + 32 * tb + ql;
    const bf16_t* br = BRS + trow * BVW + h * 128 + 4 * hh; bf16_t* orow = OAB + trow * D + 512 + h * 128 + 4 * hh; const float* gn = gnorm + 4 * hh;
#pragma unroll
    for (int vb = 0; vb < 4; ++vb)
#pragma unroll
        for (int g = 0; g < 4; ++g) {
            const int vo = 32 * vb + 8 * g;
            const u32x2 bw = *(const u32x2*)(br + vo); const f32x4 gv = *(const f32x4*)(gn + vo);
            u32x2 o; o.x = pkbf(O[vb][4 * g] * rs * gv[0] * bflo(bw.x), O[vb][4 * g + 1] * rs * gv[1] * bfhi(bw.x)); o.y = pkbf(O[vb][4 * g + 2] * rs * gv[2] * bflo(bw.y), O[vb][4 * g + 3] * rs * gv[3] * bfhi(bw.y));
            __hip_atomic_store((unsigned long long*)(orow + vo), ((unsigned long long)o.y << 32) | o.x, __ATOMIC_RELAXED, __HIP_MEMORY_SCOPE_AGENT);
        }
}
#ifndef MK_REP_PHASE
#define MK_REP_PHASE (-1)
#define MK_REP_N 1
#endif
#ifndef MK_PANEL_TEST
#define MK_PANEL_TEST 0
#endif
#ifndef MK_LAUNCHES
#define MK_LAUNCHES 1
#endif
constexpr int RING_BYTES = 131072, MISC_OFF = RING_BYTES + 512, LDS_BYTES = 147456;
constexpr int CW_BAR = 1024;
constexpr size_t CTL_ZERO_BYTES = 128 * 1024;
constexpr int CW_PANEL = 8192;
static_assert((CW_BAR + XCD_BAR_WORDS) * 4 <= (int)CTL_ZERO_BYTES, "barrier words inside the memset region");
constexpr int N_PHASES = 1 + 6 * DEPTH;

struct MKArgs { InPtrs in; unsigned char* ws; unsigned char* dout; int ph_lo, ph_hi, rep_phase, rep_n; };

__global__ void __launch_bounds__(512, 2) mk_fwd(MKArgs a) {
    extern __shared__ __attribute__((aligned(16))) unsigned char lds_raw[];
    LAS unsigned char* lds = (LAS unsigned char*)lds_raw;
    const int G0 = (int)gridDim.x, vcu0 = (int)blockIdx.x;
    const int wv0 = __builtin_amdgcn_readfirstlane((int)threadIdx.x >> 6);
    volatile LAS unsigned* MISC = (volatile LAS unsigned*)(lds + MISC_OFF);
    if (threadIdx.x < 16) MISC[threadIdx.x] = 0u;
    __syncthreads();
    const bool one_launch = (a.ph_hi - a.ph_lo) > 1;
    XcdBarrier bar; bar.bar = (unsigned*)(a.ws + WS_CTL) + CW_BAR; bar.x = 0; bar.st = MISC + 8;
    if (one_launch) bar = xcd_barrier_post((unsigned*)(a.ws + WS_CTL) + CW_BAR, MISC + 8);

    const InPtrs& in = a.in;
#define SS ((float*)(ws + WS_SSP))
#define XB ((bf16_t*)(ws + WS_XB))
#define AQ ((bf16_t*)(ws + WS_AQ))
#define AK ((bf16_t*)(ws + WS_AK))
#define AVT ((bf16_t*)(ws + WS_AVT))
#define XN ((bf16_t*)(ws + WS_XN))
#define BQ ((bf16_t*)(ws + WS_BQ))
#define BK ((bf16_t*)(ws + WS_BK))
#define BVT ((bf16_t*)(ws + WS_BVT))
#define BRS ((bf16_t*)(ws + WS_BRS))
#define GA ((bf16_t*)(ws + WS_GA))
#define GB ((bf16_t*)(dout + DO_GB))
#define MG ((bf16_t*)(ws + WS_MG))
#define Q ((bf16_t*)(dout + DO_OAB))
#define MEMN ((bf16_t*)(ws + WS_MEMN))
#define KVB ((bf16_t*)(ws + WS_KVB))
#define LOGA ((float*)(ws + WS_LOGA))
#define OAB ((bf16_t*)(dout + DO_OAB))
#define DSF ((float*)(dout + DO_ST))
#define DEC ((float*)(ws + WS_DEC))
#define SBB ((bf16_t*)(ws + WS_SB))
#define TMP ((bf16_t*)(ws + WS_TMP))
#define SELE ((int*)(ws + WS_SEL))
#define SELW ((float*)(ws + WS_SEL + (size_t)T * 2 * 4))
#define WD(l) (ws + WS_WDENSE + (size_t)(l) * WDENSE_STRIDE)
#define SSA(i) (SS + (size_t)(i) * T * 16)
#define MK_EP(l, t0) EpiProj{AQ, AK, BQ, BK, BRS, GA, GB, LOGA, in.gla_b_alpha + (size_t)(l) * BKW, (t0), 0}
    int ph = 0;
#define PH_ON (ph >= a.ph_lo && ph < a.ph_hi)
#define PH_RUN for (int rep_ = (PH_ON ? (ph == a.rep_phase ? a.rep_n : 1) : 0); rep_ > 0; --rep_)
#define PH_PTRS const int G = opaque_int(G0), vcu = opaque_int(vcu0), wv = opaque_int(wv0); (void)G; (void)vcu; unsigned char* ws = opaque_ptr(a.ws); unsigned char* dout = opaque_ptr(a.dout); (void)ws; (void)dout; const int tid = tid_of(wv), lane = tid & 63, wave = wv; (void)lane; (void)wave;
#define PH_END do { if (PH_ON && ph + 1 < a.ph_hi) xcd_barrier(bar, tid_of(opaque_int(wv0)) == 0); ++ph; } while (0)
#define GEMM_AT(EpiT, gm, ep, cc) do { pg8::StaticOrder S_; S_.init((gm).M, (gm).N, G, (cc)); pg8::gemm_phase<EpiT, pg8::StaticOrder, true, true>(lds, gm, S_, ep, wv); } while (0)
#define GEMM(EpiT, gm, ep) do { pg8::StaticOrder S_; S_.init((gm).M, (gm).N, G, vcu); pg8::gemm_phase<EpiT, pg8::StaticOrder, true, true>(lds, gm, S_, ep, wv); } while (0)

    PH_RUN { PH_PTRS ph_prologue(in, ws, lds, vcu, G, wv);
        LAS float* scr = (LAS float*)(lds + wave * 16384);
        if (G != 256) conv_expert_items(in, ws, 0, DEPTH * NE * 384, vcu * 8 + wave, G * 8, scr, lane);
        conv_router(in, ws, vcu, G, tid); }
    PH_END;

#pragma nounroll
    for (int l = 0; l < DEPTH; ++l) {
        PH_RUN { PH_PTRS
            {
                const bf16_t* Wkv = (const bf16_t*)(WD(l) + WD_WXKV);
                { const pg8::Gemm g{MEMN, Wkv, NB * NMEM, D, D, D, D, 0}; const EpiScale e{KVB + (size_t)l * 2 * NB * NMEM * D, nullptr, D, 1.0f, 1, 0}; GEMM_AT(EpiScale, g, e, (vcu + G - (G > 128 ? 64 : 0)) % G); }
                { const pg8::Gemm g{Wkv + (size_t)D * D, MEMN, D, NB * NMEM, D, D, D, 0}; const EpiScale e{KVB + (size_t)l * 2 * NB * NMEM * D + (size_t)NB * NMEM * D, nullptr, NB * NMEM, 1.0f, 1, 0}; GEMM_AT(EpiScale, g, e, (vcu + G - (G > 128 ? 72 : 0)) % G); }
            }
            { const pg8::Gemm g{XN, (const bf16_t*)(WD(l) + WD_WIN), T, NPROJ_A, D, D, D, 0}; const EpiProj e = MK_EP(l, 0); GEMM(EpiProj, g, e); }
            { const pg8::Gemm g{(const bf16_t*)(WD(l) + WD_WIN) + (size_t)NPROJ_A * D, XN, NPROJ_V, T, D, D, D, 0}; const EpiScale e{AVT, nullptr, T, 1.0f, 1, 0}; GEMM(EpiScale, g, e); }
            if (l == 0 && G == 256 && vcu >= 80) {
                LAS float* scr = (LAS float*)(lds + wave * 16384);
                conv_dense_layer(in, ws, 1, (vcu - 80) * 8 + wave, 176 * 8, (vcu - 80) * 512 + tid, 176 * 512, scr, lane);
            }
        }
        PH_END;
        PH_RUN { PH_PTRS
            LAS float* Rt = (LAS float*)lds;
            band_tables(in.rel_bias + (size_t)l * AH * RELW, Rt, tid);
            __syncthreads();
            const bool fill = (G == 256);
            if (wave < 4) {
                LAS float* Gt = (LAS float*)(lds + 32768 + wave * 24576);
#pragma nounroll
                for (int it = vcu * 4 + wave; it < NB * BH * NCH; it += G * 4) gla1_item(it, lane, Gt, BK, BVT, LOGA, DSF, DEC);
                if (fill) conv_expert_items(in, ws, l * NE * 384, (l + 1) * NE * 384, vcu * 4 + wave, G * 4, Gt, lane);
            }
            if (fill) {
                if (wave >= 4) { band_item(vcu * 8 + (wave - 4) * 2, lane, AQ, AK, AVT, Rt, OAB); band_item(vcu * 8 + (wave - 4) * 2 + 1, lane, AQ, AK, AVT, Rt, OAB); }
            } else {
#pragma nounroll
                for (int it = vcu * 8 + wave; it < NB * AH * NCH; it += G * 8) band_item(it, lane, AQ, AK, AVT, Rt, OAB);
            }
        }
        PH_END;
        PH_RUN { PH_PTRS
            for (int e2 = vcu * 512 + tid; e2 < NB * BH * 128 * 64; e2 += G * 512) gla2_scan(e2, DSF, DEC, SBB);
        }
        PH_END;
        PH_RUN { PH_PTRS
            pg8::StaticOrder S0; S0.init(T, D, G, vcu); pg8::Unit u;
            if (G == 256 && S0.next(0, u)) {
                unsigned* PC = (unsigned*)(ws + WS_CTL) + CW_PANEL + 16 * (l * 64 + u.pm);
#define P_ARRIVE(s) do { if (tid == 0) (void)xb_add(PC + 2048 * (s), 1u); } while (0)
#define P_WAIT(s) do { if (tid == 0) { unsigned sp_ = 0; while (xb_ld(PC + 2048 * (s)) < 4u) { __builtin_amdgcn_s_sleep(2); if (++sp_ > (1u << 20)) break; } \
                       __builtin_amdgcn_fence(__ATOMIC_ACQUIRE, "agent"); asm volatile("s_waitcnt vmcnt(0)" ::: "memory"); } __syncthreads(); } while (0)
                const int h = u.pn, b = u.pm >> 5;
                {
                    LAS float* Gt = (LAS float*)(lds + wave * 16384);
                    const int idx = (b * BH + h) * NCH + (u.pm & 31) * 4 + (wave >> 1);
                    gla3_unit(idx * 2 + (wave & 1), lane, Gt, BQ, BK, BVT, LOGA, SBB, BRS, in.gla_norm_g + (size_t)l * 128, OAB);
                    asm volatile("s_waitcnt vmcnt(0)" ::: "memory"); __syncthreads();
                    P_ARRIVE(0);
                }
                const bf16_t* Wg = (const bf16_t*)(WD(l) + WD_WIN) + (size_t)(NPROJ_A + NPROJ_V) * D;
                { const pg8::Gemm g{XN, Wg, T, NPROJ_B, D, D, D, 0}; const PairOrder F{u.pm, u.pn, 4 + u.pn}; const EpiProj e = MK_EP(l, 9); pg8::gemm_phase<EpiProj, PairOrder, true, true>(lds, g, F, e, wv); }
                P_ARRIVE(1);
                { const pg8::Gemm g{OAB, (const bf16_t*)(WD(l) + WD_WB), T, D, 512, D, D, 0}; const FixedOrder F{u.pm, u.pn}; const EpiGate e{GA, nullptr, GA}; pg8::gemm_phase<EpiGate, FixedOrder, true, true>(lds, g, F, e, wv); }
                if (tid == 0) { unsigned sp_ = 0; while (xb_ld(PC) < 4u || xb_ld(PC + 2048) < 4u) { __builtin_amdgcn_s_sleep(2); if (++sp_ > (1u << 20)) break; }
                    __builtin_amdgcn_fence(__ATOMIC_ACQUIRE, "agent"); asm volatile("s_waitcnt vmcnt(0)" ::: "memory"); }
                __syncthreads();
                { const pg8::Gemm g{OAB + 512, (const bf16_t*)(WD(l) + WD_WB) + 512, T, D, 512, D, D, 0}; const FixedOrder F{u.pm, u.pn}; const EpiGate e{GB, GA, MG}; pg8::gemm_phase<EpiGate, FixedOrder, true, true>(lds, g, F, e, wv); }
                P_ARRIVE(2);
                P_WAIT(2);
                { const pg8::Gemm g{MG, (const bf16_t*)(WD(l) + WD_WMO), T, D, D, D, D, 0}; const FixedOrder F{u.pm, u.pn}; const EpiResid e{XB, XB, SSA(3 * l + 1)}; pg8::gemm_phase<EpiResid, FixedOrder, true, true>(lds, g, F, e, wv); }
                P_ARRIVE(3);
                P_WAIT(3);
                {
                    const bf16_t* KBl = KVB + (size_t)l * 2 * NB * NMEM * D; const bf16_t* VTl = KBl + (size_t)NB * NMEM * D; bf16_t* Qh = Q + h * XD;
                    { const pg8::Gemm g{XB, (const bf16_t*)(WD(l) + WD_WXQ), T, D, D, D, D, 0}; const FixedOrder F{u.pm, u.pn}; const EpiScale e{Q, SSA(3 * l + 1), D, 0.0625f, 0, 0};
                      pg8::gemm_phase<EpiScale, FixedOrder, true, true>(lds, g, F, e, wv); }
                    { const pg8::Gemm g{Qh, KBl + (size_t)(b * NMEM) * D + h * XD, T, XD, XD, D, D, 0}; const FixedOrder F{u.pm, 0}; const EpiSoftmax e{Qh, D, 0};
                      pg8::gemm_phase<EpiSoftmax, FixedOrder, false, true>(lds, g, F, e, wv); }
                    asm volatile("s_waitcnt vmcnt(0)" ::: "memory"); __syncthreads();
                    { const pg8::Gemm g{Qh, VTl + (size_t)(h * XD) * (NB * NMEM) + b * NMEM, T, XD, XD, D, NB * NMEM, 0}; const FixedOrder F{u.pm, 0}; const EpiScale e{Qh, nullptr, D, 1.0f, 1, 0};
                      pg8::gemm_phase<EpiScale, FixedOrder, true, true>(lds, g, F, e, wv); }
                }
                P_ARRIVE(4);
                P_WAIT(4);
                { const pg8::Gemm g{Q, (const bf16_t*)(WD(l) + WD_WXO), T, D, D, D, D, 0}; const FixedOrder F{u.pm, u.pn}; const EpiResid e{XB, XB, SSA(3 * l + 2)}; pg8::gemm_phase<EpiResid, FixedOrder, true, true>(lds, g, F, e, wv); }
                P_ARRIVE(5);
                P_WAIT(5);
                ph_route(in, ws, lds, l, u.pm * 256 + u.pn * 64, wv, false);
#undef P_ARRIVE
#undef P_WAIT
            }
        }
        PH_END;
        PH_RUN { PH_PTRS
            LAS int* tb = (LAS int*)(lds + RING_BYTES + 1024);
            moe_tables(ws, l, tb, vcu, wave, lane);
            const int nt = tb[64], n1 = 2 * nt, r1 = n1 > G ? n1 - G : 0, ne = nt < G / 2 ? nt : G / 2, nl = nt - ne, tot1 = r1 + ne + 4 * nl;
            const int* TOKS = (const int*)(ws + WS_TOK);
            unsigned* READY = (unsigned*)(ws + WS_CTL) + CW_READY + 16 * (l * NTMAX);
            const bf16_t* WGU = (const bf16_t*)(ws + WS_WEXP + (size_t)l * WEXP_STRIDE); const bf16_t* WDT = (const bf16_t*)(ws + WS_WEXP + (size_t)l * WEXP_STRIDE + 32 * MiB);
#pragma nounroll
            for (int s = vcu - G; s < tot1; s += G) {
                const int Lu = s < 0 ? vcu : (s < r1 ? G + s : -1);
                if (s < 0 && vcu >= n1) continue;
                if (Lu >= 0) {
                    const int rt = Lu >> 1, ex = __builtin_amdgcn_readfirstlane(tb[96 + rt]), tl = rt - __builtin_amdgcn_readfirstlane(tb[32 + ex]), cn = __builtin_amdgcn_readfirstlane(tb[ex]);
                    const pg8::Gemm g{XB, WGU, nt * 256, 512, D, D, D, 0};
                    const GatherOrder F{rt, ex * 2 + (Lu & 1), TOKS + (size_t)ex * T, tl, cn};
                    const EpiHid e{(bf16_t*)(ws + WS_HID), TOKS + (size_t)ex * T, (const float*)(ws + WS_SEL + SEL_RS), (const float*)(ws + WS_SEL + SEL_SELW), tl, cn};
                    pg8::gemm_phase<EpiHid, GatherOrder, true, true>(lds, g, F, e, wv);
                    if (tid == 0) (void)xb_add(READY + 16 * rt, 1u);
                } else {
                    int rt, j0, nj;
                    if (s - r1 < ne) { rt = s - r1; j0 = 0; nj = 4; } else { const int q = s - r1 - ne; rt = ne + (q >> 2); j0 = q & 3; nj = 1; }
                    if (tid == 0) { unsigned sp = 0; while (xb_ld(READY + 16 * rt) < 2u) { __builtin_amdgcn_s_sleep(2); if (++sp > (1u << 20)) break; }
                        __builtin_amdgcn_fence(__ATOMIC_ACQUIRE, "agent"); asm volatile("s_waitcnt vmcnt(0)" ::: "memory"); }
                    __syncthreads();
                    const int ex = __builtin_amdgcn_readfirstlane(tb[96 + rt]);
                    const pg8::Gemm g{(const bf16_t*)(ws + WS_HID), WDT, nt * 256, D, EF, EF, EF, 0};
                    const QuadOrder F{rt, ex * 4 + j0, nj};
                    const EpiY e{(bf16_t*)(ws + WS_XG)};
                    pg8::gemm_phase<EpiY, QuadOrder, true, true>(lds, g, F, e, wv);
                }
            }
        }
        PH_END;
        PH_RUN { PH_PTRS ph_combine(ws, l, vcu, G, (l + 1 < DEPTH) ? XN : nullptr, (l + 1 < DEPTH) ? nullptr : (float*)dout, in.final_g, wv, rep_ > 1 ? (bf16_t*)dout : XB); }
        PH_END;
    }
#undef PH_ON
#undef PH_RUN
#undef PH_PTRS
#undef PH_END
#undef GEMM
#undef GEMM_AT
#undef SS
#undef XB
#undef AQ
#undef AK
#undef AVT
#undef XN
#undef BQ
#undef BK
#undef BVT
#undef BRS
#undef GA
#undef GB
#undef MG
#undef Q
#undef MEMN
#undef KVB
#undef LOGA
#undef OAB
#undef DSF
#undef DEC
#undef SBB
#undef TMP
#undef SELE
#undef SELW
#undef WD
#undef SSA
#undef MK_EP
}

extern "C" void kernel_launch(void* const* d_in, const int* in_sizes, int n_in, void* d_out, int out_size, void* d_ws, size_t ws_size, hipStream_t stream) {
    static int grid = 0;
    if (grid == 0) {
        int dev = 0, cus = 0;
        if (hipGetDevice(&dev) != hipSuccess || hipDeviceGetAttribute(&cus, hipDeviceAttributeMultiprocessorCount, dev) != hipSuccess || cus <= 0) cus = 256;
        grid = 256;
        if (cus != 256) fprintf(stderr, "kernel_launch: device reports %d CUs; this kernel is built for 256\n", cus);
        if (hipFuncSetAttribute((const void*)mk_fwd, hipFuncAttributeMaxDynamicSharedMemorySize, LDS_BYTES) != hipSuccess) fprintf(stderr, "kernel_launch: hipFuncSetAttribute failed\n");
        int per_cu = 0;
        if (hipOccupancyMaxActiveBlocksPerMultiprocessor(&per_cu, (const void*)mk_fwd, 512, LDS_BYTES) != hipSuccess || per_cu < 1) fprintf(stderr, "kernel_launch: occupancy query says %d blocks per CU\n", per_cu);
        (void)hipGetLastError();
        if (ws_size < WS_END || n_in != 24) fprintf(stderr, "kernel_launch: unexpected ws_size %zu / n_in %d\n", ws_size, n_in);
    }
    MKArgs a{};
    { const float** p = (const float**)&a.in; for (int i = 0; i < 24; ++i) p[i] = (const float*)d_in[i]; }
    a.ws = (unsigned char*)d_ws; a.dout = (unsigned char*)d_out;
    (void)hipMemsetAsync((unsigned char*)d_ws + WS_CTL, 0, CTL_ZERO_BYTES, stream);
#if MK_LAUNCHES == 1
    a.ph_lo = 0; a.ph_hi = N_PHASES; a.rep_phase = MK_REP_PHASE; a.rep_n = MK_REP_N;
    hipLaunchKernelGGL(mk_fwd, dim3(grid), dim3(512), LDS_BYTES, stream, a);
#else
    for (int p = 0; p < N_PHASES; ++p) { a.ph_lo = p; a.ph_hi = p + 1; a.rep_phase = -1; a.rep_n = 1; hipLaunchKernelGGL(mk_fwd, dim3(grid), dim3(512), LDS_BYTES, stream, a); }
#endif
}
```

```cpp
#include <hip/hip_runtime.h>
#include <cstdint>
#include <cstdio>
#include <cmath>

namespace cfg {
constexpr int D = 1024, NB = 2, L = 8192, T = NB * L, DEPTH = 2;
constexpr int CH = 64, NMEM = 256, NCH = L / CH;
constexpr int AH = 8, AW = 512, ALC = 8, ABAND = 576, AMAXREL = 256, RELW = 2 * AMAXREL + 1;
constexpr int BH = 4, BKW = 256, BVW = 512, BR = 16;
constexpr int INW = 5136;
constexpr int XH = 4, XD = 256;
constexpr int NG = 4, EPG = 8, NE = NG * EPG, EF = 256;
constexpr float EPS = 1e-6f;
constexpr int NPROJ = 5376;
constexpr int NPROJ_A = 9 * 256, NPROJ_V = 4 * 256, NPROJ_B = 8 * 256;

constexpr size_t MiB = 1u << 20;
constexpr size_t WS_CTL = 0, CTL_BYTES = 2 * MiB;
constexpr size_t WS_WDENSE = 2 * MiB, WDENSE_STRIDE = 23 * MiB;
constexpr size_t WD_WIN = 0, WD_WB = 11 * MiB, WD_WMO = 13 * MiB, WD_WXQ = 15 * MiB, WD_WXKV = 17 * MiB, WD_WXO = 21 * MiB;
constexpr size_t WS_WEXP = 48 * MiB, WEXP_STRIDE = 48 * MiB;
constexpr size_t WS_XB = 144 * MiB;
constexpr size_t WS_XN = 176 * MiB;
constexpr size_t WS_MIX = 208 * MiB;
constexpr size_t WS_AQ = WS_MIX, WS_AK = WS_MIX + 16 * MiB, WS_AVT = WS_MIX + 32 * MiB, WS_BVT = WS_MIX + 48 * MiB, WS_BQ = WS_MIX + 64 * MiB, WS_BK = WS_MIX + 72 * MiB,
                 WS_BRS = WS_MIX + 80 * MiB, WS_LOGA = WS_MIX + 96 * MiB;
constexpr size_t WS_SB = WS_AQ;
constexpr size_t WS_GA = WS_MIX + 16 * MiB, WS_TMP = WS_MIX + 48 * MiB, WS_MG = WS_XN;
constexpr size_t WS_Q = WS_MIX;
constexpr size_t WS_XG = WS_MIX, WS_HID = WS_MIX + 80 * MiB;
constexpr size_t WS_MEMN = 320 * MiB, WS_KVB = 321 * MiB;
constexpr size_t WS_SEL = 325 * MiB;
constexpr size_t WS_SSP = 326 * MiB;
constexpr size_t WS_DEC = 333 * MiB + 512 * 1024;
constexpr size_t WS_WR = 333 * MiB;
constexpr size_t WS_TOK = 334 * MiB;
constexpr size_t WS_END = 336 * MiB;
constexpr size_t DO_OAB = 0, DO_ST = 32 * MiB, DO_GB = 32 * MiB;
}
using namespace cfg;

#define LAS __attribute__((address_space(3)))
typedef unsigned short bf16_t;
typedef float f32x4 __attribute__((ext_vector_type(4)));
typedef unsigned u32x4 __attribute__((ext_vector_type(4)));
typedef unsigned u32x2 __attribute__((ext_vector_type(2)));

__device__ __forceinline__ float bf2f(unsigned short b) { return __uint_as_float((unsigned)b << 16); }
__device__ __forceinline__ float bflo(unsigned w) { return __uint_as_float(w << 16); }
__device__ __forceinline__ float bfhi(unsigned w) { return __uint_as_float(w & 0xffff0000u); }
__device__ __forceinline__ unsigned pkbf(float lo, float hi) { unsigned r; asm volatile("v_cvt_pk_bf16_f32 %0, %1, %2" : "=v"(r) : "v"(lo), "v"(hi)); return r; }
__device__ __forceinline__ unsigned short f2bf(float f) { return (unsigned short)(pkbf(f, 0.f) & 0xffffu); }
__device__ __forceinline__ float fsigmoid(float x) { return __builtin_amdgcn_rcpf(1.0f + __expf(-x)); }
__device__ __forceinline__ float fsilu(float x) { return x * fsigmoid(x); }
__device__ __forceinline__ float flogsigmoid(float x) { return fminf(x, 0.f) - __logf(1.0f + __expf(-fabsf(x))); }
template <int MASK> __device__ __forceinline__ float swz_xor(float v) { return __int_as_float(__builtin_amdgcn_ds_swizzle(__float_as_int(v), (MASK << 10) | 0x1f)); }
__device__ __forceinline__ float add_xor32(float v) { const auto r = __builtin_amdgcn_permlane32_swap(__float_as_uint(v), __float_as_uint(v), false, false); return __uint_as_float(r[0]) + __uint_as_float(r[1]); }
__device__ __forceinline__ float max_xor32(float v) { const auto r = __builtin_amdgcn_permlane32_swap(__float_as_uint(v), __float_as_uint(v), false, false); return fmaxf(__uint_as_float(r[0]), __uint_as_float(r[1])); }
__device__ __forceinline__ float add_xor16(float v) { return v + swz_xor<16>(v); }
__device__ __forceinline__ float wave_sum(float v) { v += swz_xor<1>(v); v += swz_xor<2>(v); v += swz_xor<4>(v); v += swz_xor<8>(v); v += swz_xor<16>(v); return add_xor32(v); }
__device__ __forceinline__ float wave_max(float v) { v = fmaxf(v, swz_xor<1>(v)); v = fmaxf(v, swz_xor<2>(v)); v = fmaxf(v, swz_xor<4>(v)); v = fmaxf(v, swz_xor<8>(v)); v = fmaxf(v, swz_xor<16>(v)); return max_xor32(v); }
__device__ __forceinline__ int shfl_idx(int v, int src_lane) { return __builtin_amdgcn_ds_bpermute(src_lane << 2, v); }
__device__ __forceinline__ unsigned char* opaque_ptr(unsigned char* p) { asm volatile("" : "+s"(p)); return p; }
__device__ __forceinline__ int lane_now() { unsigned z; asm volatile("v_mov_b32 %0, 0" : "=v"(z)); return (int)__builtin_amdgcn_mbcnt_hi(~0u, __builtin_amdgcn_mbcnt_lo(~0u, z)); }
__device__ __forceinline__ int opaque_int(int v) { asm volatile("" : "+s"(v)); return v; }
__device__ __forceinline__ int tid_of(int wv) { return (wv << 6) | lane_now(); }
__device__ __forceinline__ void st16_wt(void* p, const u32x4 v) { asm volatile("global_store_dwordx4 %0, %1, off sc1\n\ts_nop 1" :: "v"(p), "v"(v) : "memory"); }
#ifndef MK_WT
#define MK_WT 1
#endif
#if MK_WT
#define ST16_OUT(p, v) st16_wt((void*)(p), (v))
#else
#define ST16_OUT(p, v) (*(u32x4*)(p) = (v))
#endif
namespace pg8 {
#define PG8_LAS __attribute__((address_space(3)))
typedef unsigned short bf16_t;
typedef short bf16x8 __attribute__((ext_vector_type(8)));
typedef float f32x4 __attribute__((ext_vector_type(4)));
typedef unsigned u32x4 __attribute__((ext_vector_type(4)));
constexpr int BM = 256, BK = 64, HALF = 128, HTB = HALF * BK * 2  , STAGE_BYTES = 8 * HTB, NXCD = 8, WGM = 8;

__host__ __device__ __forceinline__ int lds_byte(int r, int c) { const int st = (r >> 4) * 2 + (c >> 5), rr = r & 15, cc = c & 31, ob = rr * 64 + cc * 2; return st * 1024 + (ob ^ (((ob >> 9) & 1) << 5)); }
__host__ __device__ __forceinline__ void stage_rc(int b, int& R, int& C) { const int st = b / 1024, sb = b % 1024, swz = sb ^ (((sb >> 9) & 1) << 5); R = (st >> 1) * 16 + swz / 64; C = (st & 1) * 32 + (swz % 64) / 2; }
__host__ __device__ __forceinline__ int perm32(int rho) { const int n = rho >> 4, i = rho & 15; return 8 * (i >> 2) + 4 * n + (i & 3); }

struct Unit { int pm, pn; };
struct Gemm { const bf16_t* A; const bf16_t* Bt; int M, N, K, lda, ldb, pad; };

struct StaticOrder {
    static constexpr bool GATHER = false;
    int nM, nN, nwg, G, c;
    __host__ __device__ __forceinline__ void init(int M, int N, int G_, int c_) { nM = M / BM; nN = N / BM; nwg = nM * nN; G = G_; c = c_; }
    __host__ __device__ __forceinline__ bool next(int i, Unit& u) const {
        const long L = (long)i * G + c; if (L >= nwg) return false;
        int wgid = (int)L; { const int q = nwg / NXCD, r = nwg % NXCD, xcd = wgid % NXCD, off = wgid / NXCD; wgid = (xcd < r ? xcd * (q + 1) : r * (q + 1) + (xcd - r) * q) + off; }
        const int nig = WGM * nN, gid = wgid / nig, fm = gid * WGM, gsz = (nM - fm) < WGM ? (nM - fm) : WGM;
        u.pm = fm + ((wgid % nig) % gsz); u.pn = (wgid % nig) / gsz; return true;
    }
    __device__ __forceinline__ void a_ready(const Unit&) const {}
    __device__ __forceinline__ void done(const Unit&) const {}
};


template <class Epi, class Sched, bool ALIGN_EPI = false, bool SP2 = false>
__device__ __forceinline__ void gemm_phase(PG8_LAS unsigned char* lds, const Gemm g, const Sched& S, const Epi& E, const int wv  ) {
    const int tid = tid_of(wv), wid = wv, lane = tid & 63, wr = wid >> 2, wc = wid & 3, fr = lane & 15, fq = lane >> 4;
    const int K = g.K, nt = K / BK;
    unsigned voffA[2], voffA1[2], voffB[2];
#pragma unroll
    for (int i = 0; i < 2; ++i) { int R, C; stage_rc(tid * 16 + i * 8192, R, C); const int Rb = Epi::PERM ? ((R & ~31) + perm32(R & 31)) : R;
        voffA[i] = (unsigned)(R * g.lda + C) * 2u; voffA1[i] = voffA[i]; voffB[i] = (unsigned)(Rb * g.ldb + C) * 2u; }
    const size_t kstep = (size_t)(BK * 2);
    const size_t hstepA = Sched::GATHER ? 0 : (size_t)HALF * g.lda * 2, hstepB = (size_t)HALF * g.ldb * 2;
    const size_t tstepA = 2 * hstepA, tstepB = 2 * hstepB;
    const unsigned ldsw = (unsigned)wid * 1024u;
    const int aoff = lds_byte(wr * 64 + fr, fq * 8), boff = lds_byte(wc * 32 + fr, fq * 8);
#define PG8_SA(b, h) (((b) * 2 + (h)) * HTB)
#define PG8_SB(b, h) ((4 + (b) * 2 + (h)) * HTB)
#define PG8_STAGE(bufoff, gbase, voff) do { _Pragma("unroll") for (int _i = 0; _i < 2; ++_i) \
        __builtin_amdgcn_global_load_lds((const unsigned*)((const char*)(gbase) + (voff)[_i]), (PG8_LAS unsigned*)(lds + (bufoff) + ldsw + _i * 8192), 16, 0, 0); } while (0)
#define PG8_LDA(dst, b, h) do { _Pragma("unroll") for (int m = 0; m < 4; ++m) _Pragma("unroll") for (int k = 0; k < 2; ++k) dst[m][k] = *(const PG8_LAS bf16x8*)(lds + PG8_SA(b, h) + aoff + m * 2048 + k * 1024); } while (0)
#define PG8_LDB(dst, b, h) do { _Pragma("unroll") for (int n = 0; n < 2; ++n) _Pragma("unroll") for (int k = 0; k < 2; ++k) dst[n][k] = *(const PG8_LAS bf16x8*)(lds + PG8_SB(b, h) + boff + n * 2048 + k * 1024); } while (0)
#define PG8_MMA(ai, bj, At, Bt) do { __builtin_amdgcn_s_setprio(1); _Pragma("unroll") for (int m = 0; m < 4; ++m) _Pragma("unroll") for (int n = 0; n < 2; ++n) _Pragma("unroll") for (int k = 0; k < 2; ++k) \
        acc[ai][bj][m][n] = __builtin_amdgcn_mfma_f32_16x16x32_bf16(Bt[n][k], At[m][k], acc[ai][bj][m][n], 0, 0, 0); __builtin_amdgcn_s_setprio(0); } while (0)
#define PG8_WAIT_V(n) asm volatile("s_waitcnt vmcnt(" #n ")" ::: "memory")
#define PG8_WAIT_L(n) asm volatile("s_waitcnt lgkmcnt(" #n ")" ::: "memory")
#define PG8_BAR __builtin_amdgcn_s_barrier()
#define PG8_SCHED __builtin_amdgcn_sched_barrier(0)
    Unit cur, nxt; int ui = 0;
    if (!S.next(0, cur)) return;
    if constexpr (Sched::GATHER) {
#pragma unroll
        for (int i = 0; i < 2; ++i) { int R, C; stage_rc(tid * 16 + i * 8192, R, C);
            voffA[i] = (unsigned)(S.arow(R) * g.lda + C) * 2u; voffA1[i] = (unsigned)(S.arow(R + HALF) * g.lda + C) * 2u; }
    }
    f32x4 acc[2][2][4][2];
#pragma unroll
    for (int a = 0; a < 2; ++a)
#pragma unroll
        for (int b = 0; b < 2; ++b)
#pragma unroll
            for (int m = 0; m < 4; ++m)
#pragma unroll
                for (int n = 0; n < 2; ++n) acc[a][b][m][n] = (f32x4){0.f, 0.f, 0.f, 0.f};
    bf16x8 At[4][2], B0[2][2], B1[2][2];
    const char* cA = (const char*)g.A + (size_t)cur.pm * tstepA; const char* cB = (const char*)g.Bt + (size_t)cur.pn * tstepB;
    S.a_ready(cur);
    if constexpr (SP2) {
        PG8_STAGE(PG8_SB(0, 0), cB, voffB); PG8_STAGE(PG8_SB(0, 1), cB + hstepB, voffB); PG8_STAGE(PG8_SA(0, 0), cA, voffA); PG8_STAGE(PG8_SA(0, 1), cA + hstepA, voffA1);
        if (wr == 1) PG8_BAR;
        PG8_WAIT_V(2); PG8_BAR;
        PG8_STAGE(PG8_SB(1, 0), cB + kstep, voffB); PG8_STAGE(PG8_SA(1, 0), cA + kstep, voffA); PG8_STAGE(PG8_SB(1, 1), cB + hstepB + kstep, voffB);
        PG8_WAIT_V(6); PG8_BAR;
    } else {
        PG8_STAGE(PG8_SB(0, 0), cB, voffB); PG8_STAGE(PG8_SA(0, 0), cA, voffA); PG8_STAGE(PG8_SB(0, 1), cB + hstepB, voffB); PG8_STAGE(PG8_SA(0, 1), cA + hstepA, voffA1);
        if (wr == 1) PG8_BAR;
        PG8_WAIT_V(4); PG8_BAR;
        PG8_STAGE(PG8_SB(1, 0), cB + kstep, voffB); PG8_STAGE(PG8_SA(1, 0), cA + kstep, voffA); PG8_STAGE(PG8_SB(1, 1), cB + hstepB + kstep, voffB);
        PG8_WAIT_V(6); PG8_BAR;
    }
    for (;;) {
        const bool has_next = S.next(ui + 1, nxt);
        const char* nA = has_next ? (const char*)g.A + (size_t)nxt.pm * tstepA : cA; const char* nB = has_next ? (const char*)g.Bt + (size_t)nxt.pn * tstepB : cB;
        for (int t = 0; t < nt; t += 2) {
            const bool last = (t == nt - 2);
            const char* a1 = cA + (size_t)(t + 1) * kstep;
            const char* a2 = last ? nA : cA + (size_t)(t + 2) * kstep; const char* b2 = last ? nB : cB + (size_t)(t + 2) * kstep;
            const char* a3 = a2 + kstep; const char* b3 = b2 + kstep;
            if (last && has_next) S.a_ready(nxt);
            if constexpr (SP2) {
            PG8_LDB(B0, 0, 0); PG8_LDB(B1, 0, 1); PG8_SCHED; PG8_LDA(At, 0, 0); PG8_STAGE(PG8_SA(1, 1), a1 + hstepA, voffA1);
            PG8_WAIT_V(8); PG8_WAIT_L(0); PG8_BAR; PG8_MMA(0, 0, At, B0); PG8_MMA(0, 1, At, B1); PG8_BAR; PG8_SCHED;
            PG8_LDA(At, 0, 1); PG8_STAGE(PG8_SB(0, 0), b2, voffB); PG8_STAGE(PG8_SB(0, 1), b2 + hstepB, voffB); PG8_STAGE(PG8_SA(0, 0), a2, voffA);
            PG8_WAIT_V(8); PG8_WAIT_L(0); PG8_BAR; PG8_MMA(1, 0, At, B0); PG8_MMA(1, 1, At, B1); PG8_BAR; PG8_SCHED;
            PG8_LDB(B0, 1, 0); PG8_LDB(B1, 1, 1); PG8_SCHED; PG8_LDA(At, 1, 0); PG8_STAGE(PG8_SA(0, 1), a2 + hstepA, voffA1);
            PG8_WAIT_V(8); PG8_WAIT_L(0); PG8_BAR; PG8_MMA(0, 0, At, B0); PG8_MMA(0, 1, At, B1); PG8_BAR; PG8_SCHED;
            PG8_LDA(At, 1, 1); PG8_STAGE(PG8_SB(1, 0), b3, voffB); PG8_STAGE(PG8_SB(1, 1), b3 + hstepB, voffB); PG8_STAGE(PG8_SA(1, 0), a3, voffA);
            PG8_WAIT_V(8); PG8_WAIT_L(0); PG8_BAR; PG8_MMA(1, 0, At, B0); PG8_MMA(1, 1, At, B1); PG8_BAR; PG8_SCHED;
            } else {
            PG8_LDB(B0, 0, 0); PG8_SCHED; PG8_LDA(At, 0, 0); PG8_STAGE(PG8_SA(1, 1), a1 + hstepA, voffA1);
            PG8_WAIT_L(8); PG8_BAR; PG8_WAIT_L(0); PG8_MMA(0, 0, At, B0); PG8_BAR; PG8_SCHED;
            PG8_LDB(B1, 0, 1); PG8_STAGE(PG8_SB(0, 0), b2, voffB);
            PG8_BAR; PG8_WAIT_L(0); PG8_MMA(0, 1, At, B1); PG8_BAR;
            PG8_LDA(At, 0, 1); PG8_STAGE(PG8_SA(0, 0), a2, voffA);
            PG8_BAR; PG8_WAIT_L(0); PG8_MMA(1, 0, At, B0); PG8_BAR; PG8_SCHED;
            PG8_STAGE(PG8_SB(0, 1), b2 + hstepB, voffB);
            PG8_WAIT_V(6); PG8_BAR; PG8_MMA(1, 1, At, B1); PG8_BAR;
            PG8_LDB(B0, 1, 0); PG8_SCHED; PG8_LDA(At, 1, 0); PG8_STAGE(PG8_SA(0, 1), a2 + hstepA, voffA1);
            PG8_WAIT_L(8); PG8_BAR; PG8_WAIT_L(0); PG8_MMA(0, 0, At, B0); PG8_BAR; PG8_SCHED;
            PG8_LDB(B1, 1, 1); PG8_STAGE(PG8_SB(1, 0), b3, voffB);
            PG8_BAR; PG8_WAIT_L(0); PG8_MMA(0, 1, At, B1); PG8_BAR;
            PG8_LDA(At, 1, 1); PG8_STAGE(PG8_SA(1, 0), a3, voffA);
            PG8_BAR; PG8_WAIT_L(0); PG8_MMA(1, 0, At, B0); PG8_BAR; PG8_SCHED;
            PG8_STAGE(PG8_SB(1, 1), b3 + hstepB, voffB);
            PG8_WAIT_V(6); PG8_BAR; PG8_MMA(1, 1, At, B1); PG8_BAR;
            }
        }
        if constexpr (ALIGN_EPI) { if (wr == 0) PG8_BAR; }
        if constexpr (!Epi::AFTER_DRAIN) { const int le_ = lane_now(); E(acc, cur, wr, wc, le_ & 15, le_ >> 4); S.done(cur); }
        if (!has_next) break;
#pragma unroll
        for (int a = 0; a < 2; ++a)
#pragma unroll
            for (int b = 0; b < 2; ++b)
#pragma unroll
                for (int m = 0; m < 4; ++m)
#pragma unroll
                    for (int n = 0; n < 2; ++n) acc[a][b][m][n] = (f32x4){0.f, 0.f, 0.f, 0.f};
        cur = nxt; cA = nA; cB = nB; ++ui;
        if constexpr (ALIGN_EPI) { if (wr == 1) PG8_BAR; }
    }
    PG8_WAIT_V(0);
    if constexpr (!ALIGN_EPI) { if (wr == 0) PG8_BAR; }
    PG8_BAR;
    if constexpr (Epi::AFTER_DRAIN) { const int le_ = lane_now(); E.fused(acc, cur, wr, wc, le_ & 15, le_ >> 4, lds, wid, le_); S.done(cur); }
#undef PG8_SA
#undef PG8_SB
#undef PG8_STAGE
#undef PG8_LDA
#undef PG8_LDB
#undef PG8_MMA
#undef PG8_WAIT_V
#undef PG8_WAIT_L
#undef PG8_BAR
#undef PG8_SCHED
}
}
#define XB_TMO      128
#define XB_XCNT(j)  (256  + 64 * (j))
#define XB_XSUB(j)  (1280 + 64 * (j))
#define XB_XGEN(j)  (2304 + 64 * (j))
#define XB_TOP      3328
#define XB_TOPGEN   3392
#define XCD_BAR_WORDS 3456
#define XB_SPIN_CAP (1u << 18)

__device__ __forceinline__ unsigned xb_ld(unsigned* p)              { return __hip_atomic_load(p, __ATOMIC_RELAXED, __HIP_MEMORY_SCOPE_AGENT); }
__device__ __forceinline__ unsigned xb_add(unsigned* p, unsigned v) { return __hip_atomic_fetch_add(p, v, __ATOMIC_RELAXED, __HIP_MEMORY_SCOPE_AGENT); }
__device__ __forceinline__ unsigned xb_xcc_id() { return (unsigned)__builtin_amdgcn_s_getreg((3 << 11) | 20) & 0xFu; }
#define XB_SPIN(cond, bar) do { unsigned _sp = 0; while (cond) { __builtin_amdgcn_s_sleep(1); \
    if ((++_sp & 255u) == 0u) { if (xb_ld(&(bar)[XB_TMO])) break; if (_sp > XB_SPIN_CAP) { atomicAdd(&(bar)[XB_TMO], 1u); break; } } } } while (0)

struct XcdBarrier {
    unsigned* bar; unsigned x;
    volatile LAS unsigned* st;
};

__device__ __forceinline__ XcdBarrier xcd_barrier_post(unsigned* bar, volatile LAS unsigned* st) {
    XcdBarrier b; b.bar = bar; b.x = xb_xcc_id(); b.st = st;
    if (threadIdx.x == 0) (void)xb_add(&bar[XB_XCNT(b.x)], 1u);
    return b;
}
__device__ __forceinline__ void xcd_barrier_complete(unsigned* bar, unsigned x, unsigned& nloc, unsigned& nx) {
    const unsigned G = gridDim.x * gridDim.y * gridDim.z;
    unsigned sum, cnt, mine, sp = 0u;
    for (;;) {
        sum = 0u; cnt = 0u; mine = 0u;
#pragma unroll
        for (unsigned j = 0; j < 16; ++j) { const unsigned c = xb_ld(&bar[XB_XCNT(j)]); sum += c; cnt += (c > 0u) ? 1u : 0u; }
        if (sum == G) { mine = xb_ld(&bar[XB_XCNT(x)]); break; }
        __builtin_amdgcn_s_sleep(1);
        if ((++sp & 255u) == 0u) { if (xb_ld(&bar[XB_TMO])) break; if (sp > XB_SPIN_CAP) { atomicAdd(&bar[XB_TMO], 1u); break; } }
    }
    nloc = mine > 0u ? mine : 1u; nx = cnt > 0u ? cnt : 1u;
}

__device__ __forceinline__ void xcd_barrier(const XcdBarrier& b, const bool t0  ) {
    asm volatile("s_waitcnt vmcnt(0)" ::: "memory");
    __syncthreads();
    if (t0) {
        unsigned* bar = (unsigned*)opaque_ptr((unsigned char*)b.bar);
        __builtin_amdgcn_s_waitcnt(0);
        unsigned nloc = b.st[0], nx = b.st[1];
        if (nloc == 0u) { xcd_barrier_complete(bar, b.x, nloc, nx); b.st[0] = nloc; b.st[1] = nx; }
        const unsigned old = xb_add(&bar[XB_XSUB(b.x)], 1u);
        const unsigned gen = old / nloc;
        if (old + 1u == (gen + 1u) * nloc) {
            __builtin_amdgcn_fence(__ATOMIC_RELEASE, "agent");
            asm volatile("s_waitcnt vmcnt(0)" ::: "memory");
            const unsigned og = xb_add(&bar[XB_TOP], 1u);
            const unsigned tg = og / nx;
            if (og + 1u == (tg + 1u) * nx) xb_add(&bar[XB_TOPGEN], 1u);
            else XB_SPIN(xb_ld(&bar[XB_TOPGEN]) == tg, bar);
            __builtin_amdgcn_fence(__ATOMIC_ACQUIRE, "agent");
            xb_add(&bar[XB_XGEN(b.x)], 1u);
            asm volatile("s_waitcnt vmcnt(0)" ::: "memory");
        } else {
            XB_SPIN(xb_ld(&bar[XB_XGEN(b.x)]) == gen, bar);
            __builtin_amdgcn_fence(__ATOMIC_ACQUIRE, "agent");
            asm volatile("s_waitcnt vmcnt(0)" ::: "memory");
        }
    }
    __syncthreads();
}

__device__ __forceinline__ void panel_sync(unsigned* cnt, unsigned target, const bool t0) {
    asm volatile("s_waitcnt vmcnt(0)" ::: "memory");
    __syncthreads();
    if (t0) {
        __builtin_amdgcn_s_waitcnt(0);
#if !MK_WT
        __builtin_amdgcn_fence(__ATOMIC_RELEASE, "agent");
        asm volatile("s_waitcnt vmcnt(0)" ::: "memory");
#endif
        (void)xb_add(cnt, 1u);
        unsigned sp = 0;
        while (xb_ld(cnt) < target) { __builtin_amdgcn_s_sleep(1); if (++sp > (1u << 20)) break; }
        __builtin_amdgcn_fence(__ATOMIC_ACQUIRE, "agent");
        asm volatile("s_waitcnt vmcnt(0)" ::: "memory");
    }
    __syncthreads();
}
typedef pg8::f32x4 A4;
#define EPI_ROWS_BEGIN _Pragma("unroll") for (int ai = 0; ai < 2; ++ai) _Pragma("unroll") for (int m = 0; m < 4; ++m) { const int row = u.pm * 256 + ai * 128 + wr * 64 + m * 16 + fr;
#define EPI_ROWS_END }
__device__ __forceinline__ float rstd_of(const float* ss, int row, int fq) {
    if (!ss) return 1.0f;
    const f32x4 p = *(const f32x4*)(ss + (size_t)row * 16 + fq * 4);
    float s = (p[0] + p[1]) + (p[2] + p[3]);
    s = add_xor32(add_xor16(s));
    return rsqrtf(s * (1.0f / D) + EPS);
}
__device__ __forceinline__ float rstd_row(const float* ss, size_t row) {
    const f32x4* p = (const f32x4*)(ss + row * 16); float s = 0.f;
#pragma unroll
    for (int i = 0; i < 4; ++i) { const f32x4 v = p[i]; s += (v[0] + v[1]) + (v[2] + v[3]); }
    return rsqrtf(s * (1.0f / D) + EPS);
}
__device__ __forceinline__ u32x4 pack8(const A4& a, const A4& b) { u32x4 w; w.x = pkbf(a[0], a[1]); w.y = pkbf(a[2], a[3]); w.z = pkbf(b[0], b[1]); w.w = pkbf(b[2], b[3]); return w; }
__device__ __forceinline__ void unpack8(const u32x4& w, A4& a, A4& b) { a[0] = bflo(w.x); a[1] = bfhi(w.x); a[2] = bflo(w.y); a[3] = bfhi(w.y); b[0] = bflo(w.z); b[1] = bfhi(w.z); b[2] = bflo(w.w); b[3] = bfhi(w.w); }

struct EpiScale {
    static constexpr bool PERM = true, AFTER_DRAIN = false;
    bf16_t* O; const float* ss; int ld; float scale; int wt, pad;
    __device__ __forceinline__ void operator()(const A4 (&acc)[2][2][4][2], const pg8::Unit& u, int wr, int wc, int fr, int fq) const {
        const int col0 = u.pn * 256 + wc * 32 + 8 * fq;
        EPI_ROWS_BEGIN
            const float s = rstd_of(ss, row, fq) * scale;
#pragma unroll
            for (int bj = 0; bj < 2; ++bj) { const u32x4 w = pack8(acc[ai][bj][m][0] * s, acc[ai][bj][m][1] * s); bf16_t* p = O + (size_t)row * ld + col0 + bj * 128; if (wt) ST16_OUT(p, w); else *(u32x4*)p = w; }
        EPI_ROWS_END
    }
};

struct EpiProj {
    static constexpr bool PERM = true, AFTER_DRAIN = false;
    bf16_t *AQ, *AK, *BQ, *BK, *BRS, *GA, *GB; float* LOGA; const float* balpha; int tile0, pad;
    __device__ __forceinline__ void operator()(const A4 (&acc)[2][2][4][2], const pg8::Unit& u, int wr, int wc, int fr, int fq) const {
        const int tile = u.pn + tile0;
        bf16_t* dst; int ld, c0, mode = 0; float sc = 1.f;
        if (tile < 2) { dst = AQ; ld = 512; c0 = tile * 256; sc = 0.125f * 1.4426950408889634f; }
        else if (tile < 4) { dst = AK; ld = 512; c0 = (tile - 2) * 256; }
        else if (tile == 4) { dst = BQ; ld = 256; c0 = 0; sc = 0.125f; }
        else if (tile == 5) { dst = BK; ld = 256; c0 = 0; }
        else if (tile < 8) { dst = BRS; ld = 512; c0 = (tile - 6) * 256; mode = 1; }
        else if (tile == 8) { dst = nullptr; ld = 256; c0 = 0; mode = 3; }
        else if (tile < 13) { dst = GA; ld = 1024; c0 = (tile - 9) * 256; mode = 2; }
        else { dst = GB; ld = 1024; c0 = (tile - 13) * 256; mode = 2; }
        const int cl = wc * 32 + 8 * fq;
        EPI_ROWS_BEGIN
#pragma unroll
            for (int bj = 0; bj < 2; ++bj) {
                A4 v0 = acc[ai][bj][m][0] * sc, v1 = acc[ai][bj][m][1] * sc;
                const int c = cl + bj * 128;
                if (mode == 3) {
                    const A4 b0 = *(const A4*)(balpha + c), b1 = *(const A4*)(balpha + c + 4);
#pragma unroll
                    for (int i = 0; i < 4; ++i) { v0[i] = flogsigmoid(v0[i] + b0[i]) * 0.0625f; v1[i] = flogsigmoid(v1[i] + b1[i]) * 0.0625f; }
                    float* o = LOGA + (size_t)row * 256 + c; *(A4*)o = v0; *(A4*)(o + 4) = v1;
                } else {
                    if (mode == 1) {
#pragma unroll
                        for (int i = 0; i < 4; ++i) { v0[i] = fsilu(v0[i]); v1[i] = fsilu(v1[i]); }
                    } else if (mode == 2) {
#pragma unroll
                        for (int i = 0; i < 4; ++i) { v0[i] = fsigmoid(v0[i]); v1[i] = fsigmoid(v1[i]); }
                    }
                    { const u32x4 w = pack8(v0, v1); bf16_t* p = dst + (size_t)row * ld + c0 + c; if (mode == 2) *(u32x4*)p = w; else ST16_OUT(p, w); }
                }
            }
        EPI_ROWS_END
    }
};

struct EpiGate {
    static constexpr bool PERM = true, AFTER_DRAIN = false;
    const bf16_t* G; const bf16_t* ADD; bf16_t* O;
    __device__ __forceinline__ void operator()(const A4 (&acc)[2][2][4][2], const pg8::Unit& u, int wr, int wc, int fr, int fq) const {
        const int col0 = u.pn * 256 + wc * 32 + 8 * fq;
        EPI_ROWS_BEGIN
#pragma unroll
            for (int bj = 0; bj < 2; ++bj) {
                const size_t off = (size_t)row * D + col0 + bj * 128;
                A4 g0, g1; unpack8(*(const u32x4*)(G + off), g0, g1);
                A4 v0 = acc[ai][bj][m][0] * g0, v1 = acc[ai][bj][m][1] * g1;
                if (ADD) { A4 a0, a1; unpack8(*(const u32x4*)(ADD + off), a0, a1); v0 += a0; v1 += a1; }
                { const u32x4 w = pack8(v0, v1); if (ADD) ST16_OUT(O + off, w); else *(u32x4*)(O + off) = w; }
            }
        EPI_ROWS_END
    }
};

struct EpiResid {
    static constexpr bool PERM = true, AFTER_DRAIN = false;
    bf16_t* Xo; const bf16_t* X; float* ss_out;
    __device__ __forceinline__ void operator()(const A4 (&acc)[2][2][4][2], const pg8::Unit& u, int wr, int wc, int fr, int fq) const {
        const int col0 = u.pn * 256 + wc * 32 + 8 * fq;
        EPI_ROWS_BEGIN
            float q = 0.f;
#pragma unroll
            for (int bj = 0; bj < 2; ++bj) {
                const size_t off = (size_t)row * D + col0 + bj * 128;
                A4 x0, x1; unpack8(*(const u32x4*)(X + off), x0, x1);
                x0 += acc[ai][bj][m][0]; x1 += acc[ai][bj][m][1];
                q += (x0[0] * x0[0] + x0[1] * x0[1]) + (x0[2] * x0[2] + x0[3] * x0[3]) + (x1[0] * x1[0] + x1[1] * x1[1]) + (x1[2] * x1[2] + x1[3] * x1[3]);
                ST16_OUT(Xo + off, pack8(x0, x1));
            }
            q = add_xor32(add_xor16(q));
            if (fq == 0) __hip_atomic_store(ss_out + (size_t)row * 16 + u.pn * 4 + wc, q, __ATOMIC_RELAXED, __HIP_MEMORY_SCOPE_AGENT);
        EPI_ROWS_END
    }
};

struct ConvRegs { f32x4 v[8]; };
__device__ __forceinline__ void conv_load(ConvRegs& R, const float* __restrict__ W, int ldw, int k0, int n0, int lane) {
#pragma unroll
    for (int i = 0; i < 8; ++i) { const int kk = (lane >> 3) + 8 * i; R.v[i] = __builtin_nontemporal_load((const f32x4*)(W + (size_t)(k0 + kk) * ldw + n0 + (lane & 7) * 4)); }
}
__device__ __forceinline__ void conv_store(const ConvRegs& R, const float* __restrict__ gk, bf16_t* __restrict__ WT, int ldt, int k0, int n0, LAS float* scr, int lane) {
#pragma unroll
    for (int i = 0; i < 8; ++i) { const int kk = (lane >> 3) + 8 * i; const float s = gk ? gk[k0 + kk] : 1.0f; LAS float* p = scr + kk * 33 + (lane & 7) * 4;
        p[0] = R.v[i][0] * s; p[1] = R.v[i][1] * s; p[2] = R.v[i][2] * s; p[3] = R.v[i][3] * s; }
    asm volatile("s_waitcnt lgkmcnt(0)" ::: "memory");
    const int c = lane & 7;
#pragma unroll
    for (int j = 0; j < 4; ++j) { const int n = (lane >> 3) + 8 * j; const LAS float* s = scr + (8 * c) * 33 + n;
        u32x4 o; o.x = pkbf(s[0 * 33], s[1 * 33]); o.y = pkbf(s[2 * 33], s[3 * 33]); o.z = pkbf(s[4 * 33], s[5 * 33]); o.w = pkbf(s[6 * 33], s[7 * 33]);
        *(u32x4*)(WT + (size_t)(n0 + n) * ldt + k0 + 8 * c) = o; }
    asm volatile("s_waitcnt lgkmcnt(0)" ::: "memory");
}
__device__ __forceinline__ void conv_item(const float* __restrict__ W, int ldw, const float* __restrict__ gk, bf16_t* __restrict__ WT, int ldt, int k0, int n0, LAS float* scr, int lane) {
    ConvRegs R; conv_load(R, W, ldw, k0, n0, lane); conv_store(R, gk, WT, ldt, k0, n0, scr, lane);
}

struct InPtrs {
    const float *x, *mem, *norm_mix_g, *w_in, *rel_bias, *gla_w_alpha, *gla_b_alpha, *gla_norm_g, *w_branch, *w_mix_out, *norm_x_g, *mem_norm_g, *w_xq, *w_xkv, *w_xo,
                *norm_ffn_g, *w_gr, *b_gr, *w_er, *b_er, *w_eg, *w_eu, *w_ed, *final_g;
};

struct ConvJob { const float* W; const float* gk; bf16_t* WT; int ldw, ldt, K, N; };
__device__ __forceinline__ ConvJob dense_job(const InPtrs& in, unsigned char* ws, int l, int j) {
    unsigned char* wd = ws + WS_WDENSE + (size_t)l * WDENSE_STRIDE;
    const float* Win = in.w_in + (size_t)l * D * INW; bf16_t* WIN_T = (bf16_t*)(wd + WD_WIN);
    const float* gm = in.norm_mix_g + l * D;
    ConvJob J;
    switch (j) {
    case 0: J = {Win + 0, gm, WIN_T + (size_t)0 * D, INW, D, D, 1024}; break;
    case 1: J = {Win + 1024, gm, WIN_T + (size_t)2304 * D, INW, D, D, 512}; break;
    case 2: J = {Win + 1536, gm, WIN_T + (size_t)1024 * D, INW, D, D, 512}; break;
    case 3: J = {Win + 2048, gm, WIN_T + (size_t)2816 * D, INW, D, D, 512}; break;
    case 4: J = {Win + 3088, gm, WIN_T + (size_t)3328 * D, INW, D, D, 2048}; break;
    case 11: J = {Win + 2576, gm, WIN_T + (size_t)1536 * D, INW, D, D, 512}; break;
    case 5: J = {in.w_branch + (size_t)(l * 2 + 0) * 512 * D, nullptr, (bf16_t*)(wd + WD_WB), D, D, 512, D}; break;
    case 6: J = {in.w_branch + (size_t)(l * 2 + 1) * 512 * D, nullptr, (bf16_t*)(wd + WD_WB) + 512, D, D, 512, D}; break;
    case 7: J = {in.w_mix_out + (size_t)l * D * D, nullptr, (bf16_t*)(wd + WD_WMO), D, D, D, D}; break;
    case 8: J = {in.w_xq + (size_t)l * D * D, in.norm_x_g + l * D, (bf16_t*)(wd + WD_WXQ), D, D, D, D}; break;
    case 9: J = {in.w_xkv + (size_t)l * D * 2 * D, nullptr, (bf16_t*)(wd + WD_WXKV), 2 * D, D, D, 2 * D}; break;
    default: J = {in.w_xo + (size_t)l * D * D, nullptr, (bf16_t*)(wd + WD_WXO), D, D, D, D}; break;
    }
    return J;
}

__device__ __forceinline__ void conv_dense_layer(const InPtrs& in, unsigned char* ws, int l, int gw, int NGW, int gt, int NGT, LAS float* scr, int lane) {
    constexpr int NITEMS = 5632;
#pragma nounroll
    for (int it = gw; it < NITEMS; it += 2 * NGW) {
        ConvRegs R[2]; ConvJob J[2]; int k0[2], n0[2];
#pragma unroll
        for (int q = 0; q < 2; ++q) {
            int r = it + q * NGW; const bool on = r < NITEMS; if (!on) r = it;
            int j = 0;
#pragma unroll
            for (int jj = 0; jj < 12; ++jj) { const ConvJob Jt = dense_job(in, ws, l, jj); const int n = (Jt.K / 64) * (Jt.N / 32); if (j == jj && r >= n) { r -= n; ++j; } }
            J[q] = dense_job(in, ws, l, j); const int nnb = J[q].N / 32; k0[q] = (r / nnb) * 64; n0[q] = (r % nnb) * 32;
            if (on) conv_load(R[q], J[q].W, J[q].ldw, k0[q], n0[q], lane);
        }
#pragma unroll
        for (int q = 0; q < 2; ++q) if (it + q * NGW < NITEMS) conv_store(R[q], J[q].gk, J[q].WT, J[q].ldt, k0[q], n0[q], scr, lane);
    }
    {
        bf16_t* WIN_T = (bf16_t*)(ws + WS_WDENSE + (size_t)l * WDENSE_STRIDE + WD_WIN);
        const float* Win = in.w_in + (size_t)l * D * INW; const float* Wa = in.gla_w_alpha + (size_t)l * BR * BKW; const float* gm = in.norm_mix_g + l * D;
        for (int i = gt; i < 256 * D; i += NGT) {
            const int c = i >> 10, k = i & 1023; float s = 0.f;
#pragma unroll
            for (int r = 0; r < BR; ++r) s += Win[(size_t)k * INW + 2560 + r] * Wa[r * BKW + c];
            WIN_T[(size_t)(2048 + c) * D + k] = f2bf(s * gm[k]);
        }
    }
}
__device__ __forceinline__ void ph_prologue(const InPtrs& in, unsigned char* ws, LAS unsigned char* lds, int vcu, int G, int wv) {
    const int tid = tid_of(wv), lane = tid & 63, wave = wv;
    LAS float* scr = (LAS float*)(lds + wave * 16384);
    const int gw = vcu * 8 + wave, NGW = G * 8;
#pragma nounroll
    for (int l = 0; l < (G == 256 ? 1 : DEPTH); ++l) conv_dense_layer(in, ws, l, gw, NGW, vcu * 512 + tid, G * 512, scr, lane);
    bf16_t* XB = (bf16_t*)(ws + WS_XB); bf16_t* XN = (bf16_t*)(ws + WS_XN);
    for (int r = gw; r < T; r += NGW) {
        const float4* xr = (const float4*)(in.x + (size_t)r * D) + lane; float4 v[4]; float s = 0.f;
#pragma unroll
        for (int j = 0; j < 4; ++j) { v[j] = xr[64 * j]; s += v[j].x * v[j].x + v[j].y * v[j].y + v[j].z * v[j].z + v[j].w * v[j].w;
            u32x2 o; o.x = pkbf(v[j].x, v[j].y); o.y = pkbf(v[j].z, v[j].w); *(u32x2*)(XB + (size_t)r * D + (lane + 64 * j) * 4) = o; }
        const float rs = rsqrtf(wave_sum(s) * (1.0f / D) + EPS);
#pragma unroll
        for (int j = 0; j < 4; ++j) { u32x2 o; o.x = pkbf(v[j].x * rs, v[j].y * rs); o.y = pkbf(v[j].z * rs, v[j].w * rs); *(u32x2*)(XN + (size_t)r * D + (lane + 64 * j) * 4) = o; }
    }
    bf16_t* MEMN = (bf16_t*)(ws + WS_MEMN);
    for (int r = gw; r < NB * NMEM; r += NGW) {
        const float4* xr = (const float4*)(in.mem + (size_t)r * D) + lane; float4 v[4]; float s = 0.f;
#pragma unroll
        for (int j = 0; j < 4; ++j) { v[j] = xr[64 * j]; s += v[j].x * v[j].x + v[j].y * v[j].y + v[j].z * v[j].z + v[j].w * v[j].w; }
        const float rs = rsqrtf(wave_sum(s) * (1.0f / D) + EPS);
#pragma unroll
        for (int j = 0; j < 4; ++j) { const float4 g = ((const float4*)in.mem_norm_g)[lane + 64 * j];
            u32x2 o; o.x = pkbf(v[j].x * rs * g.x, v[j].y * rs * g.y); o.y = pkbf(v[j].z * rs * g.z, v[j].w * rs * g.w); *(u32x2*)(MEMN + (size_t)r * D + (lane + 64 * j) * 4) = o; }
    }
}

__device__ __forceinline__ void d_band_attn(int blk, int qi, const bf16_t* __restrict__ AQ, const bf16_t* __restrict__ AK, const bf16_t* __restrict__ AV, const float* __restrict__ rel, bf16_t* __restrict__ OAB) {
    const int n = blk % NCH, h = (blk / NCH) % AH, b = blk / (NCH * AH);
    const size_t qrow = (size_t)(b * L + n * CH + qi);
    float q[64], acc[64];
#pragma unroll
    for (int d = 0; d < 64; d += 8) { const u32x4 w = *(const u32x4*)(AQ + qrow * AW + h * 64 + d);
        q[d] = bflo(w.x); q[d + 1] = bfhi(w.x); q[d + 2] = bflo(w.y); q[d + 3] = bfhi(w.y); q[d + 4] = bflo(w.z); q[d + 5] = bfhi(w.z); q[d + 6] = bflo(w.w); q[d + 7] = bfhi(w.w); }
#pragma unroll
    for (int d = 0; d < 64; ++d) acc[d] = 0.f;
    float m = -INFINITY, l = 0.f;
    for (int j = 0; j < ABAND; ++j) {
        const int kc = n + (j >> 6) - ALC; if (kc < 0) continue;
        const size_t krow = (size_t)(b * L + kc * CH + (j & 63));
        const bf16_t* kp = AK + krow * AW + h * 64; const bf16_t* vp = AV + krow * AW + h * 64;
        float s = 0.f;
#pragma unroll
        for (int d = 0; d < 64; d += 8) { const u32x4 w = *(const u32x4*)(kp + d);
            s += q[d] * bflo(w.x) + q[d + 1] * bfhi(w.x) + q[d + 2] * bflo(w.y) + q[d + 3] * bfhi(w.y) + q[d + 4] * bflo(w.z) + q[d + 5] * bfhi(w.z) + q[d + 6] * bflo(w.w) + q[d + 7] * bfhi(w.w); }
        int relp = (ALC * CH + qi) - j; relp = relp < -AMAXREL ? -AMAXREL : (relp > AMAXREL ? AMAXREL : relp);
        s = s + rel[h * RELW + relp + AMAXREL];
        const float mn = fmaxf(m, s), corr = __expf(m - mn), p = __expf(s - mn);
        l = l * corr + p; m = mn;
#pragma unroll
        for (int d = 0; d < 64; d += 8) { const u32x4 w = *(const u32x4*)(vp + d);
            acc[d] = acc[d] * corr + p * bflo(w.x); acc[d + 1] = acc[d + 1] * corr + p * bfhi(w.x); acc[d + 2] = acc[d + 2] * corr + p * bflo(w.y); acc[d + 3] = acc[d + 3] * corr + p * bfhi(w.y);
            acc[d + 4] = acc[d + 4] * corr + p * bflo(w.z); acc[d + 5] = acc[d + 5] * corr + p * bfhi(w.z); acc[d + 6] = acc[d + 6] * corr + p * bflo(w.w); acc[d + 7] = acc[d + 7] * corr + p * bfhi(w.w); }
    }
    const float inv = 1.0f / l;
#pragma unroll
    for (int d = 0; d < 64; d += 8) { u32x4 o; o.x = pkbf(acc[d] * inv, acc[d + 1] * inv); o.y = pkbf(acc[d + 2] * inv, acc[d + 3] * inv); o.z = pkbf(acc[d + 4] * inv, acc[d + 5] * inv); o.w = pkbf(acc[d + 6] * inv, acc[d + 7] * inv);
        *(u32x4*)(OAB + qrow * D + h * 64 + d) = o; }
}

__device__ __forceinline__ void d_gla(int wv, int item, LAS float* sm  , const bf16_t* __restrict__ BQ, const bf16_t* __restrict__ BK, const bf16_t* __restrict__ BV, const float* __restrict__ LOGA, float* __restrict__ raw) {
    LAS float* sq = sm; LAS float* sk = sm + 128; LAS float* sa = sm + 256;
    const int b = item / BH, h = item % BH, v = tid_of(wv);
    float S[64];
#pragma unroll
    for (int k = 0; k < 64; ++k) S[k] = 0.f;
    for (int t = 0; t < L; ++t) {
        const size_t row = (size_t)(b * L + t); const int bf = (t & 1) * 64;
        float vv = 0.f;
        if (v < 64) { sq[bf + v] = bf2f(BQ[row * BKW + h * 64 + v]); sa[bf + v] = __expf(LOGA[row * BKW + h * 64 + v]); }
        else if (v < 128) { sk[bf + v - 64] = bf2f(BK[row * BKW + h * 64 + (v - 64)]); }
        if (v < 128) vv = bf2f(BV[(size_t)(h * 128 + v) * T + row]);
        __syncthreads();
        if (v < 128) {
            float o = 0.f;
#pragma unroll
            for (int k = 0; k < 64; ++k) { S[k] = sa[bf + k] * S[k] + sk[bf + k] * vv; o += sq[bf + k] * S[k]; }
            raw[row * BVW + h * 128 + v] = o;
        }
    }
}
__device__ __forceinline__ void d_gla_post(int w, int lane, const float* __restrict__ raw, const bf16_t* __restrict__ BRS, const float* __restrict__ g, bf16_t* __restrict__ OAB) {
    const size_t t = w / BH; const int h = w % BH;
    const float* p = raw + t * BVW + h * 128;
    const float a = p[lane], c = p[lane + 64];
    const float rs = rsqrtf(wave_sum(a * a + c * c) * (1.0f / 128.0f) + EPS);
    const bf16_t* br = BRS + t * BVW + h * 128;
    bf16_t* o = OAB + t * D + 512 + h * 128;
    o[lane] = f2bf(a * rs * g[lane] * bf2f(br[lane])); o[lane + 64] = f2bf(c * rs * g[lane + 64] * bf2f(br[lane + 64]));
}

__device__ __forceinline__ void d_xattn(int item, int j, LAS float* sm, bf16_t* QO, const bf16_t* __restrict__ kv) {
    LAS float* qs = sm; LAS float* ps = sm + 256; LAS float* red = sm + 512;
    const size_t t = item / XH; const int h = item % XH, b = (int)(t / L);
    qs[j] = bf2f(QO[t * D + h * XD + j]);
    __syncthreads();
    const bf16_t* kp = kv + (size_t)(b * NMEM + j) * 2048 + h * XD;
    float s = 0.f;
    for (int d = 0; d < XD; d += 8) { const u32x4 w = *(const u32x4*)(kp + d);
        s += qs[d] * bflo(w.x) + qs[d + 1] * bfhi(w.x) + qs[d + 2] * bflo(w.y) + qs[d + 3] * bfhi(w.y) + qs[d + 4] * bflo(w.z) + qs[d + 5] * bfhi(w.z) + qs[d + 6] * bflo(w.w) + qs[d + 7] * bfhi(w.w); }
    float m = wave_max(s);
    if ((j & 63) == 0) red[j >> 6] = m;
    __syncthreads();
    m = fmaxf(fmaxf(red[0], red[1]), fmaxf(red[2], red[3]));
    __syncthreads();
    const float p = __expf(s - m);
    float l = wave_sum(p);
    if ((j & 63) == 0) red[j >> 6] = l;
    ps[j] = p;
    __syncthreads();
    l = red[0] + red[1] + red[2] + red[3];
    const bf16_t* vp = kv + (size_t)(b * NMEM) * 2048 + 1024 + h * XD + j;
    float o = 0.f;
    for (int jj = 0; jj < NMEM; ++jj) o += ps[jj] * bf2f(vp[(size_t)jj * 2048]);
    QO[t * D + h * XD + j] = f2bf(o / l);
    __syncthreads();
}

__device__ __forceinline__ void d_route(size_t t, int lane, const bf16_t* __restrict__ XB, const float* __restrict__ ss, const float* __restrict__ g, const float* __restrict__ wgr, const float* __restrict__ bgr,
                                        const float* __restrict__ wer, const float* __restrict__ ber, int* __restrict__ sel_e, float* __restrict__ sel_w) {
    const float rs = rstd_row(ss, t);
    float gl[4], el[32];
#pragma unroll
    for (int i = 0; i < 4; ++i) gl[i] = 0.f;
#pragma unroll
    for (int i = 0; i < 32; ++i) el[i] = 0.f;
    for (int i = 0; i < 16; ++i) { const int d = lane + 64 * i; const float hv = bf2f(XB[t * D + d]) * rs * g[d];
#pragma unroll
        for (int o = 0; o < 4; ++o) gl[o] += hv * wgr[d * NG + o];
#pragma unroll
        for (int o = 0; o < 32; ++o) el[o] += hv * wer[d * NE + o]; }
#pragma unroll
    for (int i = 0; i < 4; ++i) gl[i] = wave_sum(gl[i]) + bgr[i];
#pragma unroll
    for (int i = 0; i < 32; ++i) el[i] = wave_sum(el[i]) + ber[i];
    float gm = gl[0]; int gi = 0;
#pragma unroll
    for (int i = 1; i < 4; ++i) if (gl[i] > gm) { gm = gl[i]; gi = i; }
    float gs = 0.f;
#pragma unroll
    for (int i = 0; i < 4; ++i) gs += __expf(gl[i] - gm);
    const float gw = 1.0f / gs;
    float v0 = -INFINITY, v1 = -INFINITY; int i0 = 0, i1 = 0;
#pragma unroll
    for (int gg = 0; gg < 4; ++gg)
#pragma unroll
        for (int e = 0; e < EPG; ++e) if (gg == gi) { const float x = el[gg * EPG + e];
            if (x > v0) { v1 = v0; i1 = i0; v0 = x; i0 = e; } else if (x > v1) { v1 = x; i1 = e; } }
    const float e1 = __expf(v1 - v0), den = 1.0f + e1;
    if (lane == 0) { sel_e[t * 2] = gi * EPG + i0; sel_e[t * 2 + 1] = gi * EPG + i1; sel_w[t * 2] = gw / den; sel_w[t * 2 + 1] = gw * e1 / den; }
}

__device__ __forceinline__ void d_moe(size_t t, int f, LAS float* sm, bf16_t* XB, const float* __restrict__ ss, const float* __restrict__ g, const float* __restrict__ Wg, const float* __restrict__ Wu, const float* __restrict__ Wd,
                                      const int* __restrict__ sel_e, const float* __restrict__ sel_w, float* __restrict__ ss_next) {
    LAS float* hs = sm; LAS float* hid = sm + 1024; LAS float* red = sm + 1280;
    const float rs = rstd_row(ss, t);
    for (int i = f; i < D; i += 256) hs[i] = bf2f(XB[t * D + i]) * rs * g[i];
    float y0 = 0.f, y1 = 0.f, y2 = 0.f, y3 = 0.f;
    for (int s = 0; s < 2; ++s) {
        const int e = sel_e[t * 2 + s]; const float w = sel_w[t * 2 + s];
        __syncthreads();
        const float* wg = Wg + (size_t)e * D * EF + f; const float* wu = Wu + (size_t)e * D * EF + f;
        float ga = 0.f, up = 0.f;
        for (int d = 0; d < D; ++d) { ga += hs[d] * wg[(size_t)d * EF]; up += hs[d] * wu[(size_t)d * EF]; }
        hid[f] = ga / (1.0f + __expf(-ga)) * up * w;
        __syncthreads();
        const float* wd = Wd + (size_t)e * EF * D + f;
        for (int ff = 0; ff < EF; ++ff) { const float hv = hid[ff]; const float* r = wd + (size_t)ff * D; y0 += hv * r[0]; y1 += hv * r[256]; y2 += hv * r[512]; y3 += hv * r[768]; }
    }
    bf16_t* xr = XB + t * D + f;
    const float x0 = bf2f(xr[0]) + y0, x1 = bf2f(xr[256]) + y1, x2 = bf2f(xr[512]) + y2, x3 = bf2f(xr[768]) + y3;
    xr[0] = f2bf(x0); xr[256] = f2bf(x1); xr[512] = f2bf(x2); xr[768] = f2bf(x3);
    const float q = wave_sum(x0 * x0 + x1 * x1 + x2 * x2 + x3 * x3);
    __syncthreads();
    if ((f & 63) == 0) red[f >> 6] = q;
    __syncthreads();
    if (f < 16) ss_next[t * 16 + f] = f == 0 ? (red[0] + red[1]) + (red[2] + red[3]) : 0.f;
    __syncthreads();
}

__device__ __forceinline__ void d_final(size_t t, int i, const bf16_t* __restrict__ XB, const float* __restrict__ ss, const float* __restrict__ g, float* __restrict__ out) {
    const float rs = rstd_row(ss, t);
    const u32x2 w = *(const u32x2*)(XB + t * D + i * 4); const float4 gg = ((const float4*)g)[i];
    float4 o; o.x = bflo(w.x) * rs * gg.x; o.y = bfhi(w.x) * rs * gg.y; o.z = bflo(w.y) * rs * gg.z; o.w = bfhi(w.y) * rs * gg.w;
    ((float4*)(out + t * D))[i] = o;
}
typedef short bf16x8_t __attribute__((ext_vector_type(8)));
constexpr int NRMAX = 40960;
constexpr int NTMAX = NRMAX / 256;
constexpr int CW_CNT = 256;
constexpr size_t SEL_SELE = 0, SEL_SELW = 128 * 1024, SEL_LPOS = 256 * 1024, SEL_POS = 384 * 1024, SEL_GW = 512 * 1024, SEL_TILE = 768 * 1024, SEL_NT = 768 * 1024 + 4096, SEL_RS = 896 * 1024;

struct ExpItem { const float* W; const float* gk; bf16_t* WT; int ldw, ldt, k0, n0; };
__device__ __forceinline__ ExpItem expert_item(const InPtrs& in, unsigned char* ws, int it) {
    const int le = it / 384, r = it % 384, l = le >> 5, e = le & 31;
    bf16_t* WGU = (bf16_t*)(ws + WS_WEXP + (size_t)l * WEXP_STRIDE) + (size_t)e * 512 * D;
    bf16_t* WDT = (bf16_t*)(ws + WS_WEXP + (size_t)l * WEXP_STRIDE + 32 * MiB) + (size_t)e * D * EF;
    const size_t eo = ((size_t)l * NE + e) * D * EF;
    ExpItem I;
    if (r < 256) { const int p = r >> 6, q = r & 63; I = {((p & 1) ? in.w_eu : in.w_eg) + eo + (p >> 1) * 128, in.norm_ffn_g + l * D, WGU + (size_t)(p * 128) * D, EF, D, (q >> 2) * 64, (q & 3) * 32}; }
    else { const int q = r - 256; I = {in.w_ed + eo, nullptr, WDT, D, EF, (q >> 5) * 64, (q & 31) * 32}; }
    return I;
}
__device__ __forceinline__ void conv_expert_items(const InPtrs& in, unsigned char* ws, int it_lo, int it_hi, int gw, int NGW, LAS float* scr, int lane) {
#pragma nounroll
    for (int it = it_lo + gw; it < it_hi; it += 2 * NGW) {
        const int it2 = it + NGW; ConvRegs R0, R1;
        const ExpItem A = expert_item(in, ws, it); conv_load(R0, A.W, A.ldw, A.k0, A.n0, lane);
        ExpItem B = A; if (it2 < it_hi) { B = expert_item(in, ws, it2); conv_load(R1, B.W, B.ldw, B.k0, B.n0, lane); }
        conv_store(R0, A.gk, A.WT, A.ldt, A.k0, A.n0, scr, lane);
        if (it2 < it_hi) conv_store(R1, B.gk, B.WT, B.ldt, B.k0, B.n0, scr, lane);
    }
}
__device__ __forceinline__ void conv_router(const InPtrs& in, unsigned char* ws, int vcu, int G, int tid) {
    for (int i = vcu * 512 + tid; i < DEPTH * 48 * D; i += G * 512) {
        const int l = i / (48 * D), r = (i / D) % 48, k = i % D; float v = 0.f;
        if (r < NG) v = in.w_gr[((size_t)l * D + k) * NG + r]; else if (r < NG + NE) v = in.w_er[((size_t)l * D + k) * NE + (r - NG)];
        ((bf16_t*)(ws + WS_WR))[i] = f2bf(v * in.norm_ffn_g[l * D + k]);
    }
}

__device__ __forceinline__ void ph_route(const InPtrs& in, unsigned char* ws, LAS unsigned char* lds, int l, int t0  , int wv, bool dummy_cnt) {
    const int tid = tid_of(wv), lane = tid & 63, wave = wv;
    const bf16_t* XB = (const bf16_t*)(ws + WS_XB); const bf16_t* WR = (const bf16_t*)(ws + WS_WR) + (size_t)l * 48 * D;
    const float* ss = (const float*)(ws + WS_SSP) + (size_t)(3 * l + 2) * T * 16;
    int* SELE = (int*)(ws + WS_SEL + SEL_SELE); float* SELW = (float*)(ws + WS_SEL + SEL_SELW); int* LPOS = (int*)(ws + WS_SEL + SEL_LPOS);
    float* RSTD = (float*)(ws + WS_SEL + SEL_RS); int* TOKS = (int*)(ws + WS_TOK);
    unsigned* CNT = (unsigned*)(ws + WS_CTL) + CW_CNT + 32 * l + (dummy_cnt ? 128 : 0);
    LAS float* lg = (LAS float*)lds + wave * (16 * 49);
    LAS unsigned* hist = (LAS unsigned*)(lds + 32768); LAS unsigned* gbase = hist + 32;
    {
        if (tid < 32) hist[tid] = 0u;
        int e0 = 0, e1 = 0; unsigned r0 = 0, r1 = 0;
        {
            const int tw = t0 + (wave & 3) * 16, kh = (wave >> 2) * (D / 2);
            f32x4 acc[3];
#pragma unroll
            for (int nb = 0; nb < 3; ++nb) acc[nb] = (f32x4){0.f, 0.f, 0.f, 0.f};
            const bf16_t* ap = XB + (size_t)(tw + (lane & 15)) * D + kh + 8 * (lane >> 4);
            const bf16_t* bp = WR + (size_t)(lane & 15) * D + kh + 8 * (lane >> 4);
#pragma unroll
            for (int k0 = 0; k0 < D / 64; k0 += 8) {
                bf16x8_t a[8], b[8][3];
#pragma unroll
                for (int kk = 0; kk < 8; ++kk) { a[kk] = *(const bf16x8_t*)(ap + (k0 + kk) * 32);
#pragma unroll
                    for (int nb = 0; nb < 3; ++nb) b[kk][nb] = *(const bf16x8_t*)(bp + (size_t)nb * 16 * D + (k0 + kk) * 32); }
#pragma unroll
                for (int kk = 0; kk < 8; ++kk)
#pragma unroll
                    for (int nb = 0; nb < 3; ++nb) acc[nb] = __builtin_amdgcn_mfma_f32_16x16x32_bf16(a[kk], b[kk][nb], acc[nb], 0, 0, 0);
            }
#pragma unroll
            for (int nb = 0; nb < 3; ++nb)
#pragma unroll
                for (int r = 0; r < 4; ++r) lg[((lane >> 4) * 4 + r) * 49 + nb * 16 + (lane & 15)] = acc[nb][r];
        }
        __syncthreads();
        if (wave < 4 && lane < 16) {
            const int t = t0 + wave * 16 + lane; const float rs = rstd_row(ss, (size_t)t);
            const LAS float* p = lg + lane * 49; const LAS float* p2 = p + 4 * (16 * 49);
            float gm = -INFINITY; int gi = 0;
#pragma unroll
            for (int i = 0; i < NG; ++i) { const float x = (p[i] + p2[i]) * rs + in.b_gr[l * NG + i]; if (x > gm) { gm = x; gi = i; } }
            float gs = 0.f;
#pragma unroll
            for (int i = 0; i < NG; ++i) gs += __expf((p[i] + p2[i]) * rs + in.b_gr[l * NG + i] - gm);
            const float gw = 1.0f / gs;
            float v0 = -INFINITY, v1 = -INFINITY; int i0 = 0, i1 = 0;
#pragma unroll
            for (int e = 0; e < EPG; ++e) { const float x = (p[NG + gi * EPG + e] + p2[NG + gi * EPG + e]) * rs + in.b_er[l * NE + gi * EPG + e];
                if (x > v0) { v1 = v0; i1 = i0; v0 = x; i0 = e; } else if (x > v1) { v1 = x; i1 = e; } }
            const float ex = __expf(v1 - v0), den = 1.0f + ex;
            e0 = gi * EPG + i0; e1 = gi * EPG + i1;
            SELE[t * 2] = e0; SELE[t * 2 + 1] = e1; SELW[t * 2] = gw / den; SELW[t * 2 + 1] = gw * ex / den; RSTD[t] = rs;
            r0 = __hip_atomic_fetch_add(&hist[e0], 1u, __ATOMIC_RELAXED, __HIP_MEMORY_SCOPE_WORKGROUP); r1 = __hip_atomic_fetch_add(&hist[e1], 1u, __ATOMIC_RELAXED, __HIP_MEMORY_SCOPE_WORKGROUP);
        }
        __syncthreads();
        if (tid < 32) gbase[tid] = hist[tid] ? atomicAdd(&CNT[tid], hist[tid]) : 0u;
        __syncthreads();
        if (wave < 4 && lane < 16) { const int t = t0 + wave * 16 + lane; const int p0 = (int)(gbase[e0] + r0), p1 = (int)(gbase[e1] + r1);
            LPOS[t * 2] = p0; LPOS[t * 2 + 1] = p1; TOKS[(size_t)e0 * T + p0] = 2 * t; TOKS[(size_t)e1 * T + p1] = 2 * t + 1; }
        __syncthreads();
    }
}

__device__ __forceinline__ int moe_prefix(const unsigned* CNT, int lane, int& cnt, int& tile0, int& ntile) {
    cnt = (lane < 32) ? (int)__hip_atomic_load(CNT + (lane & 31), __ATOMIC_RELAXED, __HIP_MEMORY_SCOPE_AGENT) : 0;
    ntile = (cnt + 255) >> 8;
    int incl = ntile;
#pragma unroll
    for (int o = 1; o < 32; o <<= 1) { const int y = shfl_idx(incl, (lane - o) & 63); if ((lane & 31) >= o) incl += y; }
    tile0 = incl - ntile;
    return shfl_idx(incl, 31);
}
__device__ __forceinline__ void moe_tables(unsigned char* ws, int l, LAS int* tb, int vcu, int wave, int lane) {
    if (wave == 0) {
        int cnt, t0, nt_e; const int nt = moe_prefix((const unsigned*)(ws + WS_CTL) + CW_CNT + 32 * l, lane, cnt, t0, nt_e);
        if (lane < 32) { tb[lane] = cnt; tb[32 + lane] = t0; for (int r = t0; r < t0 + nt_e; ++r) tb[96 + r] = lane; }
        if (lane == 0) tb[64] = nt;
        if (vcu == 0) {
            int* TILE_E = (int*)(ws + WS_SEL + SEL_TILE);
            if (lane < 32) for (int r = t0; r < t0 + nt_e; ++r) TILE_E[r] = lane;
            if (lane == 0) *(int*)(ws + WS_SEL + SEL_NT) = nt;
        }
    }
    asm volatile("s_waitcnt lgkmcnt(0)" ::: "memory");
    __syncthreads();
}
struct GatherOrder {
    static constexpr bool GATHER = true;
    int pm, pn; const int* toks; int tl, cnt;
    __device__ __forceinline__ bool next(int i, pg8::Unit& u) const { if (i != 0) return false; u.pm = pm; u.pn = pn; return true; }
    __device__ __forceinline__ int arow(int R) const { const int p = tl * 256 + R; return p < cnt ? (toks[p] >> 1) : 0; }
    __device__ __forceinline__ void a_ready(const pg8::Unit&) const {}
    __device__ __forceinline__ void done(const pg8::Unit&) const {}
};
template <int NJ> struct GroupedOrder {
    static constexpr bool GATHER = false;
    const int* tile_e; int nunits, G, c;
    __device__ __forceinline__ void init(const int* te, int nt, int G_, int c_) { tile_e = te; nunits = nt * NJ; G = G_; c = c_; }
    __device__ __forceinline__ bool next(int i, pg8::Unit& u) const {
        const int L = i * G + c; if (L >= nunits) return false;
        const int rt = L / NJ, j = L % NJ;
        u.pm = rt; u.pn = __builtin_amdgcn_readfirstlane(tile_e[rt]) * NJ + j; return true;
    }
    __device__ __forceinline__ void a_ready(const pg8::Unit&) const {}
    __device__ __forceinline__ void done(const pg8::Unit&) const {}
};
struct QuadOrder {
    static constexpr bool GATHER = false;
    int pm, pn0, n;
    __device__ __forceinline__ bool next(int i, pg8::Unit& u) const { if (i >= n) return false; u.pm = pm; u.pn = pn0 + i; return true; }
    __device__ __forceinline__ void a_ready(const pg8::Unit&) const {}
    __device__ __forceinline__ void done(const pg8::Unit&) const {}
};
constexpr int CW_READY = 24576;
struct EpiHid {
    static constexpr bool PERM = true, AFTER_DRAIN = false;
    bf16_t* HID; const int* toks; const float* RSTD; const float* SELW; int tl, cnt;
    __device__ __forceinline__ void operator()(const A4 (&acc)[2][2][4][2], const pg8::Unit& u, int wr, int wc, int fr, int fq) const {
        const int f0 = (u.pn & 1) * 128 + wc * 32 + 8 * fq;
        EPI_ROWS_BEGIN
            const int p = tl * 256 + (row - u.pm * 256);
            const int slot = p < cnt ? toks[p] : 0;
            const float rs = RSTD[slot >> 1], w = SELW[slot];
            A4 h0, h1;
#pragma unroll
            for (int i = 0; i < 4; ++i) { h0[i] = fsilu(acc[ai][0][m][0][i] * rs) * (acc[ai][1][m][0][i] * rs) * w; h1[i] = fsilu(acc[ai][0][m][1][i] * rs) * (acc[ai][1][m][1][i] * rs) * w; }
            st16_wt(HID + (size_t)row * EF + f0, pack8(h0, h1));
        EPI_ROWS_END
    }
};
struct EpiY {
    static constexpr bool PERM = true, AFTER_DRAIN = false;
    bf16_t* Y;
    __device__ __forceinline__ void operator()(const A4 (&acc)[2][2][4][2], const pg8::Unit& u, int wr, int wc, int fr, int fq) const {
        const int col0 = (u.pn & 3) * 256 + wc * 32 + 8 * fq;
        EPI_ROWS_BEGIN
#pragma unroll
            for (int bj = 0; bj < 2; ++bj) ST16_OUT(Y + (size_t)row * D + col0 + bj * 128, pack8(acc[ai][bj][m][0], acc[ai][bj][m][1]));
        EPI_ROWS_END
    }
};

__device__ __forceinline__ void ph_combine(unsigned char* ws, int l, int vcu, int G, bf16_t* XN, float* OUT, const float* __restrict__ fg, int wv, bf16_t* XBo) {
    const int tid = tid_of(wv), lane = tid & 63, wave = wv; (void)tid;
    const bf16_t* XB = (const bf16_t*)(ws + WS_XB); const bf16_t* Y = (const bf16_t*)(ws + WS_XG);
    const int* SELE = (const int*)(ws + WS_SEL + SEL_SELE); const int* LPOS = (const int*)(ws + WS_SEL + SEL_LPOS); float* ssn = (float*)(ws + WS_SSP) + (size_t)(3 * l + 3) * T * 16;
    int cnt_, tile0_, ntile_; (void)moe_prefix((const unsigned*)(ws + WS_CTL) + CW_CNT + 32 * l, lane, cnt_, tile0_, ntile_);
    for (int t = vcu * 8 + wave; t < T; t += G * 8) {
        const int p0 = shfl_idx(tile0_, SELE[2 * t]) * 256 + LPOS[2 * t], p1 = shfl_idx(tile0_, SELE[2 * t + 1]) * 256 + LPOS[2 * t + 1];
        const u32x4* xr = (const u32x4*)(XB + (size_t)t * D) + lane; u32x4* xo = (u32x4*)(XBo + (size_t)t * D) + lane; const u32x4* y0 = (const u32x4*)(Y + (size_t)p0 * D) + lane; const u32x4* y1 = (const u32x4*)(Y + (size_t)p1 * D) + lane;
        A4 v[4]; float q = 0.f;
#pragma unroll
        for (int j = 0; j < 2; ++j) { A4 a0, a1, b0, b1, c0, c1; unpack8(xr[64 * j], a0, a1); unpack8(y0[64 * j], b0, b1); unpack8(y1[64 * j], c0, c1);
            a0 += b0 + c0; a1 += b1 + c1; v[2 * j] = a0; v[2 * j + 1] = a1;
            q += (a0[0] * a0[0] + a0[1] * a0[1]) + (a0[2] * a0[2] + a0[3] * a0[3]) + (a1[0] * a1[0] + a1[1] * a1[1]) + (a1[2] * a1[2] + a1[3] * a1[3]);
            ST16_OUT(xo + 64 * j, pack8(a0, a1)); }
        q = wave_sum(q);
        if (lane < 16) ssn[(size_t)t * 16 + lane] = lane == 0 ? q : 0.f;
        const float rs = rsqrtf(q * (1.0f / D) + EPS);
        if (XN) { u32x4* xn = (u32x4*)(XN + (size_t)t * D) + lane;
#pragma unroll
            for (int j = 0; j < 2; ++j) ST16_OUT(xn + 64 * j, pack8(v[2 * j] * rs, v[2 * j + 1] * rs)); }
        if (OUT) {
#pragma unroll
            for (int j = 0; j < 2; ++j) { const int c0 = 8 * lane + 512 * j; const A4 g0 = *(const A4*)(fg + c0), g1 = *(const A4*)(fg + c0 + 4);
                float* o = OUT + (size_t)t * D + c0; *(A4*)o = v[2 * j] * rs * g0; *(A4*)(o + 4) = v[2 * j + 1] * rs * g1; }
        }
    }
}
struct FixedOrder {
    static constexpr bool GATHER = false;
    int pm, pn;
    __device__ __forceinline__ bool next(int i, pg8::Unit& u) const { if (i != 0) return false; u.pm = pm; u.pn = pn; return true; }
    __device__ __forceinline__ void a_ready(const pg8::Unit&) const {}
    __device__ __forceinline__ void done(const pg8::Unit&) const {}
};
struct PairOrder {
    static constexpr bool GATHER = false;
    int pm, pn0, pn1;
    __device__ __forceinline__ bool next(int i, pg8::Unit& u) const { if (i > 1) return false; u.pm = pm; u.pn = i ? pn1 : pn0; return true; }
    __device__ __forceinline__ void a_ready(const pg8::Unit&) const {}
    __device__ __forceinline__ void done(const pg8::Unit&) const {}
};
struct EpiSoftmax {
    static constexpr bool PERM = true, AFTER_DRAIN = true;
    bf16_t* P; int ld, pad;
    __device__ __forceinline__ void fused(A4 (&acc)[2][2][4][2], const pg8::Unit& u, int wr, int wc, int fr, int fq, PG8_LAS unsigned char* lds, int wid, int lane) const {
        typedef float f32x2v __attribute__((ext_vector_type(2)));
        PG8_LAS f32x2v* X = (PG8_LAS f32x2v*)lds;
        float mw[2][4];
#pragma unroll
        for (int ai = 0; ai < 2; ++ai)
#pragma unroll
            for (int m = 0; m < 4; ++m) {
                float mx = -INFINITY;
#pragma unroll
                for (int bj = 0; bj < 2; ++bj)
#pragma unroll
                    for (int i = 0; i < 4; ++i) mx = fmaxf(mx, fmaxf(acc[ai][bj][m][0][i], acc[ai][bj][m][1][i]));
                mx = fmaxf(mx, swz_xor<16>(mx)); mx = max_xor32(mx);
                float s = 0.f;
#pragma unroll
                for (int bj = 0; bj < 2; ++bj)
#pragma unroll
                    for (int n = 0; n < 2; ++n)
#pragma unroll
                        for (int i = 0; i < 4; ++i) { const float e = __expf(acc[ai][bj][m][n][i] - mx); acc[ai][bj][m][n][i] = e; s += e; }
                s = add_xor32(add_xor16(s));
                mw[ai][m] = mx;
                if (fq == 0) X[(ai * 128 + wr * 64 + m * 16 + fr) * 4 + wc] = (f32x2v){mx, s};
            }
        asm volatile("s_waitcnt lgkmcnt(0)" ::: "memory"); __builtin_amdgcn_s_barrier(); asm volatile("" ::: "memory");
#pragma unroll
        for (int ai = 0; ai < 2; ++ai)
#pragma unroll
            for (int m = 0; m < 4; ++m) {
                const int r = ai * 128 + wr * 64 + m * 16 + fr;
                const f32x2v a = X[r * 4 + 0], b = X[r * 4 + 1], c = X[r * 4 + 2], d = X[r * 4 + 3];
                const float M = fmaxf(fmaxf(a.x, b.x), fmaxf(c.x, d.x));
                const float S = (a.y * __expf(a.x - M) + b.y * __expf(b.x - M)) + (c.y * __expf(c.x - M) + d.y * __expf(d.x - M));
                const float f = __expf(mw[ai][m] - M) * __builtin_amdgcn_rcpf(S);
#pragma unroll
                for (int bj = 0; bj < 2; ++bj) *(u32x4*)(P + (size_t)(u.pm * 256 + r) * ld + bj * 128 + wc * 32 + 8 * fq) = pack8(acc[ai][bj][m][0] * f, acc[ai][bj][m][1] * f);
            }
    }
};
typedef float f32x16 __attribute__((ext_vector_type(16)));
constexpr int RTAB = 640;
__device__ __forceinline__ bf16x8_t as_bf16x8(const u32x4 w) { return __builtin_bit_cast(bf16x8_t, w); }
constexpr float LOG2E = 1.4426950408889634f;
__device__ __forceinline__ void band_tables(const float* __restrict__ rel  , LAS float* Rt, int tid) {
    for (int i = tid; i < AH * RTAB; i += 512) { const int h = i / RTAB, k = i % RTAB; int r = 575 - k; r = r < -AMAXREL ? -AMAXREL : (r > AMAXREL ? AMAXREL : r); Rt[i] = rel[h * RELW + r + AMAXREL] * LOG2E; }
}
__device__ __forceinline__ void band_load_k(bf16x8_t (&Kf)[4], const bf16_t* __restrict__ AK, size_t key0, int h, int ql, int hh) {
#pragma unroll
    for (int s = 0; s < 4; ++s) Kf[s] = *(const bf16x8_t*)(AK + (key0 + ql) * AW + h * 64 + 16 * s + 8 * hh);
}
__device__ __forceinline__ void band_load_v(bf16x8_t (&Vf)[2][2], const bf16_t* vbase, size_t key0) {
#pragma unroll
    for (int db = 0; db < 2; ++db)
#pragma unroll
        for (int s = 0; s < 2; ++s) { const bf16_t* p = vbase + (size_t)(32 * db) * T + key0 + 16 * s;
            const u32x2 a = *(const u32x2*)p, c2 = *(const u32x2*)(p + 8); Vf[db][s] = as_bf16x8((u32x4){a.x, a.y, c2.x, c2.y}); }
}
__device__ __forceinline__ void band_item(int item, int lane, const bf16_t* __restrict__ AQ, const bf16_t* __restrict__ AK, const bf16_t* __restrict__ AVT, const LAS float* Rt, bf16_t* __restrict__ OAB) {
    const int n = item % NCH, h = (item / NCH) % AH, b = item / (NCH * AH);
    const int ql = lane & 31, hh = lane >> 5;
    const size_t tok0 = (size_t)b * L + (size_t)n * CH;
    bf16x8_t Qf[2][4];
#pragma unroll
    for (int qb = 0; qb < 2; ++qb)
#pragma unroll
        for (int s = 0; s < 4; ++s) Qf[qb][s] = *(const bf16x8_t*)(AQ + (tok0 + 32 * qb + ql) * AW + h * 64 + 16 * s + 8 * hh);
    f32x16 O[2][2];
#pragma unroll
    for (int db = 0; db < 2; ++db)
#pragma unroll
        for (int qb = 0; qb < 2; ++qb)
#pragma unroll
            for (int r = 0; r < 16; ++r) O[db][qb][r] = 0.f;
    float mrun[2] = {-INFINITY, -INFINITY}, lrun[2] = {0.f, 0.f};
    const LAS float* Rh = Rt + h * RTAB + (31 - ql + 4 * hh);
    const float bias_far = Rt[h * RTAB];
    const bf16_t* vbase = AVT + (size_t)(h * 64 + ql) * T + 4 * hh;
    const int j_lo = (n < ALC ? 2 * (ALC - n) : 0), j_hi = 2 * ALC + 1;
    const size_t keyb = (size_t)b * L + (size_t)(n - ALC) * CH;
    bf16x8_t Kf[4], Vf[2][2];
    f32x16 S[2];
    band_load_k(Kf, AK, keyb + (size_t)j_lo * 32, h, ql, hh);
    band_load_v(Vf, vbase, keyb + (size_t)j_lo * 32);
#define BAND_SCORES(jj) do { const LAS float* Rc_ = Rh + (jj) * 32; \
        _Pragma("unroll") for (int qb = 0; qb < 2; ++qb) { \
            if ((jj) < 8) { _Pragma("unroll") for (int r = 0; r < 16; ++r) S[qb][r] = bias_far; } \
            else { _Pragma("unroll") for (int r = 0; r < 16; ++r) S[qb][r] = Rc_[32 - 32 * qb + (r & 3) + 8 * (r >> 2)]; } \
            _Pragma("unroll") for (int s = 0; s < 4; ++s) S[qb] = __builtin_amdgcn_mfma_f32_32x32x16_bf16(Kf[s], Qf[qb][s], S[qb], 0, 0, 0); } } while (0)
    BAND_SCORES(j_lo);
    band_load_k(Kf, AK, keyb + (size_t)(j_lo < j_hi ? j_lo + 1 : j_lo) * 32, h, ql, hh);
#pragma nounroll
    for (int j = j_lo; j <= j_hi; ++j) {
#pragma unroll
        for (int qb = 0; qb < 2; ++qb) {
            float mx = S[qb][0];
#pragma unroll
            for (int r = 1; r < 16; ++r) mx = fmaxf(mx, S[qb][r]);
            mx = max_xor32(mx);
            const float mn = fmaxf(mrun[qb], mx), alpha = __builtin_amdgcn_exp2f(mrun[qb] - mn);
            mrun[qb] = mn;
            float sum = 0.f;
#pragma unroll
            for (int r = 0; r < 16; ++r) { const float p = __builtin_amdgcn_exp2f(S[qb][r] - mn); S[qb][r] = p; sum += p; }
            lrun[qb] = lrun[qb] * alpha + add_xor32(sum);
#pragma unroll
            for (int db = 0; db < 2; ++db)
#pragma unroll
                for (int r = 0; r < 16; ++r) O[db][qb][r] *= alpha;
#pragma unroll
            for (int s = 0; s < 2; ++s) {
                u32x4 w; w.x = pkbf(S[qb][8 * s + 0], S[qb][8 * s + 1]); w.y = pkbf(S[qb][8 * s + 2], S[qb][8 * s + 3]); w.z = pkbf(S[qb][8 * s + 4], S[qb][8 * s + 5]); w.w = pkbf(S[qb][8 * s + 6], S[qb][8 * s + 7]);
                const bf16x8_t Pf = as_bf16x8(w);
#pragma unroll
                for (int db = 0; db < 2; ++db) O[db][qb] = __builtin_amdgcn_mfma_f32_32x32x16_bf16(Vf[db][s], Pf, O[db][qb], 0, 0, 0);
            }
        }
        if (j < j_hi) {
            band_load_v(Vf, vbase, keyb + (size_t)(j + 1) * 32);
            BAND_SCORES(j + 1);
            band_load_k(Kf, AK, keyb + (size_t)(j + 2 <= j_hi ? j + 2 : j_hi) * 32, h, ql, hh);
        }
    }
#undef BAND_SCORES
#pragma unroll
    for (int qb = 0; qb < 2; ++qb) {
        const float inv = 1.0f / lrun[qb];
        bf16_t* orow = OAB + (tok0 + 32 * qb + ql) * D + h * 64 + 4 * hh;
#pragma unroll
        for (int db = 0; db < 2; ++db)
#pragma unroll
            for (int g = 0; g < 4; ++g) { u32x2 o; o.x = pkbf(O[db][qb][4 * g] * inv, O[db][qb][4 * g + 1] * inv); o.y = pkbf(O[db][qb][4 * g + 2] * inv, O[db][qb][4 * g + 3] * inv);
                *(u32x2*)(orow + 32 * db + 8 * g) = o; }
    }
}
constexpr size_t DS_ITEM = 128 * 64;
__device__ __forceinline__ int rowmap32(int r, int hh) { return (r & 3) + 8 * (r >> 2) + 4 * hh; }

__device__ __forceinline__ float gla_scan_tile(const float* __restrict__ LOGA, size_t tok0, int h, int lane, LAS float* Gt) {
    const float* p = LOGA + tok0 * BKW + h * 64 + lane;
    float cum = 0.f;
#pragma unroll
    for (int t0 = 0; t0 < 64; t0 += 16) {
        float la[16];
#pragma unroll
        for (int i = 0; i < 16; ++i) la[i] = p[(size_t)(t0 + i) * BKW];
#pragma unroll
        for (int i = 0; i < 16; ++i) { cum += la[i]; Gt[(t0 + i) * 64 + lane] = cum; }
    }
    asm volatile("s_waitcnt lgkmcnt(0)" ::: "memory");
    return cum;
}

__device__ __forceinline__ void gla1_item(int idx, int lane, LAS float* Gt, const bf16_t* __restrict__ BK, const bf16_t* __restrict__ BVT, const float* __restrict__ LOGA, float* __restrict__ DS, float* __restrict__ DEC) {
    const int c = idx & 127, h = (idx >> 7) & 3, b = idx >> 9;
    const size_t tok0 = (size_t)b * L + (size_t)c * CH;
    const int ql = lane & 31, hh = lane >> 5;
    LAS bf16_t* Kt = (LAS bf16_t*)(Gt + 64 * 64);
    {
        u32x4 kr[8];
#pragma unroll
        for (int i = 0; i < 8; ++i) kr[i] = *(const u32x4*)(BK + (tok0 + 8 * i + (lane >> 3)) * BKW + h * 64 + (lane & 7) * 8);
#pragma unroll
        for (int i = 0; i < 8; ++i) *(LAS u32x4*)(Kt + (8 * i + (lane >> 3)) * 64 + (lane & 7) * 8) = kr[i];
    }
    const float last = gla_scan_tile(LOGA, tok0, h, lane, Gt);
    DEC[(size_t)idx * 64 + lane] = __expf(last);
    bf16x8_t Xf[2][2][2];
#pragma unroll
    for (int kb = 0; kb < 2; ++kb) {
        const float lk = __int_as_float(shfl_idx(__float_as_int(last), 32 * kb + ql));
#pragma unroll
        for (int tb = 0; tb < 2; ++tb) {
            float x[16];
#pragma unroll
            for (int r = 0; r < 16; ++r) { const int t = 32 * tb + rowmap32(r, hh);
                x[r] = bf2f(Kt[t * 64 + 32 * kb + ql]) * __expf(lk - Gt[t * 64 + 32 * kb + ql]); }
#pragma unroll
            for (int s = 0; s < 2; ++s) { u32x4 w; w.x = pkbf(x[8 * s], x[8 * s + 1]); w.y = pkbf(x[8 * s + 2], x[8 * s + 3]); w.z = pkbf(x[8 * s + 4], x[8 * s + 5]); w.w = pkbf(x[8 * s + 6], x[8 * s + 7]); Xf[tb][kb][s] = as_bf16x8(w); }
        }
    }
    const bf16_t* vbase = BVT + (size_t)(h * 128 + ql) * T + tok0 + 4 * hh;
    float* dsb = DS + (size_t)idx * DS_ITEM;
#pragma unroll
    for (int vb = 0; vb < 4; ++vb) {
        bf16x8_t Vf[2][2];
#pragma unroll
        for (int tb = 0; tb < 2; ++tb)
#pragma unroll
            for (int s = 0; s < 2; ++s) { const bf16_t* p = vbase + (size_t)(32 * vb) * T + 32 * tb + 16 * s; const u32x2 a = *(const u32x2*)p, c2 = *(const u32x2*)(p + 8); Vf[tb][s] = as_bf16x8((u32x4){a.x, a.y, c2.x, c2.y}); }
#pragma unroll
        for (int kb = 0; kb < 2; ++kb) {
            f32x16 acc;
#pragma unroll
            for (int r = 0; r < 16; ++r) acc[r] = 0.f;
#pragma unroll
            for (int tb = 0; tb < 2; ++tb)
#pragma unroll
                for (int s = 0; s < 2; ++s) acc = __builtin_amdgcn_mfma_f32_32x32x16_bf16(Vf[tb][s], Xf[tb][kb][s], acc, 0, 0, 0);
#pragma unroll
            for (int r = 0; r < 16; ++r) dsb[(size_t)(32 * vb + rowmap32(r, hh)) * 64 + 32 * kb + ql] = acc[r];
        }
    }
}

__device__ __forceinline__ void gla2_scan(int e, const float* __restrict__ DS, const float* __restrict__ DEC, bf16_t* __restrict__ SB) {
    const int k = e & 63, v = (e >> 6) & 127, bh = e >> 13;
    const size_t base = (size_t)bh * 128;
    float S = 0.f;
#pragma unroll 1
    for (int c0 = 0; c0 < 128; c0 += 8) {
        float d[8], a[8];
#pragma unroll
        for (int i = 0; i < 8; ++i) { d[i] = DS[(base + c0 + i) * DS_ITEM + (size_t)v * 64 + k]; a[i] = DEC[(base + c0 + i) * 64 + k]; }
#pragma unroll
        for (int i = 0; i < 8; ++i) { SB[(base + c0 + i) * DS_ITEM + (size_t)v * 64 + k] = f2bf(S); S = a[i] * S + d[i]; }
    }
}

__device__ __forceinline__ void gla3_unit(int unit, int lane, LAS float* Gt, const bf16_t* __restrict__ BQ, const bf16_t* __restrict__ BK, const bf16_t* __restrict__ BVT, const float* __restrict__ LOGA,
                                          const bf16_t* __restrict__ SB, const bf16_t* __restrict__ BRS, const float* __restrict__ gnorm, bf16_t* __restrict__ OAB) {
    const int tb = unit & 1, idx = unit >> 1;
    const int c = idx & 127, h = (idx >> 7) & 3, b = idx >> 9;
    const size_t tok0 = (size_t)b * L + (size_t)c * CH;
    const int ql = lane & 31, hh = lane >> 5;
    (void)gla_scan_tile(LOGA, tok0, h, lane, Gt);
    bf16x8_t Qf[4];
    {
        const int t = 32 * tb + ql;
#pragma unroll
        for (int s = 0; s < 4; ++s) {
            const u32x4 q = *(const u32x4*)(BQ + (tok0 + t) * BKW + h * 64 + 16 * s + 8 * hh);
            const f32x4 g0 = *(const LAS f32x4*)(Gt + t * 64 + 16 * s + 8 * hh), g1 = *(const LAS f32x4*)(Gt + t * 64 + 16 * s + 8 * hh + 4);
            u32x4 w; w.x = pkbf(bflo(q.x) * __expf(g0[0]), bfhi(q.x) * __expf(g0[1])); w.y = pkbf(bflo(q.y) * __expf(g0[2]), bfhi(q.y) * __expf(g0[3]));
            w.z = pkbf(bflo(q.z) * __expf(g1[0]), bfhi(q.z) * __expf(g1[1])); w.w = pkbf(bflo(q.w) * __expf(g1[2]), bfhi(q.w) * __expf(g1[3]));
            Qf[s] = as_bf16x8(w);
        }
    }
    bf16x8_t Pf[2][2];
#pragma unroll
    for (int sb = 0; sb < 2; ++sb) {
        if (sb <= tb) {
            const int srow = 32 * sb + ql;
            f32x16 A;
#pragma unroll
            for (int r = 0; r < 16; ++r) A[r] = 0.f;
#pragma unroll
            for (int s = 0; s < 4; ++s) {
                const u32x4 kx = *(const u32x4*)(BK + (tok0 + srow) * BKW + h * 64 + 16 * s + 8 * hh);
                const f32x4 g0 = *(const LAS f32x4*)(Gt + srow * 64 + 16 * s + 8 * hh), g1 = *(const LAS f32x4*)(Gt + srow * 64 + 16 * s + 8 * hh + 4);
                u32x4 w; w.x = pkbf(bflo(kx.x) * __expf(-g0[0]), bfhi(kx.x) * __expf(-g0[1])); w.y = pkbf(bflo(kx.y) * __expf(-g0[2]), bfhi(kx.y) * __expf(-g0[3]));
                w.z = pkbf(bflo(kx.z) * __expf(-g1[0]), bfhi(kx.z) * __expf(-g1[1])); w.w = pkbf(bflo(kx.w) * __expf(-g1[2]), bfhi(kx.w) * __expf(-g1[3]));
                A = __builtin_amdgcn_mfma_f32_32x32x16_bf16(as_bf16x8(w), Qf[s], A, 0, 0, 0);
            }
            if (sb == tb) {
#pragma unroll
                for (int r = 0; r < 16; ++r) A[r] = (rowmap32(r, hh) <= ql) ? A[r] : 0.f;
            }
#pragma unroll
            for (int s2 = 0; s2 < 2; ++s2) { u32x4 w; w.x = pkbf(A[8 * s2], A[8 * s2 + 1]); w.y = pkbf(A[8 * s2 + 2], A[8 * s2 + 3]); w.z = pkbf(A[8 * s2 + 4], A[8 * s2 + 5]); w.w = pkbf(A[8 * s2 + 6], A[8 * s2 + 7]); Pf[sb][s2] = as_bf16x8(w); }
        }
    }
    f32x16 O[4];
    const bf16_t* vbase = BVT + (size_t)(h * 128 + ql) * T + tok0 + 4 * hh;
    const bf16_t* sbase = SB + (size_t)idx * DS_ITEM + (size_t)ql * 64 + 8 * hh;
#pragma unroll
    for (int vb = 0; vb < 4; ++vb) {
#pragma unroll
        for (int r = 0; r < 16; ++r) O[vb][r] = 0.f;
#pragma unroll
        for (int s = 0; s < 4; ++s) { const bf16x8_t Sf = *(const bf16x8_t*)(sbase + (size_t)(32 * vb) * 64 + 16 * s); O[vb] = __builtin_amdgcn_mfma_f32_32x32x16_bf16(Sf, Qf[s], O[vb], 0, 0, 0); }
#pragma unroll
        for (int sb = 0; sb < 2; ++sb) {
            if (sb <= tb) {
#pragma unroll
                for (int s2 = 0; s2 < 2; ++s2) { const bf16_t* p = vbase + (size_t)(32 * vb) * T + 32 * sb + 16 * s2; const u32x2 a = *(const u32x2*)p, c2 = *(const u32x2*)(p + 8);
                    O[vb] = __builtin_amdgcn_mfma_f32_32x32x16_bf16(as_bf16x8((u32x4){a.x, a.y, c2.x, c2.y}), Pf[sb][s2], O[vb], 0, 0, 0); }
            }
        }
    }
    float q = 0.f;
#pragma unroll
    for (int vb = 0; vb < 4; ++vb)
#pragma unroll
        for (int r = 0; r < 16; ++r) q += O[vb][r] * O[vb][r];
    const float rs = rsqrtf(add_xor32(q) * (1.0f / 128.0f) + EPS);
    const size_t trow = tok0 + 32 * tb + ql;
    const bf16_t* br = BRS + trow * BVW + h * 128 + 4 * hh; bf16_t* orow = OAB + trow * D + 512 + h * 128 + 4 * hh; const float* gn = gnorm + 4 * hh;
#pragma unroll
    for (int vb = 0; vb < 4; ++vb)
#pragma unroll
        for (int g = 0; g < 4; ++g) {
            const int vo = 32 * vb + 8 * g;
            const u32x2 bw = *(const u32x2*)(br + vo); const f32x4 gv = *(const f32x4*)(gn + vo);
            u32x2 o; o.x = pkbf(O[vb][4 * g] * rs * gv[0] * bflo(bw.x), O[vb][4 * g + 1] * rs * gv[1] * bfhi(bw.x)); o.y = pkbf(O[vb][4 * g + 2] * rs * gv[2] * bflo(bw.y), O[vb][4 * g + 3] * rs * gv[3] * bfhi(bw.y));
            __hip_atomic_store((unsigned long long*)(orow + vo), ((unsigned long long)o.y << 32) | o.x, __ATOMIC_RELAXED, __HIP_MEMORY_SCOPE_AGENT);
        }
}
#ifndef MK_REP_PHASE
#define MK_REP_PHASE (-1)
#define MK_REP_N 1
#endif
#ifndef MK_PANEL_TEST
#define MK_PANEL_TEST 0
#endif
#ifndef MK_LAUNCHES
#define MK_LAUNCHES 1
#endif
constexpr int RING_BYTES = 131072, MISC_OFF = RING_BYTES + 512, LDS_BYTES = 147456;
constexpr int CW_BAR = 1024;
constexpr size_t CTL_ZERO_BYTES = 128 * 1024;
constexpr int CW_PANEL = 8192;
static_assert((CW_BAR + XCD_BAR_WORDS) * 4 <= (int)CTL_ZERO_BYTES, "barrier words inside the memset region");
constexpr int N_PHASES = 1 + 6 * DEPTH;

struct MKArgs { InPtrs in; unsigned char* ws; unsigned char* dout; int ph_lo, ph_hi, rep_phase, rep_n; };

__global__ void __launch_bounds__(512, 2) mk_fwd(MKArgs a) {
    extern __shared__ __attribute__((aligned(16))) unsigned char lds_raw[];
    LAS unsigned char* lds = (LAS unsigned char*)lds_raw;
    const int G0 = (int)gridDim.x, vcu0 = (int)blockIdx.x;
    const int wv0 = __builtin_amdgcn_readfirstlane((int)threadIdx.x >> 6);
    volatile LAS unsigned* MISC = (volatile LAS unsigned*)(lds + MISC_OFF);
    if (threadIdx.x < 16) MISC[threadIdx.x] = 0u;
    __syncthreads();
    const bool one_launch = (a.ph_hi - a.ph_lo) > 1;
    XcdBarrier bar; bar.bar = (unsigned*)(a.ws + WS_CTL) + CW_BAR; bar.x = 0; bar.st = MISC + 8;
    if (one_launch) bar = xcd_barrier_post((unsigned*)(a.ws + WS_CTL) + CW_BAR, MISC + 8);

    const InPtrs& in = a.in;
#define SS ((float*)(ws + WS_SSP))
#define XB ((bf16_t*)(ws + WS_XB))
#define AQ ((bf16_t*)(ws + WS_AQ))
#define AK ((bf16_t*)(ws + WS_AK))
#define AVT ((bf16_t*)(ws + WS_AVT))
#define XN ((bf16_t*)(ws + WS_XN))
#define BQ ((bf16_t*)(ws + WS_BQ))
#define BK ((bf16_t*)(ws + WS_BK))
#define BVT ((bf16_t*)(ws + WS_BVT))
#define BRS ((bf16_t*)(ws + WS_BRS))
#define GA ((bf16_t*)(ws + WS_GA))
#define GB ((bf16_t*)(dout + DO_GB))
#define MG ((bf16_t*)(ws + WS_MG))
#define Q ((bf16_t*)(dout + DO_OAB))
#define MEMN ((bf16_t*)(ws + WS_MEMN))
#define KVB ((bf16_t*)(ws + WS_KVB))
#define LOGA ((float*)(ws + WS_LOGA))
#define OAB ((bf16_t*)(dout + DO_OAB))
#define DSF ((float*)(dout + DO_ST))
#define DEC ((float*)(ws + WS_DEC))
#define SBB ((bf16_t*)(ws + WS_SB))
#define TMP ((bf16_t*)(ws + WS_TMP))
#define SELE ((int*)(ws + WS_SEL))
#define SELW ((float*)(ws + WS_SEL + (size_t)T * 2 * 4))
#define WD(l) (ws + WS_WDENSE + (size_t)(l) * WDENSE_STRIDE)
#define SSA(i) (SS + (size_t)(i) * T * 16)
#define MK_EP(l, t0) EpiProj{AQ, AK, BQ, BK, BRS, GA, GB, LOGA, in.gla_b_alpha + (size_t)(l) * BKW, (t0), 0}
    int ph = 0;
#define PH_ON (ph >= a.ph_lo && ph < a.ph_hi)
#define PH_RUN for (int rep_ = (PH_ON ? (ph == a.rep_phase ? a.rep_n : 1) : 0); rep_ > 0; --rep_)
#define PH_PTRS const int G = opaque_int(G0), vcu = opaque_int(vcu0), wv = opaque_int(wv0); (void)G; (void)vcu; unsigned char* ws = opaque_ptr(a.ws); unsigned char* dout = opaque_ptr(a.dout); (void)ws; (void)dout; const int tid = tid_of(wv), lane = tid & 63, wave = wv; (void)lane; (void)wave;
#define PH_END do { if (PH_ON && ph + 1 < a.ph_hi) xcd_barrier(bar, tid_of(opaque_int(wv0)) == 0); ++ph; } while (0)
#define GEMM_AT(EpiT, gm, ep, cc) do { pg8::StaticOrder S_; S_.init((gm).M, (gm).N, G, (cc)); pg8::gemm_phase<EpiT, pg8::StaticOrder, true, true>(lds, gm, S_, ep, wv); } while (0)
#define GEMM(EpiT, gm, ep) do { pg8::StaticOrder S_; S_.init((gm).M, (gm).N, G, vcu); pg8::gemm_phase<EpiT, pg8::StaticOrder, true, true>(lds, gm, S_, ep, wv); } while (0)

    PH_RUN { PH_PTRS ph_prologue(in, ws, lds, vcu, G, wv);
        LAS float* scr = (LAS float*)(lds + wave * 16384);
        if (G != 256) conv_expert_items(in, ws, 0, DEPTH * NE * 384, vcu * 8 + wave, G * 8, scr, lane);
        conv_router(in, ws, vcu, G, tid); }
    PH_END;

#pragma nounroll
    for (int l = 0; l < DEPTH; ++l) {
        PH_RUN { PH_PTRS
            {
                const bf16_t* Wkv = (const bf16_t*)(WD(l) + WD_WXKV);
                { const pg8::Gemm g{MEMN, Wkv, NB * NMEM, D, D, D, D, 0}; const EpiScale e{KVB + (size_t)l * 2 * NB * NMEM * D, nullptr, D, 1.0f, 1, 0}; GEMM_AT(EpiScale, g, e, (vcu + G - (G > 128 ? 64 : 0)) % G); }
                { const pg8::Gemm g{Wkv + (size_t)D * D, MEMN, D, NB * NMEM, D, D, D, 0}; const EpiScale e{KVB + (size_t)l * 2 * NB * NMEM * D + (size_t)NB * NMEM * D, nullptr, NB * NMEM, 1.0f, 1, 0}; GEMM_AT(EpiScale, g, e, (vcu + G - (G > 128 ? 72 : 0)) % G); }
            }
            { const pg8::Gemm g{XN, (const bf16_t*)(WD(l) + WD_WIN), T, NPROJ_A, D, D, D, 0}; const EpiProj e = MK_EP(l, 0); GEMM(EpiProj, g, e); }
            { const pg8::Gemm g{(const bf16_t*)(WD(l) + WD_WIN) + (size_t)NPROJ_A * D, XN, NPROJ_V, T, D, D, D, 0}; const EpiScale e{AVT, nullptr, T, 1.0f, 1, 0}; GEMM(EpiScale, g, e); }
            if (l == 0 && G == 256 && vcu >= 80) {
                LAS float* scr = (LAS float*)(lds + wave * 16384);
                conv_dense_layer(in, ws, 1, (vcu - 80) * 8 + wave, 176 * 8, (vcu - 80) * 512 + tid, 176 * 512, scr, lane);
                __syncthreads();
            }
        }
        PH_END;
        PH_RUN { PH_PTRS
            LAS float* Rt = (LAS float*)lds;
            band_tables(in.rel_bias + (size_t)l * AH * RELW, Rt, tid);
            __syncthreads();
            const bool fill = (G == 256);
            if (wave < 4) {
                LAS float* Gt = (LAS float*)(lds + 32768 + wave * 24576);
#pragma nounroll
                for (int it = vcu * 4 + wave; it < NB * BH * NCH; it += G * 4) gla1_item(it, lane, Gt, BK, BVT, LOGA, DSF, DEC);
                if (fill) conv_expert_items(in, ws, l * NE * 384, (l + 1) * NE * 384, vcu * 4 + wave, G * 4, Gt, lane);
            }
            if (fill) {
                if (wave >= 4) { band_item(vcu * 8 + (wave - 4) * 2, lane, AQ, AK, AVT, Rt, OAB); band_item(vcu * 8 + (wave - 4) * 2 + 1, lane, AQ, AK, AVT, Rt, OAB); }
            } else {
#pragma nounroll
                for (int it = vcu * 8 + wave; it < NB * AH * NCH; it += G * 8) band_item(it, lane, AQ, AK, AVT, Rt, OAB);
            }
        }
        PH_END;
        PH_RUN { PH_PTRS
            for (int e2 = vcu * 512 + tid; e2 < NB * BH * 128 * 64; e2 += G * 512) gla2_scan(e2, DSF, DEC, SBB);
        }
        PH_END;
        PH_RUN { PH_PTRS
            pg8::StaticOrder S0; S0.init(T, D, G, vcu); pg8::Unit u;
            if (G == 256 && S0.next(0, u)) {
                unsigned* PC = (unsigned*)(ws + WS_CTL) + CW_PANEL + 16 * (l * 64 + u.pm);
#define P_ARRIVE(s) do { if (tid == 0) (void)xb_add(PC + 2048 * (s), 1u); } while (0)
#define P_WAIT(s) do { if (tid == 0) { unsigned sp_ = 0; while (xb_ld(PC + 2048 * (s)) < 4u) { __builtin_amdgcn_s_sleep(2); if (++sp_ > (1u << 20)) break; } \
                       __builtin_amdgcn_fence(__ATOMIC_ACQUIRE, "agent"); asm volatile("s_waitcnt vmcnt(0)" ::: "memory"); } __syncthreads(); } while (0)
                const int h = u.pn, b = u.pm >> 5;
                {
                    LAS float* Gt = (LAS float*)(lds + wave * 16384);
                    const int idx = (b * BH + h) * NCH + (u.pm & 31) * 4 + (wave >> 1);
                    gla3_unit(idx * 2 + (wave & 1), lane, Gt, BQ, BK, BVT, LOGA, SBB, BRS, in.gla_norm_g + (size_t)l * 128, OAB);
                    asm volatile("s_waitcnt vmcnt(0)" ::: "memory"); __syncthreads();
                    P_ARRIVE(0);
                }
                const bf16_t* Wg = (const bf16_t*)(WD(l) + WD_WIN) + (size_t)(NPROJ_A + NPROJ_V) * D;
                { const pg8::Gemm g{XN, Wg, T, NPROJ_B, D, D, D, 0}; const PairOrder F{u.pm, u.pn, 4 + u.pn}; const EpiProj e = MK_EP(l, 9); pg8::gemm_phase<EpiProj, PairOrder, true, true>(lds, g, F, e, wv); }
                P_ARRIVE(1);
                { const pg8::Gemm g{OAB, (const bf16_t*)(WD(l) + WD_WB), T, D, 512, D, D, 0}; const FixedOrder F{u.pm, u.pn}; const EpiGate e{GA, nullptr, GA}; pg8::gemm_phase<EpiGate, FixedOrder, true, true>(lds, g, F, e, wv); }
                if (tid == 0) { unsigned sp_ = 0; while (xb_ld(PC) < 4u || xb_ld(PC + 2048) < 4u) { __builtin_amdgcn_s_sleep(2); if (++sp_ > (1u << 20)) break; }
                    __builtin_amdgcn_fence(__ATOMIC_ACQUIRE, "agent"); asm volatile("s_waitcnt vmcnt(0)" ::: "memory"); }
                __syncthreads();
                { const pg8::Gemm g{OAB + 512, (const bf16_t*)(WD(l) + WD_WB) + 512, T, D, 512, D, D, 0}; const FixedOrder F{u.pm, u.pn}; const EpiGate e{GB, GA, MG}; pg8::gemm_phase<EpiGate, FixedOrder, true, true>(lds, g, F, e, wv); }
                P_ARRIVE(2);
                P_WAIT(2);
                { const pg8::Gemm g{MG, (const bf16_t*)(WD(l) + WD_WMO), T, D, D, D, D, 0}; const FixedOrder F{u.pm, u.pn}; const EpiResid e{XB, XB, SSA(3 * l + 1)}; pg8::gemm_phase<EpiResid, FixedOrder, true, true>(lds, g, F, e, wv); }
                P_ARRIVE(3);
                P_WAIT(3);
                {
                    const bf16_t* KBl = KVB + (size_t)l * 2 * NB * NMEM * D; const bf16_t* VTl = KBl + (size_t)NB * NMEM * D; bf16_t* Qh = Q + h * XD;
                    { const pg8::Gemm g{XB, (const bf16_t*)(WD(l) + WD_WXQ), T, D, D, D, D, 0}; const FixedOrder F{u.pm, u.pn}; const EpiScale e{Q, SSA(3 * l + 1), D, 0.0625f, 0, 0};
                      pg8::gemm_phase<EpiScale, FixedOrder, true, true>(lds, g, F, e, wv); }
                    { const pg8::Gemm g{Qh, KBl + (size_t)(b * NMEM) * D + h * XD, T, XD, XD, D, D, 0}; const FixedOrder F{u.pm, 0}; const EpiSoftmax e{Qh, D, 0};
                      pg8::gemm_phase<EpiSoftmax, FixedOrder, false, true>(lds, g, F, e, wv); }
                    asm volatile("s_waitcnt vmcnt(0)" ::: "memory"); __syncthreads();
                    { const pg8::Gemm g{Qh, VTl + (size_t)(h * XD) * (NB * NMEM) + b * NMEM, T, XD, XD, D, NB * NMEM, 0}; const FixedOrder F{u.pm, 0}; const EpiScale e{Qh, nullptr, D, 1.0f, 1, 0};
                      pg8::gemm_phase<EpiScale, FixedOrder, true, true>(lds, g, F, e, wv); }
                }
                P_ARRIVE(4);
                P_WAIT(4);
                { const pg8::Gemm g{Q, (const bf16_t*)(WD(l) + WD_WXO), T, D, D, D, D, 0}; const FixedOrder F{u.pm, u.pn}; const EpiResid e{XB, XB, SSA(3 * l + 2)}; pg8::gemm_phase<EpiResid, FixedOrder, true, true>(lds, g, F, e, wv); }
                P_ARRIVE(5);
                P_WAIT(5);
                ph_route(in, ws, lds, l, u.pm * 256 + u.pn * 64, wv, false);
#undef P_ARRIVE
#undef P_WAIT
            }
        }
        PH_END;
        PH_RUN { PH_PTRS
            LAS int* tb = (LAS int*)(lds + RING_BYTES + 1024);
            moe_tables(ws, l, tb, vcu, wave, lane);
            const int nt = tb[64], n1 = 2 * nt, r1 = n1 > G ? n1 - G : 0, ne = nt < G / 2 ? nt : G / 2, nl = nt - ne, tot1 = r1 + ne + 4 * nl;
            const int* TOKS = (const int*)(ws + WS_TOK);
            unsigned* READY = (unsigned*)(ws + WS_CTL) + CW_READY + 16 * (l * NTMAX);
            const bf16_t* WGU = (const bf16_t*)(ws + WS_WEXP + (size_t)l * WEXP_STRIDE); const bf16_t* WDT = (const bf16_t*)(ws + WS_WEXP + (size_t)l * WEXP_STRIDE + 32 * MiB);
#pragma nounroll
            for (int s = vcu - G; s < tot1; s += G) {
                const int Lu = s < 0 ? vcu : (s < r1 ? G + s : -1);
                if (s < 0 && vcu >= n1) continue;
                if (Lu >= 0) {
                    const int rt = Lu >> 1, ex = __builtin_amdgcn_readfirstlane(tb[96 + rt]), tl = rt - __builtin_amdgcn_readfirstlane(tb[32 + ex]), cn = __builtin_amdgcn_readfirstlane(tb[ex]);
                    const pg8::Gemm g{XB, WGU, nt * 256, 512, D, D, D, 0};
                    const GatherOrder F{rt, ex * 2 + (Lu & 1), TOKS + (size_t)ex * T, tl, cn};
                    const EpiHid e{(bf16_t*)(ws + WS_HID), TOKS + (size_t)ex * T, (const float*)(ws + WS_SEL + SEL_RS), (const float*)(ws + WS_SEL + SEL_SELW), tl, cn};
                    pg8::gemm_phase<EpiHid, GatherOrder, true, true>(lds, g, F, e, wv);
                    if (tid == 0) (void)xb_add(READY + 16 * rt, 1u);
                } else {
                    int rt, j0, nj;
                    if (s - r1 < ne) { rt = s - r1; j0 = 0; nj = 4; } else { const int q = s - r1 - ne; rt = ne + (q >> 2); j0 = q & 3; nj = 1; }
                    if (tid == 0) { unsigned sp = 0; while (xb_ld(READY + 16 * rt) < 2u) { __builtin_amdgcn_s_sleep(2); if (++sp > (1u << 20)) break; }
                        __builtin_amdgcn_fence(__ATOMIC_ACQUIRE, "agent"); asm volatile("s_waitcnt vmcnt(0)" ::: "memory"); }
                    __syncthreads();
                    const int ex = __builtin_amdgcn_readfirstlane(tb[96 + rt]);
                    const pg8::Gemm g{(const bf16_t*)(ws + WS_HID), WDT, nt * 256, D, EF, EF, EF, 0};
                    const QuadOrder F{rt, ex * 4 + j0, nj};
                    const EpiY e{(bf16_t*)(ws + WS_XG)};
                    pg8::gemm_phase<EpiY, QuadOrder, true, true>(lds, g, F, e, wv);
                }
            }
        }
        PH_END;
        PH_RUN { PH_PTRS ph_combine(ws, l, vcu, G, (l + 1 < DEPTH) ? XN : nullptr, (l + 1 < DEPTH) ? nullptr : (float*)dout, in.final_g, wv, rep_ > 1 ? (bf16_t*)dout : XB); }
        PH_END;
    }
#undef PH_ON
#undef PH_RUN
#undef PH_PTRS
#undef PH_END
#undef GEMM
#undef GEMM_AT
#undef SS
#undef XB
#undef AQ
#undef AK
#undef AVT
#undef XN
#undef BQ
#undef BK
#undef BVT
#undef BRS
#undef GA
#undef GB
#undef MG
#undef Q
#undef MEMN
#undef KVB
#undef LOGA
#undef OAB
#undef DSF
#undef DEC
#undef SBB
#undef TMP
#undef SELE
#undef SELW
#undef WD
#undef SSA
#undef MK_EP
}

extern "C" void kernel_launch(void* const* d_in, const int* in_sizes, int n_in, void* d_out, int out_size, void* d_ws, size_t ws_size, hipStream_t stream) {
    static int grid = 0;
    if (grid == 0) {
        int dev = 0, cus = 0;
        if (hipGetDevice(&dev) != hipSuccess || hipDeviceGetAttribute(&cus, hipDeviceAttributeMultiprocessorCount, dev) != hipSuccess || cus <= 0) cus = 256;
        grid = 256;
        if (cus != 256) fprintf(stderr, "kernel_launch: device reports %d CUs; this kernel is built for 256\n", cus);
        if (hipFuncSetAttribute((const void*)mk_fwd, hipFuncAttributeMaxDynamicSharedMemorySize, LDS_BYTES) != hipSuccess) fprintf(stderr, "kernel_launch: hipFuncSetAttribute failed\n");
        int per_cu = 0;
        if (hipOccupancyMaxActiveBlocksPerMultiprocessor(&per_cu, (const void*)mk_fwd, 512, LDS_BYTES) != hipSuccess || per_cu < 1) fprintf(stderr, "kernel_launch: occupancy query says %d blocks per CU\n", per_cu);
        (void)hipGetLastError();
        if (ws_size < WS_END || n_in != 24) fprintf(stderr, "kernel_launch: unexpected ws_size %zu / n_in %d\n", ws_size, n_in);
    }
    MKArgs a{};
    { const float** p = (const float**)&a.in; for (int i = 0; i < 24; ++i) p[i] = (const float*)d_in[i]; }
    a.ws = (unsigned char*)d_ws; a.dout = (unsigned char*)d_out;
    (void)hipMemsetAsync((unsigned char*)d_ws + WS_CTL, 0, CTL_ZERO_BYTES, stream);
#if MK_LAUNCHES == 1
    a.ph_lo = 0; a.ph_hi = N_PHASES; a.rep_phase = MK_REP_PHASE; a.rep_n = MK_REP_N;
    hipLaunchKernelGGL(mk_fwd, dim3(grid), dim3(512), LDS_BYTES, stream, a);
#else
    for (int p = 0; p < N_PHASES; ++p) { a.ph_lo = p; a.ph_hi = p + 1; a.rep_phase = -1; a.rep_n = 1; hipLaunchKernelGGL(mk_fwd, dim3(grid), dim3(512), LDS_BYTES, stream, a); }
#endif
}
```

```cpp
#include <hip/hip_runtime.h>
#include <cstdint>
#include <cstdio>
#include <cmath>

namespace cfg {
constexpr int D = 1024, NB = 2, L = 8192, T = NB * L, DEPTH = 2;
constexpr int CH = 64, NMEM = 256, NCH = L / CH;
constexpr int AH = 8, AW = 512, ALC = 8, ABAND = 576, AMAXREL = 256, RELW = 2 * AMAXREL + 1;
constexpr int BH = 4, BKW = 256, BVW = 512, BR = 16;
constexpr int INW = 5136;
constexpr int XH = 4, XD = 256;
constexpr int NG = 4, EPG = 8, NE = NG * EPG, EF = 256;
constexpr float EPS = 1e-6f;
constexpr int NPROJ_A = 9 * 256, NPROJ_V = 4 * 256, NPROJ_B = 8 * 256;

constexpr size_t MiB = 1u << 20;
constexpr size_t WS_CTL = 0, CTL_BYTES = 2 * MiB;
constexpr size_t WS_WDENSE = 2 * MiB, WDENSE_STRIDE = 23 * MiB;
constexpr size_t WD_WIN = 0, WD_WB = 11 * MiB, WD_WMO = 13 * MiB, WD_WXQ = 15 * MiB, WD_WXKV = 17 * MiB, WD_WXO = 21 * MiB;
constexpr size_t WS_WEXP = 48 * MiB, WEXP_STRIDE = 48 * MiB;
constexpr size_t WS_XB = 144 * MiB;
constexpr size_t WS_XN = 176 * MiB;
constexpr size_t WS_MIX = 208 * MiB;
constexpr size_t WS_AQ = WS_MIX, WS_AK = WS_MIX + 16 * MiB, WS_AVT = WS_MIX + 32 * MiB, WS_BVT = WS_MIX + 48 * MiB, WS_BQ = WS_MIX + 64 * MiB, WS_BK = WS_MIX + 72 * MiB,
                 WS_BRS = WS_MIX + 80 * MiB, WS_LOGA = WS_MIX + 96 * MiB;
constexpr size_t WS_SB = WS_AQ;
constexpr size_t WS_GA = WS_MIX + 16 * MiB, WS_TMP = WS_MIX + 48 * MiB, WS_MG = WS_XN;
constexpr size_t WS_XG = WS_MIX, WS_HID = WS_MIX + 80 * MiB;
constexpr size_t WS_MEMN = 320 * MiB, WS_KVB = 321 * MiB;
constexpr size_t WS_SEL = 325 * MiB;
constexpr size_t WS_SSP = 326 * MiB;
constexpr size_t WS_DEC = 333 * MiB + 512 * 1024;
constexpr size_t WS_WR = 333 * MiB;
constexpr size_t WS_TOK = 334 * MiB;
constexpr size_t WS_MT = 336 * MiB, WS_NT = 340 * MiB;
constexpr size_t WS_END = 344 * MiB;
constexpr size_t DO_OAB = 0, DO_ST = 32 * MiB, DO_GB = 32 * MiB;
}
using namespace cfg;

#define LAS __attribute__((address_space(3)))
typedef unsigned short bf16_t;
typedef float f32x4 __attribute__((ext_vector_type(4)));
typedef unsigned u32x4 __attribute__((ext_vector_type(4)));
typedef unsigned u32x2 __attribute__((ext_vector_type(2)));

__device__ __forceinline__ float bf2f(unsigned short b) { return __uint_as_float((unsigned)b << 16); }
__device__ __forceinline__ float bflo(unsigned w) { return __uint_as_float(w << 16); }
__device__ __forceinline__ float bfhi(unsigned w) { return __uint_as_float(w & 0xffff0000u); }
__device__ __forceinline__ unsigned pkbf(float lo, float hi) { unsigned r; asm volatile("v_cvt_pk_bf16_f32 %0, %1, %2" : "=v"(r) : "v"(lo), "v"(hi)); return r; }
__device__ __forceinline__ unsigned short f2bf(float f) { return (unsigned short)(pkbf(f, 0.f) & 0xffffu); }
__device__ __forceinline__ float fsigmoid(float x) { return __builtin_amdgcn_rcpf(1.0f + __expf(-x)); }
__device__ __forceinline__ float fsilu(float x) { return x * fsigmoid(x); }
__device__ __forceinline__ float flogsigmoid(float x) { return fminf(x, 0.f) - __logf(1.0f + __expf(-fabsf(x))); }
template <int MASK> __device__ __forceinline__ float swz_xor(float v) { return __int_as_float(__builtin_amdgcn_ds_swizzle(__float_as_int(v), (MASK << 10) | 0x1f)); }
__device__ __forceinline__ float add_xor32(float v) { const auto r = __builtin_amdgcn_permlane32_swap(__float_as_uint(v), __float_as_uint(v), false, false); return __uint_as_float(r[0]) + __uint_as_float(r[1]); }
__device__ __forceinline__ float max_xor32(float v) { const auto r = __builtin_amdgcn_permlane32_swap(__float_as_uint(v), __float_as_uint(v), false, false); return fmaxf(__uint_as_float(r[0]), __uint_as_float(r[1])); }
__device__ __forceinline__ float add_xor16(float v) { return v + swz_xor<16>(v); }
__device__ __forceinline__ float wave_sum(float v) { v += swz_xor<1>(v); v += swz_xor<2>(v); v += swz_xor<4>(v); v += swz_xor<8>(v); v += swz_xor<16>(v); return add_xor32(v); }
__device__ __forceinline__ float wave_max(float v) { v = fmaxf(v, swz_xor<1>(v)); v = fmaxf(v, swz_xor<2>(v)); v = fmaxf(v, swz_xor<4>(v)); v = fmaxf(v, swz_xor<8>(v)); v = fmaxf(v, swz_xor<16>(v)); return max_xor32(v); }
__device__ __forceinline__ int shfl_idx(int v, int src_lane) { return __builtin_amdgcn_ds_bpermute(src_lane << 2, v); }
typedef __attribute__((address_space(1))) unsigned char* gbl_u8_ptr;
__device__ __forceinline__ unsigned char* opaque_ptr(unsigned char* p) { gbl_u8_ptr g = (gbl_u8_ptr)p; asm volatile("" : "+s"(g)); return (unsigned char*)g; }
__device__ __forceinline__ int lane_now() { unsigned z; asm volatile("v_mov_b32 %0, 0" : "=v"(z)); return (int)__builtin_amdgcn_mbcnt_hi(~0u, __builtin_amdgcn_mbcnt_lo(~0u, z)); }
__device__ __forceinline__ int opaque_int(int v) { asm volatile("" : "+s"(v)); return v; }
__device__ __forceinline__ int tid_of(int wv) { return (wv << 6) | lane_now(); }
__device__ __forceinline__ void st16_wt(void* p, const u32x4 v) { asm volatile("global_store_dwordx4 %0, %1, off sc1\n\ts_nop 1" :: "v"(p), "v"(v) : "memory"); }
#ifndef MK_WT
#define MK_WT 1
#endif
#if MK_WT
#define ST16_OUT(p, v) st16_wt((void*)(p), (v))
#else
#define ST16_OUT(p, v) (*(u32x4*)(p) = (v))
#endif
namespace pg8 {
#define PG8_LAS __attribute__((address_space(3)))
typedef unsigned short bf16_t;
typedef short bf16x8 __attribute__((ext_vector_type(8)));
typedef float f32x4 __attribute__((ext_vector_type(4)));
typedef unsigned u32x4 __attribute__((ext_vector_type(4)));
constexpr int BM = 256, BK = 64, HALF = 128, HTB = HALF * BK * 2  , STAGE_BYTES = 8 * HTB, NXCD = 8, WGM = 8;

__host__ __device__ __forceinline__ int lds_byte(int r, int c) { const int st = (r >> 4) * 2 + (c >> 5), rr = r & 15, cc = c & 31, ob = rr * 64 + cc * 2; return st * 1024 + (ob ^ (((ob >> 9) & 1) << 5)); }
__host__ __device__ __forceinline__ void stage_rc(int b, int& R, int& C) { const int st = b / 1024, sb = b % 1024, swz = sb ^ (((sb >> 9) & 1) << 5); R = (st >> 1) * 16 + swz / 64; C = (st & 1) * 32 + (swz % 64) / 2; }
__host__ __device__ __forceinline__ int perm32(int rho) { const int n = rho >> 4, i = rho & 15; return 8 * (i >> 2) + 4 * n + (i & 3); }

struct Unit { int pm, pn; };
struct Gemm { const bf16_t* A; const bf16_t* Bt; int M, N, K, lda, ldb, pad; };

struct StaticOrder {
    static constexpr bool GATHER = false;
    int nM, nN, nwg, G, c;
    __host__ __device__ __forceinline__ void init(int M, int N, int G_, int c_) { nM = M / BM; nN = N / BM; nwg = nM * nN; G = G_; c = c_; }
    __host__ __device__ __forceinline__ bool next(int i, Unit& u) const {
        const long L = (long)i * G + c; if (L >= nwg) return false;
        int wgid = (int)L; { const int q = nwg / NXCD, r = nwg % NXCD, xcd = wgid % NXCD, off = wgid / NXCD; wgid = (xcd < r ? xcd * (q + 1) : r * (q + 1) + (xcd - r) * q) + off; }
        const int nig = WGM * nN, gid = wgid / nig, fm = gid * WGM, gsz = (nM - fm) < WGM ? (nM - fm) : WGM;
        u.pm = fm + ((wgid % nig) % gsz); u.pn = (wgid % nig) / gsz; return true;
    }
    __device__ __forceinline__ void a_ready(const Unit&) const {}
    __device__ __forceinline__ void done(const Unit&) const {}
};


template <class Epi, class Sched, bool ALIGN_EPI = false, bool SP2 = false>
__device__ __forceinline__ void gemm_phase(PG8_LAS unsigned char* lds, const Gemm g, const Sched& S, const Epi& E, const int wv  ) {
    const int tid = tid_of(wv), wid = wv, lane = tid & 63, wr = wid >> 2, wc = wid & 3, fr = lane & 15, fq = lane >> 4;
    const int K = g.K, nt = K / BK;
    unsigned voffA[2], voffA1[2], voffB[2];
#pragma unroll
    for (int i = 0; i < 2; ++i) { int R, C; stage_rc(tid * 16 + i * 8192, R, C); const int Rb = Epi::PERM ? ((R & ~31) + perm32(R & 31)) : R;
        voffA[i] = (unsigned)(R * g.lda + C) * 2u; voffA1[i] = voffA[i]; voffB[i] = (unsigned)(Rb * g.ldb + C) * 2u; }
    const size_t kstep = (size_t)(BK * 2);
    const size_t hstepA = Sched::GATHER ? 0 : (size_t)HALF * g.lda * 2, hstepB = (size_t)HALF * g.ldb * 2;
    const size_t tstepA = 2 * hstepA, tstepB = 2 * hstepB;
    const unsigned ldsw = (unsigned)wid * 1024u;
    const int aoff = lds_byte(wr * 64 + fr, fq * 8), boff = lds_byte(wc * 32 + fr, fq * 8);
#define PG8_SA(b, h) (((b) * 2 + (h)) * HTB)
#define PG8_SB(b, h) ((4 + (b) * 2 + (h)) * HTB)
#define PG8_STAGE(bufoff, gbase, voff) do { _Pragma("unroll") for (int _i = 0; _i < 2; ++_i) \
        __builtin_amdgcn_global_load_lds((const unsigned*)((const char*)(gbase) + (voff)[_i]), (PG8_LAS unsigned*)(lds + (bufoff) + ldsw + _i * 8192), 16, 0, 0); } while (0)
#define PG8_LDA(dst, b, h) do { _Pragma("unroll") for (int m = 0; m < 4; ++m) _Pragma("unroll") for (int k = 0; k < 2; ++k) dst[m][k] = *(const PG8_LAS bf16x8*)(lds + PG8_SA(b, h) + aoff + m * 2048 + k * 1024); } while (0)
#define PG8_LDB(dst, b, h) do { _Pragma("unroll") for (int n = 0; n < 2; ++n) _Pragma("unroll") for (int k = 0; k < 2; ++k) dst[n][k] = *(const PG8_LAS bf16x8*)(lds + PG8_SB(b, h) + boff + n * 2048 + k * 1024); } while (0)
#define PG8_MMA(ai, bj, At, Bt) do { __builtin_amdgcn_s_setprio(1); _Pragma("unroll") for (int m = 0; m < 4; ++m) _Pragma("unroll") for (int n = 0; n < 2; ++n) _Pragma("unroll") for (int k = 0; k < 2; ++k) \
        acc[ai][bj][m][n] = __builtin_amdgcn_mfma_f32_16x16x32_bf16(Bt[n][k], At[m][k], acc[ai][bj][m][n], 0, 0, 0); __builtin_amdgcn_s_setprio(0); } while (0)
#define PG8_WAIT_V(n) asm volatile("s_waitcnt vmcnt(" #n ")" ::: "memory")
#define PG8_WAIT_L(n) asm volatile("s_waitcnt lgkmcnt(" #n ")" ::: "memory")
#define PG8_BAR __builtin_amdgcn_s_barrier()
#define PG8_SCHED __builtin_amdgcn_sched_barrier(0)
    Unit cur, nxt; int ui = 0;
    if (!S.next(0, cur)) return;
    if constexpr (Sched::GATHER) {
#pragma unroll
        for (int i = 0; i < 2; ++i) { int R, C; stage_rc(tid * 16 + i * 8192, R, C);
            voffA[i] = (unsigned)(S.arow(R) * g.lda + C) * 2u; voffA1[i] = (unsigned)(S.arow(R + HALF) * g.lda + C) * 2u; }
    }
    f32x4 acc[2][2][4][2];
#pragma unroll
    for (int a = 0; a < 2; ++a)
#pragma unroll
        for (int b = 0; b < 2; ++b)
#pragma unroll
            for (int m = 0; m < 4; ++m)
#pragma unroll
                for (int n = 0; n < 2; ++n) acc[a][b][m][n] = (f32x4){0.f, 0.f, 0.f, 0.f};
    bf16x8 At[4][2], B0[2][2], B1[2][2];
    const char* cA = (const char*)g.A + (size_t)cur.pm * tstepA; const char* cB = (const char*)g.Bt + (size_t)cur.pn * tstepB;
    S.a_ready(cur);
    if constexpr (SP2) {
        PG8_STAGE(PG8_SB(0, 0), cB, voffB); PG8_STAGE(PG8_SB(0, 1), cB + hstepB, voffB); PG8_STAGE(PG8_SA(0, 0), cA, voffA); PG8_STAGE(PG8_SA(0, 1), cA + hstepA, voffA1);
        if (wr == 1) PG8_BAR;
        PG8_WAIT_V(2); PG8_BAR;
        PG8_STAGE(PG8_SB(1, 0), cB + kstep, voffB); PG8_STAGE(PG8_SA(1, 0), cA + kstep, voffA); PG8_STAGE(PG8_SB(1, 1), cB + hstepB + kstep, voffB);
        PG8_WAIT_V(6); PG8_BAR;
    } else {
        PG8_STAGE(PG8_SB(0, 0), cB, voffB); PG8_STAGE(PG8_SA(0, 0), cA, voffA); PG8_STAGE(PG8_SB(0, 1), cB + hstepB, voffB); PG8_STAGE(PG8_SA(0, 1), cA + hstepA, voffA1);
        if (wr == 1) PG8_BAR;
        PG8_WAIT_V(4); PG8_BAR;
        PG8_STAGE(PG8_SB(1, 0), cB + kstep, voffB); PG8_STAGE(PG8_SA(1, 0), cA + kstep, voffA); PG8_STAGE(PG8_SB(1, 1), cB + hstepB + kstep, voffB);
        PG8_WAIT_V(6); PG8_BAR;
    }
    for (;;) {
        const bool has_next = S.next(ui + 1, nxt);
        const char* nA = has_next ? (const char*)g.A + (size_t)nxt.pm * tstepA : cA; const char* nB = has_next ? (const char*)g.Bt + (size_t)nxt.pn * tstepB : cB;
        for (int t = 0; t < nt; t += 2) {
            if constexpr (Epi::MIDK) { if (t == nt / 2) { const int lm_ = lane_now(); E.mid(acc, cur, wr, wc, lm_ & 15, lm_ >> 4); } }
            const bool last = (t == nt - 2);
            const char* a1 = cA + (size_t)(t + 1) * kstep;
            const char* a2 = last ? nA : cA + (size_t)(t + 2) * kstep; const char* b2 = last ? nB : cB + (size_t)(t + 2) * kstep;
            const char* a3 = a2 + kstep; const char* b3 = b2 + kstep;
            if (last && has_next) S.a_ready(nxt);
            if constexpr (SP2) {
            PG8_LDB(B0, 0, 0); PG8_LDB(B1, 0, 1); PG8_SCHED; PG8_LDA(At, 0, 0); PG8_STAGE(PG8_SA(1, 1), a1 + hstepA, voffA1);
            PG8_WAIT_V(8); PG8_WAIT_L(0); PG8_BAR; PG8_MMA(0, 0, At, B0); PG8_MMA(0, 1, At, B1); PG8_BAR; PG8_SCHED;
            PG8_LDA(At, 0, 1); PG8_STAGE(PG8_SB(0, 0), b2, voffB); PG8_STAGE(PG8_SB(0, 1), b2 + hstepB, voffB); PG8_STAGE(PG8_SA(0, 0), a2, voffA);
            PG8_WAIT_V(8); PG8_WAIT_L(0); PG8_BAR; PG8_MMA(1, 0, At, B0); PG8_MMA(1, 1, At, B1); PG8_BAR; PG8_SCHED;
            PG8_LDB(B0, 1, 0); PG8_LDB(B1, 1, 1); PG8_SCHED; PG8_LDA(At, 1, 0); PG8_STAGE(PG8_SA(0, 1), a2 + hstepA, voffA1);
            PG8_WAIT_V(8); PG8_WAIT_L(0); PG8_BAR; PG8_MMA(0, 0, At, B0); PG8_MMA(0, 1, At, B1); PG8_BAR; PG8_SCHED;
            PG8_LDA(At, 1, 1); PG8_STAGE(PG8_SB(1, 0), b3, voffB); PG8_STAGE(PG8_SB(1, 1), b3 + hstepB, voffB); PG8_STAGE(PG8_SA(1, 0), a3, voffA);
            PG8_WAIT_V(8); PG8_WAIT_L(0); PG8_BAR; PG8_MMA(1, 0, At, B0); PG8_MMA(1, 1, At, B1); PG8_BAR; PG8_SCHED;
            } else {
            PG8_LDB(B0, 0, 0); PG8_SCHED; PG8_LDA(At, 0, 0); PG8_STAGE(PG8_SA(1, 1), a1 + hstepA, voffA1);
            PG8_WAIT_L(8); PG8_BAR; PG8_WAIT_L(0); PG8_MMA(0, 0, At, B0); PG8_BAR; PG8_SCHED;
            PG8_LDB(B1, 0, 1); PG8_STAGE(PG8_SB(0, 0), b2, voffB);
            PG8_BAR; PG8_WAIT_L(0); PG8_MMA(0, 1, At, B1); PG8_BAR;
            PG8_LDA(At, 0, 1); PG8_STAGE(PG8_SA(0, 0), a2, voffA);
            PG8_BAR; PG8_WAIT_L(0); PG8_MMA(1, 0, At, B0); PG8_BAR; PG8_SCHED;
            PG8_STAGE(PG8_SB(0, 1), b2 + hstepB, voffB);
            PG8_WAIT_V(6); PG8_BAR; PG8_MMA(1, 1, At, B1); PG8_BAR;
            PG8_LDB(B0, 1, 0); PG8_SCHED; PG8_LDA(At, 1, 0); PG8_STAGE(PG8_SA(0, 1), a2 + hstepA, voffA1);
            PG8_WAIT_L(8); PG8_BAR; PG8_WAIT_L(0); PG8_MMA(0, 0, At, B0); PG8_BAR; PG8_SCHED;
            PG8_LDB(B1, 1, 1); PG8_STAGE(PG8_SB(1, 0), b3, voffB);
            PG8_BAR; PG8_WAIT_L(0); PG8_MMA(0, 1, At, B1); PG8_BAR;
            PG8_LDA(At, 1, 1); PG8_STAGE(PG8_SA(1, 0), a3, voffA);
            PG8_BAR; PG8_WAIT_L(0); PG8_MMA(1, 0, At, B0); PG8_BAR; PG8_SCHED;
            PG8_STAGE(PG8_SB(1, 1), b3 + hstepB, voffB);
            PG8_WAIT_V(6); PG8_BAR; PG8_MMA(1, 1, At, B1); PG8_BAR;
            }
        }
        if constexpr (ALIGN_EPI) { if (wr == 0) PG8_BAR; }
        if constexpr (!Epi::AFTER_DRAIN) { const int le_ = lane_now(); E(acc, cur, wr, wc, le_ & 15, le_ >> 4); S.done(cur); }
        if (!has_next) break;
#pragma unroll
        for (int a = 0; a < 2; ++a)
#pragma unroll
            for (int b = 0; b < 2; ++b)
#pragma unroll
                for (int m = 0; m < 4; ++m)
#pragma unroll
                    for (int n = 0; n < 2; ++n) acc[a][b][m][n] = (f32x4){0.f, 0.f, 0.f, 0.f};
        cur = nxt; cA = nA; cB = nB; ++ui;
        if constexpr (ALIGN_EPI) { if (wr == 1) PG8_BAR; }
    }
    PG8_WAIT_V(0);
    if constexpr (!ALIGN_EPI) { if (wr == 0) PG8_BAR; }
    PG8_BAR;
    if constexpr (Epi::AFTER_DRAIN) { const int le_ = lane_now(); E.fused(acc, cur, wr, wc, le_ & 15, le_ >> 4, lds, wid, le_); S.done(cur); }
#undef PG8_SA
#undef PG8_SB
#undef PG8_STAGE
#undef PG8_LDA
#undef PG8_LDB
#undef PG8_MMA
#undef PG8_WAIT_V
#undef PG8_WAIT_L
#undef PG8_BAR
#undef PG8_SCHED
}
}
#define XB_TMO      128
#define XB_XCNT(j)  (256  + 64 * (j))
#define XB_XSUB(j)  (1280 + 64 * (j))
#define XB_XGEN(j)  (2304 + 64 * (j))
#define XB_TOP      3328
#define XB_TOPGEN   3392
#define XCD_BAR_WORDS 3456
#define XB_SPIN_CAP (1u << 18)

__device__ __forceinline__ unsigned xb_ld(unsigned* p)              { return __hip_atomic_load(p, __ATOMIC_RELAXED, __HIP_MEMORY_SCOPE_AGENT); }
__device__ __forceinline__ unsigned xb_add(unsigned* p, unsigned v) { return __hip_atomic_fetch_add(p, v, __ATOMIC_RELAXED, __HIP_MEMORY_SCOPE_AGENT); }
__device__ __forceinline__ unsigned xb_xcc_id() { return (unsigned)__builtin_amdgcn_s_getreg((3 << 11) | 20) & 0xFu; }
#define XB_SPIN(cond, bar) do { unsigned _sp = 0; while (cond) { __builtin_amdgcn_s_sleep(1); \
    if ((++_sp & 255u) == 0u) { if (xb_ld(&(bar)[XB_TMO])) break; if (_sp > XB_SPIN_CAP) { atomicAdd(&(bar)[XB_TMO], 1u); break; } } } } while (0)

struct XcdBarrier {
    unsigned* bar; unsigned x;
    volatile LAS unsigned* st;
};

__device__ __forceinline__ XcdBarrier xcd_barrier_post(unsigned* bar, volatile LAS unsigned* st) {
    XcdBarrier b; b.bar = bar; b.x = xb_xcc_id(); b.st = st;
    if (threadIdx.x == 0) (void)xb_add(&bar[XB_XCNT(b.x)], 1u);
    return b;
}
__device__ __forceinline__ void xcd_barrier_complete(unsigned* bar, unsigned x, unsigned& nloc, unsigned& nx) {
    const unsigned G = gridDim.x * gridDim.y * gridDim.z;
    unsigned sum, cnt, mine, sp = 0u;
    for (;;) {
        sum = 0u; cnt = 0u; mine = 0u;
#pragma unroll
        for (unsigned j = 0; j < 16; ++j) { const unsigned c = xb_ld(&bar[XB_XCNT(j)]); sum += c; cnt += (c > 0u) ? 1u : 0u; }
        if (sum == G) { mine = xb_ld(&bar[XB_XCNT(x)]); break; }
        __builtin_amdgcn_s_sleep(1);
        if ((++sp & 255u) == 0u) { if (xb_ld(&bar[XB_TMO])) break; if (sp > XB_SPIN_CAP) { atomicAdd(&bar[XB_TMO], 1u); break; } }
    }
    nloc = mine > 0u ? mine : 1u; nx = cnt > 0u ? cnt : 1u;
}

__device__ __forceinline__ void xcd_barrier(const XcdBarrier& b, const bool t0  ) {
    asm volatile("s_waitcnt vmcnt(0)" ::: "memory");
    __syncthreads();
    if (t0) {
        unsigned* bar = (unsigned*)opaque_ptr((unsigned char*)b.bar);
        __builtin_amdgcn_s_waitcnt(0);
        unsigned nloc = b.st[0], nx = b.st[1];
        if (nloc == 0u) { xcd_barrier_complete(bar, b.x, nloc, nx); b.st[0] = nloc; b.st[1] = nx; }
        const unsigned old = xb_add(&bar[XB_XSUB(b.x)], 1u);
        const unsigned gen = old / nloc;
        if (old + 1u == (gen + 1u) * nloc) {
            __builtin_amdgcn_fence(__ATOMIC_RELEASE, "agent");
            asm volatile("s_waitcnt vmcnt(0)" ::: "memory");
            const unsigned og = xb_add(&bar[XB_TOP], 1u);
            const unsigned tg = og / nx;
            if (og + 1u == (tg + 1u) * nx) xb_add(&bar[XB_TOPGEN], 1u);
            else XB_SPIN(xb_ld(&bar[XB_TOPGEN]) == tg, bar);
            __builtin_amdgcn_fence(__ATOMIC_ACQUIRE, "agent");
            xb_add(&bar[XB_XGEN(b.x)], 1u);
            asm volatile("s_waitcnt vmcnt(0)" ::: "memory");
        } else {
            XB_SPIN(xb_ld(&bar[XB_XGEN(b.x)]) == gen, bar);
            __builtin_amdgcn_fence(__ATOMIC_ACQUIRE, "agent");
            asm volatile("s_waitcnt vmcnt(0)" ::: "memory");
        }
    }
    __syncthreads();
}

__device__ __forceinline__ void panel_sync(unsigned* cnt, unsigned target, const bool t0) {
    asm volatile("s_waitcnt vmcnt(0)" ::: "memory");
    __syncthreads();
    if (t0) {
        __builtin_amdgcn_s_waitcnt(0);
#if !MK_WT
        __builtin_amdgcn_fence(__ATOMIC_RELEASE, "agent");
        asm volatile("s_waitcnt vmcnt(0)" ::: "memory");
#endif
        (void)xb_add(cnt, 1u);
        unsigned sp = 0;
        while (xb_ld(cnt) < target) { __builtin_amdgcn_s_sleep(1); if (++sp > (1u << 20)) break; }
        __builtin_amdgcn_fence(__ATOMIC_ACQUIRE, "agent");
        asm volatile("s_waitcnt vmcnt(0)" ::: "memory");
    }
    __syncthreads();
}
typedef pg8::f32x4 A4;
#define EPI_ROWS_BEGIN _Pragma("unroll") for (int ai = 0; ai < 2; ++ai) _Pragma("unroll") for (int m = 0; m < 4; ++m) { const int row = u.pm * 256 + ai * 128 + wr * 64 + m * 16 + fr;
#define EPI_ROWS_END }
__device__ __forceinline__ float rstd_of(const float* ss, int row, int fq) {
    if (!ss) return 1.0f;
    const f32x4 p = *(const f32x4*)(ss + (size_t)row * 16 + fq * 4);
    float s = (p[0] + p[1]) + (p[2] + p[3]);
    s = add_xor32(add_xor16(s));
    return rsqrtf(s * (1.0f / D) + EPS);
}
__device__ __forceinline__ float rstd_row(const float* ss, size_t row) {
    const f32x4* p = (const f32x4*)(ss + row * 16); float s = 0.f;
#pragma unroll
    for (int i = 0; i < 4; ++i) { const f32x4 v = p[i]; s += (v[0] + v[1]) + (v[2] + v[3]); }
    return rsqrtf(s * (1.0f / D) + EPS);
}
__device__ __forceinline__ u32x4 pack8(const A4& a, const A4& b) { u32x4 w; w.x = pkbf(a[0], a[1]); w.y = pkbf(a[2], a[3]); w.z = pkbf(b[0], b[1]); w.w = pkbf(b[2], b[3]); return w; }
__device__ __forceinline__ void unpack8(const u32x4& w, A4& a, A4& b) { a[0] = bflo(w.x); a[1] = bfhi(w.x); a[2] = bflo(w.y); a[3] = bfhi(w.y); b[0] = bflo(w.z); b[1] = bfhi(w.z); b[2] = bflo(w.w); b[3] = bfhi(w.w); }

struct EpiScale {
    static constexpr bool PERM = true, AFTER_DRAIN = false, MIDK = false;
    bf16_t* O; const float* ss; int ld; float scale; int wt, pad;
    __device__ __forceinline__ void operator()(const A4 (&acc)[2][2][4][2], const pg8::Unit& u, int wr, int wc, int fr, int fq) const {
        const int col0 = u.pn * 256 + wc * 32 + 8 * fq;
        EPI_ROWS_BEGIN
            const float s = rstd_of(ss, row, fq) * scale;
#pragma unroll
            for (int bj = 0; bj < 2; ++bj) { const u32x4 w = pack8(acc[ai][bj][m][0] * s, acc[ai][bj][m][1] * s); bf16_t* p = O + (size_t)row * ld + col0 + bj * 128; if (wt) ST16_OUT(p, w); else *(u32x4*)p = w; }
        EPI_ROWS_END
    }
};

__device__ __forceinline__ size_t band_frag_off(int t, int f) { return ((((size_t)(t >> 5) * AH + (f >> 6)) * 4 + ((f >> 4) & 3)) * 64 + ((f >> 3) & 1) * 32 + (t & 31)) * 8; }
__device__ __forceinline__ size_t band_vfrag_off(int F, int t) { return (((((size_t)(t >> 5) * AH + (F >> 6)) * 2 + ((F >> 5) & 1)) * 2 + ((t >> 4) & 1)) * 64 + ((t >> 3) & 1) * 32 + (F & 31)) * 8; }
struct EpiVT {
    static constexpr bool PERM = true, AFTER_DRAIN = false, MIDK = false;
    bf16_t *AVTp, *BVTp;
    __device__ __forceinline__ void operator()(const A4 (&acc)[2][2][4][2], const pg8::Unit& u, int wr, int wc, int fr, int fq) const {
        const int col0 = u.pn * 256 + wc * 32 + 8 * fq;
        EPI_ROWS_BEGIN
#pragma unroll
            for (int bj = 0; bj < 2; ++bj) { const u32x4 w = pack8(acc[ai][bj][m][0], acc[ai][bj][m][1]); const int t = col0 + bj * 128;
                bf16_t* p = u.pm < 2 ? AVTp + band_vfrag_off(row, t) : BVTp + (size_t)(row - 512) * T + t; ST16_OUT(p, w); }
        EPI_ROWS_END
    }
};

struct EpiProj {
    static constexpr bool PERM = true, AFTER_DRAIN = false, MIDK = false;
    bf16_t *AQ, *AK, *BQ, *BK, *BRS, *GA, *GB; float* LOGA; const float* balpha; int tile0, pad;
    __device__ __forceinline__ void operator()(const A4 (&acc)[2][2][4][2], const pg8::Unit& u, int wr, int wc, int fr, int fq) const {
        const int tile = u.pn + tile0;
        bf16_t* dst; int ld, c0, mode = 0; float sc = 1.f;
        if (tile < 2) { dst = AQ; ld = 512; c0 = tile * 256; sc = 0.125f * 1.4426950408889634f; }
        else if (tile < 4) { dst = AK; ld = 512; c0 = (tile - 2) * 256; }
        else if (tile == 4) { dst = BQ; ld = 256; c0 = 0; sc = 0.125f; }
        else if (tile == 5) { dst = BK; ld = 256; c0 = 0; }
        else if (tile < 8) { dst = BRS; ld = 512; c0 = (tile - 6) * 256; mode = 1; }
        else if (tile == 8) { dst = nullptr; ld = 256; c0 = 0; mode = 3; }
        else if (tile < 13) { dst = GA; ld = 1024; c0 = (tile - 9) * 256; mode = 2; }
        else { dst = GB; ld = 1024; c0 = (tile - 13) * 256; mode = 2; }
        const int cl = wc * 32 + 8 * fq;
        EPI_ROWS_BEGIN
#pragma unroll
            for (int bj = 0; bj < 2; ++bj) {
                A4 v0 = acc[ai][bj][m][0] * sc, v1 = acc[ai][bj][m][1] * sc;
                const int c = cl + bj * 128;
                if (mode == 3) {
                    const A4 b0 = *(const A4*)(balpha + c), b1 = *(const A4*)(balpha + c + 4);
#pragma unroll
                    for (int i = 0; i < 4; ++i) { v0[i] = flogsigmoid(v0[i] + b0[i]) * 0.0625f; v1[i] = flogsigmoid(v1[i] + b1[i]) * 0.0625f; }
                    float* o = LOGA + (size_t)row * 256 + c; *(A4*)o = v0; *(A4*)(o + 4) = v1;
                } else {
                    if (mode == 1) {
#pragma unroll
                        for (int i = 0; i < 4; ++i) { v0[i] = fsilu(v0[i]); v1[i] = fsilu(v1[i]); }
                    } else if (mode == 2) {
#pragma unroll
                        for (int i = 0; i < 4; ++i) { v0[i] = fsigmoid(v0[i]); v1[i] = fsigmoid(v1[i]); }
                    }
                    { const u32x4 w = pack8(v0, v1); const int f = c0 + c;
                      bf16_t* p = tile < 4 ? dst + band_frag_off(row, f) : dst + (size_t)row * ld + f; if (mode == 2) *(u32x4*)p = w; else ST16_OUT(p, w); }
                }
            }
        EPI_ROWS_END
    }
};

struct EpiResid {
    static constexpr bool PERM = true, AFTER_DRAIN = false, MIDK = false;
    bf16_t* Xo; const bf16_t* X; float* ss_out;
    __device__ __forceinline__ void operator()(const A4 (&acc)[2][2][4][2], const pg8::Unit& u, int wr, int wc, int fr, int fq) const {
        const int col0 = u.pn * 256 + wc * 32 + 8 * fq;
#pragma unroll
        for (int ai = 0; ai < 2; ++ai) {
            u32x4 xin[4][2];
#pragma unroll
            for (int m = 0; m < 4; ++m)
#pragma unroll
                for (int bj = 0; bj < 2; ++bj) xin[m][bj] = *(const u32x4*)(X + (size_t)(u.pm * 256 + ai * 128 + wr * 64 + m * 16 + fr) * D + col0 + bj * 128);
#pragma unroll
            for (int m = 0; m < 4; ++m) {
                const int row = u.pm * 256 + ai * 128 + wr * 64 + m * 16 + fr;
                float q = 0.f;
#pragma unroll
                for (int bj = 0; bj < 2; ++bj) {
                    A4 x0, x1; unpack8(xin[m][bj], x0, x1);
                    x0 += acc[ai][bj][m][0]; x1 += acc[ai][bj][m][1];
                    q += (x0[0] * x0[0] + x0[1] * x0[1]) + (x0[2] * x0[2] + x0[3] * x0[3]) + (x1[0] * x1[0] + x1[1] * x1[1]) + (x1[2] * x1[2] + x1[3] * x1[3]);
                    ST16_OUT(Xo + (size_t)row * D + col0 + bj * 128, pack8(x0, x1));
                }
                q = add_xor32(add_xor16(q));
                if (fq == 0) __hip_atomic_store(ss_out + (size_t)row * 16 + u.pn * 4 + wc, q, __ATOMIC_RELAXED, __HIP_MEMORY_SCOPE_AGENT);
            }
        }
    }
};

struct EpiMerge {
    static constexpr bool PERM = true, AFTER_DRAIN = false, MIDK = true;
    const bf16_t* GAp; const bf16_t* GBp; bf16_t* O;
    __device__ __forceinline__ void mid(A4 (&acc)[2][2][4][2], const pg8::Unit& u, int wr, int wc, int fr, int fq) const {
        const int col0 = u.pn * 256 + wc * 32 + 8 * fq;
        EPI_ROWS_BEGIN
#pragma unroll
            for (int bj = 0; bj < 2; ++bj) {
                const size_t off = (size_t)row * D + col0 + bj * 128;
                A4 a0, a1, b0, b1; unpack8(*(const u32x4*)(GAp + off), a0, a1); unpack8(*(const u32x4*)(GBp + off), b0, b1);
#pragma unroll
                for (int i = 0; i < 4; ++i) { acc[ai][bj][m][0][i] *= a0[i] * __builtin_amdgcn_rcpf(b0[i]); acc[ai][bj][m][1][i] *= a1[i] * __builtin_amdgcn_rcpf(b1[i]); }
            }
        EPI_ROWS_END
    }
    __device__ __forceinline__ void operator()(const A4 (&acc)[2][2][4][2], const pg8::Unit& u, int wr, int wc, int fr, int fq) const {
        const int col0 = u.pn * 256 + wc * 32 + 8 * fq;
#pragma unroll
        for (int ai = 0; ai < 2; ++ai) {
            u32x4 gin[4][2];
#pragma unroll
            for (int m = 0; m < 4; ++m)
#pragma unroll
                for (int bj = 0; bj < 2; ++bj) gin[m][bj] = *(const u32x4*)(GBp + (size_t)(u.pm * 256 + ai * 128 + wr * 64 + m * 16 + fr) * D + col0 + bj * 128);
#pragma unroll
            for (int m = 0; m < 4; ++m)
#pragma unroll
                for (int bj = 0; bj < 2; ++bj) {
                    A4 b0, b1; unpack8(gin[m][bj], b0, b1);
                    ST16_OUT(O + (size_t)(u.pm * 256 + ai * 128 + wr * 64 + m * 16 + fr) * D + col0 + bj * 128, pack8(acc[ai][bj][m][0] * b0, acc[ai][bj][m][1] * b1));
                }
        }
    }
};
struct ConvRegs { f32x4 v[8]; };
__device__ __forceinline__ void conv_load(ConvRegs& R, const float* __restrict__ W, int ldw, int k0, int n0, int lane) {
#pragma unroll
    for (int i = 0; i < 8; ++i) { const int kk = (lane >> 3) + 8 * i; R.v[i] = __builtin_nontemporal_load((const f32x4*)(W + (size_t)(k0 + kk) * ldw + n0 + (lane & 7) * 4)); }
}
__device__ __forceinline__ void conv_store(const ConvRegs& R, const float* __restrict__ gk, bf16_t* __restrict__ WT, int ldt, int k0, int n0, LAS float* scr, int lane) {
#pragma unroll
    for (int i = 0; i < 8; ++i) { const int kk = (lane >> 3) + 8 * i; const float s = gk ? gk[k0 + kk] : 1.0f; LAS float* p = scr + kk * 33 + (lane & 7) * 4;
        p[0] = R.v[i][0] * s; p[1] = R.v[i][1] * s; p[2] = R.v[i][2] * s; p[3] = R.v[i][3] * s; }
    asm volatile("s_waitcnt lgkmcnt(0)" ::: "memory");
    const int c = lane & 7;
#pragma unroll
    for (int j = 0; j < 4; ++j) { const int n = (lane >> 3) + 8 * j; const LAS float* s = scr + (8 * c) * 33 + n;
        u32x4 o; o.x = pkbf(s[0 * 33], s[1 * 33]); o.y = pkbf(s[2 * 33], s[3 * 33]); o.z = pkbf(s[4 * 33], s[5 * 33]); o.w = pkbf(s[6 * 33], s[7 * 33]);
        *(u32x4*)(WT + (size_t)(n0 + n) * ldt + k0 + 8 * c) = o; }
    asm volatile("s_waitcnt lgkmcnt(0)" ::: "memory");
}
__device__ __forceinline__ void conv_item(const float* __restrict__ W, int ldw, const float* __restrict__ gk, bf16_t* __restrict__ WT, int ldt, int k0, int n0, LAS float* scr, int lane) {
    ConvRegs R; conv_load(R, W, ldw, k0, n0, lane); conv_store(R, gk, WT, ldt, k0, n0, scr, lane);
}

struct InPtrs {
    const float *x, *mem, *norm_mix_g, *w_in, *rel_bias, *gla_w_alpha, *gla_b_alpha, *gla_norm_g, *w_branch, *w_mix_out, *norm_x_g, *mem_norm_g, *w_xq, *w_xkv, *w_xo,
                *norm_ffn_g, *w_gr, *b_gr, *w_er, *b_er, *w_eg, *w_eu, *w_ed, *final_g;
};

struct ConvJob { const float* W; const float* gk; bf16_t* WT; int ldw, ldt, K, N; };
__device__ __forceinline__ ConvJob dense_job(const InPtrs& in, unsigned char* ws, int l, int j) {
    unsigned char* wd = ws + WS_WDENSE + (size_t)l * WDENSE_STRIDE;
    const float* Win = in.w_in + (size_t)l * D * INW; bf16_t* WIN_T = (bf16_t*)(wd + WD_WIN);
    const float* gm = in.norm_mix_g + l * D;
    ConvJob J;
    switch (j) {
    case 0: J = {Win + 0, gm, WIN_T + (size_t)0 * D, INW, D, D, 1024}; break;
    case 1: J = {Win + 1024, gm, WIN_T + (size_t)2304 * D, INW, D, D, 512}; break;
    case 2: J = {Win + 1536, gm, WIN_T + (size_t)1024 * D, INW, D, D, 512}; break;
    case 3: J = {Win + 2048, gm, WIN_T + (size_t)2816 * D, INW, D, D, 512}; break;
    case 4: J = {Win + 3088, gm, WIN_T + (size_t)3328 * D, INW, D, D, 2048}; break;
    case 11: J = {Win + 2576, gm, WIN_T + (size_t)1536 * D, INW, D, D, 512}; break;
    case 5: J = {in.w_branch + (size_t)(l * 2 + 0) * 512 * D, nullptr, (bf16_t*)(wd + WD_WB), D, D, 512, D}; break;
    case 6: J = {in.w_branch + (size_t)(l * 2 + 1) * 512 * D, nullptr, (bf16_t*)(wd + WD_WB) + 512, D, D, 512, D}; break;
    case 7: J = {in.w_mix_out + (size_t)l * D * D, nullptr, (bf16_t*)(wd + WD_WMO), D, D, D, D}; break;
    case 8: J = {in.w_xq + (size_t)l * D * D, in.norm_x_g + l * D, (bf16_t*)(wd + WD_WXQ), D, D, D, 0}; break;
    case 9: J = {in.w_xkv + (size_t)l * D * 2 * D, nullptr, (bf16_t*)(wd + WD_WXKV), 2 * D, D, D, 2 * D}; break;
    default: J = {in.w_xo + (size_t)l * D * D, nullptr, (bf16_t*)(wd + WD_WXO), D, D, D, D}; break;
    }
    return J;
}

__device__ __forceinline__ void conv_dense_layer(const InPtrs& in, unsigned char* ws, int l, int gw, int NGW, int gt, int NGT, LAS float* scr, int lane) {
    constexpr int NITEMS = 5632 - 512;
#pragma nounroll
    for (int it = gw; it < NITEMS; it += 2 * NGW) {
        ConvRegs R[2]; ConvJob J[2]; int k0[2], n0[2];
#pragma unroll
        for (int q = 0; q < 2; ++q) {
            int r = it + q * NGW; const bool on = r < NITEMS; if (!on) r = it;
            int j = 0;
#pragma unroll
            for (int jj = 0; jj < 12; ++jj) { const ConvJob Jt = dense_job(in, ws, l, jj); const int n = (Jt.K / 64) * (Jt.N / 32); if (j == jj && r >= n) { r -= n; ++j; } }
            J[q] = dense_job(in, ws, l, j); const int nnb = J[q].N / 32; k0[q] = (r / nnb) * 64; n0[q] = (r % nnb) * 32;
            if (on) conv_load(R[q], J[q].W, J[q].ldw, k0[q], n0[q], lane);
        }
#pragma unroll
        for (int q = 0; q < 2; ++q) if (it + q * NGW < NITEMS) conv_store(R[q], J[q].gk, J[q].WT, J[q].ldt, k0[q], n0[q], scr, lane);
    }
    {
        bf16_t* WIN_T = (bf16_t*)(ws + WS_WDENSE + (size_t)l * WDENSE_STRIDE + WD_WIN);
        const float* Win = in.w_in + (size_t)l * D * INW; const float* Wa = in.gla_w_alpha + (size_t)l * BR * BKW; const float* gm = in.norm_mix_g + l * D;
        for (int i = gt; i < 256 * D; i += NGT) {
            const int c = i >> 10, k = i & 1023; float s = 0.f;
#pragma unroll
            for (int r = 0; r < BR; ++r) s += Win[(size_t)k * INW + 2560 + r] * Wa[r * BKW + c];
            WIN_T[(size_t)(2048 + c) * D + k] = f2bf(s * gm[k]);
        }
    }
    {
        bf16_t* WQN = (bf16_t*)(ws + WS_WDENSE + (size_t)l * WDENSE_STRIDE + WD_WXQ);
        const float* Wq = in.w_xq + (size_t)l * D * D; const float* gx = in.norm_x_g + l * D;
        for (int i = gt; i < D * D / 4; i += NGT) { const f32x4 v = ((const f32x4*)Wq)[i]; const float g = gx[i >> 8]; u32x2 o; o.x = pkbf(v[0] * g, v[1] * g); o.y = pkbf(v[2] * g, v[3] * g); ((u32x2*)WQN)[i] = o; }
    }
}
__device__ __forceinline__ void ph_prologue(const InPtrs& in, unsigned char* ws, LAS unsigned char* lds, int vcu, int G, int wv) {
    const int tid = tid_of(wv), lane = tid & 63, wave = wv;
    LAS float* scr = (LAS float*)(lds + wave * 16384);
    const int gw = vcu * 8 + wave, NGW = G * 8;
#pragma nounroll
    for (int l = 0; l < (G == 256 ? 1 : DEPTH); ++l) conv_dense_layer(in, ws, l, gw, NGW, vcu * 512 + tid, G * 512, scr, lane);
    bf16_t* XB = (bf16_t*)(ws + WS_XB); bf16_t* XN = (bf16_t*)(ws + WS_XN);
#pragma nounroll
    for (int rb = gw; rb < T; rb += 4 * NGW) {
        float4 v[4][4];
#pragma unroll
        for (int i = 0; i < 4; ++i) { const int r = (rb + i * NGW < T) ? rb + i * NGW : rb; const float4* xr = (const float4*)(in.x + (size_t)r * D) + lane;
#pragma unroll
            for (int j = 0; j < 4; ++j) v[i][j] = xr[64 * j]; }
#pragma unroll
        for (int i = 0; i < 4; ++i) {
            const int r = rb + i * NGW;
            if (r < T) {
                float s = 0.f;
#pragma unroll
                for (int j = 0; j < 4; ++j) { s += v[i][j].x * v[i][j].x + v[i][j].y * v[i][j].y + v[i][j].z * v[i][j].z + v[i][j].w * v[i][j].w;
                    u32x2 o; o.x = pkbf(v[i][j].x, v[i][j].y); o.y = pkbf(v[i][j].z, v[i][j].w); *(u32x2*)(XB + (size_t)r * D + (lane + 64 * j) * 4) = o; }
                const float rs = rsqrtf(wave_sum(s) * (1.0f / D) + EPS);
#pragma unroll
                for (int j = 0; j < 4; ++j) { u32x2 o; o.x = pkbf(v[i][j].x * rs, v[i][j].y * rs); o.y = pkbf(v[i][j].z * rs, v[i][j].w * rs); *(u32x2*)(XN + (size_t)r * D + (lane + 64 * j) * 4) = o; }
            }
        }
    }
    bf16_t* MEMN = (bf16_t*)(ws + WS_MEMN);
    for (int r = gw; r < NB * NMEM; r += NGW) {
        const float4* xr = (const float4*)(in.mem + (size_t)r * D) + lane; float4 v[4]; float s = 0.f;
#pragma unroll
        for (int j = 0; j < 4; ++j) { v[j] = xr[64 * j]; s += v[j].x * v[j].x + v[j].y * v[j].y + v[j].z * v[j].z + v[j].w * v[j].w; }
        const float rs = rsqrtf(wave_sum(s) * (1.0f / D) + EPS);
#pragma unroll
        for (int j = 0; j < 4; ++j) { const float4 g = ((const float4*)in.mem_norm_g)[lane + 64 * j];
            u32x2 o; o.x = pkbf(v[j].x * rs * g.x, v[j].y * rs * g.y); o.y = pkbf(v[j].z * rs * g.z, v[j].w * rs * g.w); *(u32x2*)(MEMN + (size_t)r * D + (lane + 64 * j) * 4) = o; }
    }
}

typedef short bf16x8_t __attribute__((ext_vector_type(8)));
constexpr int NRMAX = 40960;
constexpr int NTMAX = NRMAX / 256;
constexpr int CW_CNT = 256;
constexpr size_t SEL_SELE = 0, SEL_SELW = 128 * 1024, SEL_LPOS = 256 * 1024, SEL_POS = 384 * 1024, SEL_GW = 512 * 1024, SEL_TILE = 768 * 1024, SEL_NT = 768 * 1024 + 4096, SEL_RS = 896 * 1024;

struct ExpItem { const float* W; const float* gk; bf16_t* WT; int ldw, ldt, k0, n0; };
__device__ __forceinline__ ExpItem expert_item(const InPtrs& in, unsigned char* ws, int it) {
    const int le = it / 384, r = it % 384, l = le >> 5, e = le & 31;
    bf16_t* WGU = (bf16_t*)(ws + WS_WEXP + (size_t)l * WEXP_STRIDE) + (size_t)e * 512 * D;
    bf16_t* WDT = (bf16_t*)(ws + WS_WEXP + (size_t)l * WEXP_STRIDE + 32 * MiB) + (size_t)e * D * EF;
    const size_t eo = ((size_t)l * NE + e) * D * EF;
    ExpItem I;
    if (r < 256) { const int p = r >> 6, q = r & 63; I = {((p & 1) ? in.w_eu : in.w_eg) + eo + (p >> 1) * 128, in.norm_ffn_g + l * D, WGU + (size_t)(p * 128) * D, EF, D, (q >> 2) * 64, (q & 3) * 32}; }
    else { const int q = r - 256; I = {in.w_ed + eo, nullptr, WDT, D, EF, (q >> 5) * 64, (q & 31) * 32}; }
    return I;
}
__device__ __forceinline__ void conv_expert_run(const InPtrs& in, unsigned char* ws, int it0, int n, LAS float* scr, int lane) {
#pragma nounroll
    for (int i = 0; i < n; i += 2) {
        ConvRegs R0, R1;
        const ExpItem A = expert_item(in, ws, it0 + i); conv_load(R0, A.W, A.ldw, A.k0, A.n0, lane);
        ExpItem B = A; if (i + 1 < n) { B = expert_item(in, ws, it0 + i + 1); conv_load(R1, B.W, B.ldw, B.k0, B.n0, lane); }
        conv_store(R0, A.gk, A.WT, A.ldt, A.k0, A.n0, scr, lane);
        if (i + 1 < n) conv_store(R1, B.gk, B.WT, B.ldt, B.k0, B.n0, scr, lane);
    }
}
__device__ __forceinline__ void conv_expert_items(const InPtrs& in, unsigned char* ws, int it_lo, int it_hi, int gw, int NGW, LAS float* scr, int lane) {
#pragma nounroll
    for (int it = it_lo + gw; it < it_hi; it += 2 * NGW) {
        const int it2 = it + NGW; ConvRegs R0, R1;
        const ExpItem A = expert_item(in, ws, it); conv_load(R0, A.W, A.ldw, A.k0, A.n0, lane);
        ExpItem B = A; if (it2 < it_hi) { B = expert_item(in, ws, it2); conv_load(R1, B.W, B.ldw, B.k0, B.n0, lane); }
        conv_store(R0, A.gk, A.WT, A.ldt, A.k0, A.n0, scr, lane);
        if (it2 < it_hi) conv_store(R1, B.gk, B.WT, B.ldt, B.k0, B.n0, scr, lane);
    }
}
__device__ __forceinline__ void conv_router(const InPtrs& in, unsigned char* ws, int vcu, int G, int tid) {
    for (int i = vcu * 512 + tid; i < DEPTH * 48 * D; i += G * 512) {
        const int l = i / (48 * D), r = (i / D) % 48, k = i % D; float v = 0.f;
        if (r < NG) v = in.w_gr[((size_t)l * D + k) * NG + r]; else if (r < NG + NE) v = in.w_er[((size_t)l * D + k) * NE + (r - NG)];
        ((bf16_t*)(ws + WS_WR))[i] = f2bf(v * in.norm_ffn_g[l * D + k]);
    }
}

__device__ __forceinline__ void ph_route(const InPtrs& in, unsigned char* ws, LAS unsigned char* lds, int l, int t0  , int wv, bool dummy_cnt) {
    const int tid = tid_of(wv), lane = tid & 63, wave = wv;
    const bf16_t* XB = (const bf16_t*)(ws + WS_XB); const bf16_t* WR = (const bf16_t*)(ws + WS_WR) + (size_t)l * 48 * D;
    const float* ss = (const float*)(ws + WS_SSP) + (size_t)(3 * l + 2) * T * 16;
    int* SELE = (int*)(ws + WS_SEL + SEL_SELE); float* SELW = (float*)(ws + WS_SEL + SEL_SELW); int* LPOS = (int*)(ws + WS_SEL + SEL_LPOS);
    float* RSTD = (float*)(ws + WS_SEL + SEL_RS); int* TOKS = (int*)(ws + WS_TOK);
    unsigned* CNT = (unsigned*)(ws + WS_CTL) + CW_CNT + 32 * l + (dummy_cnt ? 128 : 0);
    LAS float* lg = (LAS float*)lds + wave * (16 * 49);
    LAS unsigned* hist = (LAS unsigned*)(lds + 32768); LAS unsigned* gbase = hist + 32;
    {
        if (tid < 32) hist[tid] = 0u;
        int e0 = 0, e1 = 0; unsigned r0 = 0, r1 = 0;
        {
            const int tw = t0 + (wave & 3) * 16, kh = (wave >> 2) * (D / 2);
            f32x4 acc[3];
#pragma unroll
            for (int nb = 0; nb < 3; ++nb) acc[nb] = (f32x4){0.f, 0.f, 0.f, 0.f};
            const bf16_t* ap = XB + (size_t)(tw + (lane & 15)) * D + kh + 8 * (lane >> 4);
            const bf16_t* bp = WR + (size_t)(lane & 15) * D + kh + 8 * (lane >> 4);
#pragma unroll
            for (int k0 = 0; k0 < D / 64; k0 += 8) {
                bf16x8_t a[8], b[8][3];
#pragma unroll
                for (int kk = 0; kk < 8; ++kk) { a[kk] = *(const bf16x8_t*)(ap + (k0 + kk) * 32);
#pragma unroll
                    for (int nb = 0; nb < 3; ++nb) b[kk][nb] = *(const bf16x8_t*)(bp + (size_t)nb * 16 * D + (k0 + kk) * 32); }
#pragma unroll
                for (int kk = 0; kk < 8; ++kk)
#pragma unroll
                    for (int nb = 0; nb < 3; ++nb) acc[nb] = __builtin_amdgcn_mfma_f32_16x16x32_bf16(a[kk], b[kk][nb], acc[nb], 0, 0, 0);
            }
#pragma unroll
            for (int nb = 0; nb < 3; ++nb)
#pragma unroll
                for (int r = 0; r < 4; ++r) lg[((lane >> 4) * 4 + r) * 49 + nb * 16 + (lane & 15)] = acc[nb][r];
        }
        __syncthreads();
        if (wave < 4 && lane < 16) {
            const int t = t0 + wave * 16 + lane; const float rs = rstd_row(ss, (size_t)t);
            const LAS float* p = lg + lane * 49; const LAS float* p2 = p + 4 * (16 * 49);
            float gm = -INFINITY; int gi = 0;
#pragma unroll
            for (int i = 0; i < NG; ++i) { const float x = (p[i] + p2[i]) * rs + in.b_gr[l * NG + i]; if (x > gm) { gm = x; gi = i; } }
            float gs = 0.f;
#pragma unroll
            for (int i = 0; i < NG; ++i) gs += __expf((p[i] + p2[i]) * rs + in.b_gr[l * NG + i] - gm);
            const float gw = 1.0f / gs;
            float v0 = -INFINITY, v1 = -INFINITY; int i0 = 0, i1 = 0;
#pragma unroll
            for (int e = 0; e < EPG; ++e) { const float x = (p[NG + gi * EPG + e] + p2[NG + gi * EPG + e]) * rs + in.b_er[l * NE + gi * EPG + e];
                if (x > v0) { v1 = v0; i1 = i0; v0 = x; i0 = e; } else if (x > v1) { v1 = x; i1 = e; } }
            const float ex = __expf(v1 - v0), den = 1.0f + ex;
            e0 = gi * EPG + i0; e1 = gi * EPG + i1;
            SELE[t * 2] = e0; SELE[t * 2 + 1] = e1; SELW[t * 2] = gw / den; SELW[t * 2 + 1] = gw * ex / den; RSTD[t] = rs;
            r0 = __hip_atomic_fetch_add(&hist[e0], 1u, __ATOMIC_RELAXED, __HIP_MEMORY_SCOPE_WORKGROUP); r1 = __hip_atomic_fetch_add(&hist[e1], 1u, __ATOMIC_RELAXED, __HIP_MEMORY_SCOPE_WORKGROUP);
        }
        __syncthreads();
        if (tid < 32) gbase[tid] = hist[tid] ? atomicAdd(&CNT[tid], hist[tid]) : 0u;
        __syncthreads();
        if (wave < 4 && lane < 16) { const int t = t0 + wave * 16 + lane; const int p0 = (int)(gbase[e0] + r0), p1 = (int)(gbase[e1] + r1);
            LPOS[t * 2] = p0; LPOS[t * 2 + 1] = p1; TOKS[(size_t)e0 * T + p0] = 2 * t; TOKS[(size_t)e1 * T + p1] = 2 * t + 1; }
        __syncthreads();
    }
}

__device__ __forceinline__ int moe_prefix(const unsigned* CNT, int lane, int& cnt, int& tile0, int& ntile) {
    cnt = (lane < 32) ? (int)__hip_atomic_load(CNT + (lane & 31), __ATOMIC_RELAXED, __HIP_MEMORY_SCOPE_AGENT) : 0;
    ntile = (cnt + 255) >> 8;
    int incl = ntile;
#pragma unroll
    for (int o = 1; o < 32; o <<= 1) { const int y = shfl_idx(incl, (lane - o) & 63); if ((lane & 31) >= o) incl += y; }
    tile0 = incl - ntile;
    return shfl_idx(incl, 31);
}
__device__ __forceinline__ void moe_tables(unsigned char* ws, int l, LAS int* tb, int vcu, int wave, int lane) {
    if (wave == 0) {
        int cnt, t0, nt_e; const int nt = moe_prefix((const unsigned*)(ws + WS_CTL) + CW_CNT + 32 * l, lane, cnt, t0, nt_e);
        if (lane < 32) { tb[lane] = cnt; tb[32 + lane] = t0; for (int r = t0; r < t0 + nt_e; ++r) tb[96 + r] = lane; }
        if (lane == 0) tb[64] = nt;
        if (vcu == 0) {
            int* TILE_E = (int*)(ws + WS_SEL + SEL_TILE);
            if (lane < 32) for (int r = t0; r < t0 + nt_e; ++r) TILE_E[r] = lane;
            if (lane == 0) *(int*)(ws + WS_SEL + SEL_NT) = nt;
        }
    }
    asm volatile("s_waitcnt lgkmcnt(0)" ::: "memory");
    __syncthreads();
}
struct GatherOrder {
    static constexpr bool GATHER = true;
    int pm, pn; const int* toks; int tl, cnt;
    __device__ __forceinline__ bool next(int i, pg8::Unit& u) const { if (i != 0) return false; u.pm = pm; u.pn = pn; return true; }
    __device__ __forceinline__ int arow(int R) const { const int p = tl * 256 + R; return p < cnt ? (toks[p] >> 1) : 0; }
    __device__ __forceinline__ void a_ready(const pg8::Unit&) const {}
    __device__ __forceinline__ void done(const pg8::Unit&) const {}
};
template <int NJ> struct GroupedOrder {
    static constexpr bool GATHER = false;
    const int* tile_e; int nunits, G, c;
    __device__ __forceinline__ void init(const int* te, int nt, int G_, int c_) { tile_e = te; nunits = nt * NJ; G = G_; c = c_; }
    __device__ __forceinline__ bool next(int i, pg8::Unit& u) const {
        const int L = i * G + c; if (L >= nunits) return false;
        const int rt = L / NJ, j = L % NJ;
        u.pm = rt; u.pn = __builtin_amdgcn_readfirstlane(tile_e[rt]) * NJ + j; return true;
    }
    __device__ __forceinline__ void a_ready(const pg8::Unit&) const {}
    __device__ __forceinline__ void done(const pg8::Unit&) const {}
};
struct QuadOrder {
    static constexpr bool GATHER = false;
    int pm, pn0, n;
    __device__ __forceinline__ bool next(int i, pg8::Unit& u) const { if (i >= n) return false; u.pm = pm; u.pn = pn0 + i; return true; }
    __device__ __forceinline__ void a_ready(const pg8::Unit&) const {}
    __device__ __forceinline__ void done(const pg8::Unit&) const {}
};
constexpr int CW_READY = 24576;
struct EpiHid {
    static constexpr bool PERM = true, AFTER_DRAIN = false, MIDK = false;
    bf16_t* HID; const int* toks; const float* RSTD; const float* SELW; int tl, cnt;
    __device__ __forceinline__ void operator()(const A4 (&acc)[2][2][4][2], const pg8::Unit& u, int wr, int wc, int fr, int fq) const {
        const int f0 = (u.pn & 1) * 128 + wc * 32 + 8 * fq;
        float rsv[2][4], wv_[2][4];
#pragma unroll
        for (int ai = 0; ai < 2; ++ai)
#pragma unroll
            for (int m = 0; m < 4; ++m) {
                const int p = tl * 256 + ai * 128 + wr * 64 + m * 16 + fr;
                const int slot = p < cnt ? toks[p] : 0;
                rsv[ai][m] = RSTD[slot >> 1]; wv_[ai][m] = SELW[slot];
            }
        EPI_ROWS_BEGIN
            const float rs = rsv[ai][m], w = wv_[ai][m];
            A4 h0, h1;
#pragma unroll
            for (int i = 0; i < 4; ++i) { h0[i] = fsilu(acc[ai][0][m][0][i] * rs) * (acc[ai][1][m][0][i] * rs) * w; h1[i] = fsilu(acc[ai][0][m][1][i] * rs) * (acc[ai][1][m][1][i] * rs) * w; }
            st16_wt(HID + (size_t)row * EF + f0, pack8(h0, h1));
        EPI_ROWS_END
    }
};
struct EpiY {
    static constexpr bool PERM = true, AFTER_DRAIN = false, MIDK = false;
    bf16_t* Y;
    __device__ __forceinline__ void operator()(const A4 (&acc)[2][2][4][2], const pg8::Unit& u, int wr, int wc, int fr, int fq) const {
        const int col0 = (u.pn & 3) * 256 + wc * 32 + 8 * fq;
        EPI_ROWS_BEGIN
#pragma unroll
            for (int bj = 0; bj < 2; ++bj) ST16_OUT(Y + (size_t)row * D + col0 + bj * 128, pack8(acc[ai][bj][m][0], acc[ai][bj][m][1]));
        EPI_ROWS_END
    }
};

__device__ __forceinline__ void ph_combine(unsigned char* ws, int l, int vcu, int G, bf16_t* XN, float* OUT, const float* __restrict__ fg, int wv, bf16_t* XBo) {
    const int tid = tid_of(wv), lane = tid & 63, wave = wv; (void)tid;
    const bf16_t* XB = (const bf16_t*)(ws + WS_XB); const bf16_t* Y = (const bf16_t*)(ws + WS_XG);
    const int* SELE = (const int*)(ws + WS_SEL + SEL_SELE); const int* LPOS = (const int*)(ws + WS_SEL + SEL_LPOS); float* ssn = (float*)(ws + WS_SSP) + (size_t)(3 * l + 3) * T * 16;
    int cnt_, tile0_, ntile_; (void)moe_prefix((const unsigned*)(ws + WS_CTL) + CW_CNT + 32 * l, lane, cnt_, tile0_, ntile_);
    const int stride = G * 8;
#pragma nounroll
    for (int tb = vcu * 8 + wave; tb < T; tb += 4 * stride) {
        int p0[4], p1[4];
#pragma unroll
        for (int i = 0; i < 4; ++i) { const int t = (tb + i * stride < T) ? tb + i * stride : tb;
            p0[i] = shfl_idx(tile0_, SELE[2 * t]) * 256 + LPOS[2 * t]; p1[i] = shfl_idx(tile0_, SELE[2 * t + 1]) * 256 + LPOS[2 * t + 1]; }
        u32x4 rx[4][2], ry0[4][2], ry1[4][2];
#pragma unroll
        for (int i = 0; i < 4; ++i) { const int t = (tb + i * stride < T) ? tb + i * stride : tb;
#pragma unroll
            for (int j = 0; j < 2; ++j) { rx[i][j] = ((const u32x4*)(XB + (size_t)t * D) + lane)[64 * j]; ry0[i][j] = ((const u32x4*)(Y + (size_t)p0[i] * D) + lane)[64 * j]; ry1[i][j] = ((const u32x4*)(Y + (size_t)p1[i] * D) + lane)[64 * j]; } }
#pragma unroll
        for (int i = 0; i < 4; ++i) {
            const int t = tb + i * stride;
            if (t < T) {
                A4 v[4]; float q = 0.f;
#pragma unroll
                for (int j = 0; j < 2; ++j) { A4 a0, a1, b0, b1, c0, c1; unpack8(rx[i][j], a0, a1); unpack8(ry0[i][j], b0, b1); unpack8(ry1[i][j], c0, c1);
                    a0 += b0 + c0; a1 += b1 + c1; v[2 * j] = a0; v[2 * j + 1] = a1;
                    q += (a0[0] * a0[0] + a0[1] * a0[1]) + (a0[2] * a0[2] + a0[3] * a0[3]) + (a1[0] * a1[0] + a1[1] * a1[1]) + (a1[2] * a1[2] + a1[3] * a1[3]);
                    if (!OUT) ST16_OUT((u32x4*)(XBo + (size_t)t * D) + lane + 64 * j, pack8(a0, a1)); }
                q = wave_sum(q);
                if (lane < 16) ssn[(size_t)t * 16 + lane] = lane == 0 ? q : 0.f;
                const float rs = rsqrtf(q * (1.0f / D) + EPS);
                if (XN) { u32x4* xn = (u32x4*)(XN + (size_t)t * D) + lane;
#pragma unroll
                    for (int j = 0; j < 2; ++j) ST16_OUT(xn + 64 * j, pack8(v[2 * j] * rs, v[2 * j + 1] * rs)); }
                if (OUT) {
#pragma unroll
                    for (int j = 0; j < 2; ++j) { const int c0 = 8 * lane + 512 * j; const A4 g0 = *(const A4*)(fg + c0), g1 = *(const A4*)(fg + c0 + 4);
                        float* o = OUT + (size_t)t * D + c0; *(A4*)o = v[2 * j] * rs * g0; *(A4*)(o + 4) = v[2 * j + 1] * rs * g1; }
                }
            }
        }
    }
}
struct FixedOrder {
    static constexpr bool GATHER = false;
    int pm, pn;
    __device__ __forceinline__ bool next(int i, pg8::Unit& u) const { if (i != 0) return false; u.pm = pm; u.pn = pn; return true; }
    __device__ __forceinline__ void a_ready(const pg8::Unit&) const {}
    __device__ __forceinline__ void done(const pg8::Unit&) const {}
};
struct PairOrder {
    static constexpr bool GATHER = false;
    int pm, pn0, pn1;
    __device__ __forceinline__ bool next(int i, pg8::Unit& u) const { if (i > 1) return false; u.pm = pm; u.pn = i ? pn1 : pn0; return true; }
    __device__ __forceinline__ void a_ready(const pg8::Unit&) const {}
    __device__ __forceinline__ void done(const pg8::Unit&) const {}
};
struct EpiSoftmax {
    static constexpr bool PERM = true, AFTER_DRAIN = true, MIDK = false;
    bf16_t* P; const float* ss; int ld; float scale;
    __device__ __forceinline__ void fused(A4 (&acc)[2][2][4][2], const pg8::Unit& u, int wr, int wc, int fr, int fq, PG8_LAS unsigned char* lds, int wid, int lane) const {
        typedef float f32x2v __attribute__((ext_vector_type(2)));
        PG8_LAS f32x2v* X = (PG8_LAS f32x2v*)lds;
        float mw[2][4];
#pragma unroll
        for (int ai = 0; ai < 2; ++ai)
#pragma unroll
            for (int m = 0; m < 4; ++m) {
                const float rsc = rstd_of(ss, u.pm * 256 + ai * 128 + wr * 64 + m * 16 + fr, fq) * scale;
                float mx = -INFINITY;
#pragma unroll
                for (int bj = 0; bj < 2; ++bj)
#pragma unroll
                    for (int n = 0; n < 2; ++n)
#pragma unroll
                        for (int i = 0; i < 4; ++i) { acc[ai][bj][m][n][i] *= rsc; mx = fmaxf(mx, acc[ai][bj][m][n][i]); }
                mx = fmaxf(mx, swz_xor<16>(mx)); mx = max_xor32(mx);
                float s = 0.f;
#pragma unroll
                for (int bj = 0; bj < 2; ++bj)
#pragma unroll
                    for (int n = 0; n < 2; ++n)
#pragma unroll
                        for (int i = 0; i < 4; ++i) { const float e = __expf(acc[ai][bj][m][n][i] - mx); acc[ai][bj][m][n][i] = e; s += e; }
                s = add_xor32(add_xor16(s));
                mw[ai][m] = mx;
                if (fq == 0) X[(ai * 128 + wr * 64 + m * 16 + fr) * 4 + wc] = (f32x2v){mx, s};
            }
        asm volatile("s_waitcnt lgkmcnt(0)" ::: "memory"); __builtin_amdgcn_s_barrier(); asm volatile("" ::: "memory");
#pragma unroll
        for (int ai = 0; ai < 2; ++ai)
#pragma unroll
            for (int m = 0; m < 4; ++m) {
                const int r = ai * 128 + wr * 64 + m * 16 + fr;
                const f32x2v a = X[r * 4 + 0], b = X[r * 4 + 1], c = X[r * 4 + 2], d = X[r * 4 + 3];
                const float M = fmaxf(fmaxf(a.x, b.x), fmaxf(c.x, d.x));
                const float S = (a.y * __expf(a.x - M) + b.y * __expf(b.x - M)) + (c.y * __expf(c.x - M) + d.y * __expf(d.x - M));
                const float f = __expf(mw[ai][m] - M) * __builtin_amdgcn_rcpf(S);
#pragma unroll
                for (int bj = 0; bj < 2; ++bj) *(u32x4*)(P + (size_t)(u.pm * 256 + r) * ld + bj * 128 + wc * 32 + 8 * fq) = pack8(acc[ai][bj][m][0] * f, acc[ai][bj][m][1] * f);
            }
    }
};
typedef float f32x16 __attribute__((ext_vector_type(16)));
constexpr int RTAB = 640;
__device__ __forceinline__ bf16x8_t as_bf16x8(const u32x4 w) { return __builtin_bit_cast(bf16x8_t, w); }
constexpr float LOG2E = 1.4426950408889634f;
__device__ __forceinline__ void band_tables(const float* __restrict__ rel  , LAS float* Rt, int tid, int h_lo = 0, int nh = AH) {
    rel += h_lo * RELW;
    for (int i = tid; i < nh * RTAB; i += 512) { const int h = i / RTAB, k = i % RTAB; int r = 575 - k; r = r < -AMAXREL ? -AMAXREL : (r > AMAXREL ? AMAXREL : r); Rt[i] = rel[h * RELW + r + AMAXREL] * LOG2E; }
}
__device__ __forceinline__ void band_load_k(bf16x8_t (&Kf)[4], const bf16_t* __restrict__ AK, long kt, int lane) {
#pragma unroll
    for (int s = 0; s < 4; ++s) Kf[s] = *(const bf16x8_t*)(AK + ((kt * 4 + s) * 64 + lane) * 8);
}
__device__ __forceinline__ void band_load_v(u32x4 (&Vr)[2][2], const bf16_t* __restrict__ AVT, long kt, int lane) {
#pragma unroll
    for (int db = 0; db < 2; ++db)
#pragma unroll
        for (int s = 0; s < 2; ++s) Vr[db][s] = *(const u32x4*)(AVT + (((kt * 2 + db) * 2 + s) * 64 + lane) * 8);
}
__device__ __forceinline__ bf16x8_t band_v_frag(const u32x4 r) {
    const auto a = __builtin_amdgcn_permlane32_swap(r.x, r.z, false, false); const auto c = __builtin_amdgcn_permlane32_swap(r.y, r.w, false, false);
    return as_bf16x8((u32x4){a[0], c[0], a[1], c[1]});
}
__device__ __forceinline__ void band_item(int item, int lane, const bf16_t* __restrict__ AQ, const bf16_t* __restrict__ AK, const bf16_t* __restrict__ AVT, const LAS float* Rt  , bf16_t* __restrict__ OAB, int h_tab0 = 0) {
    const int n = item % NCH, h = (item / NCH) % AH, b = item / (NCH * AH);
    const int ql = lane & 31, hh = lane >> 5;
    const size_t tok0 = (size_t)b * L + (size_t)n * CH;
    bf16x8_t Qf[2][4];
#pragma unroll
    for (int qb = 0; qb < 2; ++qb)
#pragma unroll
        for (int s = 0; s < 4; ++s) Qf[qb][s] = *(const bf16x8_t*)(AQ + (((((long)(tok0 >> 5) + qb) * AH + h) * 4 + s) * 64 + lane) * 8);
    f32x16 O[2][2];
#pragma unroll
    for (int db = 0; db < 2; ++db)
#pragma unroll
        for (int qb = 0; qb < 2; ++qb)
#pragma unroll
            for (int r = 0; r < 16; ++r) O[db][qb][r] = 0.f;
    float mrun[2] = {-INFINITY, -INFINITY}, lrun[2] = {0.f, 0.f};
    const LAS float* Rh = Rt + (h - h_tab0) * RTAB + (31 - ql + 4 * hh);
    const float bias_far = Rt[(h - h_tab0) * RTAB];
    const int j_lo = (n < ALC ? 2 * (ALC - n) : 0), j_hi = 2 * ALC + 1;
    const long ktb = ((long)b * L + (long)(n - ALC) * CH) / 32 * AH + h;
    bf16x8_t Kf0[4], Kf1[4]; u32x4 Vf0[2][2], Vf1[2][2];
    f32x16 S[2];
#define BAND_CL(jj) (ktb + (long)((jj) <= j_hi ? (jj) : j_hi) * AH)
    band_load_k(Kf0, AK, BAND_CL(j_lo), lane);
    band_load_v(Vf0, AVT, BAND_CL(j_lo), lane);
    band_load_k(Kf1, AK, BAND_CL(j_lo + 1), lane);
    band_load_v(Vf1, AVT, BAND_CL(j_lo + 1), lane);
#define BAND_SCORES(jj, Kf) do { const LAS float* Rc_ = Rh + (jj) * 32; \
        _Pragma("unroll") for (int qb = 0; qb < 2; ++qb) { \
            if ((jj) < 8) { _Pragma("unroll") for (int r = 0; r < 16; ++r) S[qb][r] = bias_far; } \
            else { _Pragma("unroll") for (int r = 0; r < 16; ++r) S[qb][r] = Rc_[32 - 32 * qb + (r & 3) + 8 * (r >> 2)]; } \
            _Pragma("unroll") for (int s = 0; s < 4; ++s) S[qb] = __builtin_amdgcn_mfma_f32_32x32x16_bf16(Kf[s], Qf[qb][s], S[qb], 0, 0, 0); } } while (0)
#define BAND_SOFTMAX_PV(Vr) do { \
        bf16x8_t Vf[2][2]; \
        _Pragma("unroll") for (int db = 0; db < 2; ++db) _Pragma("unroll") for (int s = 0; s < 2; ++s) Vf[db][s] = band_v_frag(Vr[db][s]); \
        _Pragma("unroll") for (int qb = 0; qb < 2; ++qb) { \
            float mx = S[qb][0]; \
            _Pragma("unroll") for (int r = 1; r < 16; ++r) mx = fmaxf(mx, S[qb][r]); \
            mx = max_xor32(mx); \
            const float mn = fmaxf(mrun[qb], mx), alpha = __builtin_amdgcn_exp2f(mrun[qb] - mn); \
            mrun[qb] = mn; \
            float sum = 0.f; \
            _Pragma("unroll") for (int r = 0; r < 16; ++r) { const float p = __builtin_amdgcn_exp2f(S[qb][r] - mn); S[qb][r] = p; sum += p; } \
            lrun[qb] = lrun[qb] * alpha + add_xor32(sum); \
            _Pragma("unroll") for (int db = 0; db < 2; ++db) \
                _Pragma("unroll") for (int r = 0; r < 16; ++r) O[db][qb][r] *= alpha; \
            _Pragma("unroll") for (int s = 0; s < 2; ++s) { \
                u32x4 w; w.x = pkbf(S[qb][8 * s + 0], S[qb][8 * s + 1]); w.y = pkbf(S[qb][8 * s + 2], S[qb][8 * s + 3]); w.z = pkbf(S[qb][8 * s + 4], S[qb][8 * s + 5]); w.w = pkbf(S[qb][8 * s + 6], S[qb][8 * s + 7]); \
                const bf16x8_t Pf = as_bf16x8(w); \
                _Pragma("unroll") for (int db = 0; db < 2; ++db) O[db][qb] = __builtin_amdgcn_mfma_f32_32x32x16_bf16(Vf[db][s], Pf, O[db][qb], 0, 0, 0); \
            } } } while (0)
    BAND_SCORES(j_lo, Kf0);
    band_load_k(Kf0, AK, BAND_CL(j_lo + 2), lane);
#pragma nounroll
    for (int j = j_lo; j <= j_hi; j += 2) {
        BAND_SOFTMAX_PV(Vf0);
        band_load_v(Vf0, AVT, BAND_CL(j + 2), lane);
        BAND_SCORES(j + 1, Kf1);
        band_load_k(Kf1, AK, BAND_CL(j + 3), lane);
        BAND_SOFTMAX_PV(Vf1);
        if (j + 2 <= j_hi) {
            band_load_v(Vf1, AVT, BAND_CL(j + 3), lane);
            BAND_SCORES(j + 2, Kf0);
            band_load_k(Kf0, AK, BAND_CL(j + 4), lane);
        }
    }
#undef BAND_SOFTMAX_PV
#undef BAND_CL
#undef BAND_SCORES
#pragma unroll
    for (int qb = 0; qb < 2; ++qb) {
        const float inv = 1.0f / lrun[qb];
        bf16_t* orow = OAB + (tok0 + 32 * qb + ql) * D + h * 64 + 4 * hh;
#pragma unroll
        for (int db = 0; db < 2; ++db)
#pragma unroll
            for (int g = 0; g < 4; ++g) { u32x2 o; o.x = pkbf(O[db][qb][4 * g] * inv, O[db][qb][4 * g + 1] * inv); o.y = pkbf(O[db][qb][4 * g + 2] * inv, O[db][qb][4 * g + 3] * inv);
                *(u32x2*)(orow + 32 * db + 8 * g) = o; }
    }
}
#ifndef MK_TS_A
#define MK_TS_A (-1)
#define MK_TS_B (-1)
#endif
#define GLA_TS(id) do { if (MK_TS_A >= 0 && ts && ((id) == MK_TS_A || (id) == MK_TS_B) && lane == 0) ts[(id) == MK_TS_B ? 1 : 0] = __builtin_amdgcn_s_memrealtime(); } while (0)
constexpr size_t DS_ITEM = 128 * 64;
__device__ __forceinline__ int rowmap32(int r, int hh) { return (r & 3) + 8 * (r >> 2) + 4 * hh; }

__device__ __forceinline__ float gla_scan_tile(const float* __restrict__ LOGA, size_t tok0, int h, int lane, LAS float* Gt) {
    const float* p = LOGA + tok0 * BKW + h * 64 + lane;
    float cum = 0.f;
#pragma unroll
    for (int t0 = 0; t0 < 64; t0 += 16) {
        float la[16];
#pragma unroll
        for (int i = 0; i < 16; ++i) la[i] = p[(size_t)(t0 + i) * BKW];
#pragma unroll
        for (int i = 0; i < 16; ++i) { cum += la[i]; Gt[(t0 + i) * 64 + lane] = cum; }
    }
    asm volatile("s_waitcnt lgkmcnt(0)" ::: "memory");
    return cum;
}

__device__ __forceinline__ void gla1_item(int idx, int lane, LAS float* Gt, const bf16_t* __restrict__ BK, const bf16_t* __restrict__ BVT, const float* __restrict__ LOGA, float* __restrict__ DS, float* __restrict__ DEC) {
    const int c = idx & 127, h = (idx >> 7) & 3, b = idx >> 9;
    const size_t tok0 = (size_t)b * L + (size_t)c * CH;
    const int ql = lane & 31, hh = lane >> 5;
    LAS bf16_t* Kt = (LAS bf16_t*)(Gt + 64 * 64);
    {
        u32x4 kr[8];
#pragma unroll
        for (int i = 0; i < 8; ++i) kr[i] = *(const u32x4*)(BK + (tok0 + 8 * i + (lane >> 3)) * BKW + h * 64 + (lane & 7) * 8);
#pragma unroll
        for (int i = 0; i < 8; ++i) *(LAS u32x4*)(Kt + (8 * i + (lane >> 3)) * 64 + (lane & 7) * 8) = kr[i];
    }
    const float last = gla_scan_tile(LOGA, tok0, h, lane, Gt);
    DEC[(size_t)idx * 64 + lane] = __expf(last);
    bf16x8_t Xf[2][2][2];
#pragma unroll
    for (int kb = 0; kb < 2; ++kb) {
        const float lk = __int_as_float(shfl_idx(__float_as_int(last), 32 * kb + ql));
#pragma unroll
        for (int tb = 0; tb < 2; ++tb) {
            float x[16];
#pragma unroll
            for (int r = 0; r < 16; ++r) { const int t = 32 * tb + rowmap32(r, hh);
                x[r] = bf2f(Kt[t * 64 + 32 * kb + ql]) * __expf(lk - Gt[t * 64 + 32 * kb + ql]); }
#pragma unroll
            for (int s = 0; s < 2; ++s) { u32x4 w; w.x = pkbf(x[8 * s], x[8 * s + 1]); w.y = pkbf(x[8 * s + 2], x[8 * s + 3]); w.z = pkbf(x[8 * s + 4], x[8 * s + 5]); w.w = pkbf(x[8 * s + 6], x[8 * s + 7]); Xf[tb][kb][s] = as_bf16x8(w); }
        }
    }
    const bf16_t* vbase = BVT + (size_t)(h * 128 + ql) * T + tok0 + 8 * hh;
    float* dsb = DS + (size_t)idx * DS_ITEM;
#pragma unroll
    for (int vb = 0; vb < 4; ++vb) {
        bf16x8_t Vf[2][2];
#pragma unroll
        for (int tb = 0; tb < 2; ++tb)
#pragma unroll
            for (int s = 0; s < 2; ++s) Vf[tb][s] = band_v_frag(*(const u32x4*)(vbase + (size_t)(32 * vb) * T + 32 * tb + 16 * s));
#pragma unroll
        for (int kb = 0; kb < 2; ++kb) {
            f32x16 acc;
#pragma unroll
            for (int r = 0; r < 16; ++r) acc[r] = 0.f;
#pragma unroll
            for (int tb = 0; tb < 2; ++tb)
#pragma unroll
                for (int s = 0; s < 2; ++s) acc = __builtin_amdgcn_mfma_f32_32x32x16_bf16(Vf[tb][s], Xf[tb][kb][s], acc, 0, 0, 0);
#pragma unroll
            for (int r = 0; r < 16; ++r) dsb[(size_t)(32 * vb + rowmap32(r, hh)) * 64 + 32 * kb + ql] = acc[r];
        }
    }
}

__device__ __forceinline__ void gla2_scan(int e, const float* __restrict__ DS, const float* __restrict__ DEC, bf16_t* __restrict__ SB) {
    const int k = e & 63, v = (e >> 6) & 127, bh = e >> 13;
    const size_t base = (size_t)bh * 128;
    float S = 0.f;
#pragma unroll 1
    for (int c0 = 0; c0 < 128; c0 += 8) {
        float d[8], a[8];
#pragma unroll
        for (int i = 0; i < 8; ++i) { d[i] = DS[(base + c0 + i) * DS_ITEM + (size_t)v * 64 + k]; a[i] = DEC[(base + c0 + i) * 64 + k]; }
#pragma unroll
        for (int i = 0; i < 8; ++i) { SB[(base + c0 + i) * DS_ITEM + (size_t)v * 64 + k] = f2bf(S); S = a[i] * S + d[i]; }
    }
}

__device__ __forceinline__ void gla3_unit(int unit, int lane, LAS float* Gt, const bf16_t* __restrict__ BQ, const bf16_t* __restrict__ BK, const bf16_t* __restrict__ BVT, const float* __restrict__ LOGA,
                                          const bf16_t* __restrict__ SB, const bf16_t* __restrict__ BRS, const float* __restrict__ gnorm, bf16_t* __restrict__ OAB, volatile LAS unsigned long long* ts = nullptr) {
    const int tb = unit & 1, idx = unit >> 1;
    const int c = idx & 127, h = (idx >> 7) & 3, b = idx >> 9;
    const size_t tok0 = (size_t)b * L + (size_t)c * CH;
    const int ql = lane & 31, hh = lane >> 5;
    GLA_TS(40);
    (void)gla_scan_tile(LOGA, tok0, h, lane, Gt);
    GLA_TS(41);
    bf16x8_t Qf[4];
    {
        const int t = 32 * tb + ql;
#pragma unroll
        for (int s = 0; s < 4; ++s) {
            const u32x4 q = *(const u32x4*)(BQ + (tok0 + t) * BKW + h * 64 + 16 * s + 8 * hh);
            const f32x4 g0 = *(const LAS f32x4*)(Gt + t * 64 + 16 * s + 8 * hh), g1 = *(const LAS f32x4*)(Gt + t * 64 + 16 * s + 8 * hh + 4);
            u32x4 w; w.x = pkbf(bflo(q.x) * __expf(g0[0]), bfhi(q.x) * __expf(g0[1])); w.y = pkbf(bflo(q.y) * __expf(g0[2]), bfhi(q.y) * __expf(g0[3]));
            w.z = pkbf(bflo(q.z) * __expf(g1[0]), bfhi(q.z) * __expf(g1[1])); w.w = pkbf(bflo(q.w) * __expf(g1[2]), bfhi(q.w) * __expf(g1[3]));
            Qf[s] = as_bf16x8(w);
        }
    }
    bf16x8_t Pf[2][2];
#pragma unroll
    for (int sb = 0; sb < 2; ++sb) {
        if (sb <= tb) {
            const int srow = 32 * sb + ql;
            f32x16 A;
#pragma unroll
            for (int r = 0; r < 16; ++r) A[r] = 0.f;
#pragma unroll
            for (int s = 0; s < 4; ++s) {
                const u32x4 kx = *(const u32x4*)(BK + (tok0 + srow) * BKW + h * 64 + 16 * s + 8 * hh);
                const f32x4 g0 = *(const LAS f32x4*)(Gt + srow * 64 + 16 * s + 8 * hh), g1 = *(const LAS f32x4*)(Gt + srow * 64 + 16 * s + 8 * hh + 4);
                u32x4 w; w.x = pkbf(bflo(kx.x) * __expf(-g0[0]), bfhi(kx.x) * __expf(-g0[1])); w.y = pkbf(bflo(kx.y) * __expf(-g0[2]), bfhi(kx.y) * __expf(-g0[3]));
                w.z = pkbf(bflo(kx.z) * __expf(-g1[0]), bfhi(kx.z) * __expf(-g1[1])); w.w = pkbf(bflo(kx.w) * __expf(-g1[2]), bfhi(kx.w) * __expf(-g1[3]));
                A = __builtin_amdgcn_mfma_f32_32x32x16_bf16(as_bf16x8(w), Qf[s], A, 0, 0, 0);
            }
            if (sb == tb) {
#pragma unroll
                for (int r = 0; r < 16; ++r) A[r] = (rowmap32(r, hh) <= ql) ? A[r] : 0.f;
            }
#pragma unroll
            for (int s2 = 0; s2 < 2; ++s2) { u32x4 w; w.x = pkbf(A[8 * s2], A[8 * s2 + 1]); w.y = pkbf(A[8 * s2 + 2], A[8 * s2 + 3]); w.z = pkbf(A[8 * s2 + 4], A[8 * s2 + 5]); w.w = pkbf(A[8 * s2 + 6], A[8 * s2 + 7]); Pf[sb][s2] = as_bf16x8(w); }
        }
    }
    GLA_TS(42);
    const int c16 = lane & 15, tr = lane >> 4;
    u32x4 bwv[8];
#pragma unroll
    for (int i = 0; i < 8; ++i) bwv[i] = *(const u32x4*)(BRS + (tok0 + 32 * tb + 4 * i + tr) * BVW + h * 128 + 8 * c16);
    f32x16 O[4];
    const bf16_t* vbase = BVT + (size_t)(h * 128 + ql) * T + tok0 + 8 * hh;
    const bf16_t* sbase = SB + (size_t)idx * DS_ITEM + (size_t)ql * 64 + 8 * hh;
#pragma unroll
    for (int vb = 0; vb < 4; ++vb) {
#pragma unroll
        for (int r = 0; r < 16; ++r) O[vb][r] = 0.f;
#pragma unroll
        for (int s = 0; s < 4; ++s) { const bf16x8_t Sf = *(const bf16x8_t*)(sbase + (size_t)(32 * vb) * 64 + 16 * s); O[vb] = __builtin_amdgcn_mfma_f32_32x32x16_bf16(Sf, Qf[s], O[vb], 0, 0, 0); }
#pragma unroll
        for (int sb = 0; sb < 2; ++sb) {
            if (sb <= tb) {
#pragma unroll
                for (int s2 = 0; s2 < 2; ++s2) { const u32x4 vr = *(const u32x4*)(vbase + (size_t)(32 * vb) * T + 32 * sb + 16 * s2);
                    O[vb] = __builtin_amdgcn_mfma_f32_32x32x16_bf16(band_v_frag(vr), Pf[sb][s2], O[vb], 0, 0, 0); }
            }
        }
    }
    GLA_TS(43);
    float q = 0.f;
#pragma unroll
    for (int vb = 0; vb < 4; ++vb)
#pragma unroll
        for (int r = 0; r < 16; ++r) q += O[vb][r] * O[vb][r];
    const float rs = rsqrtf(add_xor32(q) * (1.0f / 128.0f) + EPS);
    asm volatile("s_waitcnt lgkmcnt(0)" ::: "memory");
#pragma unroll
    for (int vb = 0; vb < 4; ++vb)
#pragma unroll
        for (int g4 = 0; g4 < 4; ++g4) {
            const int v0 = 32 * vb + 8 * g4 + 4 * hh; const f32x4 gv = *(const f32x4*)(gnorm + v0);
            f32x4 o; o[0] = O[vb][4 * g4] * rs * gv[0]; o[1] = O[vb][4 * g4 + 1] * rs * gv[1]; o[2] = O[vb][4 * g4 + 2] * rs * gv[2]; o[3] = O[vb][4 * g4 + 3] * rs * gv[3];
            *(LAS f32x4*)(Gt + ql * 128 + (((v0 >> 2) ^ ql) << 2)) = o;
        }
    asm volatile("s_waitcnt lgkmcnt(0)" ::: "memory");
    {
#pragma unroll
        for (int i = 0; i < 8; ++i) {
            const int t = 4 * i + tr; const size_t trow = tok0 + 32 * tb + t;
            const u32x4 bw = bwv[i];
            const f32x4 a0 = *(const LAS f32x4*)(Gt + t * 128 + (((2 * c16) ^ t) << 2)), a1 = *(const LAS f32x4*)(Gt + t * 128 + (((2 * c16 + 1) ^ t) << 2));
            u32x4 o; o.x = pkbf(a0[0] * bflo(bw.x), a0[1] * bfhi(bw.x)); o.y = pkbf(a0[2] * bflo(bw.y), a0[3] * bfhi(bw.y)); o.z = pkbf(a1[0] * bflo(bw.z), a1[1] * bfhi(bw.z)); o.w = pkbf(a1[2] * bflo(bw.w), a1[3] * bfhi(bw.w));
            st16_wt(OAB + trow * D + 512 + h * 128 + 8 * c16, o);
        }
    }
    GLA_TS(44);
}
#ifndef MK_TS_PHASE
#define MK_TS_PHASE (-1)
#define MK_TS_MODE 0
#endif
#ifndef MK_SIMD_W
#define MK_SIMD_W (-1)
#endif
#ifndef MK_ROLE_SWAP
#define MK_ROLE_SWAP 0
#endif
#ifndef MK_TS_WG
#define MK_TS_WG 0
#endif
#define TS_MARKW(id, w) do { if (MK_TS_A >= 0 && l == 0 && ((id) == MK_TS_A || (id) == MK_TS_B) && tid_of(opaque_int(wv0)) == (w) * 64) TS_[(id) == MK_TS_B ? 1 : 0] = __builtin_amdgcn_s_memrealtime(); } while (0)
#define TS_MARK(id) do { if (MK_TS_A >= 0 && l == 0 && ((id) == MK_TS_A || (id) == MK_TS_B) && tid_of(opaque_int(wv0)) == 0) TS_[(id) == MK_TS_B ? 1 : 0] = __builtin_amdgcn_s_memrealtime(); } while (0)
#ifndef MK_REP_PHASE
#define MK_REP_PHASE (-1)
#define MK_REP_N 1
#endif
#ifndef MK_PANEL_TEST
#define MK_PANEL_TEST 0
#endif
#ifndef MK_LAUNCHES
#define MK_LAUNCHES 1
#endif
constexpr int RING_BYTES = 131072, MISC_OFF = RING_BYTES + 512, LDS_BYTES = 147456;
constexpr int CW_BAR = 1024;
constexpr size_t CTL_ZERO_BYTES = 128 * 1024;
constexpr int CW_PANEL = 8192;
static_assert((CW_BAR + XCD_BAR_WORDS) * 4 <= (int)CTL_ZERO_BYTES, "barrier words inside the memset region");
constexpr int N_PHASES = 1 + 6 * DEPTH;

struct MKArgs { InPtrs in; unsigned char* ws; unsigned char* dout; int ph_lo, ph_hi, rep_phase, rep_n; };

__global__ void __launch_bounds__(512, 2) mk_fwd(MKArgs a) {
    extern __shared__ __attribute__((aligned(16))) unsigned char lds_raw[];
    LAS unsigned char* lds = (LAS unsigned char*)lds_raw;
    const int G0 = (int)gridDim.x, vcu0 = (int)blockIdx.x;
    const int wv0 = __builtin_amdgcn_readfirstlane((int)threadIdx.x >> 6);
    volatile LAS unsigned* MISC = (volatile LAS unsigned*)(lds + MISC_OFF);
    if (threadIdx.x < 16) MISC[threadIdx.x] = 0u;
    __syncthreads();
    const bool one_launch = (a.ph_hi - a.ph_lo) > 1;
    XcdBarrier bar; bar.bar = (unsigned*)(a.ws + WS_CTL) + CW_BAR; bar.x = 0; bar.st = MISC + 8;
    if (one_launch) bar = xcd_barrier_post((unsigned*)(a.ws + WS_CTL) + CW_BAR, MISC + 8);

    const InPtrs& in = a.in;
#define SS ((float*)(ws + WS_SSP))
#define XB ((bf16_t*)(ws + WS_XB))
#define AQ ((bf16_t*)(ws + WS_AQ))
#define AK ((bf16_t*)(ws + WS_AK))
#define AVT ((bf16_t*)(ws + WS_AVT))
#define XN ((bf16_t*)(ws + WS_XN))
#define BQ ((bf16_t*)(ws + WS_BQ))
#define BK ((bf16_t*)(ws + WS_BK))
#define BVT ((bf16_t*)(ws + WS_BVT))
#define BRS ((bf16_t*)(ws + WS_BRS))
#define GA ((bf16_t*)(ws + WS_GA))
#define GB ((bf16_t*)(dout + DO_GB))
#define MG ((bf16_t*)(ws + WS_MG))
#define Q ((bf16_t*)(dout + DO_OAB))
#define MEMN ((bf16_t*)(ws + WS_MEMN))
#define KVB ((bf16_t*)(ws + WS_KVB))
#define LOGA ((float*)(ws + WS_LOGA))
#define OAB ((bf16_t*)(dout + DO_OAB))
#define DSF ((float*)(dout + DO_ST))
#define DEC ((float*)(ws + WS_DEC))
#define SBB ((bf16_t*)(ws + WS_SB))
#define TMP ((bf16_t*)(ws + WS_TMP))
#define SELE ((int*)(ws + WS_SEL))
#define SELW ((float*)(ws + WS_SEL + (size_t)T * 2 * 4))
#define WD(l) (ws + WS_WDENSE + (size_t)(l) * WDENSE_STRIDE)
#define SSA(i) (SS + (size_t)(i) * T * 16)
#define MK_EP(l, t0) EpiProj{AQ, AK, BQ, BK, BRS, GA, GB, LOGA, in.gla_b_alpha + (size_t)(l) * BKW, (t0), 0}
    int ph = 0;
    volatile LAS unsigned long long* TS_ = (volatile LAS unsigned long long*)(lds + RING_BYTES + 640);
#define PH_ON (ph >= a.ph_lo && ph < a.ph_hi)
#define PH_RUN for (int rep_ = (PH_ON ? (ph == a.rep_phase ? a.rep_n : 1) : 0); rep_ > 0; --rep_)
#define PH_PTRS const int G = opaque_int(G0), vcu = opaque_int(vcu0), wv = opaque_int(wv0); (void)G; (void)vcu; unsigned char* ws = opaque_ptr(a.ws); unsigned char* dout = opaque_ptr(a.dout); (void)ws; (void)dout; const int tid = tid_of(wv), lane = tid & 63, wave = wv; (void)lane; (void)wave;
#define PH_END do { if (MK_TS_PHASE >= 0 && ph == MK_TS_PHASE && MK_TS_MODE == 1 && tid_of(opaque_int(wv0)) == 0) TS_[1] = __builtin_amdgcn_s_memrealtime(); \
    if (PH_ON && ph + 1 < a.ph_hi) xcd_barrier(bar, tid_of(opaque_int(wv0)) == 0); \
    if (MK_TS_PHASE >= 0 && ph == MK_TS_PHASE && MK_TS_MODE == 0 && tid_of(opaque_int(wv0)) == 0) TS_[1] = __builtin_amdgcn_s_memrealtime(); \
    if (MK_TS_PHASE >= 0 && ph + 1 == MK_TS_PHASE && tid_of(opaque_int(wv0)) == 0) TS_[0] = __builtin_amdgcn_s_memrealtime(); ++ph; } while (0)
#define GEMM_AT(EpiT, gm, ep, cc) do { pg8::StaticOrder S_; S_.init((gm).M, (gm).N, G, (cc)); pg8::gemm_phase<EpiT, pg8::StaticOrder, true, true>(lds, gm, S_, ep, wv); } while (0)
#define GEMM(EpiT, gm, ep) do { pg8::StaticOrder S_; S_.init((gm).M, (gm).N, G, vcu); pg8::gemm_phase<EpiT, pg8::StaticOrder, true, true>(lds, gm, S_, ep, wv); } while (0)

    PH_RUN { PH_PTRS ph_prologue(in, ws, lds, vcu, G, wv);
        LAS float* scr = (LAS float*)(lds + wave * 16384);
        if (G != 256) conv_expert_items(in, ws, 0, DEPTH * NE * 384, vcu * 8 + wave, G * 8, scr, lane);
        conv_router(in, ws, vcu, G, tid); }
    PH_END;

#pragma nounroll
    for (int l = 0; l < DEPTH; ++l) {
        PH_RUN { PH_PTRS
            {
                const bf16_t* Wkv = (const bf16_t*)(WD(l) + WD_WXKV);
                { const pg8::Gemm g{MEMN, Wkv, NB * NMEM, D, D, D, D, 0}; const EpiScale e{KVB + (size_t)l * 2 * NB * NMEM * D, nullptr, D, 1.0f, 1, 0}; GEMM_AT(EpiScale, g, e, (vcu + G - (G > 128 ? 64 : 0)) % G); }
                { const pg8::Gemm g{MEMN, Wkv + (size_t)D * D, NB * NMEM, D, D, D, D, 0}; const EpiScale e{KVB + (size_t)l * 2 * NB * NMEM * D + (size_t)NB * NMEM * D, nullptr, D, 1.0f, 1, 0}; GEMM_AT(EpiScale, g, e, (vcu + G - (G > 128 ? 72 : 0)) % G); }
            }
            { const pg8::Gemm g{XN, (const bf16_t*)(WD(l) + WD_WIN), T, NPROJ_A, D, D, D, 0}; const EpiProj e = MK_EP(l, 0); GEMM(EpiProj, g, e); }
            { const pg8::Gemm g{(const bf16_t*)(WD(l) + WD_WIN) + (size_t)NPROJ_A * D, XN, NPROJ_V, T, D, D, D, 0}; const EpiVT e{AVT, AVT + (size_t)512 * T}; GEMM(EpiVT, g, e); }
            if (l == 0 && G == 256 && vcu >= 80) {
                LAS float* scr = (LAS float*)(lds + wave * 16384);
                conv_dense_layer(in, ws, 1, (vcu - 80) * 8 + wave, 176 * 8, (vcu - 80) * 512 + tid, 176 * 512, scr, lane);
                __syncthreads();
            }
        }
        PH_END;
        PH_RUN { PH_PTRS
            LAS float* Rt = (LAS float*)lds;
            const int rw = MK_ROLE_SWAP ? ((wave >> 1) | ((wave & 1) << 2)) : wave;
            const bool fill = (G == 256);
            const int h0 = fill ? ((vcu * 8) / NCH) % AH : 0;
            TS_MARK(30);
            band_tables(in.rel_bias + (size_t)l * AH * RELW, Rt, tid, h0, fill ? 1 : AH);
            __syncthreads();
            const int xit0 = l * NE * 384 + vcu * 48;
            if (fill) {
                const bool conv_first = ((vcu >> 3) & 1) != 0;
#define MK_HBM_PART do { \
                    if (rw < 4) { \
                        LAS float* Gt = (LAS float*)(lds + 32768 + rw * 24576);        \
                        _Pragma("nounroll") for (int it = vcu * 4 + rw; it < NB * BH * NCH; it += G * 4) gla1_item(it, lane, Gt, BK, BVT, LOGA, DSF, DEC); \
                        conv_expert_run(in, ws, xit0 + rw * 4, 4, Gt, lane); \
                    } else { \
                        LAS float* scr = (rw < 7) ? (LAS float*)(lds + 2560 + (rw - 4) * 8448) : (LAS float*)(lds + RING_BYTES + 4096); \
                        conv_expert_run(in, ws, xit0 + 16 + (rw - 4) * 8, 8, scr, lane); \
                    } } while (0)
                if (conv_first) MK_HBM_PART;
                band_item(vcu * 8 + rw, lane, AQ, AK, AVT, Rt, OAB, h0);
                TS_MARKW(33, 4);
                if (!conv_first) MK_HBM_PART;
                TS_MARKW(34, 4);
                TS_MARKW(32, 0);
#undef MK_HBM_PART
            } else {
                if (rw < 4) {
                    LAS float* Gt = (LAS float*)(lds + 32768 + rw * 24576);
#pragma nounroll
                    for (int it = vcu * 4 + rw; it < NB * BH * NCH; it += G * 4) gla1_item(it, lane, Gt, BK, BVT, LOGA, DSF, DEC);
                }
#pragma nounroll
                for (int it = vcu * 8 + rw; it < NB * AH * NCH; it += G * 8) band_item(it, lane, AQ, AK, AVT, Rt, OAB);
            }
        }
        PH_END;
        PH_RUN { PH_PTRS
            if (G == 256) { if (vcu >= 64) for (int e2 = (vcu - 64) * 512 + tid; e2 < NB * BH * 128 * 64; e2 += 192 * 512) gla2_scan(e2, DSF, DEC, SBB); }
            else for (int e2 = vcu * 512 + tid; e2 < NB * BH * 128 * 64; e2 += G * 512) gla2_scan(e2, DSF, DEC, SBB);
            __syncthreads();
            const bf16_t* KBl = KVB + (size_t)l * 2 * NB * NMEM * D; const bf16_t* VBl = KBl + (size_t)NB * NMEM * D;
#pragma nounroll
            for (int j = 0; j < NB * XH; ++j) {
                const int b = j >> 2, h = j & 3;
                { const pg8::Gemm g{KBl + (size_t)(b * NMEM) * D + h * XD, (const bf16_t*)(WD(l) + WD_WXQ) + h * XD, NMEM, D, XD, D, D, 0};
                  const EpiScale e{(bf16_t*)(ws + WS_MT) + (size_t)(j * NMEM) * D, nullptr, D, 1.0f, 1, 0}; GEMM_AT(EpiScale, g, e, (vcu + G - 4 * j) % G); }
                { const pg8::Gemm g{(const bf16_t*)(WD(l) + WD_WXO) + h * XD, VBl + (size_t)(b * NMEM) * D + h * XD, D, NMEM, XD, D, D, 0};
                  const EpiScale e{(bf16_t*)(ws + WS_NT) + (size_t)b * D * D + h * XD, nullptr, D, 1.0f, 1, 0}; GEMM_AT(EpiScale, g, e, (vcu + G - 32 - 4 * j) % G); }
            }
        }
        PH_END;
        PH_RUN { PH_PTRS
            pg8::StaticOrder S0; S0.init(T, D, G, vcu); pg8::Unit u;
            if (G == 256 && S0.next(0, u)) {
                unsigned* PC = (unsigned*)(ws + WS_CTL) + CW_PANEL + 16 * (l * 64 + u.pm);
#define P_ARRIVE(s) do { if (tid == 0) (void)xb_add(PC + 2048 * (s), 1u); } while (0)
#define P_WAIT(s) do { if (tid == 0) { unsigned sp_ = 0; while (xb_ld(PC + 2048 * (s)) < 4u) { __builtin_amdgcn_s_sleep(2); if (++sp_ > (1u << 20)) break; } \
                       __builtin_amdgcn_fence(__ATOMIC_ACQUIRE, "agent"); asm volatile("s_waitcnt vmcnt(0)" ::: "memory"); } __syncthreads(); } while (0)
                const int h = u.pn, b = u.pm >> 5;
                TS_MARK(0);
                {
                    LAS float* Gt = (LAS float*)(lds + wave * 16384);
                    const int idx = (b * BH + h) * NCH + (u.pm & 31) * 4 + (wave >> 1);
                    gla3_unit(idx * 2 + (wave & 1), lane, Gt, BQ, BK, BVT, LOGA, SBB, BRS, in.gla_norm_g + (size_t)l * 128, OAB, (MK_TS_A >= 0 && l == 0 && wave == 0) ? TS_ : nullptr);
                    asm volatile("s_waitcnt vmcnt(0)" ::: "memory"); __syncthreads();
                    P_ARRIVE(0);
                }
                TS_MARK(1);
                const bf16_t* Wg = (const bf16_t*)(WD(l) + WD_WIN) + (size_t)(NPROJ_A + NPROJ_V) * D;
                { const pg8::Gemm g{XN, Wg, T, NPROJ_B, D, D, D, 0}; const PairOrder F{u.pm, u.pn, 4 + u.pn}; const EpiProj e = MK_EP(l, 9); pg8::gemm_phase<EpiProj, PairOrder, true, true>(lds, g, F, e, wv); }
                P_ARRIVE(1);
                TS_MARK(2);
                if (tid == 0) { unsigned sp_ = 0; while (xb_ld(PC) < 4u || xb_ld(PC + 2048) < 4u) { __builtin_amdgcn_s_sleep(2); if (++sp_ > (1u << 20)) break; }
                    __builtin_amdgcn_fence(__ATOMIC_ACQUIRE, "agent"); asm volatile("s_waitcnt vmcnt(0)" ::: "memory"); }
                __syncthreads();
                TS_MARK(3);
                { const pg8::Gemm g{OAB, (const bf16_t*)(WD(l) + WD_WB), T, D, D, D, D, 0}; const FixedOrder F{u.pm, u.pn}; const EpiMerge e{GA, GB, MG}; pg8::gemm_phase<EpiMerge, FixedOrder, true, true>(lds, g, F, e, wv); }
                P_ARRIVE(2);
                TS_MARK(4);
                P_WAIT(2);
                TS_MARK(5);
                { const pg8::Gemm g{MG, (const bf16_t*)(WD(l) + WD_WMO), T, D, D, D, D, 0}; const FixedOrder F{u.pm, u.pn}; const EpiResid e{XB, XB, SSA(3 * l + 1)}; pg8::gemm_phase<EpiResid, FixedOrder, true, true>(lds, g, F, e, wv); }
                P_ARRIVE(3);
                TS_MARK(6);
                P_WAIT(3);
                TS_MARK(7);
                {
                    const pg8::Gemm g{XB, (const bf16_t*)(ws + WS_MT) + (size_t)((b * XH + h) * NMEM) * D, T, NMEM, D, D, D, 0}; const FixedOrder F{u.pm, 0}; const EpiSoftmax e{Q + h * XD, SSA(3 * l + 1), D, 0.0625f};
                    pg8::gemm_phase<EpiSoftmax, FixedOrder, false, true>(lds, g, F, e, wv);
                    asm volatile("s_waitcnt vmcnt(0)" ::: "memory"); __syncthreads();
                }
                P_ARRIVE(4);
                TS_MARK(8);
                P_WAIT(4);
                TS_MARK(9);
                { const pg8::Gemm g{Q, (const bf16_t*)(ws + WS_NT) + (size_t)b * D * D, T, D, D, D, D, 0}; const FixedOrder F{u.pm, u.pn}; const EpiResid e{XB, XB, SSA(3 * l + 2)}; pg8::gemm_phase<EpiResid, FixedOrder, true, true>(lds, g, F, e, wv); }
                P_ARRIVE(5);
                TS_MARK(10);
                P_WAIT(5);
                TS_MARK(11);
                ph_route(in, ws, lds, l, u.pm * 256 + u.pn * 64, wv, false);
                TS_MARK(12);
#undef P_ARRIVE
#undef P_WAIT
            }
        }
        PH_END;
        PH_RUN { PH_PTRS
            LAS int* tb = (LAS int*)(lds + RING_BYTES + 1024);
            moe_tables(ws, l, tb, vcu, wave, lane);
            const int nt = tb[64], n1 = 2 * nt, r1 = n1 > G ? n1 - G : 0, ne = nt < G / 2 ? nt : G / 2, nl = nt - ne, tot1 = r1 + ne + 4 * nl;
            const int* TOKS = (const int*)(ws + WS_TOK);
            unsigned* READY = (unsigned*)(ws + WS_CTL) + CW_READY + 16 * (l * NTMAX);
            const bf16_t* WGU = (const bf16_t*)(ws + WS_WEXP + (size_t)l * WEXP_STRIDE); const bf16_t* WDT = (const bf16_t*)(ws + WS_WEXP + (size_t)l * WEXP_STRIDE + 32 * MiB);
#pragma nounroll
            TS_MARK(20);
            for (int s = vcu - G; s < tot1; s += G) {
                const int u0 = (G == 256) ? (vcu & 7) * 32 + (vcu >> 3) : vcu;
                const int Lu = s < 0 ? u0 : (s < r1 ? G + s : -1);
                if (s < 0 && u0 >= n1) continue;
                if (Lu >= 0) {
                    const int rt = Lu >> 1, ex = __builtin_amdgcn_readfirstlane(tb[96 + rt]), tl = rt - __builtin_amdgcn_readfirstlane(tb[32 + ex]), cn = __builtin_amdgcn_readfirstlane(tb[ex]);
                    const pg8::Gemm g{XB, WGU, nt * 256, 512, D, D, D, 0};
                    const GatherOrder F{rt, ex * 2 + (Lu & 1), TOKS + (size_t)ex * T, tl, cn};
                    const EpiHid e{(bf16_t*)(ws + WS_HID), TOKS + (size_t)ex * T, (const float*)(ws + WS_SEL + SEL_RS), (const float*)(ws + WS_SEL + SEL_SELW), tl, cn};
                    pg8::gemm_phase<EpiHid, GatherOrder, true, true>(lds, g, F, e, wv);
                    if (tid == 0) (void)xb_add(READY + 16 * rt, 1u);
                    TS_MARK(s < 0 ? 21 : 22);
                } else {
                    int rt, j0, nj;
                    if (s - r1 < ne) { rt = s - r1; j0 = 0; nj = 4; } else { const int q = s - r1 - ne; rt = ne + (q >> 2); j0 = q & 3; nj = 1; }
                    if (tid == 0) { unsigned sp = 0; while (xb_ld(READY + 16 * rt) < 2u) { __builtin_amdgcn_s_sleep(2); if (++sp > (1u << 20)) break; }
                        __builtin_amdgcn_fence(__ATOMIC_ACQUIRE, "agent"); asm volatile("s_waitcnt vmcnt(0)" ::: "memory"); }
                    __syncthreads();
                    const int ex = __builtin_amdgcn_readfirstlane(tb[96 + rt]);
                    const pg8::Gemm g{(const bf16_t*)(ws + WS_HID), WDT, nt * 256, D, EF, EF, EF, 0};
                    const QuadOrder F{rt, ex * 4 + j0, nj};
                    const EpiY e{(bf16_t*)(ws + WS_XG)};
                    pg8::gemm_phase<EpiY, QuadOrder, true, true>(lds, g, F, e, wv);
                }
            }
        }
        PH_END;
        PH_RUN { PH_PTRS ph_combine(ws, l, vcu, G, (l + 1 < DEPTH) ? XN : nullptr, (l + 1 < DEPTH) ? nullptr : (float*)dout, in.final_g, wv, rep_ > 1 ? (bf16_t*)dout : XB); }
        PH_END;
    }
    if ((MK_TS_PHASE >= 0 || MK_TS_A >= 0) && blockIdx.x == MK_TS_WG && tid_of(opaque_int(wv0)) == 0) { asm volatile("s_waitcnt vmcnt(0)" ::: "memory"); ((float*)a.dout)[(size_t)MK_TS_WG * 8 * D] = (float)(TS_[1] - TS_[0]) * 0.01f; }
#undef PH_ON
#undef PH_RUN
#undef PH_PTRS
#undef PH_END
#undef GEMM
#undef GEMM_AT
#undef SS
#undef XB
#undef AQ
#undef AK
#undef AVT
#undef XN
#undef BQ
#undef BK
#undef BVT
#undef BRS
#undef GA
#undef GB
#undef MG
#undef Q
#undef MEMN
#undef KVB
#undef LOGA
#undef OAB
#undef DSF
#undef DEC
#undef SBB
#undef TMP
#undef SELE
#undef SELW
#undef WD
#undef SSA
#undef MK_EP
}

extern "C" void kernel_launch(void* const* d_in, const int* in_sizes, int n_in, void* d_out, int out_size, void* d_ws, size_t ws_size, hipStream_t stream) {
    static int grid = 0;
    if (grid == 0) {
        int dev = 0, cus = 0;
        if (hipGetDevice(&dev) != hipSuccess || hipDeviceGetAttribute(&cus, hipDeviceAttributeMultiprocessorCount, dev) != hipSuccess || cus <= 0) cus = 256;
        grid = 256;
        if (cus != 256) fprintf(stderr, "kernel_launch: device reports %d CUs; this kernel is built for 256\n", cus);
        if (hipFuncSetAttribute((const void*)mk_fwd, hipFuncAttributeMaxDynamicSharedMemorySize, LDS_BYTES) != hipSuccess) fprintf(stderr, "kernel_launch: hipFuncSetAttribute failed\n");
        int per_cu = 0;
        if (hipOccupancyMaxActiveBlocksPerMultiprocessor(&per_cu, (const void*)mk_fwd, 512, LDS_BYTES) != hipSuccess || per_cu < 1) fprintf(stderr, "kernel_launch: occupancy query says %d blocks per CU\n", per_cu);
        (void)hipGetLastError();
        if (ws_size < WS_END || n_in != 24) fprintf(stderr, "kernel_launch: unexpected ws_size %zu / n_in %d\n", ws_size, n_in);
    }
    MKArgs a{};
    { const float** p = (const float**)&a.in; for (int i = 0; i < 24; ++i) p[i] = (const float*)d_in[i]; }
    a.ws = (unsigned char*)d_ws; a.dout = (unsigned char*)d_out;
    (void)hipMemsetAsync((unsigned char*)d_ws + WS_CTL, 0, CTL_ZERO_BYTES, stream);
#if MK_LAUNCHES == 1
    a.ph_lo = 0; a.ph_hi = N_PHASES; a.rep_phase = MK_REP_PHASE; a.rep_n = MK_REP_N;
    hipLaunchKernelGGL(mk_fwd, dim3(grid), dim3(512), LDS_BYTES, stream, a);
#else
    for (int p = 0; p < N_PHASES; ++p) { a.ph_lo = p; a.ph_hi = p + 1; a.rep_phase = -1; a.rep_n = 1; hipLaunchKernelGGL(mk_fwd, dim3(grid), dim3(512), LDS_BYTES, stream, a); }
#endif
}
```

```cpp
#include <hip/hip_runtime.h>
#include <cstdint>
#include <cstdio>
#include <cmath>

namespace cfg {
constexpr int D = 1024, NB = 2, L = 8192, T = NB * L, DEPTH = 2;
constexpr int CH = 64, NMEM = 256, NCH = L / CH;
constexpr int AH = 8, AW = 512, ALC = 8, ABAND = 576, AMAXREL = 256, RELW = 2 * AMAXREL + 1;
constexpr int BH = 4, BKW = 256, BVW = 512, BR = 16;
constexpr int INW = 5136;
constexpr int XH = 4, XD = 256;
constexpr int NG = 4, EPG = 8, NE = NG * EPG, EF = 256;
constexpr float EPS = 1e-6f;
constexpr int NPROJ_A = 9 * 256, NPROJ_V = 4 * 256, NPROJ_B = 8 * 256;

constexpr size_t MiB = 1u << 20;
constexpr size_t WS_CTL = 0, CTL_BYTES = 2 * MiB;
constexpr size_t WS_WDENSE = 2 * MiB, WDENSE_STRIDE = 23 * MiB;
constexpr size_t WD_WIN = 0, WD_WB = 11 * MiB, WD_WMO = 13 * MiB, WD_WXQ = 15 * MiB, WD_WXKV = 17 * MiB, WD_WXO = 21 * MiB;
constexpr size_t WS_WEXP = 48 * MiB, WEXP_STRIDE = 48 * MiB;
constexpr size_t WS_XB = 144 * MiB;
constexpr size_t WS_XN = 176 * MiB;
constexpr size_t WS_MIX = 208 * MiB;
constexpr size_t WS_AQ = WS_MIX, WS_AK = WS_MIX + 16 * MiB, WS_AVT = WS_MIX + 32 * MiB, WS_BVT = WS_MIX + 48 * MiB, WS_BQ = WS_MIX + 64 * MiB, WS_BK = WS_MIX + 72 * MiB,
                 WS_BRS = WS_MIX + 80 * MiB, WS_LOGA = WS_MIX + 96 * MiB;
constexpr size_t WS_SB = WS_AQ;
constexpr size_t WS_GA = WS_MIX + 16 * MiB, WS_TMP = WS_MIX + 48 * MiB, WS_MG = WS_XN;
constexpr size_t WS_XG = WS_MIX, WS_HID = WS_MIX + 80 * MiB;
constexpr size_t WS_MEMN = 320 * MiB, WS_KVB = 321 * MiB;
constexpr size_t WS_SEL = 325 * MiB;
constexpr size_t WS_SSP = 326 * MiB;
constexpr size_t WS_DEC = 333 * MiB + 512 * 1024;
constexpr size_t WS_WR = 333 * MiB;
constexpr size_t WS_TOK = 334 * MiB;
constexpr size_t WS_MT = 336 * MiB, WS_NT = 340 * MiB;
constexpr size_t WS_END = 344 * MiB;
constexpr size_t DO_OAB = 0, DO_ST = 32 * MiB, DO_GB = 32 * MiB;
}
using namespace cfg;

#define LAS __attribute__((address_space(3)))
typedef unsigned short bf16_t;
typedef float f32x4 __attribute__((ext_vector_type(4)));
typedef unsigned u32x4 __attribute__((ext_vector_type(4)));
typedef unsigned u32x2 __attribute__((ext_vector_type(2)));

__device__ __forceinline__ float bf2f(unsigned short b) { return __uint_as_float((unsigned)b << 16); }
__device__ __forceinline__ float bflo(unsigned w) { return __uint_as_float(w << 16); }
__device__ __forceinline__ float bfhi(unsigned w) { return __uint_as_float(w & 0xffff0000u); }
__device__ __forceinline__ unsigned pkbf(float lo, float hi) { unsigned r; asm volatile("v_cvt_pk_bf16_f32 %0, %1, %2" : "=v"(r) : "v"(lo), "v"(hi)); return r; }
__device__ __forceinline__ unsigned short f2bf(float f) { return (unsigned short)(pkbf(f, 0.f) & 0xffffu); }
__device__ __forceinline__ float fsigmoid(float x) { return __builtin_amdgcn_rcpf(1.0f + __expf(-x)); }
__device__ __forceinline__ float fsilu(float x) { return x * fsigmoid(x); }
__device__ __forceinline__ float flogsigmoid(float x) { return fminf(x, 0.f) - __logf(1.0f + __expf(-fabsf(x))); }
template <int MASK> __device__ __forceinline__ float swz_xor(float v) { return __int_as_float(__builtin_amdgcn_ds_swizzle(__float_as_int(v), (MASK << 10) | 0x1f)); }
__device__ __forceinline__ float add_xor32(float v) { const auto r = __builtin_amdgcn_permlane32_swap(__float_as_uint(v), __float_as_uint(v), false, false); return __uint_as_float(r[0]) + __uint_as_float(r[1]); }
__device__ __forceinline__ float max_xor32(float v) { const auto r = __builtin_amdgcn_permlane32_swap(__float_as_uint(v), __float_as_uint(v), false, false); return fmaxf(__uint_as_float(r[0]), __uint_as_float(r[1])); }
__device__ __forceinline__ float add_xor16(float v) { return v + swz_xor<16>(v); }
__device__ __forceinline__ float wave_sum(float v) { v += swz_xor<1>(v); v += swz_xor<2>(v); v += swz_xor<4>(v); v += swz_xor<8>(v); v += swz_xor<16>(v); return add_xor32(v); }
__device__ __forceinline__ float wave_max(float v) { v = fmaxf(v, swz_xor<1>(v)); v = fmaxf(v, swz_xor<2>(v)); v = fmaxf(v, swz_xor<4>(v)); v = fmaxf(v, swz_xor<8>(v)); v = fmaxf(v, swz_xor<16>(v)); return max_xor32(v); }
__device__ __forceinline__ int shfl_idx(int v, int src_lane) { return __builtin_amdgcn_ds_bpermute(src_lane << 2, v); }
typedef __attribute__((address_space(1))) unsigned char* gbl_u8_ptr;
__device__ __forceinline__ unsigned char* opaque_ptr(unsigned char* p) { gbl_u8_ptr g = (gbl_u8_ptr)p; asm volatile("" : "+s"(g)); return (unsigned char*)g; }
__device__ __forceinline__ int lane_now() { unsigned z; asm volatile("v_mov_b32 %0, 0" : "=v"(z)); return (int)__builtin_amdgcn_mbcnt_hi(~0u, __builtin_amdgcn_mbcnt_lo(~0u, z)); }
__device__ __forceinline__ int opaque_int(int v) { asm volatile("" : "+s"(v)); return v; }
__device__ __forceinline__ int tid_of(int wv) { return (wv << 6) | lane_now(); }
__device__ __forceinline__ void st16_wt(void* p, const u32x4 v) { asm volatile("global_store_dwordx4 %0, %1, off sc1\n\ts_nop 1" :: "v"(p), "v"(v) : "memory"); }
#ifndef MK_WT
#define MK_WT 1
#endif
#if MK_WT
#define ST16_OUT(p, v) st16_wt((void*)(p), (v))
#else
#define ST16_OUT(p, v) (*(u32x4*)(p) = (v))
#endif
namespace pg8 {
#define PG8_LAS __attribute__((address_space(3)))
typedef unsigned short bf16_t;
typedef short bf16x8 __attribute__((ext_vector_type(8)));
typedef float f32x4 __attribute__((ext_vector_type(4)));
typedef unsigned u32x4 __attribute__((ext_vector_type(4)));
constexpr int BM = 256, BK = 64, HALF = 128, HTB = HALF * BK * 2  , STAGE_BYTES = 8 * HTB, NXCD = 8, WGM = 8;

__host__ __device__ __forceinline__ int lds_byte(int r, int c) { const int st = (r >> 4) * 2 + (c >> 5), rr = r & 15, cc = c & 31, ob = rr * 64 + cc * 2; return st * 1024 + (ob ^ (((ob >> 9) & 1) << 5)); }
__host__ __device__ __forceinline__ void stage_rc(int b, int& R, int& C) { const int st = b / 1024, sb = b % 1024, swz = sb ^ (((sb >> 9) & 1) << 5); R = (st >> 1) * 16 + swz / 64; C = (st & 1) * 32 + (swz % 64) / 2; }
__host__ __device__ __forceinline__ int perm32(int rho) { const int n = rho >> 4, i = rho & 15; return 8 * (i >> 2) + 4 * n + (i & 3); }

struct Unit { int pm, pn; };
struct Gemm { const bf16_t* A; const bf16_t* Bt; int M, N, K, lda, ldb, pad; };

struct StaticOrder {
    static constexpr bool GATHER = false;
    int nM, nN, nwg, G, c;
    __host__ __device__ __forceinline__ void init(int M, int N, int G_, int c_) { nM = M / BM; nN = N / BM; nwg = nM * nN; G = G_; c = c_; }
    __host__ __device__ __forceinline__ bool next(int i, Unit& u) const {
        const long L = (long)i * G + c; if (L >= nwg) return false;
        int wgid = (int)L; { const int q = nwg / NXCD, r = nwg % NXCD, xcd = wgid % NXCD, off = wgid / NXCD; wgid = (xcd < r ? xcd * (q + 1) : r * (q + 1) + (xcd - r) * q) + off; }
        const int nig = WGM * nN, gid = wgid / nig, fm = gid * WGM, gsz = (nM - fm) < WGM ? (nM - fm) : WGM;
        u.pm = fm + ((wgid % nig) % gsz); u.pn = (wgid % nig) / gsz; return true;
    }
    __device__ __forceinline__ void a_ready(const Unit&) const {}
    __device__ __forceinline__ void done(const Unit&) const {}
};


template <class Epi, class Sched, bool ALIGN_EPI = false, bool SP2 = false>
__device__ __forceinline__ void gemm_phase(PG8_LAS unsigned char* lds, const Gemm g, const Sched& S, const Epi& E, const int wv  ) {
    const int tid = tid_of(wv), wid = wv, lane = tid & 63, wr = wid >> 2, wc = wid & 3, fr = lane & 15, fq = lane >> 4;
    const int K = g.K, nt = K / BK;
    unsigned voffA[2], voffA1[2], voffB[2];
#pragma unroll
    for (int i = 0; i < 2; ++i) { int R, C; stage_rc(tid * 16 + i * 8192, R, C); const int Rb = Epi::PERM ? ((R & ~31) + perm32(R & 31)) : R;
        voffA[i] = (unsigned)(R * g.lda + C) * 2u; voffA1[i] = voffA[i]; voffB[i] = (unsigned)(Rb * g.ldb + C) * 2u; }
    const size_t kstep = (size_t)(BK * 2);
    const size_t hstepA = Sched::GATHER ? 0 : (size_t)HALF * g.lda * 2, hstepB = (size_t)HALF * g.ldb * 2;
    const size_t tstepA = 2 * hstepA, tstepB = 2 * hstepB;
    const unsigned ldsw = (unsigned)wid * 1024u;
    const int aoff = lds_byte(wr * 64 + fr, fq * 8), boff = lds_byte(wc * 32 + fr, fq * 8);
#define PG8_SA(b, h) (((b) * 2 + (h)) * HTB)
#define PG8_SB(b, h) ((4 + (b) * 2 + (h)) * HTB)
#define PG8_STAGE(bufoff, gbase, voff) do { _Pragma("unroll") for (int _i = 0; _i < 2; ++_i) \
        __builtin_amdgcn_global_load_lds((const unsigned*)((const char*)(gbase) + (voff)[_i]), (PG8_LAS unsigned*)(lds + (bufoff) + ldsw + _i * 8192), 16, 0, 0); } while (0)
#define PG8_LDA(dst, b, h) do { _Pragma("unroll") for (int m = 0; m < 4; ++m) _Pragma("unroll") for (int k = 0; k < 2; ++k) dst[m][k] = *(const PG8_LAS bf16x8*)(lds + PG8_SA(b, h) + aoff + m * 2048 + k * 1024); } while (0)
#define PG8_LDB(dst, b, h) do { _Pragma("unroll") for (int n = 0; n < 2; ++n) _Pragma("unroll") for (int k = 0; k < 2; ++k) dst[n][k] = *(const PG8_LAS bf16x8*)(lds + PG8_SB(b, h) + boff + n * 2048 + k * 1024); } while (0)
#define PG8_MMA(ai, bj, At, Bt) do { __builtin_amdgcn_s_setprio(1); _Pragma("unroll") for (int m = 0; m < 4; ++m) _Pragma("unroll") for (int n = 0; n < 2; ++n) _Pragma("unroll") for (int k = 0; k < 2; ++k) \
        acc[ai][bj][m][n] = __builtin_amdgcn_mfma_f32_16x16x32_bf16(Bt[n][k], At[m][k], acc[ai][bj][m][n], 0, 0, 0); __builtin_amdgcn_s_setprio(0); } while (0)
#define PG8_WAIT_V(n) asm volatile("s_waitcnt vmcnt(" #n ")" ::: "memory")
#define PG8_WAIT_L(n) asm volatile("s_waitcnt lgkmcnt(" #n ")" ::: "memory")
#define PG8_BAR __builtin_amdgcn_s_barrier()
#define PG8_SCHED __builtin_amdgcn_sched_barrier(0)
    Unit cur, nxt; int ui = 0;
    if (!S.next(0, cur)) return;
    if constexpr (Sched::GATHER) {
#pragma unroll
        for (int i = 0; i < 2; ++i) { int R, C; stage_rc(tid * 16 + i * 8192, R, C);
            voffA[i] = (unsigned)(S.arow(R) * g.lda + C) * 2u; voffA1[i] = (unsigned)(S.arow(R + HALF) * g.lda + C) * 2u; }
    }
    f32x4 acc[2][2][4][2];
#pragma unroll
    for (int a = 0; a < 2; ++a)
#pragma unroll
        for (int b = 0; b < 2; ++b)
#pragma unroll
            for (int m = 0; m < 4; ++m)
#pragma unroll
                for (int n = 0; n < 2; ++n) acc[a][b][m][n] = (f32x4){0.f, 0.f, 0.f, 0.f};
    bf16x8 At[4][2], B0[2][2], B1[2][2];
    const char* cA = (const char*)g.A + (size_t)cur.pm * tstepA; const char* cB = (const char*)g.Bt + (size_t)cur.pn * tstepB;
    S.a_ready(cur);
    if constexpr (SP2) {
        PG8_STAGE(PG8_SB(0, 0), cB, voffB); PG8_STAGE(PG8_SB(0, 1), cB + hstepB, voffB); PG8_STAGE(PG8_SA(0, 0), cA, voffA); PG8_STAGE(PG8_SA(0, 1), cA + hstepA, voffA1);
        if (wr == 1) PG8_BAR;
        PG8_WAIT_V(2); PG8_BAR;
        PG8_STAGE(PG8_SB(1, 0), cB + kstep, voffB); PG8_STAGE(PG8_SA(1, 0), cA + kstep, voffA); PG8_STAGE(PG8_SB(1, 1), cB + hstepB + kstep, voffB);
        PG8_WAIT_V(6); PG8_BAR;
    } else {
        PG8_STAGE(PG8_SB(0, 0), cB, voffB); PG8_STAGE(PG8_SA(0, 0), cA, voffA); PG8_STAGE(PG8_SB(0, 1), cB + hstepB, voffB); PG8_STAGE(PG8_SA(0, 1), cA + hstepA, voffA1);
        if (wr == 1) PG8_BAR;
        PG8_WAIT_V(4); PG8_BAR;
        PG8_STAGE(PG8_SB(1, 0), cB + kstep, voffB); PG8_STAGE(PG8_SA(1, 0), cA + kstep, voffA); PG8_STAGE(PG8_SB(1, 1), cB + hstepB + kstep, voffB);
        PG8_WAIT_V(6); PG8_BAR;
    }
    for (;;) {
        const bool has_next = S.next(ui + 1, nxt);
        const char* nA = has_next ? (const char*)g.A + (size_t)nxt.pm * tstepA : cA; const char* nB = has_next ? (const char*)g.Bt + (size_t)nxt.pn * tstepB : cB;
        for (int t = 0; t < nt; t += 2) {
            if constexpr (Epi::MIDK) { if (t == nt / 2) { const int lm_ = lane_now(); E.mid(acc, cur, wr, wc, lm_ & 15, lm_ >> 4); } }
            const bool last = (t == nt - 2);
            const char* a1 = cA + (size_t)(t + 1) * kstep;
            const char* a2 = last ? nA : cA + (size_t)(t + 2) * kstep; const char* b2 = last ? nB : cB + (size_t)(t + 2) * kstep;
            const char* a3 = a2 + kstep; const char* b3 = b2 + kstep;
            if (last && has_next) S.a_ready(nxt);
            if constexpr (SP2) {
            PG8_LDB(B0, 0, 0); PG8_LDB(B1, 0, 1); PG8_SCHED; PG8_LDA(At, 0, 0); PG8_STAGE(PG8_SA(1, 1), a1 + hstepA, voffA1);
            PG8_WAIT_V(8); PG8_WAIT_L(0); PG8_BAR; PG8_MMA(0, 0, At, B0); PG8_MMA(0, 1, At, B1); PG8_BAR; PG8_SCHED;
            PG8_LDA(At, 0, 1); PG8_STAGE(PG8_SB(0, 0), b2, voffB); PG8_STAGE(PG8_SB(0, 1), b2 + hstepB, voffB); PG8_STAGE(PG8_SA(0, 0), a2, voffA);
            PG8_WAIT_V(8); PG8_WAIT_L(0); PG8_BAR; PG8_MMA(1, 0, At, B0); PG8_MMA(1, 1, At, B1); PG8_BAR; PG8_SCHED;
            PG8_LDB(B0, 1, 0); PG8_LDB(B1, 1, 1); PG8_SCHED; PG8_LDA(At, 1, 0); PG8_STAGE(PG8_SA(0, 1), a2 + hstepA, voffA1);
            PG8_WAIT_V(8); PG8_WAIT_L(0); PG8_BAR; PG8_MMA(0, 0, At, B0); PG8_MMA(0, 1, At, B1); PG8_BAR; PG8_SCHED;
            PG8_LDA(At, 1, 1); PG8_STAGE(PG8_SB(1, 0), b3, voffB); PG8_STAGE(PG8_SB(1, 1), b3 + hstepB, voffB); PG8_STAGE(PG8_SA(1, 0), a3, voffA);
            PG8_WAIT_V(8); PG8_WAIT_L(0); PG8_BAR; PG8_MMA(1, 0, At, B0); PG8_MMA(1, 1, At, B1); PG8_BAR; PG8_SCHED;
            } else {
            PG8_LDB(B0, 0, 0); PG8_SCHED; PG8_LDA(At, 0, 0); PG8_STAGE(PG8_SA(1, 1), a1 + hstepA, voffA1);
            PG8_WAIT_L(8); PG8_BAR; PG8_WAIT_L(0); PG8_MMA(0, 0, At, B0); PG8_BAR; PG8_SCHED;
            PG8_LDB(B1, 0, 1); PG8_STAGE(PG8_SB(0, 0), b2, voffB);
            PG8_BAR; PG8_WAIT_L(0); PG8_MMA(0, 1, At, B1); PG8_BAR;
            PG8_LDA(At, 0, 1); PG8_STAGE(PG8_SA(0, 0), a2, voffA);
            PG8_BAR; PG8_WAIT_L(0); PG8_MMA(1, 0, At, B0); PG8_BAR; PG8_SCHED;
            PG8_STAGE(PG8_SB(0, 1), b2 + hstepB, voffB);
            PG8_WAIT_V(6); PG8_BAR; PG8_MMA(1, 1, At, B1); PG8_BAR;
            PG8_LDB(B0, 1, 0); PG8_SCHED; PG8_LDA(At, 1, 0); PG8_STAGE(PG8_SA(0, 1), a2 + hstepA, voffA1);
            PG8_WAIT_L(8); PG8_BAR; PG8_WAIT_L(0); PG8_MMA(0, 0, At, B0); PG8_BAR; PG8_SCHED;
            PG8_LDB(B1, 1, 1); PG8_STAGE(PG8_SB(1, 0), b3, voffB);
            PG8_BAR; PG8_WAIT_L(0); PG8_MMA(0, 1, At, B1); PG8_BAR;
            PG8_LDA(At, 1, 1); PG8_STAGE(PG8_SA(1, 0), a3, voffA);
            PG8_BAR; PG8_WAIT_L(0); PG8_MMA(1, 0, At, B0); PG8_BAR; PG8_SCHED;
            PG8_STAGE(PG8_SB(1, 1), b3 + hstepB, voffB);
            PG8_WAIT_V(6); PG8_BAR; PG8_MMA(1, 1, At, B1); PG8_BAR;
            }
        }
        if constexpr (ALIGN_EPI) { if (wr == 0) PG8_BAR; }
        if constexpr (!Epi::AFTER_DRAIN) { const int le_ = lane_now(); E(acc, cur, wr, wc, le_ & 15, le_ >> 4); S.done(cur); }
        if (!has_next) break;
#pragma unroll
        for (int a = 0; a < 2; ++a)
#pragma unroll
            for (int b = 0; b < 2; ++b)
#pragma unroll
                for (int m = 0; m < 4; ++m)
#pragma unroll
                    for (int n = 0; n < 2; ++n) acc[a][b][m][n] = (f32x4){0.f, 0.f, 0.f, 0.f};
        cur = nxt; cA = nA; cB = nB; ++ui;
        if constexpr (ALIGN_EPI) { if (wr == 1) PG8_BAR; }
    }
    PG8_WAIT_V(0);
    if constexpr (!ALIGN_EPI) { if (wr == 0) PG8_BAR; }
    PG8_BAR;
    if constexpr (Epi::AFTER_DRAIN) { const int le_ = lane_now(); E.fused(acc, cur, wr, wc, le_ & 15, le_ >> 4, lds, wid, le_); S.done(cur); }
#undef PG8_SA
#undef PG8_SB
#undef PG8_STAGE
#undef PG8_LDA
#undef PG8_LDB
#undef PG8_MMA
#undef PG8_WAIT_V
#undef PG8_WAIT_L
#undef PG8_BAR
#undef PG8_SCHED
}
}
#define XB_TMO      128
#define XB_XCNT(j)  (256  + 64 * (j))
#define XB_XSUB(j)  (1280 + 64 * (j))
#define XB_XGEN(j)  (2304 + 64 * (j))
#define XB_TOP      3328
#define XB_TOPGEN   3392
#define XCD_BAR_WORDS 3456
#define XB_SPIN_CAP (1u << 18)

__device__ __forceinline__ unsigned xb_ld(unsigned* p)              { return __hip_atomic_load(p, __ATOMIC_RELAXED, __HIP_MEMORY_SCOPE_AGENT); }
__device__ __forceinline__ unsigned xb_add(unsigned* p, unsigned v) { return __hip_atomic_fetch_add(p, v, __ATOMIC_RELAXED, __HIP_MEMORY_SCOPE_AGENT); }
__device__ __forceinline__ unsigned xb_xcc_id() { return (unsigned)__builtin_amdgcn_s_getreg((3 << 11) | 20) & 0xFu; }
#define XB_SPIN(cond, bar) do { unsigned _sp = 0; while (cond) { __builtin_amdgcn_s_sleep(1); \
    if ((++_sp & 255u) == 0u) { if (xb_ld(&(bar)[XB_TMO])) break; if (_sp > XB_SPIN_CAP) { atomicAdd(&(bar)[XB_TMO], 1u); break; } } } } while (0)

struct XcdBarrier {
    unsigned* bar; unsigned x;
    volatile LAS unsigned* st;
};

__device__ __forceinline__ XcdBarrier xcd_barrier_post(unsigned* bar, volatile LAS unsigned* st) {
    XcdBarrier b; b.bar = bar; b.x = xb_xcc_id(); b.st = st;
    if (threadIdx.x == 0) (void)xb_add(&bar[XB_XCNT(b.x)], 1u);
    return b;
}
__device__ __forceinline__ void xcd_barrier_complete(unsigned* bar, unsigned x, unsigned& nloc, unsigned& nx) {
    const unsigned G = gridDim.x * gridDim.y * gridDim.z;
    unsigned sum, cnt, mine, sp = 0u;
    for (;;) {
        sum = 0u; cnt = 0u; mine = 0u;
#pragma unroll
        for (unsigned j = 0; j < 16; ++j) { const unsigned c = xb_ld(&bar[XB_XCNT(j)]); sum += c; cnt += (c > 0u) ? 1u : 0u; }
        if (sum == G) { mine = xb_ld(&bar[XB_XCNT(x)]); break; }
        __builtin_amdgcn_s_sleep(1);
        if ((++sp & 255u) == 0u) { if (xb_ld(&bar[XB_TMO])) break; if (sp > XB_SPIN_CAP) { atomicAdd(&bar[XB_TMO], 1u); break; } }
    }
    nloc = mine > 0u ? mine : 1u; nx = cnt > 0u ? cnt : 1u;
}

__device__ __forceinline__ void xcd_barrier(const XcdBarrier& b, const bool t0  ) {
    asm volatile("s_waitcnt vmcnt(0)" ::: "memory");
    __syncthreads();
    if (t0) {
        unsigned* bar = (unsigned*)opaque_ptr((unsigned char*)b.bar);
        __builtin_amdgcn_s_waitcnt(0);
        unsigned nloc = b.st[0], nx = b.st[1];
        if (nloc == 0u) { xcd_barrier_complete(bar, b.x, nloc, nx); b.st[0] = nloc; b.st[1] = nx; }
        const unsigned old = xb_add(&bar[XB_XSUB(b.x)], 1u);
        const unsigned gen = old / nloc;
        if (old + 1u == (gen + 1u) * nloc) {
            __builtin_amdgcn_fence(__ATOMIC_RELEASE, "agent");
            asm volatile("s_waitcnt vmcnt(0)" ::: "memory");
            const unsigned og = xb_add(&bar[XB_TOP], 1u);
            const unsigned tg = og / nx;
            if (og + 1u == (tg + 1u) * nx) xb_add(&bar[XB_TOPGEN], 1u);
            else XB_SPIN(xb_ld(&bar[XB_TOPGEN]) == tg, bar);
            __builtin_amdgcn_fence(__ATOMIC_ACQUIRE, "agent");
            xb_add(&bar[XB_XGEN(b.x)], 1u);
            asm volatile("s_waitcnt vmcnt(0)" ::: "memory");
        } else {
            XB_SPIN(xb_ld(&bar[XB_XGEN(b.x)]) == gen, bar);
            __builtin_amdgcn_fence(__ATOMIC_ACQUIRE, "agent");
            asm volatile("s_waitcnt vmcnt(0)" ::: "memory");
        }
    }
    __syncthreads();
}

__device__ __forceinline__ void panel_sync(unsigned* cnt, unsigned target, const bool t0) {
    asm volatile("s_waitcnt vmcnt(0)" ::: "memory");
    __syncthreads();
    if (t0) {
        __builtin_amdgcn_s_waitcnt(0);
#if !MK_WT
        __builtin_amdgcn_fence(__ATOMIC_RELEASE, "agent");
        asm volatile("s_waitcnt vmcnt(0)" ::: "memory");
#endif
        (void)xb_add(cnt, 1u);
        unsigned sp = 0;
        while (xb_ld(cnt) < target) { __builtin_amdgcn_s_sleep(1); if (++sp > (1u << 20)) break; }
        __builtin_amdgcn_fence(__ATOMIC_ACQUIRE, "agent");
        asm volatile("s_waitcnt vmcnt(0)" ::: "memory");
    }
    __syncthreads();
}
typedef pg8::f32x4 A4;
#define EPI_ROWS_BEGIN _Pragma("unroll") for (int ai = 0; ai < 2; ++ai) _Pragma("unroll") for (int m = 0; m < 4; ++m) { const int row = u.pm * 256 + ai * 128 + wr * 64 + m * 16 + fr;
#define EPI_ROWS_END }
__device__ __forceinline__ float rstd_of(const float* ss, int row, int fq) {
    if (!ss) return 1.0f;
    const f32x4 p = *(const f32x4*)(ss + (size_t)row * 16 + fq * 4);
    float s = (p[0] + p[1]) + (p[2] + p[3]);
    s = add_xor32(add_xor16(s));
    return rsqrtf(s * (1.0f / D) + EPS);
}
__device__ __forceinline__ float rstd_row(const float* ss, size_t row) {
    const f32x4* p = (const f32x4*)(ss + row * 16); float s = 0.f;
#pragma unroll
    for (int i = 0; i < 4; ++i) { const f32x4 v = p[i]; s += (v[0] + v[1]) + (v[2] + v[3]); }
    return rsqrtf(s * (1.0f / D) + EPS);
}
__device__ __forceinline__ u32x4 pack8(const A4& a, const A4& b) { u32x4 w; w.x = pkbf(a[0], a[1]); w.y = pkbf(a[2], a[3]); w.z = pkbf(b[0], b[1]); w.w = pkbf(b[2], b[3]); return w; }
__device__ __forceinline__ void unpack8(const u32x4& w, A4& a, A4& b) { a[0] = bflo(w.x); a[1] = bfhi(w.x); a[2] = bflo(w.y); a[3] = bfhi(w.y); b[0] = bflo(w.z); b[1] = bfhi(w.z); b[2] = bflo(w.w); b[3] = bfhi(w.w); }

struct EpiScale {
    static constexpr bool PERM = true, AFTER_DRAIN = false, MIDK = false;
    bf16_t* O; const float* ss; int ld; float scale; int wt, pad;
    __device__ __forceinline__ void operator()(const A4 (&acc)[2][2][4][2], const pg8::Unit& u, int wr, int wc, int fr, int fq) const {
        const int col0 = u.pn * 256 + wc * 32 + 8 * fq;
        EPI_ROWS_BEGIN
            const float s = rstd_of(ss, row, fq) * scale;
#pragma unroll
            for (int bj = 0; bj < 2; ++bj) { const u32x4 w = pack8(acc[ai][bj][m][0] * s, acc[ai][bj][m][1] * s); bf16_t* p = O + (size_t)row * ld + col0 + bj * 128; if (wt) ST16_OUT(p, w); else *(u32x4*)p = w; }
        EPI_ROWS_END
    }
};

__device__ __forceinline__ size_t band_frag_off(int t, int f) { return ((((size_t)(t >> 5) * AH + (f >> 6)) * 4 + ((f >> 4) & 3)) * 64 + ((f >> 3) & 1) * 32 + (t & 31)) * 8; }
__device__ __forceinline__ size_t band_vfrag_off(int F, int t) { return (((((size_t)(t >> 5) * AH + (F >> 6)) * 2 + ((F >> 5) & 1)) * 2 + ((t >> 4) & 1)) * 64 + ((t >> 3) & 1) * 32 + (F & 31)) * 8; }
struct EpiVT {
    static constexpr bool PERM = true, AFTER_DRAIN = false, MIDK = false;
    bf16_t *AVTp, *BVTp;
    __device__ __forceinline__ void operator()(const A4 (&acc)[2][2][4][2], const pg8::Unit& u, int wr, int wc, int fr, int fq) const {
        const int col0 = u.pn * 256 + wc * 32 + 8 * fq;
        EPI_ROWS_BEGIN
#pragma unroll
            for (int bj = 0; bj < 2; ++bj) { const u32x4 w = pack8(acc[ai][bj][m][0], acc[ai][bj][m][1]); const int t = col0 + bj * 128;
                bf16_t* p = u.pm < 2 ? AVTp + band_vfrag_off(row, t) : BVTp + (size_t)(row - 512) * T + t; ST16_OUT(p, w); }
        EPI_ROWS_END
    }
};

struct EpiProj {
    static constexpr bool PERM = true, AFTER_DRAIN = false, MIDK = false;
    bf16_t *AQ, *AK, *BQ, *BK, *BRS, *GA, *GB; float* LOGA; const float* balpha; int tile0, pad;
    __device__ __forceinline__ void operator()(const A4 (&acc)[2][2][4][2], const pg8::Unit& u, int wr, int wc, int fr, int fq) const {
        const int tile = u.pn + tile0;
        bf16_t* dst; int ld, c0, mode = 0; float sc = 1.f;
        if (tile < 2) { dst = AQ; ld = 512; c0 = tile * 256; sc = 0.125f * 1.4426950408889634f; }
        else if (tile < 4) { dst = AK; ld = 512; c0 = (tile - 2) * 256; }
        else if (tile == 4) { dst = BQ; ld = 256; c0 = 0; sc = 0.125f; }
        else if (tile == 5) { dst = BK; ld = 256; c0 = 0; }
        else if (tile < 8) { dst = BRS; ld = 512; c0 = (tile - 6) * 256; mode = 1; }
        else if (tile == 8) { dst = nullptr; ld = 256; c0 = 0; mode = 3; }
        else if (tile < 13) { dst = GA; ld = 1024; c0 = (tile - 9) * 256; mode = 2; }
        else { dst = GB; ld = 1024; c0 = (tile - 13) * 256; mode = 2; }
        const int cl = wc * 32 + 8 * fq;
        EPI_ROWS_BEGIN
#pragma unroll
            for (int bj = 0; bj < 2; ++bj) {
                A4 v0 = acc[ai][bj][m][0] * sc, v1 = acc[ai][bj][m][1] * sc;
                const int c = cl + bj * 128;
                if (mode == 3) {
                    const A4 b0 = *(const A4*)(balpha + c), b1 = *(const A4*)(balpha + c + 4);
#pragma unroll
                    for (int i = 0; i < 4; ++i) { v0[i] = flogsigmoid(v0[i] + b0[i]) * 0.0625f; v1[i] = flogsigmoid(v1[i] + b1[i]) * 0.0625f; }
                    float* o = LOGA + (size_t)row * 256 + c; *(A4*)o = v0; *(A4*)(o + 4) = v1;
                } else {
                    if (mode == 1) {
#pragma unroll
                        for (int i = 0; i < 4; ++i) { v0[i] = fsilu(v0[i]); v1[i] = fsilu(v1[i]); }
                    } else if (mode == 2) {
#pragma unroll
                        for (int i = 0; i < 4; ++i) { v0[i] = fsigmoid(v0[i]); v1[i] = fsigmoid(v1[i]); }
                    }
                    { const u32x4 w = pack8(v0, v1); const int f = c0 + c;
                      bf16_t* p = tile < 4 ? dst + band_frag_off(row, f) : dst + (size_t)row * ld + f; if (mode == 2) *(u32x4*)p = w; else ST16_OUT(p, w); }
                }
            }
        EPI_ROWS_END
    }
};

struct EpiResid {
    static constexpr bool PERM = true, AFTER_DRAIN = false, MIDK = false;
    bf16_t* Xo; const bf16_t* X; float* ss_out;
    __device__ __forceinline__ void operator()(const A4 (&acc)[2][2][4][2], const pg8::Unit& u, int wr, int wc, int fr, int fq) const {
        const int col0 = u.pn * 256 + wc * 32 + 8 * fq;
#pragma unroll
        for (int ai = 0; ai < 2; ++ai) {
            u32x4 xin[4][2];
#pragma unroll
            for (int m = 0; m < 4; ++m)
#pragma unroll
                for (int bj = 0; bj < 2; ++bj) xin[m][bj] = *(const u32x4*)(X + (size_t)(u.pm * 256 + ai * 128 + wr * 64 + m * 16 + fr) * D + col0 + bj * 128);
#pragma unroll
            for (int m = 0; m < 4; ++m) {
                const int row = u.pm * 256 + ai * 128 + wr * 64 + m * 16 + fr;
                float q = 0.f;
#pragma unroll
                for (int bj = 0; bj < 2; ++bj) {
                    A4 x0, x1; unpack8(xin[m][bj], x0, x1);
                    x0 += acc[ai][bj][m][0]; x1 += acc[ai][bj][m][1];
                    q += (x0[0] * x0[0] + x0[1] * x0[1]) + (x0[2] * x0[2] + x0[3] * x0[3]) + (x1[0] * x1[0] + x1[1] * x1[1]) + (x1[2] * x1[2] + x1[3] * x1[3]);
                    ST16_OUT(Xo + (size_t)row * D + col0 + bj * 128, pack8(x0, x1));
                }
                q = add_xor32(add_xor16(q));
                if (fq == 0) __hip_atomic_store(ss_out + (size_t)row * 16 + u.pn * 4 + wc, q, __ATOMIC_RELAXED, __HIP_MEMORY_SCOPE_AGENT);
            }
        }
    }
};

struct EpiMerge {
    static constexpr bool PERM = true, AFTER_DRAIN = false, MIDK = true;
    const bf16_t* GAp; const bf16_t* GBp; bf16_t* O;
    __device__ __forceinline__ void mid(A4 (&acc)[2][2][4][2], const pg8::Unit& u, int wr, int wc, int fr, int fq) const {
        const int col0 = u.pn * 256 + wc * 32 + 8 * fq;
        EPI_ROWS_BEGIN
#pragma unroll
            for (int bj = 0; bj < 2; ++bj) {
                const size_t off = (size_t)row * D + col0 + bj * 128;
                A4 a0, a1, b0, b1; unpack8(*(const u32x4*)(GAp + off), a0, a1); unpack8(*(const u32x4*)(GBp + off), b0, b1);
#pragma unroll
                for (int i = 0; i < 4; ++i) { acc[ai][bj][m][0][i] *= a0[i] * __builtin_amdgcn_rcpf(b0[i]); acc[ai][bj][m][1][i] *= a1[i] * __builtin_amdgcn_rcpf(b1[i]); }
            }
        EPI_ROWS_END
    }
    __device__ __forceinline__ void operator()(const A4 (&acc)[2][2][4][2], const pg8::Unit& u, int wr, int wc, int fr, int fq) const {
        const int col0 = u.pn * 256 + wc * 32 + 8 * fq;
#pragma unroll
        for (int ai = 0; ai < 2; ++ai) {
            u32x4 gin[4][2];
#pragma unroll
            for (int m = 0; m < 4; ++m)
#pragma unroll
                for (int bj = 0; bj < 2; ++bj) gin[m][bj] = *(const u32x4*)(GBp + (size_t)(u.pm * 256 + ai * 128 + wr * 64 + m * 16 + fr) * D + col0 + bj * 128);
#pragma unroll
            for (int m = 0; m < 4; ++m)
#pragma unroll
                for (int bj = 0; bj < 2; ++bj) {
                    A4 b0, b1; unpack8(gin[m][bj], b0, b1);
                    ST16_OUT(O + (size_t)(u.pm * 256 + ai * 128 + wr * 64 + m * 16 + fr) * D + col0 + bj * 128, pack8(acc[ai][bj][m][0] * b0, acc[ai][bj][m][1] * b1));
                }
        }
    }
};
struct ConvRegs { f32x4 v[8]; };
__device__ __forceinline__ void conv_load(ConvRegs& R, const float* __restrict__ W, int ldw, int k0, int n0, int lane) {
#pragma unroll
    for (int i = 0; i < 8; ++i) { const int kk = (lane >> 3) + 8 * i; R.v[i] = __builtin_nontemporal_load((const f32x4*)(W + (size_t)(k0 + kk) * ldw + n0 + (lane & 7) * 4)); }
}
__device__ __forceinline__ void conv_store(const ConvRegs& R, const float* __restrict__ gk, bf16_t* __restrict__ WT, int ldt, int k0, int n0, LAS float* scr, int lane) {
#pragma unroll
    for (int i = 0; i < 8; ++i) { const int kk = (lane >> 3) + 8 * i; const float s = gk ? gk[k0 + kk] : 1.0f; LAS float* p = scr + kk * 33 + (lane & 7) * 4;
        p[0] = R.v[i][0] * s; p[1] = R.v[i][1] * s; p[2] = R.v[i][2] * s; p[3] = R.v[i][3] * s; }
    asm volatile("s_waitcnt lgkmcnt(0)" ::: "memory");
    const int c = lane & 7;
#pragma unroll
    for (int j = 0; j < 4; ++j) { const int n = (lane >> 3) + 8 * j; const LAS float* s = scr + (8 * c) * 33 + n;
        u32x4 o; o.x = pkbf(s[0 * 33], s[1 * 33]); o.y = pkbf(s[2 * 33], s[3 * 33]); o.z = pkbf(s[4 * 33], s[5 * 33]); o.w = pkbf(s[6 * 33], s[7 * 33]);
        *(u32x4*)(WT + (size_t)(n0 + n) * ldt + k0 + 8 * c) = o; }
    asm volatile("s_waitcnt lgkmcnt(0)" ::: "memory");
}
__device__ __forceinline__ void conv_item(const float* __restrict__ W, int ldw, const float* __restrict__ gk, bf16_t* __restrict__ WT, int ldt, int k0, int n0, LAS float* scr, int lane) {
    ConvRegs R; conv_load(R, W, ldw, k0, n0, lane); conv_store(R, gk, WT, ldt, k0, n0, scr, lane);
}

struct InPtrs {
    const float *x, *mem, *norm_mix_g, *w_in, *rel_bias, *gla_w_alpha, *gla_b_alpha, *gla_norm_g, *w_branch, *w_mix_out, *norm_x_g, *mem_norm_g, *w_xq, *w_xkv, *w_xo,
                *norm_ffn_g, *w_gr, *b_gr, *w_er, *b_er, *w_eg, *w_eu, *w_ed, *final_g;
};

struct ConvJob { const float* W; const float* gk; bf16_t* WT; int ldw, ldt, K, N; };
__device__ __forceinline__ ConvJob dense_job(const InPtrs& in, unsigned char* ws, int l, int j) {
    unsigned char* wd = ws + WS_WDENSE + (size_t)l * WDENSE_STRIDE;
    const float* Win = in.w_in + (size_t)l * D * INW; bf16_t* WIN_T = (bf16_t*)(wd + WD_WIN);
    const float* gm = in.norm_mix_g + l * D;
    ConvJob J;
    switch (j) {
    case 0: J = {Win + 0, gm, WIN_T + (size_t)0 * D, INW, D, D, 1024}; break;
    case 1: J = {Win + 1024, gm, WIN_T + (size_t)2304 * D, INW, D, D, 512}; break;
    case 2: J = {Win + 1536, gm, WIN_T + (size_t)1024 * D, INW, D, D, 512}; break;
    case 3: J = {Win + 2048, gm, WIN_T + (size_t)2816 * D, INW, D, D, 512}; break;
    case 4: J = {Win + 3088, gm, WIN_T + (size_t)3328 * D, INW, D, D, 2048}; break;
    case 11: J = {Win + 2576, gm, WIN_T + (size_t)1536 * D, INW, D, D, 512}; break;
    case 5: J = {in.w_branch + (size_t)(l * 2 + 0) * 512 * D, nullptr, (bf16_t*)(wd + WD_WB), D, D, 512, D}; break;
    case 6: J = {in.w_branch + (size_t)(l * 2 + 1) * 512 * D, nullptr, (bf16_t*)(wd + WD_WB) + 512, D, D, 512, D}; break;
    case 7: J = {in.w_mix_out + (size_t)l * D * D, nullptr, (bf16_t*)(wd + WD_WMO), D, D, D, D}; break;
    case 8: J = {in.w_xq + (size_t)l * D * D, in.norm_x_g + l * D, (bf16_t*)(wd + WD_WXQ), D, D, D, 0}; break;
    case 9: J = {in.w_xkv + (size_t)l * D * 2 * D, nullptr, (bf16_t*)(wd + WD_WXKV), 2 * D, D, D, 2 * D}; break;
    default: J = {in.w_xo + (size_t)l * D * D, nullptr, (bf16_t*)(wd + WD_WXO), D, D, D, D}; break;
    }
    return J;
}

__device__ __forceinline__ void conv_dense_layer(const InPtrs& in, unsigned char* ws, int l, int gw, int NGW, int gt, int NGT, LAS float* scr, int lane) {
    constexpr int NITEMS = 5632 - 512;
#pragma nounroll
    for (int it = gw; it < NITEMS; it += 2 * NGW) {
        ConvRegs R[2]; ConvJob J[2]; int k0[2], n0[2];
#pragma unroll
        for (int q = 0; q < 2; ++q) {
            int r = it + q * NGW; const bool on = r < NITEMS; if (!on) r = it;
            int j = 0;
#pragma unroll
            for (int jj = 0; jj < 12; ++jj) { const ConvJob Jt = dense_job(in, ws, l, jj); const int n = (Jt.K / 64) * (Jt.N / 32); if (j == jj && r >= n) { r -= n; ++j; } }
            J[q] = dense_job(in, ws, l, j); const int nnb = J[q].N / 32; k0[q] = (r / nnb) * 64; n0[q] = (r % nnb) * 32;
            if (on) conv_load(R[q], J[q].W, J[q].ldw, k0[q], n0[q], lane);
        }
#pragma unroll
        for (int q = 0; q < 2; ++q) if (it + q * NGW < NITEMS) conv_store(R[q], J[q].gk, J[q].WT, J[q].ldt, k0[q], n0[q], scr, lane);
    }
    {
        bf16_t* WIN_T = (bf16_t*)(ws + WS_WDENSE + (size_t)l * WDENSE_STRIDE + WD_WIN);
        const float* Win = in.w_in + (size_t)l * D * INW; const float* Wa = in.gla_w_alpha + (size_t)l * BR * BKW; const float* gm = in.norm_mix_g + l * D;
        for (int i = gt; i < 256 * D; i += NGT) {
            const int c = i >> 10, k = i & 1023; float s = 0.f;
#pragma unroll
            for (int r = 0; r < BR; ++r) s += Win[(size_t)k * INW + 2560 + r] * Wa[r * BKW + c];
            WIN_T[(size_t)(2048 + c) * D + k] = f2bf(s * gm[k]);
        }
    }
    {
        bf16_t* WQN = (bf16_t*)(ws + WS_WDENSE + (size_t)l * WDENSE_STRIDE + WD_WXQ);
        const float* Wq = in.w_xq + (size_t)l * D * D; const float* gx = in.norm_x_g + l * D;
        for (int i = gt; i < D * D / 4; i += NGT) { const f32x4 v = ((const f32x4*)Wq)[i]; const float g = gx[i >> 8]; u32x2 o; o.x = pkbf(v[0] * g, v[1] * g); o.y = pkbf(v[2] * g, v[3] * g); ((u32x2*)WQN)[i] = o; }
    }
}
__device__ __forceinline__ void ph_prologue(const InPtrs& in, unsigned char* ws, LAS unsigned char* lds, int vcu, int G, int wv) {
    const int tid = tid_of(wv), lane = tid & 63, wave = wv;
    LAS float* scr = (LAS float*)(lds + wave * 16384);
    const int gw = vcu * 8 + wave, NGW = G * 8;
#pragma nounroll
    for (int l = 0; l < (G == 256 ? 1 : DEPTH); ++l) conv_dense_layer(in, ws, l, gw, NGW, vcu * 512 + tid, G * 512, scr, lane);
    bf16_t* XB = (bf16_t*)(ws + WS_XB); bf16_t* XN = (bf16_t*)(ws + WS_XN);
#pragma nounroll
    for (int rb = 4 * gw; rb < T; rb += 4 * NGW) {
        float4 v[4][4];
#pragma unroll
        for (int i = 0; i < 4; ++i) { const int r = (rb + i < T) ? rb + i : rb; const float4* xr = (const float4*)(in.x + (size_t)r * D) + lane;
#pragma unroll
            for (int j = 0; j < 4; ++j) v[i][j] = xr[64 * j]; }
#pragma unroll
        for (int i = 0; i < 4; ++i) {
            const int r = rb + i;
            if (r < T) {
                float s = 0.f;
#pragma unroll
                for (int j = 0; j < 4; ++j) { s += v[i][j].x * v[i][j].x + v[i][j].y * v[i][j].y + v[i][j].z * v[i][j].z + v[i][j].w * v[i][j].w;
                    u32x2 o; o.x = pkbf(v[i][j].x, v[i][j].y); o.y = pkbf(v[i][j].z, v[i][j].w); *(u32x2*)(XB + (size_t)r * D + (lane + 64 * j) * 4) = o; }
                const float rs = rsqrtf(wave_sum(s) * (1.0f / D) + EPS);
#pragma unroll
                for (int j = 0; j < 4; ++j) { u32x2 o; o.x = pkbf(v[i][j].x * rs, v[i][j].y * rs); o.y = pkbf(v[i][j].z * rs, v[i][j].w * rs); *(u32x2*)(XN + (size_t)r * D + (lane + 64 * j) * 4) = o; }
            }
        }
    }
    bf16_t* MEMN = (bf16_t*)(ws + WS_MEMN);
    for (int r = gw; r < NB * NMEM; r += NGW) {
        const float4* xr = (const float4*)(in.mem + (size_t)r * D) + lane; float4 v[4]; float s = 0.f;
#pragma unroll
        for (int j = 0; j < 4; ++j) { v[j] = xr[64 * j]; s += v[j].x * v[j].x + v[j].y * v[j].y + v[j].z * v[j].z + v[j].w * v[j].w; }
        const float rs = rsqrtf(wave_sum(s) * (1.0f / D) + EPS);
#pragma unroll
        for (int j = 0; j < 4; ++j) { const float4 g = ((const float4*)in.mem_norm_g)[lane + 64 * j];
            u32x2 o; o.x = pkbf(v[j].x * rs * g.x, v[j].y * rs * g.y); o.y = pkbf(v[j].z * rs * g.z, v[j].w * rs * g.w); *(u32x2*)(MEMN + (size_t)r * D + (lane + 64 * j) * 4) = o; }
    }
}

typedef short bf16x8_t __attribute__((ext_vector_type(8)));
constexpr int NRMAX = 40960;
constexpr int NTMAX = NRMAX / 256;
constexpr int CW_CNT = 256;
constexpr size_t SEL_SELE = 0, SEL_SELW = 128 * 1024, SEL_LPOS = 256 * 1024, SEL_POS = 384 * 1024, SEL_GW = 512 * 1024, SEL_TILE = 768 * 1024, SEL_NT = 768 * 1024 + 4096, SEL_RS = 896 * 1024;

struct ExpItem { const float* W; const float* gk; bf16_t* WT; int ldw, ldt, k0, n0; };
__device__ __forceinline__ ExpItem expert_item(const InPtrs& in, unsigned char* ws, int it) {
    const int le = it / 384, r = it % 384, l = le >> 5, e = le & 31;
    bf16_t* WGU = (bf16_t*)(ws + WS_WEXP + (size_t)l * WEXP_STRIDE) + (size_t)e * 512 * D;
    bf16_t* WDT = (bf16_t*)(ws + WS_WEXP + (size_t)l * WEXP_STRIDE + 32 * MiB) + (size_t)e * D * EF;
    const size_t eo = ((size_t)l * NE + e) * D * EF;
    ExpItem I;
    if (r < 256) { const int p = r >> 6, q = r & 63; I = {((p & 1) ? in.w_eu : in.w_eg) + eo + (p >> 1) * 128, in.norm_ffn_g + l * D, WGU + (size_t)(p * 128) * D, EF, D, (q >> 2) * 64, (q & 3) * 32}; }
    else { const int q = r - 256; I = {in.w_ed + eo, nullptr, WDT, D, EF, (q >> 5) * 64, (q & 31) * 32}; }
    return I;
}
__device__ __forceinline__ void conv_expert_run(const InPtrs& in, unsigned char* ws, int it0, int n, LAS float* scr, int lane) {
#pragma nounroll
    for (int i = 0; i < n; i += 2) {
        ConvRegs R0, R1;
        const ExpItem A = expert_item(in, ws, it0 + i); conv_load(R0, A.W, A.ldw, A.k0, A.n0, lane);
        ExpItem B = A; if (i + 1 < n) { B = expert_item(in, ws, it0 + i + 1); conv_load(R1, B.W, B.ldw, B.k0, B.n0, lane); }
        conv_store(R0, A.gk, A.WT, A.ldt, A.k0, A.n0, scr, lane);
        if (i + 1 < n) conv_store(R1, B.gk, B.WT, B.ldt, B.k0, B.n0, scr, lane);
    }
}
__device__ __forceinline__ void conv_expert_items(const InPtrs& in, unsigned char* ws, int it_lo, int it_hi, int gw, int NGW, LAS float* scr, int lane) {
#pragma nounroll
    for (int it = it_lo + gw; it < it_hi; it += 2 * NGW) {
        const int it2 = it + NGW; ConvRegs R0, R1;
        const ExpItem A = expert_item(in, ws, it); conv_load(R0, A.W, A.ldw, A.k0, A.n0, lane);
        ExpItem B = A; if (it2 < it_hi) { B = expert_item(in, ws, it2); conv_load(R1, B.W, B.ldw, B.k0, B.n0, lane); }
        conv_store(R0, A.gk, A.WT, A.ldt, A.k0, A.n0, scr, lane);
        if (it2 < it_hi) conv_store(R1, B.gk, B.WT, B.ldt, B.k0, B.n0, scr, lane);
    }
}
__device__ __forceinline__ void conv_router(const InPtrs& in, unsigned char* ws, int vcu, int G, int tid) {
    for (int i = vcu * 512 + tid; i < DEPTH * 48 * D; i += G * 512) {
        const int l = i / (48 * D), r = (i / D) % 48, k = i % D; float v = 0.f;
        if (r < NG) v = in.w_gr[((size_t)l * D + k) * NG + r]; else if (r < NG + NE) v = in.w_er[((size_t)l * D + k) * NE + (r - NG)];
        ((bf16_t*)(ws + WS_WR))[i] = f2bf(v * in.norm_ffn_g[l * D + k]);
    }
}

__device__ __forceinline__ void ph_route(const InPtrs& in, unsigned char* ws, LAS unsigned char* lds, int l, int t0  , int wv, bool dummy_cnt) {
    const int tid = tid_of(wv), lane = tid & 63, wave = wv;
    const bf16_t* XB = (const bf16_t*)(ws + WS_XB); const bf16_t* WR = (const bf16_t*)(ws + WS_WR) + (size_t)l * 48 * D;
    const float* ss = (const float*)(ws + WS_SSP) + (size_t)(3 * l + 2) * T * 16;
    int* SELE = (int*)(ws + WS_SEL + SEL_SELE); float* SELW = (float*)(ws + WS_SEL + SEL_SELW); int* LPOS = (int*)(ws + WS_SEL + SEL_LPOS);
    float* RSTD = (float*)(ws + WS_SEL + SEL_RS); int* TOKS = (int*)(ws + WS_TOK);
    unsigned* CNT = (unsigned*)(ws + WS_CTL) + CW_CNT + 32 * l + (dummy_cnt ? 128 : 0);
    LAS float* lg = (LAS float*)lds + wave * (16 * 49);
    LAS unsigned* hist = (LAS unsigned*)(lds + 32768); LAS unsigned* gbase = hist + 32;
    {
        if (tid < 32) hist[tid] = 0u;
        int e0 = 0, e1 = 0; unsigned r0 = 0, r1 = 0;
        {
            const int tw = t0 + (wave & 3) * 16, kh = (wave >> 2) * (D / 2);
            f32x4 acc[3];
#pragma unroll
            for (int nb = 0; nb < 3; ++nb) acc[nb] = (f32x4){0.f, 0.f, 0.f, 0.f};
            const bf16_t* ap = XB + (size_t)(tw + (lane & 15)) * D + kh + 8 * (lane >> 4);
            const bf16_t* bp = WR + (size_t)(lane & 15) * D + kh + 8 * (lane >> 4);
#pragma unroll
            for (int k0 = 0; k0 < D / 64; k0 += 8) {
                bf16x8_t a[8], b[8][3];
#pragma unroll
                for (int kk = 0; kk < 8; ++kk) { a[kk] = *(const bf16x8_t*)(ap + (k0 + kk) * 32);
#pragma unroll
                    for (int nb = 0; nb < 3; ++nb) b[kk][nb] = *(const bf16x8_t*)(bp + (size_t)nb * 16 * D + (k0 + kk) * 32); }
#pragma unroll
                for (int kk = 0; kk < 8; ++kk)
#pragma unroll
                    for (int nb = 0; nb < 3; ++nb) acc[nb] = __builtin_amdgcn_mfma_f32_16x16x32_bf16(a[kk], b[kk][nb], acc[nb], 0, 0, 0);
            }
#pragma unroll
            for (int nb = 0; nb < 3; ++nb)
#pragma unroll
                for (int r = 0; r < 4; ++r) lg[((lane >> 4) * 4 + r) * 49 + nb * 16 + (lane & 15)] = acc[nb][r];
        }
        __syncthreads();
        if (wave < 4 && lane < 16) {
            const int t = t0 + wave * 16 + lane; const float rs = rstd_row(ss, (size_t)t);
            const LAS float* p = lg + lane * 49; const LAS float* p2 = p + 4 * (16 * 49);
            float gm = -INFINITY; int gi = 0;
#pragma unroll
            for (int i = 0; i < NG; ++i) { const float x = (p[i] + p2[i]) * rs + in.b_gr[l * NG + i]; if (x > gm) { gm = x; gi = i; } }
            float gs = 0.f;
#pragma unroll
            for (int i = 0; i < NG; ++i) gs += __expf((p[i] + p2[i]) * rs + in.b_gr[l * NG + i] - gm);
            const float gw = 1.0f / gs;
            float v0 = -INFINITY, v1 = -INFINITY; int i0 = 0, i1 = 0;
#pragma unroll
            for (int e = 0; e < EPG; ++e) { const float x = (p[NG + gi * EPG + e] + p2[NG + gi * EPG + e]) * rs + in.b_er[l * NE + gi * EPG + e];
                if (x > v0) { v1 = v0; i1 = i0; v0 = x; i0 = e; } else if (x > v1) { v1 = x; i1 = e; } }
            const float ex = __expf(v1 - v0), den = 1.0f + ex;
            e0 = gi * EPG + i0; e1 = gi * EPG + i1;
            SELE[t * 2] = e0; SELE[t * 2 + 1] = e1; SELW[t * 2] = gw / den; SELW[t * 2 + 1] = gw * ex / den; RSTD[t] = rs;
            r0 = __hip_atomic_fetch_add(&hist[e0], 1u, __ATOMIC_RELAXED, __HIP_MEMORY_SCOPE_WORKGROUP); r1 = __hip_atomic_fetch_add(&hist[e1], 1u, __ATOMIC_RELAXED, __HIP_MEMORY_SCOPE_WORKGROUP);
        }
        __syncthreads();
        if (tid < 32) gbase[tid] = hist[tid] ? atomicAdd(&CNT[tid], hist[tid]) : 0u;
        __syncthreads();
        if (wave < 4 && lane < 16) { const int t = t0 + wave * 16 + lane; const int p0 = (int)(gbase[e0] + r0), p1 = (int)(gbase[e1] + r1);
            LPOS[t * 2] = p0; LPOS[t * 2 + 1] = p1; TOKS[(size_t)e0 * T + p0] = 2 * t; TOKS[(size_t)e1 * T + p1] = 2 * t + 1; }
        __syncthreads();
    }
}

__device__ __forceinline__ int moe_prefix(const unsigned* CNT, int lane, int& cnt, int& tile0, int& ntile) {
    cnt = (lane < 32) ? (int)__hip_atomic_load(CNT + (lane & 31), __ATOMIC_RELAXED, __HIP_MEMORY_SCOPE_AGENT) : 0;
    ntile = (cnt + 255) >> 8;
    int incl = ntile;
#pragma unroll
    for (int o = 1; o < 32; o <<= 1) { const int y = shfl_idx(incl, (lane - o) & 63); if ((lane & 31) >= o) incl += y; }
    tile0 = incl - ntile;
    return shfl_idx(incl, 31);
}
__device__ __forceinline__ void moe_tables(unsigned char* ws, int l, LAS int* tb, int vcu, int wave, int lane) {
    if (wave == 0) {
        int cnt, t0, nt_e; const int nt = moe_prefix((const unsigned*)(ws + WS_CTL) + CW_CNT + 32 * l, lane, cnt, t0, nt_e);
        if (lane < 32) { tb[lane] = cnt; tb[32 + lane] = t0; for (int r = t0; r < t0 + nt_e; ++r) tb[96 + r] = lane; }
        if (lane == 0) tb[64] = nt;
        if (vcu == 0) {
            int* TILE_E = (int*)(ws + WS_SEL + SEL_TILE);
            if (lane < 32) for (int r = t0; r < t0 + nt_e; ++r) TILE_E[r] = lane;
            if (lane == 0) *(int*)(ws + WS_SEL + SEL_NT) = nt;
        }
    }
    asm volatile("s_waitcnt lgkmcnt(0)" ::: "memory");
    __syncthreads();
}
struct GatherOrder {
    static constexpr bool GATHER = true;
    int pm, pn; const int* toks; int tl, cnt;
    __device__ __forceinline__ bool next(int i, pg8::Unit& u) const { if (i != 0) return false; u.pm = pm; u.pn = pn; return true; }
    __device__ __forceinline__ int arow(int R) const { const int p = tl * 256 + R; return p < cnt ? (toks[p] >> 1) : 0; }
    __device__ __forceinline__ void a_ready(const pg8::Unit&) const {}
    __device__ __forceinline__ void done(const pg8::Unit&) const {}
};
template <int NJ> struct GroupedOrder {
    static constexpr bool GATHER = false;
    const int* tile_e; int nunits, G, c;
    __device__ __forceinline__ void init(const int* te, int nt, int G_, int c_) { tile_e = te; nunits = nt * NJ; G = G_; c = c_; }
    __device__ __forceinline__ bool next(int i, pg8::Unit& u) const {
        const int L = i * G + c; if (L >= nunits) return false;
        const int rt = L / NJ, j = L % NJ;
        u.pm = rt; u.pn = __builtin_amdgcn_readfirstlane(tile_e[rt]) * NJ + j; return true;
    }
    __device__ __forceinline__ void a_ready(const pg8::Unit&) const {}
    __device__ __forceinline__ void done(const pg8::Unit&) const {}
};
struct QuadOrder {
    static constexpr bool GATHER = false;
    int pm, pn0, n;
    __device__ __forceinline__ bool next(int i, pg8::Unit& u) const { if (i >= n) return false; u.pm = pm; u.pn = pn0 + i; return true; }
    __device__ __forceinline__ void a_ready(const pg8::Unit&) const {}
    __device__ __forceinline__ void done(const pg8::Unit&) const {}
};
constexpr int CW_READY = 24576;
struct EpiHid {
    static constexpr bool PERM = true, AFTER_DRAIN = false, MIDK = false;
    bf16_t* HID; const int* toks; const float* RSTD; const float* SELW; int tl, cnt;
    __device__ __forceinline__ void operator()(const A4 (&acc)[2][2][4][2], const pg8::Unit& u, int wr, int wc, int fr, int fq) const {
        const int f0 = (u.pn & 1) * 128 + wc * 32 + 8 * fq;
        float rsv[2][4], wv_[2][4];
#pragma unroll
        for (int ai = 0; ai < 2; ++ai)
#pragma unroll
            for (int m = 0; m < 4; ++m) {
                const int p = tl * 256 + ai * 128 + wr * 64 + m * 16 + fr;
                const int slot = p < cnt ? toks[p] : 0;
                rsv[ai][m] = RSTD[slot >> 1]; wv_[ai][m] = SELW[slot];
            }
        EPI_ROWS_BEGIN
            const float rs = rsv[ai][m], w = wv_[ai][m];
            A4 h0, h1;
#pragma unroll
            for (int i = 0; i < 4; ++i) { h0[i] = fsilu(acc[ai][0][m][0][i] * rs) * (acc[ai][1][m][0][i] * rs) * w; h1[i] = fsilu(acc[ai][0][m][1][i] * rs) * (acc[ai][1][m][1][i] * rs) * w; }
            st16_wt(HID + (size_t)row * EF + f0, pack8(h0, h1));
        EPI_ROWS_END
    }
};
struct EpiY {
    static constexpr bool PERM = true, AFTER_DRAIN = false, MIDK = false;
    bf16_t* Y;
    __device__ __forceinline__ void operator()(const A4 (&acc)[2][2][4][2], const pg8::Unit& u, int wr, int wc, int fr, int fq) const {
        const int col0 = (u.pn & 3) * 256 + wc * 32 + 8 * fq;
        EPI_ROWS_BEGIN
#pragma unroll
            for (int bj = 0; bj < 2; ++bj) ST16_OUT(Y + (size_t)row * D + col0 + bj * 128, pack8(acc[ai][bj][m][0], acc[ai][bj][m][1]));
        EPI_ROWS_END
    }
};

__device__ __forceinline__ void ph_combine(unsigned char* ws, int l, int vcu, int G, bf16_t* XN, float* OUT, const float* __restrict__ fg, int wv, bf16_t* XBo) {
    const int tid = tid_of(wv), lane = tid & 63, wave = wv; (void)tid;
    const bf16_t* XB = (const bf16_t*)(ws + WS_XB); const bf16_t* Y = (const bf16_t*)(ws + WS_XG);
    const int* SELE = (const int*)(ws + WS_SEL + SEL_SELE); const int* LPOS = (const int*)(ws + WS_SEL + SEL_LPOS); float* ssn = (float*)(ws + WS_SSP) + (size_t)(3 * l + 3) * T * 16;
    int cnt_, tile0_, ntile_; (void)moe_prefix((const unsigned*)(ws + WS_CTL) + CW_CNT + 32 * l, lane, cnt_, tile0_, ntile_);
    const int stride = G * 8;
#pragma nounroll
    for (int tb = vcu * 8 + wave; tb < T; tb += 4 * stride) {
        int p0[4], p1[4];
#pragma unroll
        for (int i = 0; i < 4; ++i) { const int t = (tb + i * stride < T) ? tb + i * stride : tb;
            p0[i] = shfl_idx(tile0_, SELE[2 * t]) * 256 + LPOS[2 * t]; p1[i] = shfl_idx(tile0_, SELE[2 * t + 1]) * 256 + LPOS[2 * t + 1]; }
        u32x4 rx[4][2], ry0[4][2], ry1[4][2];
#pragma unroll
        for (int i = 0; i < 4; ++i) { const int t = (tb + i * stride < T) ? tb + i * stride : tb;
#pragma unroll
            for (int j = 0; j < 2; ++j) { rx[i][j] = ((const u32x4*)(XB + (size_t)t * D) + lane)[64 * j]; ry0[i][j] = ((const u32x4*)(Y + (size_t)p0[i] * D) + lane)[64 * j]; ry1[i][j] = ((const u32x4*)(Y + (size_t)p1[i] * D) + lane)[64 * j]; } }
#pragma unroll
        for (int i = 0; i < 4; ++i) {
            const int t = tb + i * stride;
            if (t < T) {
                A4 v[4]; float q = 0.f;
#pragma unroll
                for (int j = 0; j < 2; ++j) { A4 a0, a1, b0, b1, c0, c1; unpack8(rx[i][j], a0, a1); unpack8(ry0[i][j], b0, b1); unpack8(ry1[i][j], c0, c1);
                    a0 += b0 + c0; a1 += b1 + c1; v[2 * j] = a0; v[2 * j + 1] = a1;
                    q += (a0[0] * a0[0] + a0[1] * a0[1]) + (a0[2] * a0[2] + a0[3] * a0[3]) + (a1[0] * a1[0] + a1[1] * a1[1]) + (a1[2] * a1[2] + a1[3] * a1[3]);
                    if (!OUT) ST16_OUT((u32x4*)(XBo + (size_t)t * D) + lane + 64 * j, pack8(a0, a1)); }
                q = wave_sum(q);
                if (lane < 16) ssn[(size_t)t * 16 + lane] = lane == 0 ? q : 0.f;
                const float rs = rsqrtf(q * (1.0f / D) + EPS);
                if (XN) { u32x4* xn = (u32x4*)(XN + (size_t)t * D) + lane;
#pragma unroll
                    for (int j = 0; j < 2; ++j) ST16_OUT(xn + 64 * j, pack8(v[2 * j] * rs, v[2 * j + 1] * rs)); }
                if (OUT) {
#pragma unroll
                    for (int j = 0; j < 2; ++j) { const int c0 = 8 * lane + 512 * j; const A4 g0 = *(const A4*)(fg + c0), g1 = *(const A4*)(fg + c0 + 4);
                        float* o = OUT + (size_t)t * D + c0; *(A4*)o = v[2 * j] * rs * g0; *(A4*)(o + 4) = v[2 * j + 1] * rs * g1; }
                }
            }
        }
    }
}
struct FixedOrder {
    static constexpr bool GATHER = false;
    int pm, pn;
    __device__ __forceinline__ bool next(int i, pg8::Unit& u) const { if (i != 0) return false; u.pm = pm; u.pn = pn; return true; }
    __device__ __forceinline__ void a_ready(const pg8::Unit&) const {}
    __device__ __forceinline__ void done(const pg8::Unit&) const {}
};
struct PairOrder {
    static constexpr bool GATHER = false;
    int pm, pn0, pn1;
    __device__ __forceinline__ bool next(int i, pg8::Unit& u) const { if (i > 1) return false; u.pm = pm; u.pn = i ? pn1 : pn0; return true; }
    __device__ __forceinline__ void a_ready(const pg8::Unit&) const {}
    __device__ __forceinline__ void done(const pg8::Unit&) const {}
};
struct EpiSoftmax {
    static constexpr bool PERM = true, AFTER_DRAIN = true, MIDK = false;
    bf16_t* P; const float* ss; int ld; float scale;
    __device__ __forceinline__ void fused(A4 (&acc)[2][2][4][2], const pg8::Unit& u, int wr, int wc, int fr, int fq, PG8_LAS unsigned char* lds, int wid, int lane) const {
        typedef float f32x2v __attribute__((ext_vector_type(2)));
        PG8_LAS f32x2v* X = (PG8_LAS f32x2v*)lds;
        float mw[2][4];
#pragma unroll
        for (int ai = 0; ai < 2; ++ai)
#pragma unroll
            for (int m = 0; m < 4; ++m) {
                const float rsc = rstd_of(ss, u.pm * 256 + ai * 128 + wr * 64 + m * 16 + fr, fq) * scale;
                float mx = -INFINITY;
#pragma unroll
                for (int bj = 0; bj < 2; ++bj)
#pragma unroll
                    for (int n = 0; n < 2; ++n)
#pragma unroll
                        for (int i = 0; i < 4; ++i) { acc[ai][bj][m][n][i] *= rsc; mx = fmaxf(mx, acc[ai][bj][m][n][i]); }
                mx = fmaxf(mx, swz_xor<16>(mx)); mx = max_xor32(mx);
                float s = 0.f;
#pragma unroll
                for (int bj = 0; bj < 2; ++bj)
#pragma unroll
                    for (int n = 0; n < 2; ++n)
#pragma unroll
                        for (int i = 0; i < 4; ++i) { const float e = __expf(acc[ai][bj][m][n][i] - mx); acc[ai][bj][m][n][i] = e; s += e; }
                s = add_xor32(add_xor16(s));
                mw[ai][m] = mx;
                if (fq == 0) X[(ai * 128 + wr * 64 + m * 16 + fr) * 4 + wc] = (f32x2v){mx, s};
            }
        asm volatile("s_waitcnt lgkmcnt(0)" ::: "memory"); __builtin_amdgcn_s_barrier(); asm volatile("" ::: "memory");
#pragma unroll
        for (int ai = 0; ai < 2; ++ai)
#pragma unroll
            for (int m = 0; m < 4; ++m) {
                const int r = ai * 128 + wr * 64 + m * 16 + fr;
                const f32x2v a = X[r * 4 + 0], b = X[r * 4 + 1], c = X[r * 4 + 2], d = X[r * 4 + 3];
                const float M = fmaxf(fmaxf(a.x, b.x), fmaxf(c.x, d.x));
                const float S = (a.y * __expf(a.x - M) + b.y * __expf(b.x - M)) + (c.y * __expf(c.x - M) + d.y * __expf(d.x - M));
                const float f = __expf(mw[ai][m] - M) * __builtin_amdgcn_rcpf(S);
#pragma unroll
                for (int bj = 0; bj < 2; ++bj) *(u32x4*)(P + (size_t)(u.pm * 256 + r) * ld + bj * 128 + wc * 32 + 8 * fq) = pack8(acc[ai][bj][m][0] * f, acc[ai][bj][m][1] * f);
            }
    }
};
typedef float f32x16 __attribute__((ext_vector_type(16)));
constexpr int RTAB = 640;
__device__ __forceinline__ bf16x8_t as_bf16x8(const u32x4 w) { return __builtin_bit_cast(bf16x8_t, w); }
constexpr float LOG2E = 1.4426950408889634f;
__device__ __forceinline__ void band_tables(const float* __restrict__ rel  , LAS float* Rt, int tid, int h_lo = 0, int nh = AH) {
    rel += h_lo * RELW;
    for (int i = tid; i < nh * RTAB; i += 512) { const int h = i / RTAB, k = i % RTAB; int r = 575 - k; r = r < -AMAXREL ? -AMAXREL : (r > AMAXREL ? AMAXREL : r); Rt[i] = rel[h * RELW + r + AMAXREL] * LOG2E; }
}
__device__ __forceinline__ void band_load_k(bf16x8_t (&Kf)[4], const bf16_t* __restrict__ AK, long kt, int lane) {
#pragma unroll
    for (int s = 0; s < 4; ++s) Kf[s] = *(const bf16x8_t*)(AK + ((kt * 4 + s) * 64 + lane) * 8);
}
__device__ __forceinline__ void band_load_v(u32x4 (&Vr)[2][2], const bf16_t* __restrict__ AVT, long kt, int lane) {
#pragma unroll
    for (int db = 0; db < 2; ++db)
#pragma unroll
        for (int s = 0; s < 2; ++s) Vr[db][s] = *(const u32x4*)(AVT + (((kt * 2 + db) * 2 + s) * 64 + lane) * 8);
}
__device__ __forceinline__ bf16x8_t band_v_frag(const u32x4 r) {
    const auto a = __builtin_amdgcn_permlane32_swap(r.x, r.z, false, false); const auto c = __builtin_amdgcn_permlane32_swap(r.y, r.w, false, false);
    return as_bf16x8((u32x4){a[0], c[0], a[1], c[1]});
}
__device__ __forceinline__ void band_item(int item, int lane, const bf16_t* __restrict__ AQ, const bf16_t* __restrict__ AK, const bf16_t* __restrict__ AVT, const LAS float* Rt  , bf16_t* __restrict__ OAB, int h_tab0 = 0) {
    const int n = item % NCH, h = (item / NCH) % AH, b = item / (NCH * AH);
    const int ql = lane & 31, hh = lane >> 5;
    const size_t tok0 = (size_t)b * L + (size_t)n * CH;
    bf16x8_t Qf[2][4];
#pragma unroll
    for (int qb = 0; qb < 2; ++qb)
#pragma unroll
        for (int s = 0; s < 4; ++s) Qf[qb][s] = *(const bf16x8_t*)(AQ + (((((long)(tok0 >> 5) + qb) * AH + h) * 4 + s) * 64 + lane) * 8);
    f32x16 O[2][2];
#pragma unroll
    for (int db = 0; db < 2; ++db)
#pragma unroll
        for (int qb = 0; qb < 2; ++qb)
#pragma unroll
            for (int r = 0; r < 16; ++r) O[db][qb][r] = 0.f;
    float mrun[2] = {-INFINITY, -INFINITY}, lrun[2] = {0.f, 0.f};
    const LAS float* Rh = Rt + (h - h_tab0) * RTAB + (31 - ql + 4 * hh);
    const float bias_far = Rt[(h - h_tab0) * RTAB];
    const int j_lo = (n < ALC ? 2 * (ALC - n) : 0), j_hi = 2 * ALC + 1;
    const long ktb = ((long)b * L + (long)(n - ALC) * CH) / 32 * AH + h;
    bf16x8_t Kf0[4], Kf1[4]; u32x4 Vf0[2][2], Vf1[2][2];
    f32x16 S[2];
#define BAND_CL(jj) (ktb + (long)((jj) <= j_hi ? (jj) : j_hi) * AH)
    band_load_k(Kf0, AK, BAND_CL(j_lo), lane);
    band_load_v(Vf0, AVT, BAND_CL(j_lo), lane);
    band_load_k(Kf1, AK, BAND_CL(j_lo + 1), lane);
    band_load_v(Vf1, AVT, BAND_CL(j_lo + 1), lane);
#define BAND_SCORES(jj, Kf) do { const LAS float* Rc_ = Rh + (jj) * 32; \
        _Pragma("unroll") for (int qb = 0; qb < 2; ++qb) { \
            if ((jj) < 8) { _Pragma("unroll") for (int r = 0; r < 16; ++r) S[qb][r] = bias_far; } \
            else { _Pragma("unroll") for (int r = 0; r < 16; ++r) S[qb][r] = Rc_[32 - 32 * qb + (r & 3) + 8 * (r >> 2)]; } \
            _Pragma("unroll") for (int s = 0; s < 4; ++s) S[qb] = __builtin_amdgcn_mfma_f32_32x32x16_bf16(Kf[s], Qf[qb][s], S[qb], 0, 0, 0); } } while (0)
#define BAND_SOFTMAX_PV(Vr) do { \
        bf16x8_t Vf[2][2]; \
        _Pragma("unroll") for (int db = 0; db < 2; ++db) _Pragma("unroll") for (int s = 0; s < 2; ++s) Vf[db][s] = band_v_frag(Vr[db][s]); \
        _Pragma("unroll") for (int qb = 0; qb < 2; ++qb) { \
            float mx = S[qb][0]; \
            _Pragma("unroll") for (int r = 1; r < 16; ++r) mx = fmaxf(mx, S[qb][r]); \
            mx = max_xor32(mx); \
            const float mn = fmaxf(mrun[qb], mx), alpha = __builtin_amdgcn_exp2f(mrun[qb] - mn); \
            mrun[qb] = mn; \
            float sum = 0.f; \
            _Pragma("unroll") for (int r = 0; r < 16; ++r) { const float p = __builtin_amdgcn_exp2f(S[qb][r] - mn); S[qb][r] = p; sum += p; } \
            lrun[qb] = lrun[qb] * alpha + add_xor32(sum); \
            _Pragma("unroll") for (int db = 0; db < 2; ++db) \
                _Pragma("unroll") for (int r = 0; r < 16; ++r) O[db][qb][r] *= alpha; \
            _Pragma("unroll") for (int s = 0; s < 2; ++s) { \
                u32x4 w; w.x = pkbf(S[qb][8 * s + 0], S[qb][8 * s + 1]); w.y = pkbf(S[qb][8 * s + 2], S[qb][8 * s + 3]); w.z = pkbf(S[qb][8 * s + 4], S[qb][8 * s + 5]); w.w = pkbf(S[qb][8 * s + 6], S[qb][8 * s + 7]); \
                const bf16x8_t Pf = as_bf16x8(w); \
                _Pragma("unroll") for (int db = 0; db < 2; ++db) O[db][qb] = __builtin_amdgcn_mfma_f32_32x32x16_bf16(Vf[db][s], Pf, O[db][qb], 0, 0, 0); \
            } } } while (0)
    BAND_SCORES(j_lo, Kf0);
    band_load_k(Kf0, AK, BAND_CL(j_lo + 2), lane);
#pragma nounroll
    for (int j = j_lo; j <= j_hi; j += 2) {
        BAND_SOFTMAX_PV(Vf0);
        band_load_v(Vf0, AVT, BAND_CL(j + 2), lane);
        BAND_SCORES(j + 1, Kf1);
        band_load_k(Kf1, AK, BAND_CL(j + 3), lane);
        BAND_SOFTMAX_PV(Vf1);
        if (j + 2 <= j_hi) {
            band_load_v(Vf1, AVT, BAND_CL(j + 3), lane);
            BAND_SCORES(j + 2, Kf0);
            band_load_k(Kf0, AK, BAND_CL(j + 4), lane);
        }
    }
#undef BAND_SOFTMAX_PV
#undef BAND_CL
#undef BAND_SCORES
#pragma unroll
    for (int qb = 0; qb < 2; ++qb) {
        const float inv = 1.0f / lrun[qb];
        bf16_t* orow = OAB + (tok0 + 32 * qb + ql) * D + h * 64 + 4 * hh;
#pragma unroll
        for (int db = 0; db < 2; ++db)
#pragma unroll
            for (int g = 0; g < 4; ++g) { u32x2 o; o.x = pkbf(O[db][qb][4 * g] * inv, O[db][qb][4 * g + 1] * inv); o.y = pkbf(O[db][qb][4 * g + 2] * inv, O[db][qb][4 * g + 3] * inv);
                *(u32x2*)(orow + 32 * db + 8 * g) = o; }
    }
}
#ifndef MK_TS_A
#define MK_TS_A (-1)
#define MK_TS_B (-1)
#endif
#define GLA_TS(id) do { if (MK_TS_A >= 0 && ts && ((id) == MK_TS_A || (id) == MK_TS_B) && lane == 0) ts[(id) == MK_TS_B ? 1 : 0] = __builtin_amdgcn_s_memrealtime(); } while (0)
constexpr size_t DS_ITEM = 128 * 64;
__device__ __forceinline__ int rowmap32(int r, int hh) { return (r & 3) + 8 * (r >> 2) + 4 * hh; }

__device__ __forceinline__ float gla_scan_tile(const float* __restrict__ LOGA, size_t tok0, int h, int lane, LAS float* Gt) {
    const float* p = LOGA + tok0 * BKW + h * 64 + lane;
    float cum = 0.f;
#pragma unroll
    for (int t0 = 0; t0 < 64; t0 += 16) {
        float la[16];
#pragma unroll
        for (int i = 0; i < 16; ++i) la[i] = p[(size_t)(t0 + i) * BKW];
#pragma unroll
        for (int i = 0; i < 16; ++i) { cum += la[i]; Gt[(t0 + i) * 64 + lane] = cum; }
    }
    asm volatile("s_waitcnt lgkmcnt(0)" ::: "memory");
    return cum;
}

__device__ __forceinline__ void gla1_item(int idx, int lane, LAS float* Gt, const bf16_t* __restrict__ BK, const bf16_t* __restrict__ BVT, const float* __restrict__ LOGA, float* __restrict__ DS, float* __restrict__ DEC) {
    const int c = idx & 127, h = (idx >> 7) & 3, b = idx >> 9;
    const size_t tok0 = (size_t)b * L + (size_t)c * CH;
    const int ql = lane & 31, hh = lane >> 5;
    LAS bf16_t* Kt = (LAS bf16_t*)(Gt + 64 * 64);
    {
        u32x4 kr[8];
#pragma unroll
        for (int i = 0; i < 8; ++i) kr[i] = *(const u32x4*)(BK + (tok0 + 8 * i + (lane >> 3)) * BKW + h * 64 + (lane & 7) * 8);
#pragma unroll
        for (int i = 0; i < 8; ++i) *(LAS u32x4*)(Kt + (8 * i + (lane >> 3)) * 64 + (lane & 7) * 8) = kr[i];
    }
    const float last = gla_scan_tile(LOGA, tok0, h, lane, Gt);
    DEC[(size_t)idx * 64 + lane] = __expf(last);
    bf16x8_t Xf[2][2][2];
#pragma unroll
    for (int kb = 0; kb < 2; ++kb) {
        const float lk = __int_as_float(shfl_idx(__float_as_int(last), 32 * kb + ql));
#pragma unroll
        for (int tb = 0; tb < 2; ++tb) {
            float x[16];
#pragma unroll
            for (int r = 0; r < 16; ++r) { const int t = 32 * tb + rowmap32(r, hh);
                x[r] = bf2f(Kt[t * 64 + 32 * kb + ql]) * __expf(lk - Gt[t * 64 + 32 * kb + ql]); }
#pragma unroll
            for (int s = 0; s < 2; ++s) { u32x4 w; w.x = pkbf(x[8 * s], x[8 * s + 1]); w.y = pkbf(x[8 * s + 2], x[8 * s + 3]); w.z = pkbf(x[8 * s + 4], x[8 * s + 5]); w.w = pkbf(x[8 * s + 6], x[8 * s + 7]); Xf[tb][kb][s] = as_bf16x8(w); }
        }
    }
    const bf16_t* vbase = BVT + (size_t)(h * 128 + ql) * T + tok0 + 8 * hh;
    float* dsb = DS + (size_t)idx * DS_ITEM;
#pragma unroll
    for (int vb = 0; vb < 4; ++vb) {
        bf16x8_t Vf[2][2];
#pragma unroll
        for (int tb = 0; tb < 2; ++tb)
#pragma unroll
            for (int s = 0; s < 2; ++s) Vf[tb][s] = band_v_frag(*(const u32x4*)(vbase + (size_t)(32 * vb) * T + 32 * tb + 16 * s));
#pragma unroll
        for (int kb = 0; kb < 2; ++kb) {
            f32x16 acc;
#pragma unroll
            for (int r = 0; r < 16; ++r) acc[r] = 0.f;
#pragma unroll
            for (int tb = 0; tb < 2; ++tb)
#pragma unroll
                for (int s = 0; s < 2; ++s) acc = __builtin_amdgcn_mfma_f32_32x32x16_bf16(Vf[tb][s], Xf[tb][kb][s], acc, 0, 0, 0);
#pragma unroll
            for (int r = 0; r < 16; ++r) dsb[(size_t)(32 * vb + rowmap32(r, hh)) * 64 + 32 * kb + ql] = acc[r];
        }
    }
}

__device__ __forceinline__ void gla2_scan(int e, const float* __restrict__ DS, const float* __restrict__ DEC, bf16_t* __restrict__ SB) {
    const int k = e & 63, v = (e >> 6) & 127, bh = e >> 13;
    const size_t base = (size_t)bh * 128;
    float S = 0.f;
#pragma unroll 1
    for (int c0 = 0; c0 < 128; c0 += 8) {
        float d[8], a[8];
#pragma unroll
        for (int i = 0; i < 8; ++i) { d[i] = DS[(base + c0 + i) * DS_ITEM + (size_t)v * 64 + k]; a[i] = DEC[(base + c0 + i) * 64 + k]; }
#pragma unroll
        for (int i = 0; i < 8; ++i) { SB[(base + c0 + i) * DS_ITEM + (size_t)v * 64 + k] = f2bf(S); S = a[i] * S + d[i]; }
    }
}

__device__ __forceinline__ void gla3_unit(int unit, int lane, LAS float* Gt, const bf16_t* __restrict__ BQ, const bf16_t* __restrict__ BK, const bf16_t* __restrict__ BVT, const float* __restrict__ LOGA,
                                          const bf16_t* __restrict__ SB, const bf16_t* __restrict__ BRS, const float* __restrict__ gnorm, bf16_t* __restrict__ OAB, volatile LAS unsigned long long* ts = nullptr) {
    const int tb = unit & 1, idx = unit >> 1;
    const int c = idx & 127, h = (idx >> 7) & 3, b = idx >> 9;
    const size_t tok0 = (size_t)b * L + (size_t)c * CH;
    const int ql = lane & 31, hh = lane >> 5;
    GLA_TS(40);
    (void)gla_scan_tile(LOGA, tok0, h, lane, Gt);
    GLA_TS(41);
    bf16x8_t Qf[4];
    {
        const int t = 32 * tb + ql;
#pragma unroll
        for (int s = 0; s < 4; ++s) {
            const u32x4 q = *(const u32x4*)(BQ + (tok0 + t) * BKW + h * 64 + 16 * s + 8 * hh);
            const f32x4 g0 = *(const LAS f32x4*)(Gt + t * 64 + 16 * s + 8 * hh), g1 = *(const LAS f32x4*)(Gt + t * 64 + 16 * s + 8 * hh + 4);
            u32x4 w; w.x = pkbf(bflo(q.x) * __expf(g0[0]), bfhi(q.x) * __expf(g0[1])); w.y = pkbf(bflo(q.y) * __expf(g0[2]), bfhi(q.y) * __expf(g0[3]));
            w.z = pkbf(bflo(q.z) * __expf(g1[0]), bfhi(q.z) * __expf(g1[1])); w.w = pkbf(bflo(q.w) * __expf(g1[2]), bfhi(q.w) * __expf(g1[3]));
            Qf[s] = as_bf16x8(w);
        }
    }
    bf16x8_t Pf[2][2];
#pragma unroll
    for (int sb = 0; sb < 2; ++sb) {
        if (sb <= tb) {
            const int srow = 32 * sb + ql;
            f32x16 A;
#pragma unroll
            for (int r = 0; r < 16; ++r) A[r] = 0.f;
#pragma unroll
            for (int s = 0; s < 4; ++s) {
                const u32x4 kx = *(const u32x4*)(BK + (tok0 + srow) * BKW + h * 64 + 16 * s + 8 * hh);
                const f32x4 g0 = *(const LAS f32x4*)(Gt + srow * 64 + 16 * s + 8 * hh), g1 = *(const LAS f32x4*)(Gt + srow * 64 + 16 * s + 8 * hh + 4);
                u32x4 w; w.x = pkbf(bflo(kx.x) * __expf(-g0[0]), bfhi(kx.x) * __expf(-g0[1])); w.y = pkbf(bflo(kx.y) * __expf(-g0[2]), bfhi(kx.y) * __expf(-g0[3]));
                w.z = pkbf(bflo(kx.z) * __expf(-g1[0]), bfhi(kx.z) * __expf(-g1[1])); w.w = pkbf(bflo(kx.w) * __expf(-g1[2]), bfhi(kx.w) * __expf(-g1[3]));
                A = __builtin_amdgcn_mfma_f32_32x32x16_bf16(as_bf16x8(w), Qf[s], A, 0, 0, 0);
            }
            if (sb == tb) {
#pragma unroll
                for (int r = 0; r < 16; ++r) A[r] = (rowmap32(r, hh) <= ql) ? A[r] : 0.f;
            }
#pragma unroll
            for (int s2 = 0; s2 < 2; ++s2) { u32x4 w; w.x = pkbf(A[8 * s2], A[8 * s2 + 1]); w.y = pkbf(A[8 * s2 + 2], A[8 * s2 + 3]); w.z = pkbf(A[8 * s2 + 4], A[8 * s2 + 5]); w.w = pkbf(A[8 * s2 + 6], A[8 * s2 + 7]); Pf[sb][s2] = as_bf16x8(w); }
        }
    }
    GLA_TS(42);
    const int c16 = lane & 15, tr = lane >> 4;
    u32x4 bwv[8];
#pragma unroll
    for (int i = 0; i < 8; ++i) bwv[i] = *(const u32x4*)(BRS + (tok0 + 32 * tb + 4 * i + tr) * BVW + h * 128 + 8 * c16);
    f32x16 O[4];
    const bf16_t* vbase = BVT + (size_t)(h * 128 + ql) * T + tok0 + 8 * hh;
    const bf16_t* sbase = SB + (size_t)idx * DS_ITEM + (size_t)ql * 64 + 8 * hh;
#pragma unroll
    for (int vb = 0; vb < 4; ++vb) {
#pragma unroll
        for (int r = 0; r < 16; ++r) O[vb][r] = 0.f;
#pragma unroll
        for (int s = 0; s < 4; ++s) { const bf16x8_t Sf = *(const bf16x8_t*)(sbase + (size_t)(32 * vb) * 64 + 16 * s); O[vb] = __builtin_amdgcn_mfma_f32_32x32x16_bf16(Sf, Qf[s], O[vb], 0, 0, 0); }
#pragma unroll
        for (int sb = 0; sb < 2; ++sb) {
            if (sb <= tb) {
#pragma unroll
                for (int s2 = 0; s2 < 2; ++s2) { const u32x4 vr = *(const u32x4*)(vbase + (size_t)(32 * vb) * T + 32 * sb + 16 * s2);
                    O[vb] = __builtin_amdgcn_mfma_f32_32x32x16_bf16(band_v_frag(vr), Pf[sb][s2], O[vb], 0, 0, 0); }
            }
        }
    }
    GLA_TS(43);
    float q = 0.f;
#pragma unroll
    for (int vb = 0; vb < 4; ++vb)
#pragma unroll
        for (int r = 0; r < 16; ++r) q += O[vb][r] * O[vb][r];
    const float rs = rsqrtf(add_xor32(q) * (1.0f / 128.0f) + EPS);
    asm volatile("s_waitcnt lgkmcnt(0)" ::: "memory");
#pragma unroll
    for (int vb = 0; vb < 4; ++vb)
#pragma unroll
        for (int g4 = 0; g4 < 4; ++g4) {
            const int v0 = 32 * vb + 8 * g4 + 4 * hh; const f32x4 gv = *(const f32x4*)(gnorm + v0);
            f32x4 o; o[0] = O[vb][4 * g4] * rs * gv[0]; o[1] = O[vb][4 * g4 + 1] * rs * gv[1]; o[2] = O[vb][4 * g4 + 2] * rs * gv[2]; o[3] = O[vb][4 * g4 + 3] * rs * gv[3];
            *(LAS f32x4*)(Gt + ql * 128 + (((v0 >> 2) ^ ql) << 2)) = o;
        }
    asm volatile("s_waitcnt lgkmcnt(0)" ::: "memory");
    {
#pragma unroll
        for (int i = 0; i < 8; ++i) {
            const int t = 4 * i + tr; const size_t trow = tok0 + 32 * tb + t;
            const u32x4 bw = bwv[i];
            const f32x4 a0 = *(const LAS f32x4*)(Gt + t * 128 + (((2 * c16) ^ t) << 2)), a1 = *(const LAS f32x4*)(Gt + t * 128 + (((2 * c16 + 1) ^ t) << 2));
            u32x4 o; o.x = pkbf(a0[0] * bflo(bw.x), a0[1] * bfhi(bw.x)); o.y = pkbf(a0[2] * bflo(bw.y), a0[3] * bfhi(bw.y)); o.z = pkbf(a1[0] * bflo(bw.z), a1[1] * bfhi(bw.z)); o.w = pkbf(a1[2] * bflo(bw.w), a1[3] * bfhi(bw.w));
            st16_wt(OAB + trow * D + 512 + h * 128 + 8 * c16, o);
        }
    }
    GLA_TS(44);
}
#ifndef MK_TS_PHASE
#define MK_TS_PHASE (-1)
#define MK_TS_MODE 0
#endif
#ifndef MK_SIMD_W
#define MK_SIMD_W (-1)
#endif
#ifndef MK_ROLE_SWAP
#define MK_ROLE_SWAP 0
#endif
#ifndef MK_TS_WG
#define MK_TS_WG 0
#endif
#define TS_MARKW(id, w) do { if (MK_TS_A >= 0 && l == 0 && ((id) == MK_TS_A || (id) == MK_TS_B) && tid_of(opaque_int(wv0)) == (w) * 64) TS_[(id) == MK_TS_B ? 1 : 0] = __builtin_amdgcn_s_memrealtime(); } while (0)
#define TS_MARK(id) do { if (MK_TS_A >= 0 && l == 0 && ((id) == MK_TS_A || (id) == MK_TS_B) && tid_of(opaque_int(wv0)) == 0) TS_[(id) == MK_TS_B ? 1 : 0] = __builtin_amdgcn_s_memrealtime(); } while (0)
#ifndef MK_REP_PHASE
#define MK_REP_PHASE (-1)
#define MK_REP_N 1
#endif
#ifndef MK_PANEL_TEST
#define MK_PANEL_TEST 0
#endif
#ifndef MK_LAUNCHES
#define MK_LAUNCHES 1
#endif
constexpr int RING_BYTES = 131072, MISC_OFF = RING_BYTES + 512, LDS_BYTES = 147456;
constexpr int CW_BAR = 1024;
constexpr size_t CTL_ZERO_BYTES = 128 * 1024;
constexpr int CW_PANEL = 8192;
static_assert((CW_BAR + XCD_BAR_WORDS) * 4 <= (int)CTL_ZERO_BYTES, "barrier words inside the memset region");
constexpr int N_PHASES = 1 + 6 * DEPTH;

struct MKArgs { InPtrs in; unsigned char* ws; unsigned char* dout; int ph_lo, ph_hi, rep_phase, rep_n; };

__global__ void __launch_bounds__(512, 2) mk_fwd(MKArgs a) {
    extern __shared__ __attribute__((aligned(16))) unsigned char lds_raw[];
    LAS unsigned char* lds = (LAS unsigned char*)lds_raw;
    const int G0 = (int)gridDim.x, vcu0 = (int)blockIdx.x;
    const int wv0 = __builtin_amdgcn_readfirstlane((int)threadIdx.x >> 6);
    volatile LAS unsigned* MISC = (volatile LAS unsigned*)(lds + MISC_OFF);
    if (threadIdx.x < 16) MISC[threadIdx.x] = 0u;
    __syncthreads();
    const bool one_launch = (a.ph_hi - a.ph_lo) > 1;
    XcdBarrier bar; bar.bar = (unsigned*)(a.ws + WS_CTL) + CW_BAR; bar.x = 0; bar.st = MISC + 8;
    if (one_launch) bar = xcd_barrier_post((unsigned*)(a.ws + WS_CTL) + CW_BAR, MISC + 8);

    const InPtrs& in = a.in;
#define SS ((float*)(ws + WS_SSP))
#define XB ((bf16_t*)(ws + WS_XB))
#define AQ ((bf16_t*)(ws + WS_AQ))
#define AK ((bf16_t*)(ws + WS_AK))
#define AVT ((bf16_t*)(ws + WS_AVT))
#define XN ((bf16_t*)(ws + WS_XN))
#define BQ ((bf16_t*)(ws + WS_BQ))
#define BK ((bf16_t*)(ws + WS_BK))
#define BVT ((bf16_t*)(ws + WS_BVT))
#define BRS ((bf16_t*)(ws + WS_BRS))
#define GA ((bf16_t*)(ws + WS_GA))
#define GB ((bf16_t*)(dout + DO_GB))
#define MG ((bf16_t*)(ws + WS_MG))
#define Q ((bf16_t*)(dout + DO_OAB))
#define MEMN ((bf16_t*)(ws + WS_MEMN))
#define KVB ((bf16_t*)(ws + WS_KVB))
#define LOGA ((float*)(ws + WS_LOGA))
#define OAB ((bf16_t*)(dout + DO_OAB))
#define DSF ((float*)(dout + DO_ST))
#define DEC ((float*)(ws + WS_DEC))
#define SBB ((bf16_t*)(ws + WS_SB))
#define TMP ((bf16_t*)(ws + WS_TMP))
#define SELE ((int*)(ws + WS_SEL))
#define SELW ((float*)(ws + WS_SEL + (size_t)T * 2 * 4))
#define WD(l) (ws + WS_WDENSE + (size_t)(l) * WDENSE_STRIDE)
#define SSA(i) (SS + (size_t)(i) * T * 16)
#define MK_EP(l, t0) EpiProj{AQ, AK, BQ, BK, BRS, GA, GB, LOGA, in.gla_b_alpha + (size_t)(l) * BKW, (t0), 0}
    int ph = 0;
    volatile LAS unsigned long long* TS_ = (volatile LAS unsigned long long*)(lds + RING_BYTES + 640);
#define PH_ON (ph >= a.ph_lo && ph < a.ph_hi)
#define PH_RUN for (int rep_ = (PH_ON ? (ph == a.rep_phase ? a.rep_n : 1) : 0); rep_ > 0; --rep_)
#define PH_PTRS const int G = opaque_int(G0), vcu = opaque_int(vcu0), wv = opaque_int(wv0); (void)G; (void)vcu; unsigned char* ws = opaque_ptr(a.ws); unsigned char* dout = opaque_ptr(a.dout); (void)ws; (void)dout; const int tid = tid_of(wv), lane = tid & 63, wave = wv; (void)lane; (void)wave;
#define PH_END do { if (MK_TS_PHASE >= 0 && ph == MK_TS_PHASE && MK_TS_MODE == 1 && tid_of(opaque_int(wv0)) == 0) TS_[1] = __builtin_amdgcn_s_memrealtime(); \
    if (PH_ON && ph + 1 < a.ph_hi) xcd_barrier(bar, tid_of(opaque_int(wv0)) == 0); \
    if (MK_TS_PHASE >= 0 && ph == MK_TS_PHASE && MK_TS_MODE == 0 && tid_of(opaque_int(wv0)) == 0) TS_[1] = __builtin_amdgcn_s_memrealtime(); \
    if (MK_TS_PHASE >= 0 && ph + 1 == MK_TS_PHASE && tid_of(opaque_int(wv0)) == 0) TS_[0] = __builtin_amdgcn_s_memrealtime(); ++ph; } while (0)
#define GEMM_AT(EpiT, gm, ep, cc) do { pg8::StaticOrder S_; S_.init((gm).M, (gm).N, G, (cc)); pg8::gemm_phase<EpiT, pg8::StaticOrder, true, true>(lds, gm, S_, ep, wv); } while (0)
#define GEMM(EpiT, gm, ep) do { pg8::StaticOrder S_; S_.init((gm).M, (gm).N, G, vcu); pg8::gemm_phase<EpiT, pg8::StaticOrder, true, true>(lds, gm, S_, ep, wv); } while (0)

    PH_RUN { PH_PTRS ph_prologue(in, ws, lds, vcu, G, wv);
        LAS float* scr = (LAS float*)(lds + wave * 16384);
        if (G != 256) conv_expert_items(in, ws, 0, DEPTH * NE * 384, vcu * 8 + wave, G * 8, scr, lane);
        conv_router(in, ws, vcu, G, tid); }
    PH_END;

#pragma nounroll
    for (int l = 0; l < DEPTH; ++l) {
        PH_RUN { PH_PTRS
            {
                const bf16_t* Wkv = (const bf16_t*)(WD(l) + WD_WXKV);
                { const pg8::Gemm g{MEMN, Wkv, NB * NMEM, D, D, D, D, 0}; const EpiScale e{KVB + (size_t)l * 2 * NB * NMEM * D, nullptr, D, 1.0f, 1, 0}; GEMM_AT(EpiScale, g, e, (vcu + G - (G > 128 ? 64 : 0)) % G); }
                { const pg8::Gemm g{MEMN, Wkv + (size_t)D * D, NB * NMEM, D, D, D, D, 0}; const EpiScale e{KVB + (size_t)l * 2 * NB * NMEM * D + (size_t)NB * NMEM * D, nullptr, D, 1.0f, 1, 0}; GEMM_AT(EpiScale, g, e, (vcu + G - (G > 128 ? 72 : 0)) % G); }
            }
            { const pg8::Gemm g{XN, (const bf16_t*)(WD(l) + WD_WIN), T, NPROJ_A, D, D, D, 0}; const EpiProj e = MK_EP(l, 0); GEMM(EpiProj, g, e); }
            { const pg8::Gemm g{(const bf16_t*)(WD(l) + WD_WIN) + (size_t)NPROJ_A * D, XN, NPROJ_V, T, D, D, D, 0}; const EpiVT e{AVT, AVT + (size_t)512 * T}; GEMM(EpiVT, g, e); }
            if (l == 0 && G == 256 && vcu >= 80) {
                LAS float* scr = (LAS float*)(lds + wave * 16384);
                conv_dense_layer(in, ws, 1, (vcu - 80) * 8 + wave, 176 * 8, (vcu - 80) * 512 + tid, 176 * 512, scr, lane);
                __syncthreads();
            }
        }
        PH_END;
        PH_RUN { PH_PTRS
            LAS float* Rt = (LAS float*)lds;
            const int rw = MK_ROLE_SWAP ? ((wave >> 1) | ((wave & 1) << 2)) : wave;
            const bool fill = (G == 256);
            const int h0 = fill ? ((vcu * 8) / NCH) % AH : 0;
            TS_MARK(30);
            band_tables(in.rel_bias + (size_t)l * AH * RELW, Rt, tid, h0, fill ? 1 : AH);
            __syncthreads();
            const int xit0 = l * NE * 384 + vcu * 48;
            if (fill) {
                const bool conv_first = ((vcu >> 3) & 1) != 0;
#define MK_HBM_PART do { \
                    if (rw < 4) { \
                        LAS float* Gt = (LAS float*)(lds + 32768 + rw * 24576);        \
                        _Pragma("nounroll") for (int it = vcu * 4 + rw; it < NB * BH * NCH; it += G * 4) gla1_item(it, lane, Gt, BK, BVT, LOGA, DSF, DEC); \
                        conv_expert_run(in, ws, xit0 + rw * 4, 4, Gt, lane); \
                    } else { \
                        LAS float* scr = (rw < 7) ? (LAS float*)(lds + 2560 + (rw - 4) * 8448) : (LAS float*)(lds + RING_BYTES + 4096); \
                        conv_expert_run(in, ws, xit0 + 16 + (rw - 4) * 8, 8, scr, lane); \
                    } } while (0)
                if (conv_first) MK_HBM_PART;
                band_item(vcu * 8 + rw, lane, AQ, AK, AVT, Rt, OAB, h0);
                TS_MARKW(33, 4);
                if (!conv_first) MK_HBM_PART;
                TS_MARKW(34, 4);
                TS_MARKW(32, 0);
#undef MK_HBM_PART
            } else {
                if (rw < 4) {
                    LAS float* Gt = (LAS float*)(lds + 32768 + rw * 24576);
#pragma nounroll
                    for (int it = vcu * 4 + rw; it < NB * BH * NCH; it += G * 4) gla1_item(it, lane, Gt, BK, BVT, LOGA, DSF, DEC);
                }
#pragma nounroll
                for (int it = vcu * 8 + rw; it < NB * AH * NCH; it += G * 8) band_item(it, lane, AQ, AK, AVT, Rt, OAB);
            }
        }
        PH_END;
        PH_RUN { PH_PTRS
            if (G == 256) { if (vcu >= 64) for (int e2 = (vcu - 64) * 512 + tid; e2 < NB * BH * 128 * 64; e2 += 192 * 512) gla2_scan(e2, DSF, DEC, SBB); }
            else for (int e2 = vcu * 512 + tid; e2 < NB * BH * 128 * 64; e2 += G * 512) gla2_scan(e2, DSF, DEC, SBB);
            __syncthreads();
            const bf16_t* KBl = KVB + (size_t)l * 2 * NB * NMEM * D; const bf16_t* VBl = KBl + (size_t)NB * NMEM * D;
#pragma nounroll
            for (int j = 0; j < NB * XH; ++j) {
                const int b = j >> 2, h = j & 3;
                { const pg8::Gemm g{KBl + (size_t)(b * NMEM) * D + h * XD, (const bf16_t*)(WD(l) + WD_WXQ) + h * XD, NMEM, D, XD, D, D, 0};
                  const EpiScale e{(bf16_t*)(ws + WS_MT) + (size_t)(j * NMEM) * D, nullptr, D, 1.0f, 1, 0}; GEMM_AT(EpiScale, g, e, (vcu + G - 4 * j) % G); }
                { const pg8::Gemm g{(const bf16_t*)(WD(l) + WD_WXO) + h * XD, VBl + (size_t)(b * NMEM) * D + h * XD, D, NMEM, XD, D, D, 0};
                  const EpiScale e{(bf16_t*)(ws + WS_NT) + (size_t)b * D * D + h * XD, nullptr, D, 1.0f, 1, 0}; GEMM_AT(EpiScale, g, e, (vcu + G - 32 - 4 * j) % G); }
            }
        }
        PH_END;
        PH_RUN { PH_PTRS
            pg8::StaticOrder S0; S0.init(T, D, G, vcu); pg8::Unit u;
            if (G == 256 && S0.next(0, u)) {
                unsigned* PC = (unsigned*)(ws + WS_CTL) + CW_PANEL + 16 * (l * 64 + u.pm);
#define P_ARRIVE(s) do { if (tid == 0) (void)xb_add(PC + 2048 * (s), 1u); } while (0)
#define P_WAIT(s) do { if (tid == 0) { unsigned sp_ = 0; while (xb_ld(PC + 2048 * (s)) < 4u) { __builtin_amdgcn_s_sleep(2); if (++sp_ > (1u << 20)) break; } \
                       __builtin_amdgcn_fence(__ATOMIC_ACQUIRE, "agent"); asm volatile("s_waitcnt vmcnt(0)" ::: "memory"); } __syncthreads(); } while (0)
                const int h = u.pn, b = u.pm >> 5;
                TS_MARK(0);
                {
                    LAS float* Gt = (LAS float*)(lds + wave * 16384);
                    const int idx = (b * BH + h) * NCH + (u.pm & 31) * 4 + (wave >> 1);
                    gla3_unit(idx * 2 + (wave & 1), lane, Gt, BQ, BK, BVT, LOGA, SBB, BRS, in.gla_norm_g + (size_t)l * 128, OAB, (MK_TS_A >= 0 && l == 0 && wave == 0) ? TS_ : nullptr);
                    asm volatile("s_waitcnt vmcnt(0)" ::: "memory"); __syncthreads();
                    P_ARRIVE(0);
                }
                TS_MARK(1);
                const bf16_t* Wg = (const bf16_t*)(WD(l) + WD_WIN) + (size_t)(NPROJ_A + NPROJ_V) * D;
                { const pg8::Gemm g{XN, Wg, T, NPROJ_B, D, D, D, 0}; const PairOrder F{u.pm, u.pn, 4 + u.pn}; const EpiProj e = MK_EP(l, 9); pg8::gemm_phase<EpiProj, PairOrder, true, true>(lds, g, F, e, wv); }
                P_ARRIVE(1);
                TS_MARK(2);
                if (tid == 0) { unsigned sp_ = 0; while (xb_ld(PC) < 4u || xb_ld(PC + 2048) < 4u) { __builtin_amdgcn_s_sleep(2); if (++sp_ > (1u << 20)) break; }
                    __builtin_amdgcn_fence(__ATOMIC_ACQUIRE, "agent"); asm volatile("s_waitcnt vmcnt(0)" ::: "memory"); }
                __syncthreads();
                TS_MARK(3);
                { const pg8::Gemm g{OAB, (const bf16_t*)(WD(l) + WD_WB), T, D, D, D, D, 0}; const FixedOrder F{u.pm, u.pn}; const EpiMerge e{GA, GB, MG}; pg8::gemm_phase<EpiMerge, FixedOrder, true, true>(lds, g, F, e, wv); }
                P_ARRIVE(2);
                TS_MARK(4);
                P_WAIT(2);
                TS_MARK(5);
                { const pg8::Gemm g{MG, (const bf16_t*)(WD(l) + WD_WMO), T, D, D, D, D, 0}; const FixedOrder F{u.pm, u.pn}; const EpiResid e{XB, XB, SSA(3 * l + 1)}; pg8::gemm_phase<EpiResid, FixedOrder, true, true>(lds, g, F, e, wv); }
                P_ARRIVE(3);
                TS_MARK(6);
                P_WAIT(3);
                TS_MARK(7);
                {
                    const pg8::Gemm g{XB, (const bf16_t*)(ws + WS_MT) + (size_t)((b * XH + h) * NMEM) * D, T, NMEM, D, D, D, 0}; const FixedOrder F{u.pm, 0}; const EpiSoftmax e{Q + h * XD, SSA(3 * l + 1), D, 0.0625f};
                    pg8::gemm_phase<EpiSoftmax, FixedOrder, false, true>(lds, g, F, e, wv);
                    asm volatile("s_waitcnt vmcnt(0)" ::: "memory"); __syncthreads();
                }
                P_ARRIVE(4);
                TS_MARK(8);
                P_WAIT(4);
                TS_MARK(9);
                { const pg8::Gemm g{Q, (const bf16_t*)(ws + WS_NT) + (size_t)b * D * D, T, D, D, D, D, 0}; const FixedOrder F{u.pm, u.pn}; const EpiResid e{XB, XB, SSA(3 * l + 2)}; pg8::gemm_phase<EpiResid, FixedOrder, true, true>(lds, g, F, e, wv); }
                P_ARRIVE(5);
                TS_MARK(10);
                P_WAIT(5);
                TS_MARK(11);
                ph_route(in, ws, lds, l, u.pm * 256 + u.pn * 64, wv, false);
                TS_MARK(12);
#undef P_ARRIVE
#undef P_WAIT
            }
        }
        PH_END;
        PH_RUN { PH_PTRS
            LAS int* tb = (LAS int*)(lds + RING_BYTES + 1024);
            moe_tables(ws, l, tb, vcu, wave, lane);
            const int nt = tb[64], n1 = 2 * nt, r1 = n1 > G ? n1 - G : 0, ne = nt < G / 2 ? nt : G / 2, nl = nt - ne, tot1 = r1 + ne + 4 * nl;
            const int* TOKS = (const int*)(ws + WS_TOK);
            unsigned* READY = (unsigned*)(ws + WS_CTL) + CW_READY + 16 * (l * NTMAX);
            const bf16_t* WGU = (const bf16_t*)(ws + WS_WEXP + (size_t)l * WEXP_STRIDE); const bf16_t* WDT = (const bf16_t*)(ws + WS_WEXP + (size_t)l * WEXP_STRIDE + 32 * MiB);
#pragma nounroll
            TS_MARK(20);
            for (int s = vcu - G; s < tot1; s += G) {
                const int u0 = (G == 256) ? (vcu & 7) * 32 + (vcu >> 3) : vcu;
                const int Lu = s < 0 ? u0 : (s < r1 ? G + s : -1);
                if (s < 0 && u0 >= n1) continue;
                if (Lu >= 0) {
                    const int rt = Lu >> 1, ex = __builtin_amdgcn_readfirstlane(tb[96 + rt]), tl = rt - __builtin_amdgcn_readfirstlane(tb[32 + ex]), cn = __builtin_amdgcn_readfirstlane(tb[ex]);
                    const pg8::Gemm g{XB, WGU, nt * 256, 512, D, D, D, 0};
                    const GatherOrder F{rt, ex * 2 + (Lu & 1), TOKS + (size_t)ex * T, tl, cn};
                    const EpiHid e{(bf16_t*)(ws + WS_HID), TOKS + (size_t)ex * T, (const float*)(ws + WS_SEL + SEL_RS), (const float*)(ws + WS_SEL + SEL_SELW), tl, cn};
                    pg8::gemm_phase<EpiHid, GatherOrder, true, true>(lds, g, F, e, wv);
                    if (tid == 0) (void)xb_add(READY + 16 * rt, 1u);
                    TS_MARK(s < 0 ? 21 : 22);
                } else {
                    int rt, j0, nj;
                    if (s - r1 < ne) { rt = s - r1; j0 = 0; nj = 4; } else { const int q = s - r1 - ne; rt = ne + (q >> 2); j0 = q & 3; nj = 1; }
                    if (tid == 0) { unsigned sp = 0; while (xb_ld(READY + 16 * rt) < 2u) { __builtin_amdgcn_s_sleep(2); if (++sp > (1u << 20)) break; }
                        __builtin_amdgcn_fence(__ATOMIC_ACQUIRE, "agent"); asm volatile("s_waitcnt vmcnt(0)" ::: "memory"); }
                    __syncthreads();
                    const int ex = __builtin_amdgcn_readfirstlane(tb[96 + rt]);
                    const pg8::Gemm g{(const bf16_t*)(ws + WS_HID), WDT, nt * 256, D, EF, EF, EF, 0};
                    const QuadOrder F{rt, ex * 4 + j0, nj};
                    const EpiY e{(bf16_t*)(ws + WS_XG)};
                    pg8::gemm_phase<EpiY, QuadOrder, true, true>(lds, g, F, e, wv);
                }
            }
        }
        PH_END;
        PH_RUN { PH_PTRS ph_combine(ws, l, vcu, G, (l + 1 < DEPTH) ? XN : nullptr, (l + 1 < DEPTH) ? nullptr : (float*)dout, in.final_g, wv, rep_ > 1 ? (bf16_t*)dout : XB); }
        PH_END;
    }
    if ((MK_TS_PHASE >= 0 || MK_TS_A >= 0) && blockIdx.x == MK_TS_WG && tid_of(opaque_int(wv0)) == 0) { asm volatile("s_waitcnt vmcnt(0)" ::: "memory"); ((float*)a.dout)[(size_t)MK_TS_WG * 8 * D] = (float)(TS_[1] - TS_[0]) * 0.01f; }
#undef PH_ON
#undef PH_RUN
#undef PH_PTRS
#undef PH_END
#undef GEMM
#undef GEMM_AT
#undef SS
#undef XB
#undef AQ
#undef AK
#undef AVT
#undef XN
#undef BQ
#undef BK
#undef BVT
#undef BRS
#undef GA
#undef GB
#undef MG
#undef Q
#undef MEMN
#undef KVB
#undef LOGA
#undef OAB
#undef DSF
#undef DEC
#undef SBB
#undef TMP
#undef SELE
#undef SELW
#undef WD
#undef SSA
#undef MK_EP
}

extern "C" void kernel_launch(void* const* d_in, const int* in_sizes, int n_in, void* d_out, int out_size, void* d_ws, size_t ws_size, hipStream_t stream) {
    static int grid = 0;
    if (grid == 0) {
        int dev = 0, cus = 0;
        if (hipGetDevice(&dev) != hipSuccess || hipDeviceGetAttribute(&cus, hipDeviceAttributeMultiprocessorCount, dev) != hipSuccess || cus <= 0) cus = 256;
        grid = 256;
        if (cus != 256) fprintf(stderr, "kernel_launch: device reports %d CUs; this kernel is built for 256\n", cus);
        if (hipFuncSetAttribute((const void*)mk_fwd, hipFuncAttributeMaxDynamicSharedMemorySize, LDS_BYTES) != hipSuccess) fprintf(stderr, "kernel_launch: hipFuncSetAttribute failed\n");
        int per_cu = 0;
        if (hipOccupancyMaxActiveBlocksPerMultiprocessor(&per_cu, (const void*)mk_fwd, 512, LDS_BYTES) != hipSuccess || per_cu < 1) fprintf(stderr, "kernel_launch: occupancy query says %d blocks per CU\n", per_cu);
        (void)hipGetLastError();
        if (ws_size < WS_END || n_in != 24) fprintf(stderr, "kernel_launch: unexpected ws_size %zu / n_in %d\n", ws_size, n_in);
    }
    MKArgs a{};
    { const float** p = (const float**)&a.in; for (int i = 0; i < 24; ++i) p[i] = (const float*)d_in[i]; }
    a.ws = (unsigned char*)d_ws; a.dout = (unsigned char*)d_out;
    (void)hipMemsetAsync((unsigned char*)d_ws + WS_CTL, 0, CTL_ZERO_BYTES, stream);
#if MK_LAUNCHES == 1
    a.ph_lo = 0; a.ph_hi = N_PHASES; a.rep_phase = MK_REP_PHASE; a.rep_n = MK_REP_N;
    hipLaunchKernelGGL(mk_fwd, dim3(grid), dim3(512), LDS_BYTES, stream, a);
#else
    for (int p = 0; p < N_PHASES; ++p) { a.ph_lo = p; a.ph_hi = p + 1; a.rep_phase = -1; a.rep_n = 1; hipLaunchKernelGGL(mk_fwd, dim3(grid), dim3(512), LDS_BYTES, stream, a); }
#endif
}
```

```cpp
#include <hip/hip_runtime.h>
#include <cstdint>
#include <cstdio>
#include <cmath>

namespace cfg {
constexpr int D = 1024, NB = 2, L = 8192, T = NB * L, DEPTH = 2;
constexpr int CH = 64, NMEM = 256, NCH = L / CH;
constexpr int AH = 8, AW = 512, ALC = 8, ABAND = 576, AMAXREL = 256, RELW = 2 * AMAXREL + 1;
constexpr int BH = 4, BKW = 256, BVW = 512, BR = 16;
constexpr int INW = 5136;
constexpr int XH = 4, XD = 256;
constexpr int NG = 4, EPG = 8, NE = NG * EPG, EF = 256;
constexpr float EPS = 1e-6f;
constexpr int NPROJ_A = 9 * 256, NPROJ_V = 4 * 256, NPROJ_B = 8 * 256;

constexpr size_t MiB = 1u << 20;
constexpr size_t WS_CTL = 0, CTL_BYTES = 2 * MiB;
constexpr size_t WS_WDENSE = 2 * MiB, WDENSE_STRIDE = 23 * MiB;
constexpr size_t WD_WIN = 0, WD_WB = 11 * MiB, WD_WMO = 13 * MiB, WD_WXQ = 15 * MiB, WD_WXKV = 17 * MiB, WD_WXO = 21 * MiB;
constexpr size_t WS_WEXP = 48 * MiB, WEXP_STRIDE = 48 * MiB;
constexpr size_t WS_XB = 144 * MiB;
constexpr size_t WS_XN = 176 * MiB;
constexpr size_t WS_MIX = 208 * MiB;
constexpr size_t WS_AQ = WS_MIX, WS_AK = WS_MIX + 16 * MiB, WS_AVT = WS_MIX + 32 * MiB, WS_BVT = WS_MIX + 48 * MiB, WS_BQ = WS_MIX + 64 * MiB, WS_BK = WS_MIX + 72 * MiB,
                 WS_BRS = WS_MIX + 80 * MiB, WS_LOGA = WS_MIX + 96 * MiB;
constexpr size_t WS_SB = WS_AQ;
constexpr size_t WS_GA = WS_MIX + 16 * MiB, WS_TMP = WS_MIX + 48 * MiB, WS_MG = WS_XN;
constexpr size_t WS_XG = WS_MIX, WS_HID = WS_MIX + 80 * MiB;
constexpr size_t WS_MEMN = 320 * MiB, WS_KVB = 321 * MiB;
constexpr size_t WS_SEL = 325 * MiB;
constexpr size_t WS_SSP = 326 * MiB;
constexpr size_t WS_DEC = 333 * MiB + 512 * 1024;
constexpr size_t WS_WR = 333 * MiB;
constexpr size_t WS_TOK = 334 * MiB;
constexpr size_t WS_MT = 336 * MiB, WS_NT = 340 * MiB;
constexpr size_t WS_END = 344 * MiB;
constexpr size_t DO_OAB = 0, DO_ST = 32 * MiB, DO_GB = 32 * MiB;
}
using namespace cfg;

#define LAS __attribute__((address_space(3)))
typedef unsigned short bf16_t;
typedef float f32x4 __attribute__((ext_vector_type(4)));
typedef unsigned u32x4 __attribute__((ext_vector_type(4)));
typedef unsigned u32x2 __attribute__((ext_vector_type(2)));

__device__ __forceinline__ float bf2f(unsigned short b) { return __uint_as_float((unsigned)b << 16); }
__device__ __forceinline__ float bflo(unsigned w) { return __uint_as_float(w << 16); }
__device__ __forceinline__ float bfhi(unsigned w) { return __uint_as_float(w & 0xffff0000u); }
__device__ __forceinline__ unsigned pkbf(float lo, float hi) { unsigned r; asm volatile("v_cvt_pk_bf16_f32 %0, %1, %2" : "=v"(r) : "v"(lo), "v"(hi)); return r; }
__device__ __forceinline__ unsigned short f2bf(float f) { return (unsigned short)(pkbf(f, 0.f) & 0xffffu); }
__device__ __forceinline__ float fsigmoid(float x) { return __builtin_amdgcn_rcpf(1.0f + __expf(-x)); }
__device__ __forceinline__ float fsilu(float x) { return x * fsigmoid(x); }
__device__ __forceinline__ float flogsigmoid(float x) { return fminf(x, 0.f) - __logf(1.0f + __expf(-fabsf(x))); }
template <int MASK> __device__ __forceinline__ float swz_xor(float v) { return __int_as_float(__builtin_amdgcn_ds_swizzle(__float_as_int(v), (MASK << 10) | 0x1f)); }
__device__ __forceinline__ float add_xor32(float v) { const auto r = __builtin_amdgcn_permlane32_swap(__float_as_uint(v), __float_as_uint(v), false, false); return __uint_as_float(r[0]) + __uint_as_float(r[1]); }
__device__ __forceinline__ float max_xor32(float v) { const auto r = __builtin_amdgcn_permlane32_swap(__float_as_uint(v), __float_as_uint(v), false, false); return fmaxf(__uint_as_float(r[0]), __uint_as_float(r[1])); }
__device__ __forceinline__ float add_xor16(float v) { return v + swz_xor<16>(v); }
__device__ __forceinline__ float wave_sum(float v) { v += swz_xor<1>(v); v += swz_xor<2>(v); v += swz_xor<4>(v); v += swz_xor<8>(v); v += swz_xor<16>(v); return add_xor32(v); }
__device__ __forceinline__ float wave_max(float v) { v = fmaxf(v, swz_xor<1>(v)); v = fmaxf(v, swz_xor<2>(v)); v = fmaxf(v, swz_xor<4>(v)); v = fmaxf(v, swz_xor<8>(v)); v = fmaxf(v, swz_xor<16>(v)); return max_xor32(v); }
__device__ __forceinline__ int shfl_idx(int v, int src_lane) { return __builtin_amdgcn_ds_bpermute(src_lane << 2, v); }
typedef __attribute__((address_space(1))) unsigned char* gbl_u8_ptr;
__device__ __forceinline__ unsigned char* opaque_ptr(unsigned char* p) { gbl_u8_ptr g = (gbl_u8_ptr)p; asm volatile("" : "+s"(g)); return (unsigned char*)g; }
__device__ __forceinline__ int lane_now() { unsigned z; asm volatile("v_mov_b32 %0, 0" : "=v"(z)); return (int)__builtin_amdgcn_mbcnt_hi(~0u, __builtin_amdgcn_mbcnt_lo(~0u, z)); }
__device__ __forceinline__ int opaque_int(int v) { asm volatile("" : "+s"(v)); return v; }
__device__ __forceinline__ int tid_of(int wv) { return (wv << 6) | lane_now(); }
__device__ __forceinline__ void st16_wt(void* p, const u32x4 v) { asm volatile("global_store_dwordx4 %0, %1, off sc1\n\ts_nop 1" :: "v"(p), "v"(v) : "memory"); }
#ifndef MK_WT
#define MK_WT 1
#endif
#if MK_WT
#define ST16_OUT(p, v) st16_wt((void*)(p), (v))
#else
#define ST16_OUT(p, v) (*(u32x4*)(p) = (v))
#endif
namespace pg8 {
#define PG8_LAS __attribute__((address_space(3)))
typedef unsigned short bf16_t;
typedef short bf16x8 __attribute__((ext_vector_type(8)));
typedef float f32x4 __attribute__((ext_vector_type(4)));
typedef unsigned u32x4 __attribute__((ext_vector_type(4)));
constexpr int BM = 256, BK = 64, HALF = 128, HTB = HALF * BK * 2  , STAGE_BYTES = 8 * HTB, NXCD = 8, WGM = 8;

__host__ __device__ __forceinline__ int lds_byte(int r, int c) { const int st = (r >> 4) * 2 + (c >> 5), rr = r & 15, cc = c & 31, ob = rr * 64 + cc * 2; return st * 1024 + (ob ^ (((ob >> 9) & 1) << 5)); }
__host__ __device__ __forceinline__ void stage_rc(int b, int& R, int& C) { const int st = b / 1024, sb = b % 1024, swz = sb ^ (((sb >> 9) & 1) << 5); R = (st >> 1) * 16 + swz / 64; C = (st & 1) * 32 + (swz % 64) / 2; }
__host__ __device__ __forceinline__ int perm32(int rho) { const int n = rho >> 4, i = rho & 15; return 8 * (i >> 2) + 4 * n + (i & 3); }

struct Unit { int pm, pn; };
struct Gemm { const bf16_t* A; const bf16_t* Bt; int M, N, K, lda, ldb, pad; };

struct StaticOrder {
    static constexpr bool GATHER = false;
    int nM, nN, nwg, G, c;
    __host__ __device__ __forceinline__ void init(int M, int N, int G_, int c_) { nM = M / BM; nN = N / BM; nwg = nM * nN; G = G_; c = c_; }
    __host__ __device__ __forceinline__ bool next(int i, Unit& u) const {
        const long L = (long)i * G + c; if (L >= nwg) return false;
        int wgid = (int)L; { const int q = nwg / NXCD, r = nwg % NXCD, xcd = wgid % NXCD, off = wgid / NXCD; wgid = (xcd < r ? xcd * (q + 1) : r * (q + 1) + (xcd - r) * q) + off; }
        const int nig = WGM * nN, gid = wgid / nig, fm = gid * WGM, gsz = (nM - fm) < WGM ? (nM - fm) : WGM;
        u.pm = fm + ((wgid % nig) % gsz); u.pn = (wgid % nig) / gsz; return true;
    }
    __device__ __forceinline__ void a_ready(const Unit&) const {}
    __device__ __forceinline__ void done(const Unit&) const {}
};


template <class Epi, class Sched, bool ALIGN_EPI = false, bool SP2 = false>
__device__ __forceinline__ void gemm_phase(PG8_LAS unsigned char* lds, const Gemm g, const Sched& S, const Epi& E, const int wv  ) {
    const int tid = tid_of(wv), wid = wv, lane = tid & 63, wr = wid >> 2, wc = wid & 3, fr = lane & 15, fq = lane >> 4;
    const int K = g.K, nt = K / BK;
    unsigned voffA[2], voffA1[2], voffB[2];
#pragma unroll
    for (int i = 0; i < 2; ++i) { int R, C; stage_rc(tid * 16 + i * 8192, R, C); const int Rb = Epi::PERM ? ((R & ~31) + perm32(R & 31)) : R;
        voffA[i] = (unsigned)(R * g.lda + C) * 2u; voffA1[i] = voffA[i]; voffB[i] = (unsigned)(Rb * g.ldb + C) * 2u; }
    const size_t kstep = (size_t)(BK * 2);
    const size_t hstepA = Sched::GATHER ? 0 : (size_t)HALF * g.lda * 2, hstepB = (size_t)HALF * g.ldb * 2;
    const size_t tstepA = 2 * hstepA, tstepB = 2 * hstepB;
    const unsigned ldsw = (unsigned)wid * 1024u;
    const int aoff = lds_byte(wr * 64 + fr, fq * 8), boff = lds_byte(wc * 32 + fr, fq * 8);
#define PG8_SA(b, h) (((b) * 2 + (h)) * HTB)
#define PG8_SB(b, h) ((4 + (b) * 2 + (h)) * HTB)
#define PG8_STAGE(bufoff, gbase, voff) do { _Pragma("unroll") for (int _i = 0; _i < 2; ++_i) \
        __builtin_amdgcn_global_load_lds((const unsigned*)((const char*)(gbase) + (voff)[_i]), (PG8_LAS unsigned*)(lds + (bufoff) + ldsw + _i * 8192), 16, 0, 0); } while (0)
#define PG8_LDA(dst, b, h) do { _Pragma("unroll") for (int m = 0; m < 4; ++m) _Pragma("unroll") for (int k = 0; k < 2; ++k) dst[m][k] = *(const PG8_LAS bf16x8*)(lds + PG8_SA(b, h) + aoff + m * 2048 + k * 1024); } while (0)
#define PG8_LDB(dst, b, h) do { _Pragma("unroll") for (int n = 0; n < 2; ++n) _Pragma("unroll") for (int k = 0; k < 2; ++k) dst[n][k] = *(const PG8_LAS bf16x8*)(lds + PG8_SB(b, h) + boff + n * 2048 + k * 1024); } while (0)
#define PG8_MMA(ai, bj, At, Bt) do { __builtin_amdgcn_s_setprio(1); _Pragma("unroll") for (int m = 0; m < 4; ++m) _Pragma("unroll") for (int n = 0; n < 2; ++n) _Pragma("unroll") for (int k = 0; k < 2; ++k) \
        acc[ai][bj][m][n] = __builtin_amdgcn_mfma_f32_16x16x32_bf16(Bt[n][k], At[m][k], acc[ai][bj][m][n], 0, 0, 0); __builtin_amdgcn_s_setprio(0); } while (0)
#define PG8_WAIT_V(n) asm volatile("s_waitcnt vmcnt(" #n ")" ::: "memory")
#define PG8_WAIT_L(n) asm volatile("s_waitcnt lgkmcnt(" #n ")" ::: "memory")
#define PG8_BAR __builtin_amdgcn_s_barrier()
#define PG8_SCHED __builtin_amdgcn_sched_barrier(0)
    Unit cur, nxt; int ui = 0;
    if (!S.next(0, cur)) return;
    if constexpr (Sched::GATHER) {
#pragma unroll
        for (int i = 0; i < 2; ++i) { int R, C; stage_rc(tid * 16 + i * 8192, R, C);
            voffA[i] = (unsigned)(S.arow(R) * g.lda + C) * 2u; voffA1[i] = (unsigned)(S.arow(R + HALF) * g.lda + C) * 2u; }
    }
    f32x4 acc[2][2][4][2];
#pragma unroll
    for (int a = 0; a < 2; ++a)
#pragma unroll
        for (int b = 0; b < 2; ++b)
#pragma unroll
            for (int m = 0; m < 4; ++m)
#pragma unroll
                for (int n = 0; n < 2; ++n) acc[a][b][m][n] = (f32x4){0.f, 0.f, 0.f, 0.f};
    bf16x8 At[4][2], B0[2][2], B1[2][2];
    const char* cA = (const char*)g.A + (size_t)cur.pm * tstepA; const char* cB = (const char*)g.Bt + (size_t)cur.pn * tstepB;
    S.a_ready(cur);
    if constexpr (SP2) {
        PG8_STAGE(PG8_SB(0, 0), cB, voffB); PG8_STAGE(PG8_SB(0, 1), cB + hstepB, voffB); PG8_STAGE(PG8_SA(0, 0), cA, voffA); PG8_STAGE(PG8_SA(0, 1), cA + hstepA, voffA1);
        if (wr == 1) PG8_BAR;
        PG8_WAIT_V(2); PG8_BAR;
        PG8_STAGE(PG8_SB(1, 0), cB + kstep, voffB); PG8_STAGE(PG8_SA(1, 0), cA + kstep, voffA); PG8_STAGE(PG8_SB(1, 1), cB + hstepB + kstep, voffB);
        PG8_WAIT_V(6); PG8_BAR;
    } else {
        PG8_STAGE(PG8_SB(0, 0), cB, voffB); PG8_STAGE(PG8_SA(0, 0), cA, voffA); PG8_STAGE(PG8_SB(0, 1), cB + hstepB, voffB); PG8_STAGE(PG8_SA(0, 1), cA + hstepA, voffA1);
        if (wr == 1) PG8_BAR;
        PG8_WAIT_V(4); PG8_BAR;
        PG8_STAGE(PG8_SB(1, 0), cB + kstep, voffB); PG8_STAGE(PG8_SA(1, 0), cA + kstep, voffA); PG8_STAGE(PG8_SB(1, 1), cB + hstepB + kstep, voffB);
        PG8_WAIT_V(6); PG8_BAR;
    }
    for (;;) {
        const bool has_next = S.next(ui + 1, nxt);
        const char* nA = has_next ? (const char*)g.A + (size_t)nxt.pm * tstepA : cA; const char* nB = has_next ? (const char*)g.Bt + (size_t)nxt.pn * tstepB : cB;
        for (int t = 0; t < nt; t += 2) {
            if constexpr (Epi::MIDK) { if (t == nt / 2) { const int lm_ = lane_now(); E.mid(acc, cur, wr, wc, lm_ & 15, lm_ >> 4); } }
            const bool last = (t == nt - 2);
            const char* a1 = cA + (size_t)(t + 1) * kstep;
            const char* a2 = last ? nA : cA + (size_t)(t + 2) * kstep; const char* b2 = last ? nB : cB + (size_t)(t + 2) * kstep;
            const char* a3 = a2 + kstep; const char* b3 = b2 + kstep;
            if (last && has_next) S.a_ready(nxt);
            if constexpr (SP2) {
            PG8_LDB(B0, 0, 0); PG8_LDB(B1, 0, 1); PG8_SCHED; PG8_LDA(At, 0, 0); PG8_STAGE(PG8_SA(1, 1), a1 + hstepA, voffA1);
            PG8_WAIT_V(8); PG8_WAIT_L(0); PG8_BAR; PG8_MMA(0, 0, At, B0); PG8_MMA(0, 1, At, B1); PG8_BAR; PG8_SCHED;
            PG8_LDA(At, 0, 1); PG8_STAGE(PG8_SB(0, 0), b2, voffB); PG8_STAGE(PG8_SB(0, 1), b2 + hstepB, voffB); PG8_STAGE(PG8_SA(0, 0), a2, voffA);
            PG8_WAIT_V(8); PG8_WAIT_L(0); PG8_BAR; PG8_MMA(1, 0, At, B0); PG8_MMA(1, 1, At, B1); PG8_BAR; PG8_SCHED;
            PG8_LDB(B0, 1, 0); PG8_LDB(B1, 1, 1); PG8_SCHED; PG8_LDA(At, 1, 0); PG8_STAGE(PG8_SA(0, 1), a2 + hstepA, voffA1);
            PG8_WAIT_V(8); PG8_WAIT_L(0); PG8_BAR; PG8_MMA(0, 0, At, B0); PG8_MMA(0, 1, At, B1); PG8_BAR; PG8_SCHED;
            PG8_LDA(At, 1, 1); PG8_STAGE(PG8_SB(1, 0), b3, voffB); PG8_STAGE(PG8_SB(1, 1), b3 + hstepB, voffB); PG8_STAGE(PG8_SA(1, 0), a3, voffA);
            PG8_WAIT_V(8); PG8_WAIT_L(0); PG8_BAR; PG8_MMA(1, 0, At, B0); PG8_MMA(1, 1, At, B1); PG8_BAR; PG8_SCHED;
            } else {
            PG8_LDB(B0, 0, 0); PG8_SCHED; PG8_LDA(At, 0, 0); PG8_STAGE(PG8_SA(1, 1), a1 + hstepA, voffA1);
            PG8_WAIT_L(8); PG8_BAR; PG8_WAIT_L(0); PG8_MMA(0, 0, At, B0); PG8_BAR; PG8_SCHED;
            PG8_LDB(B1, 0, 1); PG8_STAGE(PG8_SB(0, 0), b2, voffB);
            PG8_BAR; PG8_WAIT_L(0); PG8_MMA(0, 1, At, B1); PG8_BAR;
            PG8_LDA(At, 0, 1); PG8_STAGE(PG8_SA(0, 0), a2, voffA);
            PG8_BAR; PG8_WAIT_L(0); PG8_MMA(1, 0, At, B0); PG8_BAR; PG8_SCHED;
            PG8_STAGE(PG8_SB(0, 1), b2 + hstepB, voffB);
            PG8_WAIT_V(6); PG8_BAR; PG8_MMA(1, 1, At, B1); PG8_BAR;
            PG8_LDB(B0, 1, 0); PG8_SCHED; PG8_LDA(At, 1, 0); PG8_STAGE(PG8_SA(0, 1), a2 + hstepA, voffA1);
            PG8_WAIT_L(8); PG8_BAR; PG8_WAIT_L(0); PG8_MMA(0, 0, At, B0); PG8_BAR; PG8_SCHED;
            PG8_LDB(B1, 1, 1); PG8_STAGE(PG8_SB(1, 0), b3, voffB);
            PG8_BAR; PG8_WAIT_L(0); PG8_MMA(0, 1, At, B1); PG8_BAR;
            PG8_LDA(At, 1, 1); PG8_STAGE(PG8_SA(1, 0), a3, voffA);
            PG8_BAR; PG8_WAIT_L(0); PG8_MMA(1, 0, At, B0); PG8_BAR; PG8_SCHED;
            PG8_STAGE(PG8_SB(1, 1), b3 + hstepB, voffB);
            PG8_WAIT_V(6); PG8_BAR; PG8_MMA(1, 1, At, B1); PG8_BAR;
            }
        }
        if constexpr (ALIGN_EPI) { if (wr == 0) PG8_BAR; }
        if constexpr (!Epi::AFTER_DRAIN) { const int le_ = lane_now(); E(acc, cur, wr, wc, le_ & 15, le_ >> 4); S.done(cur); }
        if (!has_next) break;
#pragma unroll
        for (int a = 0; a < 2; ++a)
#pragma unroll
            for (int b = 0; b < 2; ++b)
#pragma unroll
                for (int m = 0; m < 4; ++m)
#pragma unroll
                    for (int n = 0; n < 2; ++n) acc[a][b][m][n] = (f32x4){0.f, 0.f, 0.f, 0.f};
        cur = nxt; cA = nA; cB = nB; ++ui;
        if constexpr (ALIGN_EPI) { if (wr == 1) PG8_BAR; }
    }
    PG8_WAIT_V(0);
    if constexpr (!ALIGN_EPI) { if (wr == 0) PG8_BAR; }
    PG8_BAR;
    if constexpr (Epi::AFTER_DRAIN) { const int le_ = lane_now(); E.fused(acc, cur, wr, wc, le_ & 15, le_ >> 4, lds, wid, le_); S.done(cur); }
#undef PG8_SA
#undef PG8_SB
#undef PG8_STAGE
#undef PG8_LDA
#undef PG8_LDB
#undef PG8_MMA
#undef PG8_WAIT_V
#undef PG8_WAIT_L
#undef PG8_BAR
#undef PG8_SCHED
}
}
#define XB_TMO      128
#define XB_XCNT(j)  (256  + 64 * (j))
#define XB_XSUB(j)  (1280 + 64 * (j))
#define XB_XGEN(j)  (2304 + 64 * (j))
#define XB_TOP      3328
#define XB_TOPGEN   3392
#define XCD_BAR_WORDS 3456
#define XB_SPIN_CAP (1u << 18)

__device__ __forceinline__ unsigned xb_ld(unsigned* p)              { return __hip_atomic_load(p, __ATOMIC_RELAXED, __HIP_MEMORY_SCOPE_AGENT); }
__device__ __forceinline__ unsigned xb_add(unsigned* p, unsigned v) { return __hip_atomic_fetch_add(p, v, __ATOMIC_RELAXED, __HIP_MEMORY_SCOPE_AGENT); }
__device__ __forceinline__ unsigned xb_xcc_id() { return (unsigned)__builtin_amdgcn_s_getreg((3 << 11) | 20) & 0xFu; }
#define XB_SPIN(cond, bar) do { unsigned _sp = 0; while (cond) { __builtin_amdgcn_s_sleep(1); \
    if ((++_sp & 255u) == 0u) { if (xb_ld(&(bar)[XB_TMO])) break; if (_sp > XB_SPIN_CAP) { atomicAdd(&(bar)[XB_TMO], 1u); break; } } } } while (0)

struct XcdBarrier {
    unsigned* bar; unsigned x;
    volatile LAS unsigned* st;
};

__device__ __forceinline__ XcdBarrier xcd_barrier_post(unsigned* bar, volatile LAS unsigned* st) {
    XcdBarrier b; b.bar = bar; b.x = xb_xcc_id(); b.st = st;
    if (threadIdx.x == 0) (void)xb_add(&bar[XB_XCNT(b.x)], 1u);
    return b;
}
__device__ __forceinline__ void xcd_barrier_complete(unsigned* bar, unsigned x, unsigned& nloc, unsigned& nx) {
    const unsigned G = gridDim.x * gridDim.y * gridDim.z;
    unsigned sum, cnt, mine, sp = 0u;
    for (;;) {
        sum = 0u; cnt = 0u; mine = 0u;
#pragma unroll
        for (unsigned j = 0; j < 16; ++j) { const unsigned c = xb_ld(&bar[XB_XCNT(j)]); sum += c; cnt += (c > 0u) ? 1u : 0u; }
        if (sum == G) { mine = xb_ld(&bar[XB_XCNT(x)]); break; }
        __builtin_amdgcn_s_sleep(1);
        if ((++sp & 255u) == 0u) { if (xb_ld(&bar[XB_TMO])) break; if (sp > XB_SPIN_CAP) { atomicAdd(&bar[XB_TMO], 1u); break; } }
    }
    nloc = mine > 0u ? mine : 1u; nx = cnt > 0u ? cnt : 1u;
}

__device__ __forceinline__ void xcd_barrier(const XcdBarrier& b, const bool t0  ) {
    asm volatile("s_waitcnt vmcnt(0)" ::: "memory");
    __syncthreads();
    if (t0) {
        unsigned* bar = (unsigned*)opaque_ptr((unsigned char*)b.bar);
        __builtin_amdgcn_s_waitcnt(0);
        unsigned nloc = b.st[0], nx = b.st[1];
        if (nloc == 0u) { xcd_barrier_complete(bar, b.x, nloc, nx); b.st[0] = nloc; b.st[1] = nx; }
        const unsigned old = xb_add(&bar[XB_XSUB(b.x)], 1u);
        const unsigned gen = old / nloc;
        if (old + 1u == (gen + 1u) * nloc) {
            __builtin_amdgcn_fence(__ATOMIC_RELEASE, "agent");
            asm volatile("s_waitcnt vmcnt(0)" ::: "memory");
            const unsigned og = xb_add(&bar[XB_TOP], 1u);
            const unsigned tg = og / nx;
            if (og + 1u == (tg + 1u) * nx) xb_add(&bar[XB_TOPGEN], 1u);
            else XB_SPIN(xb_ld(&bar[XB_TOPGEN]) == tg, bar);
            __builtin_amdgcn_fence(__ATOMIC_ACQUIRE, "agent");
            xb_add(&bar[XB_XGEN(b.x)], 1u);
            asm volatile("s_waitcnt vmcnt(0)" ::: "memory");
        } else {
            XB_SPIN(xb_ld(&bar[XB_XGEN(b.x)]) == gen, bar);
            __builtin_amdgcn_fence(__ATOMIC_ACQUIRE, "agent");
            asm volatile("s_waitcnt vmcnt(0)" ::: "memory");
        }
    }
    __syncthreads();
}

__device__ __forceinline__ void panel_sync(unsigned* cnt, unsigned target, const bool t0) {
    asm volatile("s_waitcnt vmcnt(0)" ::: "memory");
    __syncthreads();
    if (t0) {
        __builtin_amdgcn_s_waitcnt(0);
#if !MK_WT
        __builtin_amdgcn_fence(__ATOMIC_RELEASE, "agent");
        asm volatile("s_waitcnt vmcnt(0)" ::: "memory");
#endif
        (void)xb_add(cnt, 1u);
        unsigned sp = 0;
        while (xb_ld(cnt) < target) { __builtin_amdgcn_s_sleep(1); if (++sp > (1u << 20)) break; }
        __builtin_amdgcn_fence(__ATOMIC_ACQUIRE, "agent");
        asm volatile("s_waitcnt vmcnt(0)" ::: "memory");
    }
    __syncthreads();
}
typedef pg8::f32x4 A4;
#define EPI_ROWS_BEGIN _Pragma("unroll") for (int ai = 0; ai < 2; ++ai) _Pragma("unroll") for (int m = 0; m < 4; ++m) { const int row = u.pm * 256 + ai * 128 + wr * 64 + m * 16 + fr;
#define EPI_ROWS_END }
__device__ __forceinline__ float rstd_of(const float* ss, int row, int fq) {
    if (!ss) return 1.0f;
    const f32x4 p = *(const f32x4*)(ss + (size_t)row * 16 + fq * 4);
    float s = (p[0] + p[1]) + (p[2] + p[3]);
    s = add_xor32(add_xor16(s));
    return rsqrtf(s * (1.0f / D) + EPS);
}
__device__ __forceinline__ float rstd_row(const float* ss, size_t row) {
    const f32x4* p = (const f32x4*)(ss + row * 16); float s = 0.f;
#pragma unroll
    for (int i = 0; i < 4; ++i) { const f32x4 v = p[i]; s += (v[0] + v[1]) + (v[2] + v[3]); }
    return rsqrtf(s * (1.0f / D) + EPS);
}
__device__ __forceinline__ u32x4 pack8(const A4& a, const A4& b) { u32x4 w; w.x = pkbf(a[0], a[1]); w.y = pkbf(a[2], a[3]); w.z = pkbf(b[0], b[1]); w.w = pkbf(b[2], b[3]); return w; }
__device__ __forceinline__ void unpack8(const u32x4& w, A4& a, A4& b) { a[0] = bflo(w.x); a[1] = bfhi(w.x); a[2] = bflo(w.y); a[3] = bfhi(w.y); b[0] = bflo(w.z); b[1] = bfhi(w.z); b[2] = bflo(w.w); b[3] = bfhi(w.w); }

struct EpiScale {
    static constexpr bool PERM = true, AFTER_DRAIN = false, MIDK = false;
    bf16_t* O; const float* ss; int ld; float scale; int wt, pad;
    __device__ __forceinline__ void operator()(const A4 (&acc)[2][2][4][2], const pg8::Unit& u, int wr, int wc, int fr, int fq) const {
        const int col0 = u.pn * 256 + wc * 32 + 8 * fq;
        EPI_ROWS_BEGIN
            const float s = rstd_of(ss, row, fq) * scale;
#pragma unroll
            for (int bj = 0; bj < 2; ++bj) { const u32x4 w = pack8(acc[ai][bj][m][0] * s, acc[ai][bj][m][1] * s); bf16_t* p = O + (size_t)row * ld + col0 + bj * 128; if (wt) ST16_OUT(p, w); else *(u32x4*)p = w; }
        EPI_ROWS_END
    }
};

__device__ __forceinline__ size_t band_frag_off(int t, int f) { return ((((size_t)(t >> 5) * AH + (f >> 6)) * 4 + ((f >> 4) & 3)) * 64 + ((f >> 3) & 1) * 32 + (t & 31)) * 8; }
__device__ __forceinline__ size_t band_vfrag_off(int F, int t) { return (((((size_t)(t >> 5) * AH + (F >> 6)) * 2 + ((F >> 5) & 1)) * 2 + ((t >> 4) & 1)) * 64 + ((t >> 3) & 1) * 32 + (F & 31)) * 8; }
struct EpiVT {
    static constexpr bool PERM = true, AFTER_DRAIN = false, MIDK = false;
    bf16_t *AVTp, *BVTp;
    __device__ __forceinline__ void operator()(const A4 (&acc)[2][2][4][2], const pg8::Unit& u, int wr, int wc, int fr, int fq) const {
        const int col0 = u.pn * 256 + wc * 32 + 8 * fq;
        EPI_ROWS_BEGIN
#pragma unroll
            for (int bj = 0; bj < 2; ++bj) { const u32x4 w = pack8(acc[ai][bj][m][0], acc[ai][bj][m][1]); const int t = col0 + bj * 128;
                bf16_t* p = u.pm < 2 ? AVTp + band_vfrag_off(row, t) : BVTp + (size_t)(row - 512) * T + t; ST16_OUT(p, w); }
        EPI_ROWS_END
    }
};

struct EpiProj {
    static constexpr bool PERM = true, AFTER_DRAIN = false, MIDK = false;
    bf16_t *AQ, *AK, *BQ, *BK, *BRS, *GA, *GB; float* LOGA; const float* balpha; int tile0, pad;
    __device__ __forceinline__ void operator()(const A4 (&acc)[2][2][4][2], const pg8::Unit& u, int wr, int wc, int fr, int fq) const {
        const int tile = u.pn + tile0;
        bf16_t* dst; int ld, c0, mode = 0; float sc = 1.f;
        if (tile < 2) { dst = AQ; ld = 512; c0 = tile * 256; sc = 0.125f * 1.4426950408889634f; }
        else if (tile < 4) { dst = AK; ld = 512; c0 = (tile - 2) * 256; }
        else if (tile == 4) { dst = BQ; ld = 256; c0 = 0; sc = 0.125f; }
        else if (tile == 5) { dst = BK; ld = 256; c0 = 0; }
        else if (tile < 8) { dst = BRS; ld = 512; c0 = (tile - 6) * 256; mode = 1; }
        else if (tile == 8) { dst = nullptr; ld = 256; c0 = 0; mode = 3; }
        else if (tile < 13) { dst = GA; ld = 1024; c0 = (tile - 9) * 256; mode = 2; }
        else { dst = GB; ld = 1024; c0 = (tile - 13) * 256; mode = 2; }
        const int cl = wc * 32 + 8 * fq;
        EPI_ROWS_BEGIN
#pragma unroll
            for (int bj = 0; bj < 2; ++bj) {
                A4 v0 = acc[ai][bj][m][0] * sc, v1 = acc[ai][bj][m][1] * sc;
                const int c = cl + bj * 128;
                if (mode == 3) {
                    const A4 b0 = *(const A4*)(balpha + c), b1 = *(const A4*)(balpha + c + 4);
#pragma unroll
                    for (int i = 0; i < 4; ++i) { v0[i] = flogsigmoid(v0[i] + b0[i]) * 0.0625f; v1[i] = flogsigmoid(v1[i] + b1[i]) * 0.0625f; }
                    float* o = LOGA + (size_t)row * 256 + c; *(A4*)o = v0; *(A4*)(o + 4) = v1;
                } else {
                    if (mode == 1) {
#pragma unroll
                        for (int i = 0; i < 4; ++i) { v0[i] = fsilu(v0[i]); v1[i] = fsilu(v1[i]); }
                    } else if (mode == 2) {
#pragma unroll
                        for (int i = 0; i < 4; ++i) { v0[i] = fsigmoid(v0[i]); v1[i] = fsigmoid(v1[i]); }
                    }
                    { const u32x4 w = pack8(v0, v1); const int f = c0 + c;
                      bf16_t* p = tile < 4 ? dst + band_frag_off(row, f) : dst + (size_t)row * ld + f; if (mode == 2) *(u32x4*)p = w; else ST16_OUT(p, w); }
                }
            }
        EPI_ROWS_END
    }
};

struct EpiResid {
    static constexpr bool PERM = true, AFTER_DRAIN = false, MIDK = false;
    bf16_t* Xo; const bf16_t* X; float* ss_out;
    __device__ __forceinline__ void operator()(const A4 (&acc)[2][2][4][2], const pg8::Unit& u, int wr, int wc, int fr, int fq) const {
        const int col0 = u.pn * 256 + wc * 32 + 8 * fq;
#pragma unroll
        for (int ai = 0; ai < 2; ++ai) {
            u32x4 xin[4][2];
#pragma unroll
            for (int m = 0; m < 4; ++m)
#pragma unroll
                for (int bj = 0; bj < 2; ++bj) xin[m][bj] = *(const u32x4*)(X + (size_t)(u.pm * 256 + ai * 128 + wr * 64 + m * 16 + fr) * D + col0 + bj * 128);
#pragma unroll
            for (int m = 0; m < 4; ++m) {
                const int row = u.pm * 256 + ai * 128 + wr * 64 + m * 16 + fr;
                float q = 0.f;
#pragma unroll
                for (int bj = 0; bj < 2; ++bj) {
                    A4 x0, x1; unpack8(xin[m][bj], x0, x1);
                    x0 += acc[ai][bj][m][0]; x1 += acc[ai][bj][m][1];
                    q += (x0[0] * x0[0] + x0[1] * x0[1]) + (x0[2] * x0[2] + x0[3] * x0[3]) + (x1[0] * x1[0] + x1[1] * x1[1]) + (x1[2] * x1[2] + x1[3] * x1[3]);
                    ST16_OUT(Xo + (size_t)row * D + col0 + bj * 128, pack8(x0, x1));
                }
                q = add_xor32(add_xor16(q));
                if (fq == 0) __hip_atomic_store(ss_out + (size_t)row * 16 + u.pn * 4 + wc, q, __ATOMIC_RELAXED, __HIP_MEMORY_SCOPE_AGENT);
            }
        }
    }
};

struct EpiMerge {
    static constexpr bool PERM = true, AFTER_DRAIN = false, MIDK = true;
    const bf16_t* GAp; const bf16_t* GBp; bf16_t* O;
    __device__ __forceinline__ void mid(A4 (&acc)[2][2][4][2], const pg8::Unit& u, int wr, int wc, int fr, int fq) const {
        const int col0 = u.pn * 256 + wc * 32 + 8 * fq;
        EPI_ROWS_BEGIN
#pragma unroll
            for (int bj = 0; bj < 2; ++bj) {
                const size_t off = (size_t)row * D + col0 + bj * 128;
                A4 a0, a1, b0, b1; unpack8(*(const u32x4*)(GAp + off), a0, a1); unpack8(*(const u32x4*)(GBp + off), b0, b1);
#pragma unroll
                for (int i = 0; i < 4; ++i) { acc[ai][bj][m][0][i] *= a0[i] * __builtin_amdgcn_rcpf(b0[i]); acc[ai][bj][m][1][i] *= a1[i] * __builtin_amdgcn_rcpf(b1[i]); }
            }
        EPI_ROWS_END
    }
    __device__ __forceinline__ void operator()(const A4 (&acc)[2][2][4][2], const pg8::Unit& u, int wr, int wc, int fr, int fq) const {
        const int col0 = u.pn * 256 + wc * 32 + 8 * fq;
#pragma unroll
        for (int ai = 0; ai < 2; ++ai) {
            u32x4 gin[4][2];
#pragma unroll
            for (int m = 0; m < 4; ++m)
#pragma unroll
                for (int bj = 0; bj < 2; ++bj) gin[m][bj] = *(const u32x4*)(GBp + (size_t)(u.pm * 256 + ai * 128 + wr * 64 + m * 16 + fr) * D + col0 + bj * 128);
#pragma unroll
            for (int m = 0; m < 4; ++m)
#pragma unroll
                for (int bj = 0; bj < 2; ++bj) {
                    A4 b0, b1; unpack8(gin[m][bj], b0, b1);
                    ST16_OUT(O + (size_t)(u.pm * 256 + ai * 128 + wr * 64 + m * 16 + fr) * D + col0 + bj * 128, pack8(acc[ai][bj][m][0] * b0, acc[ai][bj][m][1] * b1));
                }
        }
    }
};
struct ConvRegs { f32x4 v[8]; };
__device__ __forceinline__ void conv_load(ConvRegs& R, const float* __restrict__ W, int ldw, int k0, int n0, int lane) {
#pragma unroll
    for (int i = 0; i < 8; ++i) { const int kk = (lane >> 3) + 8 * i; R.v[i] = __builtin_nontemporal_load((const f32x4*)(W + (size_t)(k0 + kk) * ldw + n0 + (lane & 7) * 4)); }
}
__device__ __forceinline__ void conv_store(const ConvRegs& R, const float* __restrict__ gk, bf16_t* __restrict__ WT, int ldt, int k0, int n0, LAS float* scr, int lane) {
#pragma unroll
    for (int i = 0; i < 8; ++i) { const int kk = (lane >> 3) + 8 * i; const float s = gk ? gk[k0 + kk] : 1.0f; LAS float* p = scr + kk * 33 + (lane & 7) * 4;
        p[0] = R.v[i][0] * s; p[1] = R.v[i][1] * s; p[2] = R.v[i][2] * s; p[3] = R.v[i][3] * s; }
    asm volatile("s_waitcnt lgkmcnt(0)" ::: "memory");
    const int c = lane & 7;
#pragma unroll
    for (int j = 0; j < 4; ++j) { const int n = (lane >> 3) + 8 * j; const LAS float* s = scr + (8 * c) * 33 + n;
        u32x4 o; o.x = pkbf(s[0 * 33], s[1 * 33]); o.y = pkbf(s[2 * 33], s[3 * 33]); o.z = pkbf(s[4 * 33], s[5 * 33]); o.w = pkbf(s[6 * 33], s[7 * 33]);
        *(u32x4*)(WT + (size_t)(n0 + n) * ldt + k0 + 8 * c) = o; }
    asm volatile("s_waitcnt lgkmcnt(0)" ::: "memory");
}
__device__ __forceinline__ void conv_item(const float* __restrict__ W, int ldw, const float* __restrict__ gk, bf16_t* __restrict__ WT, int ldt, int k0, int n0, LAS float* scr, int lane) {
    ConvRegs R; conv_load(R, W, ldw, k0, n0, lane); conv_store(R, gk, WT, ldt, k0, n0, scr, lane);
}

struct InPtrs {
    const float *x, *mem, *norm_mix_g, *w_in, *rel_bias, *gla_w_alpha, *gla_b_alpha, *gla_norm_g, *w_branch, *w_mix_out, *norm_x_g, *mem_norm_g, *w_xq, *w_xkv, *w_xo,
                *norm_ffn_g, *w_gr, *b_gr, *w_er, *b_er, *w_eg, *w_eu, *w_ed, *final_g;
};

struct ConvJob { const float* W; const float* gk; bf16_t* WT; int ldw, ldt, K, N; };
__device__ __forceinline__ ConvJob dense_job(const InPtrs& in, unsigned char* ws, int l, int j) {
    unsigned char* wd = ws + WS_WDENSE + (size_t)l * WDENSE_STRIDE;
    const float* Win = in.w_in + (size_t)l * D * INW; bf16_t* WIN_T = (bf16_t*)(wd + WD_WIN);
    const float* gm = in.norm_mix_g + l * D;
    ConvJob J;
    switch (j) {
    case 0: J = {Win + 0, gm, WIN_T + (size_t)0 * D, INW, D, D, 1024}; break;
    case 1: J = {Win + 1024, gm, WIN_T + (size_t)2304 * D, INW, D, D, 512}; break;
    case 2: J = {Win + 1536, gm, WIN_T + (size_t)1024 * D, INW, D, D, 512}; break;
    case 3: J = {Win + 2048, gm, WIN_T + (size_t)2816 * D, INW, D, D, 512}; break;
    case 4: J = {Win + 3088, gm, WIN_T + (size_t)3328 * D, INW, D, D, 2048}; break;
    case 11: J = {Win + 2576, gm, WIN_T + (size_t)1536 * D, INW, D, D, 512}; break;
    case 5: J = {in.w_branch + (size_t)(l * 2 + 0) * 512 * D, nullptr, (bf16_t*)(wd + WD_WB), D, D, 512, D}; break;
    case 6: J = {in.w_branch + (size_t)(l * 2 + 1) * 512 * D, nullptr, (bf16_t*)(wd + WD_WB) + 512, D, D, 512, D}; break;
    case 7: J = {in.w_mix_out + (size_t)l * D * D, nullptr, (bf16_t*)(wd + WD_WMO), D, D, D, D}; break;
    case 8: J = {in.w_xq + (size_t)l * D * D, in.norm_x_g + l * D, (bf16_t*)(wd + WD_WXQ), D, D, D, 0}; break;
    case 9: J = {in.w_xkv + (size_t)l * D * 2 * D, nullptr, (bf16_t*)(wd + WD_WXKV), 2 * D, D, D, 2 * D}; break;
    default: J = {in.w_xo + (size_t)l * D * D, nullptr, (bf16_t*)(wd + WD_WXO), D, D, D, D}; break;
    }
    return J;
}

__device__ __forceinline__ void conv_dense_layer(const InPtrs& in, unsigned char* ws, int l, int gw, int NGW, int gt, int NGT, LAS float* scr, int lane) {
    constexpr int NITEMS = 5632 - 512;
#pragma nounroll
    for (int it = gw; it < NITEMS; it += 2 * NGW) {
        ConvRegs R[2]; ConvJob J[2]; int k0[2], n0[2];
#pragma unroll
        for (int q = 0; q < 2; ++q) {
            int r = it + q * NGW; const bool on = r < NITEMS; if (!on) r = it;
            int j = 0;
#pragma unroll
            for (int jj = 0; jj < 12; ++jj) { const ConvJob Jt = dense_job(in, ws, l, jj); const int n = (Jt.K / 64) * (Jt.N / 32); if (j == jj && r >= n) { r -= n; ++j; } }
            J[q] = dense_job(in, ws, l, j); const int nnb = J[q].N / 32; k0[q] = (r / nnb) * 64; n0[q] = (r % nnb) * 32;
            if (on) conv_load(R[q], J[q].W, J[q].ldw, k0[q], n0[q], lane);
        }
#pragma unroll
        for (int q = 0; q < 2; ++q) if (it + q * NGW < NITEMS) conv_store(R[q], J[q].gk, J[q].WT, J[q].ldt, k0[q], n0[q], scr, lane);
    }
    {
        bf16_t* WIN_T = (bf16_t*)(ws + WS_WDENSE + (size_t)l * WDENSE_STRIDE + WD_WIN);
        const float* Win = in.w_in + (size_t)l * D * INW; const float* Wa = in.gla_w_alpha + (size_t)l * BR * BKW; const float* gm = in.norm_mix_g + l * D;
        for (int i = gt; i < 256 * D; i += NGT) {
            const int c = i >> 10, k = i & 1023; float s = 0.f;
#pragma unroll
            for (int r = 0; r < BR; ++r) s += Win[(size_t)k * INW + 2560 + r] * Wa[r * BKW + c];
            WIN_T[(size_t)(2048 + c) * D + k] = f2bf(s * gm[k]);
        }
    }
    {
        bf16_t* WQN = (bf16_t*)(ws + WS_WDENSE + (size_t)l * WDENSE_STRIDE + WD_WXQ);
        const float* Wq = in.w_xq + (size_t)l * D * D; const float* gx = in.norm_x_g + l * D;
        for (int i = gt; i < D * D / 4; i += NGT) { const f32x4 v = ((const f32x4*)Wq)[i]; const float g = gx[i >> 8]; u32x2 o; o.x = pkbf(v[0] * g, v[1] * g); o.y = pkbf(v[2] * g, v[3] * g); ((u32x2*)WQN)[i] = o; }
    }
}
__device__ __forceinline__ void ph_prologue(const InPtrs& in, unsigned char* ws, LAS unsigned char* lds, int vcu, int G, int wv) {
    const int tid = tid_of(wv), lane = tid & 63, wave = wv;
    LAS float* scr = (LAS float*)(lds + wave * 16384);
    const int gw = vcu * 8 + wave, NGW = G * 8;
#pragma nounroll
    for (int l = 0; l < (G == 256 ? 1 : DEPTH); ++l) conv_dense_layer(in, ws, l, gw, NGW, vcu * 512 + tid, G * 512, scr, lane);
    bf16_t* XB = (bf16_t*)(ws + WS_XB); bf16_t* XN = (bf16_t*)(ws + WS_XN);
    for (int r = gw; r < T; r += NGW) {
        const float4* xr = (const float4*)(in.x + (size_t)r * D) + lane; float4 v[4]; float s = 0.f;
#pragma unroll
        for (int j = 0; j < 4; ++j) { v[j] = xr[64 * j]; s += v[j].x * v[j].x + v[j].y * v[j].y + v[j].z * v[j].z + v[j].w * v[j].w;
            u32x2 o; o.x = pkbf(v[j].x, v[j].y); o.y = pkbf(v[j].z, v[j].w); *(u32x2*)(XB + (size_t)r * D + (lane + 64 * j) * 4) = o; }
        const float rs = rsqrtf(wave_sum(s) * (1.0f / D) + EPS);
#pragma unroll
        for (int j = 0; j < 4; ++j) { u32x2 o; o.x = pkbf(v[j].x * rs, v[j].y * rs); o.y = pkbf(v[j].z * rs, v[j].w * rs); *(u32x2*)(XN + (size_t)r * D + (lane + 64 * j) * 4) = o; }
    }
    bf16_t* MEMN = (bf16_t*)(ws + WS_MEMN);
    for (int r = gw; r < NB * NMEM; r += NGW) {
        const float4* xr = (const float4*)(in.mem + (size_t)r * D) + lane; float4 v[4]; float s = 0.f;
#pragma unroll
        for (int j = 0; j < 4; ++j) { v[j] = xr[64 * j]; s += v[j].x * v[j].x + v[j].y * v[j].y + v[j].z * v[j].z + v[j].w * v[j].w; }
        const float rs = rsqrtf(wave_sum(s) * (1.0f / D) + EPS);
#pragma unroll
        for (int j = 0; j < 4; ++j) { const float4 g = ((const float4*)in.mem_norm_g)[lane + 64 * j];
            u32x2 o; o.x = pkbf(v[j].x * rs * g.x, v[j].y * rs * g.y); o.y = pkbf(v[j].z * rs * g.z, v[j].w * rs * g.w); *(u32x2*)(MEMN + (size_t)r * D + (lane + 64 * j) * 4) = o; }
    }
}

typedef short bf16x8_t __attribute__((ext_vector_type(8)));
constexpr int NRMAX = 40960;
constexpr int NTMAX = NRMAX / 256;
constexpr int CW_CNT = 256;
constexpr size_t SEL_SELE = 0, SEL_SELW = 128 * 1024, SEL_LPOS = 256 * 1024, SEL_POS = 384 * 1024, SEL_GW = 512 * 1024, SEL_TILE = 768 * 1024, SEL_NT = 768 * 1024 + 4096, SEL_RS = 896 * 1024;

struct ExpItem { const float* W; const float* gk; bf16_t* WT; int ldw, ldt, k0, n0; };
__device__ __forceinline__ ExpItem expert_item(const InPtrs& in, unsigned char* ws, int it) {
    const int le = it / 384, r = it % 384, l = le >> 5, e = le & 31;
    bf16_t* WGU = (bf16_t*)(ws + WS_WEXP + (size_t)l * WEXP_STRIDE) + (size_t)e * 512 * D;
    bf16_t* WDT = (bf16_t*)(ws + WS_WEXP + (size_t)l * WEXP_STRIDE + 32 * MiB) + (size_t)e * D * EF;
    const size_t eo = ((size_t)l * NE + e) * D * EF;
    ExpItem I;
    if (r < 256) { const int p = r >> 6, q = r & 63; I = {((p & 1) ? in.w_eu : in.w_eg) + eo + (p >> 1) * 128, in.norm_ffn_g + l * D, WGU + (size_t)(p * 128) * D, EF, D, (q >> 2) * 64, (q & 3) * 32}; }
    else { const int q = r - 256; I = {in.w_ed + eo, nullptr, WDT, D, EF, (q >> 5) * 64, (q & 31) * 32}; }
    return I;
}
__device__ __forceinline__ void conv_expert_run(const InPtrs& in, unsigned char* ws, int it0, int n, LAS float* scr, int lane) {
#pragma nounroll
    for (int i = 0; i < n; i += 2) {
        ConvRegs R0, R1;
        const ExpItem A = expert_item(in, ws, it0 + i); conv_load(R0, A.W, A.ldw, A.k0, A.n0, lane);
        ExpItem B = A; if (i + 1 < n) { B = expert_item(in, ws, it0 + i + 1); conv_load(R1, B.W, B.ldw, B.k0, B.n0, lane); }
        conv_store(R0, A.gk, A.WT, A.ldt, A.k0, A.n0, scr, lane);
        if (i + 1 < n) conv_store(R1, B.gk, B.WT, B.ldt, B.k0, B.n0, scr, lane);
    }
}
__device__ __forceinline__ void conv_expert_items(const InPtrs& in, unsigned char* ws, int it_lo, int it_hi, int gw, int NGW, LAS float* scr, int lane) {
#pragma nounroll
    for (int it = it_lo + gw; it < it_hi; it += 2 * NGW) {
        const int it2 = it + NGW; ConvRegs R0, R1;
        const ExpItem A = expert_item(in, ws, it); conv_load(R0, A.W, A.ldw, A.k0, A.n0, lane);
        ExpItem B = A; if (it2 < it_hi) { B = expert_item(in, ws, it2); conv_load(R1, B.W, B.ldw, B.k0, B.n0, lane); }
        conv_store(R0, A.gk, A.WT, A.ldt, A.k0, A.n0, scr, lane);
        if (it2 < it_hi) conv_store(R1, B.gk, B.WT, B.ldt, B.k0, B.n0, scr, lane);
    }
}
__device__ __forceinline__ void conv_router(const InPtrs& in, unsigned char* ws, int vcu, int G, int tid) {
    for (int i = vcu * 512 + tid; i < DEPTH * 48 * D; i += G * 512) {
        const int l = i / (48 * D), r = (i / D) % 48, k = i % D; float v = 0.f;
        if (r < NG) v = in.w_gr[((size_t)l * D + k) * NG + r]; else if (r < NG + NE) v = in.w_er[((size_t)l * D + k) * NE + (r - NG)];
        ((bf16_t*)(ws + WS_WR))[i] = f2bf(v * in.norm_ffn_g[l * D + k]);
    }
}

__device__ __forceinline__ void ph_route(const InPtrs& in, unsigned char* ws, LAS unsigned char* lds, int l, int t0  , int wv, bool dummy_cnt) {
    const int tid = tid_of(wv), lane = tid & 63, wave = wv;
    const bf16_t* XB = (const bf16_t*)(ws + WS_XB); const bf16_t* WR = (const bf16_t*)(ws + WS_WR) + (size_t)l * 48 * D;
    const float* ss = (const float*)(ws + WS_SSP) + (size_t)(3 * l + 2) * T * 16;
    int* SELE = (int*)(ws + WS_SEL + SEL_SELE); float* SELW = (float*)(ws + WS_SEL + SEL_SELW); int* LPOS = (int*)(ws + WS_SEL + SEL_LPOS);
    float* RSTD = (float*)(ws + WS_SEL + SEL_RS); int* TOKS = (int*)(ws + WS_TOK);
    unsigned* CNT = (unsigned*)(ws + WS_CTL) + CW_CNT + 32 * l + (dummy_cnt ? 128 : 0);
    LAS float* lg = (LAS float*)lds + wave * (16 * 49);
    LAS unsigned* hist = (LAS unsigned*)(lds + 32768); LAS unsigned* gbase = hist + 32;
    {
        if (tid < 32) hist[tid] = 0u;
        int e0 = 0, e1 = 0; unsigned r0 = 0, r1 = 0;
        {
            const int tw = t0 + (wave & 3) * 16, kh = (wave >> 2) * (D / 2);
            f32x4 acc[3];
#pragma unroll
            for (int nb = 0; nb < 3; ++nb) acc[nb] = (f32x4){0.f, 0.f, 0.f, 0.f};
            const bf16_t* ap = XB + (size_t)(tw + (lane & 15)) * D + kh + 8 * (lane >> 4);
            const bf16_t* bp = WR + (size_t)(lane & 15) * D + kh + 8 * (lane >> 4);
#pragma unroll
            for (int k0 = 0; k0 < D / 64; k0 += 8) {
                bf16x8_t a[8], b[8][3];
#pragma unroll
                for (int kk = 0; kk < 8; ++kk) { a[kk] = *(const bf16x8_t*)(ap + (k0 + kk) * 32);
#pragma unroll
                    for (int nb = 0; nb < 3; ++nb) b[kk][nb] = *(const bf16x8_t*)(bp + (size_t)nb * 16 * D + (k0 + kk) * 32); }
#pragma unroll
                for (int kk = 0; kk < 8; ++kk)
#pragma unroll
                    for (int nb = 0; nb < 3; ++nb) acc[nb] = __builtin_amdgcn_mfma_f32_16x16x32_bf16(a[kk], b[kk][nb], acc[nb], 0, 0, 0);
            }
#pragma unroll
            for (int nb = 0; nb < 3; ++nb)
#pragma unroll
                for (int r = 0; r < 4; ++r) lg[((lane >> 4) * 4 + r) * 49 + nb * 16 + (lane & 15)] = acc[nb][r];
        }
        __syncthreads();
        if (wave < 4 && lane < 16) {
            const int t = t0 + wave * 16 + lane; const float rs = rstd_row(ss, (size_t)t);
            const LAS float* p = lg + lane * 49; const LAS float* p2 = p + 4 * (16 * 49);
            float gm = -INFINITY; int gi = 0;
#pragma unroll
            for (int i = 0; i < NG; ++i) { const float x = (p[i] + p2[i]) * rs + in.b_gr[l * NG + i]; if (x > gm) { gm = x; gi = i; } }
            float gs = 0.f;
#pragma unroll
            for (int i = 0; i < NG; ++i) gs += __expf((p[i] + p2[i]) * rs + in.b_gr[l * NG + i] - gm);
            const float gw = 1.0f / gs;
            float v0 = -INFINITY, v1 = -INFINITY; int i0 = 0, i1 = 0;
#pragma unroll
            for (int e = 0; e < EPG; ++e) { const float x = (p[NG + gi * EPG + e] + p2[NG + gi * EPG + e]) * rs + in.b_er[l * NE + gi * EPG + e];
                if (x > v0) { v1 = v0; i1 = i0; v0 = x; i0 = e; } else if (x > v1) { v1 = x; i1 = e; } }
            const float ex = __expf(v1 - v0), den = 1.0f + ex;
            e0 = gi * EPG + i0; e1 = gi * EPG + i1;
            SELE[t * 2] = e0; SELE[t * 2 + 1] = e1; SELW[t * 2] = gw / den; SELW[t * 2 + 1] = gw * ex / den; RSTD[t] = rs;
            r0 = __hip_atomic_fetch_add(&hist[e0], 1u, __ATOMIC_RELAXED, __HIP_MEMORY_SCOPE_WORKGROUP); r1 = __hip_atomic_fetch_add(&hist[e1], 1u, __ATOMIC_RELAXED, __HIP_MEMORY_SCOPE_WORKGROUP);
        }
        __syncthreads();
        if (tid < 32) gbase[tid] = hist[tid] ? atomicAdd(&CNT[tid], hist[tid]) : 0u;
        __syncthreads();
        if (wave < 4 && lane < 16) { const int t = t0 + wave * 16 + lane; const int p0 = (int)(gbase[e0] + r0), p1 = (int)(gbase[e1] + r1);
            LPOS[t * 2] = p0; LPOS[t * 2 + 1] = p1; TOKS[(size_t)e0 * T + p0] = 2 * t; TOKS[(size_t)e1 * T + p1] = 2 * t + 1; }
        __syncthreads();
    }
}

__device__ __forceinline__ int moe_prefix(const unsigned* CNT, int lane, int& cnt, int& tile0, int& ntile) {
    cnt = (lane < 32) ? (int)__hip_atomic_load(CNT + (lane & 31), __ATOMIC_RELAXED, __HIP_MEMORY_SCOPE_AGENT) : 0;
    ntile = (cnt + 255) >> 8;
    int incl = ntile;
#pragma unroll
    for (int o = 1; o < 32; o <<= 1) { const int y = shfl_idx(incl, (lane - o) & 63); if ((lane & 31) >= o) incl += y; }
    tile0 = incl - ntile;
    return shfl_idx(incl, 31);
}
__device__ __forceinline__ void moe_tables(unsigned char* ws, int l, LAS int* tb, int vcu, int wave, int lane) {
    if (wave == 0) {
        int cnt, t0, nt_e; const int nt = moe_prefix((const unsigned*)(ws + WS_CTL) + CW_CNT + 32 * l, lane, cnt, t0, nt_e);
        if (lane < 32) { tb[lane] = cnt; tb[32 + lane] = t0; for (int r = t0; r < t0 + nt_e; ++r) tb[96 + r] = lane; }
        if (lane == 0) tb[64] = nt;
        if (vcu == 0) {
            int* TILE_E = (int*)(ws + WS_SEL + SEL_TILE);
            if (lane < 32) for (int r = t0; r < t0 + nt_e; ++r) TILE_E[r] = lane;
            if (lane == 0) *(int*)(ws + WS_SEL + SEL_NT) = nt;
        }
    }
    asm volatile("s_waitcnt lgkmcnt(0)" ::: "memory");
    __syncthreads();
}
struct GatherOrder {
    static constexpr bool GATHER = true;
    int pm, pn; const int* toks; int tl, cnt;
    __device__ __forceinline__ bool next(int i, pg8::Unit& u) const { if (i != 0) return false; u.pm = pm; u.pn = pn; return true; }
    __device__ __forceinline__ int arow(int R) const { const int p = tl * 256 + R; return p < cnt ? (toks[p] >> 1) : 0; }
    __device__ __forceinline__ void a_ready(const pg8::Unit&) const {}
    __device__ __forceinline__ void done(const pg8::Unit&) const {}
};
template <int NJ> struct GroupedOrder {
    static constexpr bool GATHER = false;
    const int* tile_e; int nunits, G, c;
    __device__ __forceinline__ void init(const int* te, int nt, int G_, int c_) { tile_e = te; nunits = nt * NJ; G = G_; c = c_; }
    __device__ __forceinline__ bool next(int i, pg8::Unit& u) const {
        const int L = i * G + c; if (L >= nunits) return false;
        const int rt = L / NJ, j = L % NJ;
        u.pm = rt; u.pn = __builtin_amdgcn_readfirstlane(tile_e[rt]) * NJ + j; return true;
    }
    __device__ __forceinline__ void a_ready(const pg8::Unit&) const {}
    __device__ __forceinline__ void done(const pg8::Unit&) const {}
};
struct QuadOrder {
    static constexpr bool GATHER = false;
    int pm, pn0, n;
    __device__ __forceinline__ bool next(int i, pg8::Unit& u) const { if (i >= n) return false; u.pm = pm; u.pn = pn0 + i; return true; }
    __device__ __forceinline__ void a_ready(const pg8::Unit&) const {}
    __device__ __forceinline__ void done(const pg8::Unit&) const {}
};
constexpr int CW_READY = 24576;
struct EpiHid {
    static constexpr bool PERM = true, AFTER_DRAIN = false, MIDK = false;
    bf16_t* HID; const int* toks; const float* RSTD; const float* SELW; int tl, cnt;
    __device__ __forceinline__ void operator()(const A4 (&acc)[2][2][4][2], const pg8::Unit& u, int wr, int wc, int fr, int fq) const {
        const int f0 = (u.pn & 1) * 128 + wc * 32 + 8 * fq;
        float rsv[2][4], wv_[2][4];
#pragma unroll
        for (int ai = 0; ai < 2; ++ai)
#pragma unroll
            for (int m = 0; m < 4; ++m) {
                const int p = tl * 256 + ai * 128 + wr * 64 + m * 16 + fr;
                const int slot = p < cnt ? toks[p] : 0;
                rsv[ai][m] = RSTD[slot >> 1]; wv_[ai][m] = SELW[slot];
            }
        EPI_ROWS_BEGIN
            const float rs = rsv[ai][m], w = wv_[ai][m];
            A4 h0, h1;
#pragma unroll
            for (int i = 0; i < 4; ++i) { h0[i] = fsilu(acc[ai][0][m][0][i] * rs) * (acc[ai][1][m][0][i] * rs) * w; h1[i] = fsilu(acc[ai][0][m][1][i] * rs) * (acc[ai][1][m][1][i] * rs) * w; }
            st16_wt(HID + (size_t)row * EF + f0, pack8(h0, h1));
        EPI_ROWS_END
    }
};
struct EpiY {
    static constexpr bool PERM = true, AFTER_DRAIN = false, MIDK = false;
    bf16_t* Y;
    __device__ __forceinline__ void operator()(const A4 (&acc)[2][2][4][2], const pg8::Unit& u, int wr, int wc, int fr, int fq) const {
        const int col0 = (u.pn & 3) * 256 + wc * 32 + 8 * fq;
        EPI_ROWS_BEGIN
#pragma unroll
            for (int bj = 0; bj < 2; ++bj) ST16_OUT(Y + (size_t)row * D + col0 + bj * 128, pack8(acc[ai][bj][m][0], acc[ai][bj][m][1]));
        EPI_ROWS_END
    }
};

__device__ __forceinline__ void ph_combine(unsigned char* ws, int l, int vcu, int G, bf16_t* XN, float* OUT, const float* __restrict__ fg, int wv, bf16_t* XBo) {
    const int tid = tid_of(wv), lane = tid & 63, wave = wv; (void)tid;
    const bf16_t* XB = (const bf16_t*)(ws + WS_XB); const bf16_t* Y = (const bf16_t*)(ws + WS_XG);
    const int* SELE = (const int*)(ws + WS_SEL + SEL_SELE); const int* LPOS = (const int*)(ws + WS_SEL + SEL_LPOS); float* ssn = (float*)(ws + WS_SSP) + (size_t)(3 * l + 3) * T * 16;
    int cnt_, tile0_, ntile_; (void)moe_prefix((const unsigned*)(ws + WS_CTL) + CW_CNT + 32 * l, lane, cnt_, tile0_, ntile_);
    const int stride = G * 8;
#pragma nounroll
    for (int tb = vcu * 8 + wave; tb < T; tb += 4 * stride) {
        int p0[4], p1[4];
#pragma unroll
        for (int i = 0; i < 4; ++i) { const int t = (tb + i * stride < T) ? tb + i * stride : tb;
            p0[i] = shfl_idx(tile0_, SELE[2 * t]) * 256 + LPOS[2 * t]; p1[i] = shfl_idx(tile0_, SELE[2 * t + 1]) * 256 + LPOS[2 * t + 1]; }
        u32x4 rx[4][2], ry0[4][2], ry1[4][2];
#pragma unroll
        for (int i = 0; i < 4; ++i) { const int t = (tb + i * stride < T) ? tb + i * stride : tb;
#pragma unroll
            for (int j = 0; j < 2; ++j) { rx[i][j] = ((const u32x4*)(XB + (size_t)t * D) + lane)[64 * j]; ry0[i][j] = ((const u32x4*)(Y + (size_t)p0[i] * D) + lane)[64 * j]; ry1[i][j] = ((const u32x4*)(Y + (size_t)p1[i] * D) + lane)[64 * j]; } }
#pragma unroll
        for (int i = 0; i < 4; ++i) {
            const int t = tb + i * stride;
            if (t < T) {
                A4 v[4]; float q = 0.f;
#pragma unroll
                for (int j = 0; j < 2; ++j) { A4 a0, a1, b0, b1, c0, c1; unpack8(rx[i][j], a0, a1); unpack8(ry0[i][j], b0, b1); unpack8(ry1[i][j], c0, c1);
                    a0 += b0 + c0; a1 += b1 + c1; v[2 * j] = a0; v[2 * j + 1] = a1;
                    q += (a0[0] * a0[0] + a0[1] * a0[1]) + (a0[2] * a0[2] + a0[3] * a0[3]) + (a1[0] * a1[0] + a1[1] * a1[1]) + (a1[2] * a1[2] + a1[3] * a1[3]);
                    if (!OUT) ST16_OUT((u32x4*)(XBo + (size_t)t * D) + lane + 64 * j, pack8(a0, a1)); }
                q = wave_sum(q);
                if (lane < 16) ssn[(size_t)t * 16 + lane] = lane == 0 ? q : 0.f;
                const float rs = rsqrtf(q * (1.0f / D) + EPS);
                if (XN) { u32x4* xn = (u32x4*)(XN + (size_t)t * D) + lane;
#pragma unroll
                    for (int j = 0; j < 2; ++j) ST16_OUT(xn + 64 * j, pack8(v[2 * j] * rs, v[2 * j + 1] * rs)); }
                if (OUT) {
#pragma unroll
                    for (int j = 0; j < 2; ++j) { const int c0 = 8 * lane + 512 * j; const A4 g0 = *(const A4*)(fg + c0), g1 = *(const A4*)(fg + c0 + 4);
                        float* o = OUT + (size_t)t * D + c0; *(A4*)o = v[2 * j] * rs * g0; *(A4*)(o + 4) = v[2 * j + 1] * rs * g1; }
                }
            }
        }
    }
}
struct FixedOrder {
    static constexpr bool GATHER = false;
    int pm, pn;
    __device__ __forceinline__ bool next(int i, pg8::Unit& u) const { if (i != 0) return false; u.pm = pm; u.pn = pn; return true; }
    __device__ __forceinline__ void a_ready(const pg8::Unit&) const {}
    __device__ __forceinline__ void done(const pg8::Unit&) const {}
};
struct PairOrder {
    static constexpr bool GATHER = false;
    int pm, pn0, pn1;
    __device__ __forceinline__ bool next(int i, pg8::Unit& u) const { if (i > 1) return false; u.pm = pm; u.pn = i ? pn1 : pn0; return true; }
    __device__ __forceinline__ void a_ready(const pg8::Unit&) const {}
    __device__ __forceinline__ void done(const pg8::Unit&) const {}
};
struct EpiSoftmax {
    static constexpr bool PERM = true, AFTER_DRAIN = true, MIDK = false;
    bf16_t* P; const float* ss; int ld; float scale;
    __device__ __forceinline__ void fused(A4 (&acc)[2][2][4][2], const pg8::Unit& u, int wr, int wc, int fr, int fq, PG8_LAS unsigned char* lds, int wid, int lane) const {
        typedef float f32x2v __attribute__((ext_vector_type(2)));
        PG8_LAS f32x2v* X = (PG8_LAS f32x2v*)lds;
        float mw[2][4];
#pragma unroll
        for (int ai = 0; ai < 2; ++ai)
#pragma unroll
            for (int m = 0; m < 4; ++m) {
                const float rsc = rstd_of(ss, u.pm * 256 + ai * 128 + wr * 64 + m * 16 + fr, fq) * scale;
                float mx = -INFINITY;
#pragma unroll
                for (int bj = 0; bj < 2; ++bj)
#pragma unroll
                    for (int n = 0; n < 2; ++n)
#pragma unroll
                        for (int i = 0; i < 4; ++i) { acc[ai][bj][m][n][i] *= rsc; mx = fmaxf(mx, acc[ai][bj][m][n][i]); }
                mx = fmaxf(mx, swz_xor<16>(mx)); mx = max_xor32(mx);
                float s = 0.f;
#pragma unroll
                for (int bj = 0; bj < 2; ++bj)
#pragma unroll
                    for (int n = 0; n < 2; ++n)
#pragma unroll
                        for (int i = 0; i < 4; ++i) { const float e = __expf(acc[ai][bj][m][n][i] - mx); acc[ai][bj][m][n][i] = e; s += e; }
                s = add_xor32(add_xor16(s));
                mw[ai][m] = mx;
                if (fq == 0) X[(ai * 128 + wr * 64 + m * 16 + fr) * 4 + wc] = (f32x2v){mx, s};
            }
        asm volatile("s_waitcnt lgkmcnt(0)" ::: "memory"); __builtin_amdgcn_s_barrier(); asm volatile("" ::: "memory");
#pragma unroll
        for (int ai = 0; ai < 2; ++ai)
#pragma unroll
            for (int m = 0; m < 4; ++m) {
                const int r = ai * 128 + wr * 64 + m * 16 + fr;
                const f32x2v a = X[r * 4 + 0], b = X[r * 4 + 1], c = X[r * 4 + 2], d = X[r * 4 + 3];
                const float M = fmaxf(fmaxf(a.x, b.x), fmaxf(c.x, d.x));
                const float S = (a.y * __expf(a.x - M) + b.y * __expf(b.x - M)) + (c.y * __expf(c.x - M) + d.y * __expf(d.x - M));
                const float f = __expf(mw[ai][m] - M) * __builtin_amdgcn_rcpf(S);
#pragma unroll
                for (int bj = 0; bj < 2; ++bj) *(u32x4*)(P + (size_t)(u.pm * 256 + r) * ld + bj * 128 + wc * 32 + 8 * fq) = pack8(acc[ai][bj][m][0] * f, acc[ai][bj][m][1] * f);
            }
    }
};
typedef float f32x16 __attribute__((ext_vector_type(16)));
constexpr int RTAB = 640;
__device__ __forceinline__ bf16x8_t as_bf16x8(const u32x4 w) { return __builtin_bit_cast(bf16x8_t, w); }
constexpr float LOG2E = 1.4426950408889634f;
__device__ __forceinline__ void band_tables(const float* __restrict__ rel  , LAS float* Rt, int tid, int h_lo = 0, int nh = AH) {
    rel += h_lo * RELW;
    for (int i = tid; i < nh * RTAB; i += 512) { const int h = i / RTAB, k = i % RTAB; int r = 575 - k; r = r < -AMAXREL ? -AMAXREL : (r > AMAXREL ? AMAXREL : r); Rt[i] = rel[h * RELW + r + AMAXREL] * LOG2E; }
}
__device__ __forceinline__ void band_load_k(bf16x8_t (&Kf)[4], const bf16_t* __restrict__ AK, long kt, int lane) {
#pragma unroll
    for (int s = 0; s < 4; ++s) Kf[s] = *(const bf16x8_t*)(AK + ((kt * 4 + s) * 64 + lane) * 8);
}
__device__ __forceinline__ void band_load_v(u32x4 (&Vr)[2][2], const bf16_t* __restrict__ AVT, long kt, int lane) {
#pragma unroll
    for (int db = 0; db < 2; ++db)
#pragma unroll
        for (int s = 0; s < 2; ++s) Vr[db][s] = *(const u32x4*)(AVT + (((kt * 2 + db) * 2 + s) * 64 + lane) * 8);
}
__device__ __forceinline__ bf16x8_t band_v_frag(const u32x4 r) {
    const auto a = __builtin_amdgcn_permlane32_swap(r.x, r.z, false, false); const auto c = __builtin_amdgcn_permlane32_swap(r.y, r.w, false, false);
    return as_bf16x8((u32x4){a[0], c[0], a[1], c[1]});
}
__device__ __forceinline__ void band_item(int item, int lane, const bf16_t* __restrict__ AQ, const bf16_t* __restrict__ AK, const bf16_t* __restrict__ AVT, const LAS float* Rt  , bf16_t* __restrict__ OAB, int h_tab0 = 0) {
    const int n = item % NCH, h = (item / NCH) % AH, b = item / (NCH * AH);
    const int ql = lane & 31, hh = lane >> 5;
    const size_t tok0 = (size_t)b * L + (size_t)n * CH;
    bf16x8_t Qf[2][4];
#pragma unroll
    for (int qb = 0; qb < 2; ++qb)
#pragma unroll
        for (int s = 0; s < 4; ++s) Qf[qb][s] = *(const bf16x8_t*)(AQ + (((((long)(tok0 >> 5) + qb) * AH + h) * 4 + s) * 64 + lane) * 8);
    f32x16 O[2][2];
#pragma unroll
    for (int db = 0; db < 2; ++db)
#pragma unroll
        for (int qb = 0; qb < 2; ++qb)
#pragma unroll
            for (int r = 0; r < 16; ++r) O[db][qb][r] = 0.f;
    float mrun[2] = {-INFINITY, -INFINITY}, lrun[2] = {0.f, 0.f};
    const LAS float* Rh = Rt + (h - h_tab0) * RTAB + (31 - ql + 4 * hh);
    const float bias_far = Rt[(h - h_tab0) * RTAB];
    const int j_lo = (n < ALC ? 2 * (ALC - n) : 0), j_hi = 2 * ALC + 1;
    const long ktb = ((long)b * L + (long)(n - ALC) * CH) / 32 * AH + h;
    bf16x8_t Kf0[4], Kf1[4]; u32x4 Vf0[2][2], Vf1[2][2];
    f32x16 S[2];
#define BAND_CL(jj) (ktb + (long)((jj) <= j_hi ? (jj) : j_hi) * AH)
    band_load_k(Kf0, AK, BAND_CL(j_lo), lane);
    band_load_v(Vf0, AVT, BAND_CL(j_lo), lane);
    band_load_k(Kf1, AK, BAND_CL(j_lo + 1), lane);
    band_load_v(Vf1, AVT, BAND_CL(j_lo + 1), lane);
#define BAND_SCORES(jj, Kf) do { const LAS float* Rc_ = Rh + (jj) * 32; \
        _Pragma("unroll") for (int qb = 0; qb < 2; ++qb) { \
            if ((jj) < 8) { _Pragma("unroll") for (int r = 0; r < 16; ++r) S[qb][r] = bias_far; } \
            else { _Pragma("unroll") for (int r = 0; r < 16; ++r) S[qb][r] = Rc_[32 - 32 * qb + (r & 3) + 8 * (r >> 2)]; } \
            _Pragma("unroll") for (int s = 0; s < 4; ++s) S[qb] = __builtin_amdgcn_mfma_f32_32x32x16_bf16(Kf[s], Qf[qb][s], S[qb], 0, 0, 0); } } while (0)
#define BAND_SOFTMAX_PV(Vr) do { \
        bf16x8_t Vf[2][2]; \
        _Pragma("unroll") for (int db = 0; db < 2; ++db) _Pragma("unroll") for (int s = 0; s < 2; ++s) Vf[db][s] = band_v_frag(Vr[db][s]); \
        _Pragma("unroll") for (int qb = 0; qb < 2; ++qb) { \
            float mx = S[qb][0]; \
            _Pragma("unroll") for (int r = 1; r < 16; ++r) mx = fmaxf(mx, S[qb][r]); \
            mx = max_xor32(mx); \
            const float mn = fmaxf(mrun[qb], mx), alpha = __builtin_amdgcn_exp2f(mrun[qb] - mn); \
            mrun[qb] = mn; \
            float sum = 0.f; \
            _Pragma("unroll") for (int r = 0; r < 16; ++r) { const float p = __builtin_amdgcn_exp2f(S[qb][r] - mn); S[qb][r] = p; sum += p; } \
            lrun[qb] = lrun[qb] * alpha + add_xor32(sum); \
            _Pragma("unroll") for (int db = 0; db < 2; ++db) \
                _Pragma("unroll") for (int r = 0; r < 16; ++r) O[db][qb][r] *= alpha; \
            _Pragma("unroll") for (int s = 0; s < 2; ++s) { \
                u32x4 w; w.x = pkbf(S[qb][8 * s + 0], S[qb][8 * s + 1]); w.y = pkbf(S[qb][8 * s + 2], S[qb][8 * s + 3]); w.z = pkbf(S[qb][8 * s + 4], S[qb][8 * s + 5]); w.w = pkbf(S[qb][8 * s + 6], S[qb][8 * s + 7]); \
                const bf16x8_t Pf = as_bf16x8(w); \
                _Pragma("unroll") for (int db = 0; db < 2; ++db) O[db][qb] = __builtin_amdgcn_mfma_f32_32x32x16_bf16(Vf[db][s], Pf, O[db][qb], 0, 0, 0); \
            } } } while (0)
    BAND_SCORES(j_lo, Kf0);
    band_load_k(Kf0, AK, BAND_CL(j_lo + 2), lane);
#pragma nounroll
    for (int j = j_lo; j <= j_hi; j += 2) {
        BAND_SOFTMAX_PV(Vf0);
        band_load_v(Vf0, AVT, BAND_CL(j + 2), lane);
        BAND_SCORES(j + 1, Kf1);
        band_load_k(Kf1, AK, BAND_CL(j + 3), lane);
        BAND_SOFTMAX_PV(Vf1);
        if (j + 2 <= j_hi) {
            band_load_v(Vf1, AVT, BAND_CL(j + 3), lane);
            BAND_SCORES(j + 2, Kf0);
            band_load_k(Kf0, AK, BAND_CL(j + 4), lane);
        }
    }
#undef BAND_SOFTMAX_PV
#undef BAND_CL
#undef BAND_SCORES
#pragma unroll
    for (int qb = 0; qb < 2; ++qb) {
        const float inv = 1.0f / lrun[qb];
        bf16_t* orow = OAB + (tok0 + 32 * qb + ql) * D + h * 64 + 4 * hh;
#pragma unroll
        for (int db = 0; db < 2; ++db)
#pragma unroll
            for (int g = 0; g < 4; ++g) { u32x2 o; o.x = pkbf(O[db][qb][4 * g] * inv, O[db][qb][4 * g + 1] * inv); o.y = pkbf(O[db][qb][4 * g + 2] * inv, O[db][qb][4 * g + 3] * inv);
                *(u32x2*)(orow + 32 * db + 8 * g) = o; }
    }
}
#ifndef MK_TS_A
#define MK_TS_A (-1)
#define MK_TS_B (-1)
#endif
#define GLA_TS(id) do { if (MK_TS_A >= 0 && ts && ((id) == MK_TS_A || (id) == MK_TS_B) && lane == 0) ts[(id) == MK_TS_B ? 1 : 0] = __builtin_amdgcn_s_memrealtime(); } while (0)
constexpr size_t DS_ITEM = 128 * 64;
__device__ __forceinline__ int rowmap32(int r, int hh) { return (r & 3) + 8 * (r >> 2) + 4 * hh; }

__device__ __forceinline__ float gla_scan_tile(const float* __restrict__ LOGA, size_t tok0, int h, int lane, LAS float* Gt) {
    const float* p = LOGA + tok0 * BKW + h * 64 + lane;
    float cum = 0.f;
#pragma unroll
    for (int t0 = 0; t0 < 64; t0 += 16) {
        float la[16];
#pragma unroll
        for (int i = 0; i < 16; ++i) la[i] = p[(size_t)(t0 + i) * BKW];
#pragma unroll
        for (int i = 0; i < 16; ++i) { cum += la[i]; Gt[(t0 + i) * 64 + lane] = cum; }
    }
    asm volatile("s_waitcnt lgkmcnt(0)" ::: "memory");
    return cum;
}

__device__ __forceinline__ void gla1_item(int idx, int lane, LAS float* Gt, const bf16_t* __restrict__ BK, const bf16_t* __restrict__ BVT, const float* __restrict__ LOGA, float* __restrict__ DS, float* __restrict__ DEC) {
    const int c = idx & 127, h = (idx >> 7) & 3, b = idx >> 9;
    const size_t tok0 = (size_t)b * L + (size_t)c * CH;
    const int ql = lane & 31, hh = lane >> 5;
    LAS bf16_t* Kt = (LAS bf16_t*)(Gt + 64 * 64);
    {
        u32x4 kr[8];
#pragma unroll
        for (int i = 0; i < 8; ++i) kr[i] = *(const u32x4*)(BK + (tok0 + 8 * i + (lane >> 3)) * BKW + h * 64 + (lane & 7) * 8);
#pragma unroll
        for (int i = 0; i < 8; ++i) *(LAS u32x4*)(Kt + (8 * i + (lane >> 3)) * 64 + (lane & 7) * 8) = kr[i];
    }
    const float last = gla_scan_tile(LOGA, tok0, h, lane, Gt);
    DEC[(size_t)idx * 64 + lane] = __expf(last);
    bf16x8_t Xf[2][2][2];
#pragma unroll
    for (int kb = 0; kb < 2; ++kb) {
        const float lk = __int_as_float(shfl_idx(__float_as_int(last), 32 * kb + ql));
#pragma unroll
        for (int tb = 0; tb < 2; ++tb) {
            float x[16];
#pragma unroll
            for (int r = 0; r < 16; ++r) { const int t = 32 * tb + rowmap32(r, hh);
                x[r] = bf2f(Kt[t * 64 + 32 * kb + ql]) * __expf(lk - Gt[t * 64 + 32 * kb + ql]); }
#pragma unroll
            for (int s = 0; s < 2; ++s) { u32x4 w; w.x = pkbf(x[8 * s], x[8 * s + 1]); w.y = pkbf(x[8 * s + 2], x[8 * s + 3]); w.z = pkbf(x[8 * s + 4], x[8 * s + 5]); w.w = pkbf(x[8 * s + 6], x[8 * s + 7]); Xf[tb][kb][s] = as_bf16x8(w); }
        }
    }
    const bf16_t* vbase = BVT + (size_t)(h * 128 + ql) * T + tok0 + 8 * hh;
    float* dsb = DS + (size_t)idx * DS_ITEM;
#pragma unroll
    for (int vb = 0; vb < 4; ++vb) {
        bf16x8_t Vf[2][2];
#pragma unroll
        for (int tb = 0; tb < 2; ++tb)
#pragma unroll
            for (int s = 0; s < 2; ++s) Vf[tb][s] = band_v_frag(*(const u32x4*)(vbase + (size_t)(32 * vb) * T + 32 * tb + 16 * s));
#pragma unroll
        for (int kb = 0; kb < 2; ++kb) {
            f32x16 acc;
#pragma unroll
            for (int r = 0; r < 16; ++r) acc[r] = 0.f;
#pragma unroll
            for (int tb = 0; tb < 2; ++tb)
#pragma unroll
                for (int s = 0; s < 2; ++s) acc = __builtin_amdgcn_mfma_f32_32x32x16_bf16(Vf[tb][s], Xf[tb][kb][s], acc, 0, 0, 0);
#pragma unroll
            for (int r = 0; r < 16; ++r) dsb[(size_t)(32 * vb + rowmap32(r, hh)) * 64 + 32 * kb + ql] = acc[r];
        }
    }
}

__device__ __forceinline__ void gla2_scan(int e, const float* __restrict__ DS, const float* __restrict__ DEC, bf16_t* __restrict__ SB) {
    const int k = e & 63, v = (e >> 6) & 127, bh = e >> 13;
    const size_t base = (size_t)bh * 128;
    float S = 0.f;
#pragma unroll 1
    for (int c0 = 0; c0 < 128; c0 += 32) {
        float d[32], a[32];
#pragma unroll
        for (int i = 0; i < 32; ++i) { d[i] = DS[(base + c0 + i) * DS_ITEM + (size_t)v * 64 + k]; a[i] = DEC[(base + c0 + i) * 64 + k]; }
#pragma unroll
        for (int i = 0; i < 32; ++i) { SB[(base + c0 + i) * DS_ITEM + (size_t)v * 64 + k] = f2bf(S); S = a[i] * S + d[i]; }
    }
}

__device__ __forceinline__ void gla3_unit(int unit, int lane, LAS float* Gt, const bf16_t* __restrict__ BQ, const bf16_t* __restrict__ BK, const bf16_t* __restrict__ BVT, const float* __restrict__ LOGA,
                                          const bf16_t* __restrict__ SB, const bf16_t* __restrict__ BRS, const float* __restrict__ gnorm, bf16_t* __restrict__ OAB, volatile LAS unsigned long long* ts = nullptr) {
    const int tb = unit & 1, idx = unit >> 1;
    const int c = idx & 127, h = (idx >> 7) & 3, b = idx >> 9;
    const size_t tok0 = (size_t)b * L + (size_t)c * CH;
    const int ql = lane & 31, hh = lane >> 5;
    GLA_TS(40);
    (void)gla_scan_tile(LOGA, tok0, h, lane, Gt);
    GLA_TS(41);
    bf16x8_t Qf[4];
    {
        const int t = 32 * tb + ql;
#pragma unroll
        for (int s = 0; s < 4; ++s) {
            const u32x4 q = *(const u32x4*)(BQ + (tok0 + t) * BKW + h * 64 + 16 * s + 8 * hh);
            const f32x4 g0 = *(const LAS f32x4*)(Gt + t * 64 + 16 * s + 8 * hh), g1 = *(const LAS f32x4*)(Gt + t * 64 + 16 * s + 8 * hh + 4);
            u32x4 w; w.x = pkbf(bflo(q.x) * __expf(g0[0]), bfhi(q.x) * __expf(g0[1])); w.y = pkbf(bflo(q.y) * __expf(g0[2]), bfhi(q.y) * __expf(g0[3]));
            w.z = pkbf(bflo(q.z) * __expf(g1[0]), bfhi(q.z) * __expf(g1[1])); w.w = pkbf(bflo(q.w) * __expf(g1[2]), bfhi(q.w) * __expf(g1[3]));
            Qf[s] = as_bf16x8(w);
        }
    }
    bf16x8_t Pf[2][2];
#pragma unroll
    for (int sb = 0; sb < 2; ++sb) {
        if (sb <= tb) {
            const int srow = 32 * sb + ql;
            f32x16 A;
#pragma unroll
            for (int r = 0; r < 16; ++r) A[r] = 0.f;
#pragma unroll
            for (int s = 0; s < 4; ++s) {
                const u32x4 kx = *(const u32x4*)(BK + (tok0 + srow) * BKW + h * 64 + 16 * s + 8 * hh);
                const f32x4 g0 = *(const LAS f32x4*)(Gt + srow * 64 + 16 * s + 8 * hh), g1 = *(const LAS f32x4*)(Gt + srow * 64 + 16 * s + 8 * hh + 4);
                u32x4 w; w.x = pkbf(bflo(kx.x) * __expf(-g0[0]), bfhi(kx.x) * __expf(-g0[1])); w.y = pkbf(bflo(kx.y) * __expf(-g0[2]), bfhi(kx.y) * __expf(-g0[3]));
                w.z = pkbf(bflo(kx.z) * __expf(-g1[0]), bfhi(kx.z) * __expf(-g1[1])); w.w = pkbf(bflo(kx.w) * __expf(-g1[2]), bfhi(kx.w) * __expf(-g1[3]));
                A = __builtin_amdgcn_mfma_f32_32x32x16_bf16(as_bf16x8(w), Qf[s], A, 0, 0, 0);
            }
            if (sb == tb) {
#pragma unroll
                for (int r = 0; r < 16; ++r) A[r] = (rowmap32(r, hh) <= ql) ? A[r] : 0.f;
            }
#pragma unroll
            for (int s2 = 0; s2 < 2; ++s2) { u32x4 w; w.x = pkbf(A[8 * s2], A[8 * s2 + 1]); w.y = pkbf(A[8 * s2 + 2], A[8 * s2 + 3]); w.z = pkbf(A[8 * s2 + 4], A[8 * s2 + 5]); w.w = pkbf(A[8 * s2 + 6], A[8 * s2 + 7]); Pf[sb][s2] = as_bf16x8(w); }
        }
    }
    GLA_TS(42);
    const int c16 = lane & 15, tr = lane >> 4;
    u32x4 bwv[8];
#pragma unroll
    for (int i = 0; i < 8; ++i) bwv[i] = *(const u32x4*)(BRS + (tok0 + 32 * tb + 4 * i + tr) * BVW + h * 128 + 8 * c16);
    f32x16 O[4];
    const bf16_t* vbase = BVT + (size_t)(h * 128 + ql) * T + tok0 + 8 * hh;
    const bf16_t* sbase = SB + (size_t)idx * DS_ITEM + (size_t)ql * 64 + 8 * hh;
#pragma unroll
    for (int vb = 0; vb < 4; ++vb) {
#pragma unroll
        for (int r = 0; r < 16; ++r) O[vb][r] = 0.f;
#pragma unroll
        for (int s = 0; s < 4; ++s) { const bf16x8_t Sf = *(const bf16x8_t*)(sbase + (size_t)(32 * vb) * 64 + 16 * s); O[vb] = __builtin_amdgcn_mfma_f32_32x32x16_bf16(Sf, Qf[s], O[vb], 0, 0, 0); }
#pragma unroll
        for (int sb = 0; sb < 2; ++sb) {
            if (sb <= tb) {
#pragma unroll
                for (int s2 = 0; s2 < 2; ++s2) { const u32x4 vr = *(const u32x4*)(vbase + (size_t)(32 * vb) * T + 32 * sb + 16 * s2);
                    O[vb] = __builtin_amdgcn_mfma_f32_32x32x16_bf16(band_v_frag(vr), Pf[sb][s2], O[vb], 0, 0, 0); }
            }
        }
    }
    GLA_TS(43);
    float q = 0.f;
#pragma unroll
    for (int vb = 0; vb < 4; ++vb)
#pragma unroll
        for (int r = 0; r < 16; ++r) q += O[vb][r] * O[vb][r];
    const float rs = rsqrtf(add_xor32(q) * (1.0f / 128.0f) + EPS);
    asm volatile("s_waitcnt lgkmcnt(0)" ::: "memory");
#pragma unroll
    for (int vb = 0; vb < 4; ++vb)
#pragma unroll
        for (int g4 = 0; g4 < 4; ++g4) {
            const int v0 = 32 * vb + 8 * g4 + 4 * hh; const f32x4 gv = *(const f32x4*)(gnorm + v0);
            f32x4 o; o[0] = O[vb][4 * g4] * rs * gv[0]; o[1] = O[vb][4 * g4 + 1] * rs * gv[1]; o[2] = O[vb][4 * g4 + 2] * rs * gv[2]; o[3] = O[vb][4 * g4 + 3] * rs * gv[3];
            *(LAS f32x4*)(Gt + ql * 128 + (((v0 >> 2) ^ ql) << 2)) = o;
        }
    asm volatile("s_waitcnt lgkmcnt(0)" ::: "memory");
    {
#pragma unroll
        for (int i = 0; i < 8; ++i) {
            const int t = 4 * i + tr; const size_t trow = tok0 + 32 * tb + t;
            const u32x4 bw = bwv[i];
            const f32x4 a0 = *(const LAS f32x4*)(Gt + t * 128 + (((2 * c16) ^ t) << 2)), a1 = *(const LAS f32x4*)(Gt + t * 128 + (((2 * c16 + 1) ^ t) << 2));
            u32x4 o; o.x = pkbf(a0[0] * bflo(bw.x), a0[1] * bfhi(bw.x)); o.y = pkbf(a0[2] * bflo(bw.y), a0[3] * bfhi(bw.y)); o.z = pkbf(a1[0] * bflo(bw.z), a1[1] * bfhi(bw.z)); o.w = pkbf(a1[2] * bflo(bw.w), a1[3] * bfhi(bw.w));
            st16_wt(OAB + trow * D + 512 + h * 128 + 8 * c16, o);
        }
    }
    GLA_TS(44);
}
#ifndef MK_TS_PHASE
#define MK_TS_PHASE (-1)
#define MK_TS_MODE 0
#endif
#ifndef MK_SIMD_W
#define MK_SIMD_W (-1)
#endif
#ifndef MK_ROLE_SWAP
#define MK_ROLE_SWAP 0
#endif
#ifndef MK_TS_WG
#define MK_TS_WG 0
#endif
#define TS_MARKW(id, w) do { if (MK_TS_A >= 0 && l == 0 && ((id) == MK_TS_A || (id) == MK_TS_B) && tid_of(opaque_int(wv0)) == (w) * 64) TS_[(id) == MK_TS_B ? 1 : 0] = __builtin_amdgcn_s_memrealtime(); } while (0)
#define TS_MARK(id) do { if (MK_TS_A >= 0 && l == 0 && ((id) == MK_TS_A || (id) == MK_TS_B) && tid_of(opaque_int(wv0)) == 0) TS_[(id) == MK_TS_B ? 1 : 0] = __builtin_amdgcn_s_memrealtime(); } while (0)
#ifndef MK_REP_PHASE
#define MK_REP_PHASE (-1)
#define MK_REP_N 1
#endif
#ifndef MK_PANEL_TEST
#define MK_PANEL_TEST 0
#endif
#ifndef MK_LAUNCHES
#define MK_LAUNCHES 1
#endif
constexpr int RING_BYTES = 131072, MISC_OFF = RING_BYTES + 512, LDS_BYTES = 147456;
constexpr int CW_BAR = 1024;
constexpr size_t CTL_ZERO_BYTES = 128 * 1024;
constexpr int CW_PANEL = 8192;
static_assert((CW_BAR + XCD_BAR_WORDS) * 4 <= (int)CTL_ZERO_BYTES, "barrier words inside the memset region");
constexpr int N_PHASES = 1 + 6 * DEPTH;

struct MKArgs { InPtrs in; unsigned char* ws; unsigned char* dout; int ph_lo, ph_hi, rep_phase, rep_n; };

__global__ void __launch_bounds__(512, 2) mk_fwd(MKArgs a) {
    extern __shared__ __attribute__((aligned(16))) unsigned char lds_raw[];
    LAS unsigned char* lds = (LAS unsigned char*)lds_raw;
    const int G0 = (int)gridDim.x, vcu0 = (int)blockIdx.x;
    const int wv0 = __builtin_amdgcn_readfirstlane((int)threadIdx.x >> 6);
    volatile LAS unsigned* MISC = (volatile LAS unsigned*)(lds + MISC_OFF);
    if (threadIdx.x < 16) MISC[threadIdx.x] = 0u;
    __syncthreads();
    const bool one_launch = (a.ph_hi - a.ph_lo) > 1;
    XcdBarrier bar; bar.bar = (unsigned*)(a.ws + WS_CTL) + CW_BAR; bar.x = 0; bar.st = MISC + 8;
    if (one_launch) bar = xcd_barrier_post((unsigned*)(a.ws + WS_CTL) + CW_BAR, MISC + 8);

    const InPtrs& in = a.in;
#define SS ((float*)(ws + WS_SSP))
#define XB ((bf16_t*)(ws + WS_XB))
#define AQ ((bf16_t*)(ws + WS_AQ))
#define AK ((bf16_t*)(ws + WS_AK))
#define AVT ((bf16_t*)(ws + WS_AVT))
#define XN ((bf16_t*)(ws + WS_XN))
#define BQ ((bf16_t*)(ws + WS_BQ))
#define BK ((bf16_t*)(ws + WS_BK))
#define BVT ((bf16_t*)(ws + WS_BVT))
#define BRS ((bf16_t*)(ws + WS_BRS))
#define GA ((bf16_t*)(ws + WS_GA))
#define GB ((bf16_t*)(dout + DO_GB))
#define MG ((bf16_t*)(ws + WS_MG))
#define Q ((bf16_t*)(dout + DO_OAB))
#define MEMN ((bf16_t*)(ws + WS_MEMN))
#define KVB ((bf16_t*)(ws + WS_KVB))
#define LOGA ((float*)(ws + WS_LOGA))
#define OAB ((bf16_t*)(dout + DO_OAB))
#define DSF ((float*)(dout + DO_ST))
#define DEC ((float*)(ws + WS_DEC))
#define SBB ((bf16_t*)(ws + WS_SB))
#define TMP ((bf16_t*)(ws + WS_TMP))
#define SELE ((int*)(ws + WS_SEL))
#define SELW ((float*)(ws + WS_SEL + (size_t)T * 2 * 4))
#define WD(l) (ws + WS_WDENSE + (size_t)(l) * WDENSE_STRIDE)
#define SSA(i) (SS + (size_t)(i) * T * 16)
#define MK_EP(l, t0) EpiProj{AQ, AK, BQ, BK, BRS, GA, GB, LOGA, in.gla_b_alpha + (size_t)(l) * BKW, (t0), 0}
    int ph = 0;
    volatile LAS unsigned long long* TS_ = (volatile LAS unsigned long long*)(lds + RING_BYTES + 640);
#define PH_ON (ph >= a.ph_lo && ph < a.ph_hi)
#define PH_RUN for (int rep_ = (PH_ON ? (ph == a.rep_phase ? a.rep_n : 1) : 0); rep_ > 0; --rep_)
#define PH_PTRS const int G = opaque_int(G0), vcu = opaque_int(vcu0), wv = opaque_int(wv0); (void)G; (void)vcu; unsigned char* ws = opaque_ptr(a.ws); unsigned char* dout = opaque_ptr(a.dout); (void)ws; (void)dout; const int tid = tid_of(wv), lane = tid & 63, wave = wv; (void)lane; (void)wave;
#define PH_END do { if (MK_TS_PHASE >= 0 && ph == MK_TS_PHASE && MK_TS_MODE == 1 && tid_of(opaque_int(wv0)) == 0) TS_[1] = __builtin_amdgcn_s_memrealtime(); \
    if (PH_ON && ph + 1 < a.ph_hi) xcd_barrier(bar, tid_of(opaque_int(wv0)) == 0); \
    if (MK_TS_PHASE >= 0 && ph == MK_TS_PHASE && MK_TS_MODE == 0 && tid_of(opaque_int(wv0)) == 0) TS_[1] = __builtin_amdgcn_s_memrealtime(); \
    if (MK_TS_PHASE >= 0 && ph + 1 == MK_TS_PHASE && tid_of(opaque_int(wv0)) == 0) TS_[0] = __builtin_amdgcn_s_memrealtime(); ++ph; } while (0)
#define GEMM_AT(EpiT, gm, ep, cc) do { pg8::StaticOrder S_; S_.init((gm).M, (gm).N, G, (cc)); pg8::gemm_phase<EpiT, pg8::StaticOrder, true, true>(lds, gm, S_, ep, wv); } while (0)
#define GEMM(EpiT, gm, ep) do { pg8::StaticOrder S_; S_.init((gm).M, (gm).N, G, vcu); pg8::gemm_phase<EpiT, pg8::StaticOrder, true, true>(lds, gm, S_, ep, wv); } while (0)

    PH_RUN { PH_PTRS ph_prologue(in, ws, lds, vcu, G, wv);
        LAS float* scr = (LAS float*)(lds + wave * 16384);
        if (G != 256) conv_expert_items(in, ws, 0, DEPTH * NE * 384, vcu * 8 + wave, G * 8, scr, lane);
        conv_router(in, ws, vcu, G, tid); }
    PH_END;

#pragma nounroll
    for (int l = 0; l < DEPTH; ++l) {
        PH_RUN { PH_PTRS
            {
                const bf16_t* Wkv = (const bf16_t*)(WD(l) + WD_WXKV);
                { const pg8::Gemm g{MEMN, Wkv, NB * NMEM, D, D, D, D, 0}; const EpiScale e{KVB + (size_t)l * 2 * NB * NMEM * D, nullptr, D, 1.0f, 1, 0}; GEMM_AT(EpiScale, g, e, (vcu + G - (G > 128 ? 64 : 0)) % G); }
                { const pg8::Gemm g{MEMN, Wkv + (size_t)D * D, NB * NMEM, D, D, D, D, 0}; const EpiScale e{KVB + (size_t)l * 2 * NB * NMEM * D + (size_t)NB * NMEM * D, nullptr, D, 1.0f, 1, 0}; GEMM_AT(EpiScale, g, e, (vcu + G - (G > 128 ? 72 : 0)) % G); }
            }
            { const pg8::Gemm g{XN, (const bf16_t*)(WD(l) + WD_WIN), T, NPROJ_A, D, D, D, 0}; const EpiProj e = MK_EP(l, 0); GEMM(EpiProj, g, e); }
            { const pg8::Gemm g{(const bf16_t*)(WD(l) + WD_WIN) + (size_t)NPROJ_A * D, XN, NPROJ_V, T, D, D, D, 0}; const EpiVT e{AVT, AVT + (size_t)512 * T}; GEMM(EpiVT, g, e); }
            if (l == 0 && G == 256 && vcu >= 80) {
                LAS float* scr = (LAS float*)(lds + wave * 16384);
                conv_dense_layer(in, ws, 1, (vcu - 80) * 8 + wave, 176 * 8, (vcu - 80) * 512 + tid, 176 * 512, scr, lane);
                __syncthreads();
            }
        }
        PH_END;
        PH_RUN { PH_PTRS
            LAS float* Rt = (LAS float*)lds;
            const int rw = MK_ROLE_SWAP ? ((wave >> 1) | ((wave & 1) << 2)) : wave;
            const bool fill = (G == 256);
            const int h0 = fill ? ((vcu * 8) / NCH) % AH : 0;
            TS_MARK(30);
            band_tables(in.rel_bias + (size_t)l * AH * RELW, Rt, tid, h0, fill ? 1 : AH);
            __syncthreads();
            const int xit0 = l * NE * 384 + vcu * 48;
            if (fill) {
                const bool conv_first = ((vcu >> 3) & 1) != 0;
#define MK_HBM_PART do { \
                    if (rw < 4) { \
                        LAS float* Gt = (LAS float*)(lds + 32768 + rw * 24576);        \
                        _Pragma("nounroll") for (int it = vcu * 4 + rw; it < NB * BH * NCH; it += G * 4) gla1_item(it, lane, Gt, BK, BVT, LOGA, DSF, DEC); \
                        conv_expert_run(in, ws, xit0 + rw * 4, 4, Gt, lane); \
                    } else { \
                        LAS float* scr = (rw < 7) ? (LAS float*)(lds + 2560 + (rw - 4) * 8448) : (LAS float*)(lds + RING_BYTES + 4096); \
                        conv_expert_run(in, ws, xit0 + 16 + (rw - 4) * 8, 8, scr, lane); \
                    } } while (0)
                if (conv_first) MK_HBM_PART;
                band_item(vcu * 8 + rw, lane, AQ, AK, AVT, Rt, OAB, h0);
                TS_MARKW(33, 4);
                if (!conv_first) MK_HBM_PART;
                TS_MARKW(34, 4);
                TS_MARKW(32, 0);
#undef MK_HBM_PART
            } else {
                if (rw < 4) {
                    LAS float* Gt = (LAS float*)(lds + 32768 + rw * 24576);
#pragma nounroll
                    for (int it = vcu * 4 + rw; it < NB * BH * NCH; it += G * 4) gla1_item(it, lane, Gt, BK, BVT, LOGA, DSF, DEC);
                }
#pragma nounroll
                for (int it = vcu * 8 + rw; it < NB * AH * NCH; it += G * 8) band_item(it, lane, AQ, AK, AVT, Rt, OAB);
            }
        }
        PH_END;
        PH_RUN { PH_PTRS
            if (G == 256) { if (vcu >= 64) for (int e2 = (vcu - 64) * 512 + tid; e2 < NB * BH * 128 * 64; e2 += 192 * 512) gla2_scan(e2, DSF, DEC, SBB); }
            else for (int e2 = vcu * 512 + tid; e2 < NB * BH * 128 * 64; e2 += G * 512) gla2_scan(e2, DSF, DEC, SBB);
            __syncthreads();
            const bf16_t* KBl = KVB + (size_t)l * 2 * NB * NMEM * D; const bf16_t* VBl = KBl + (size_t)NB * NMEM * D;
#pragma nounroll
            for (int j = 0; j < NB * XH; ++j) {
                const int b = j >> 2, h = j & 3;
                { const pg8::Gemm g{KBl + (size_t)(b * NMEM) * D + h * XD, (const bf16_t*)(WD(l) + WD_WXQ) + h * XD, NMEM, D, XD, D, D, 0};
                  const EpiScale e{(bf16_t*)(ws + WS_MT) + (size_t)(j * NMEM) * D, nullptr, D, 1.0f, 1, 0}; GEMM_AT(EpiScale, g, e, (vcu + G - 4 * j) % G); }
                { const pg8::Gemm g{(const bf16_t*)(WD(l) + WD_WXO) + h * XD, VBl + (size_t)(b * NMEM) * D + h * XD, D, NMEM, XD, D, D, 0};
                  const EpiScale e{(bf16_t*)(ws + WS_NT) + (size_t)b * D * D + h * XD, nullptr, D, 1.0f, 1, 0}; GEMM_AT(EpiScale, g, e, (vcu + G - 32 - 4 * j) % G); }
            }
        }
        PH_END;
        PH_RUN { PH_PTRS
            pg8::StaticOrder S0; S0.init(T, D, G, vcu); pg8::Unit u;
            if (G == 256 && S0.next(0, u)) {
                unsigned* PC = (unsigned*)(ws + WS_CTL) + CW_PANEL + 16 * (l * 64 + u.pm);
#define P_ARRIVE(s) do { if (tid == 0) (void)xb_add(PC + 2048 * (s), 1u); } while (0)
#define P_WAIT(s) do { if (tid == 0) { unsigned sp_ = 0; while (xb_ld(PC + 2048 * (s)) < 4u) { __builtin_amdgcn_s_sleep(2); if (++sp_ > (1u << 20)) break; } \
                       __builtin_amdgcn_fence(__ATOMIC_ACQUIRE, "agent"); asm volatile("s_waitcnt vmcnt(0)" ::: "memory"); } __syncthreads(); } while (0)
                const int h = u.pn, b = u.pm >> 5;
                TS_MARK(0);
                {
                    LAS float* Gt = (LAS float*)(lds + wave * 16384);
                    const int idx = (b * BH + h) * NCH + (u.pm & 31) * 4 + (wave >> 1);
                    gla3_unit(idx * 2 + (wave & 1), lane, Gt, BQ, BK, BVT, LOGA, SBB, BRS, in.gla_norm_g + (size_t)l * 128, OAB, (MK_TS_A >= 0 && l == 0 && wave == 0) ? TS_ : nullptr);
                    asm volatile("s_waitcnt vmcnt(0)" ::: "memory"); __syncthreads();
                    P_ARRIVE(0);
                }
                TS_MARK(1);
                const bf16_t* Wg = (const bf16_t*)(WD(l) + WD_WIN) + (size_t)(NPROJ_A + NPROJ_V) * D;
                { const pg8::Gemm g{XN, Wg, T, NPROJ_B, D, D, D, 0}; const PairOrder F{u.pm, u.pn, 4 + u.pn}; const EpiProj e = MK_EP(l, 9); pg8::gemm_phase<EpiProj, PairOrder, true, true>(lds, g, F, e, wv); }
                P_ARRIVE(1);
                TS_MARK(2);
                if (tid == 0) { unsigned sp_ = 0; while (xb_ld(PC) < 4u || xb_ld(PC + 2048) < 4u) { __builtin_amdgcn_s_sleep(2); if (++sp_ > (1u << 20)) break; }
                    __builtin_amdgcn_fence(__ATOMIC_ACQUIRE, "agent"); asm volatile("s_waitcnt vmcnt(0)" ::: "memory"); }
                __syncthreads();
                TS_MARK(3);
                { const pg8::Gemm g{OAB, (const bf16_t*)(WD(l) + WD_WB), T, D, D, D, D, 0}; const FixedOrder F{u.pm, u.pn}; const EpiMerge e{GA, GB, MG}; pg8::gemm_phase<EpiMerge, FixedOrder, true, true>(lds, g, F, e, wv); }
                P_ARRIVE(2);
                TS_MARK(4);
                P_WAIT(2);
                TS_MARK(5);
                { const pg8::Gemm g{MG, (const bf16_t*)(WD(l) + WD_WMO), T, D, D, D, D, 0}; const FixedOrder F{u.pm, u.pn}; const EpiResid e{XB, XB, SSA(3 * l + 1)}; pg8::gemm_phase<EpiResid, FixedOrder, true, true>(lds, g, F, e, wv); }
                P_ARRIVE(3);
                TS_MARK(6);
                P_WAIT(3);
                TS_MARK(7);
                {
                    const pg8::Gemm g{XB, (const bf16_t*)(ws + WS_MT) + (size_t)((b * XH + h) * NMEM) * D, T, NMEM, D, D, D, 0}; const FixedOrder F{u.pm, 0}; const EpiSoftmax e{Q + h * XD, SSA(3 * l + 1), D, 0.0625f};
                    pg8::gemm_phase<EpiSoftmax, FixedOrder, false, true>(lds, g, F, e, wv);
                    asm volatile("s_waitcnt vmcnt(0)" ::: "memory"); __syncthreads();
                }
                P_ARRIVE(4);
                TS_MARK(8);
                P_WAIT(4);
                TS_MARK(9);
                { const pg8::Gemm g{Q, (const bf16_t*)(ws + WS_NT) + (size_t)b * D * D, T, D, D, D, D, 0}; const FixedOrder F{u.pm, u.pn}; const EpiResid e{XB, XB, SSA(3 * l + 2)}; pg8::gemm_phase<EpiResid, FixedOrder, true, true>(lds, g, F, e, wv); }
                P_ARRIVE(5);
                TS_MARK(10);
                P_WAIT(5);
                TS_MARK(11);
                ph_route(in, ws, lds, l, u.pm * 256 + u.pn * 64, wv, false);
                TS_MARK(12);
#undef P_ARRIVE
#undef P_WAIT
            }
        }
        PH_END;
        PH_RUN { PH_PTRS
            LAS int* tb = (LAS int*)(lds + RING_BYTES + 1024);
            moe_tables(ws, l, tb, vcu, wave, lane);
            const int nt = tb[64], n1 = 2 * nt, r1 = n1 > G ? n1 - G : 0, ne = nt < G / 2 ? nt : G / 2, nl = nt - ne, tot1 = r1 + ne + 4 * nl;
            const int* TOKS = (const int*)(ws + WS_TOK);
            unsigned* READY = (unsigned*)(ws + WS_CTL) + CW_READY + 16 * (l * NTMAX);
            const bf16_t* WGU = (const bf16_t*)(ws + WS_WEXP + (size_t)l * WEXP_STRIDE); const bf16_t* WDT = (const bf16_t*)(ws + WS_WEXP + (size_t)l * WEXP_STRIDE + 32 * MiB);
#pragma nounroll
            TS_MARK(20);
            for (int s = vcu - G; s < tot1; s += G) {
                const int u0 = (G == 256) ? (vcu & 7) * 32 + (vcu >> 3) : vcu;
                const int Lu = s < 0 ? u0 : (s < r1 ? G + s : -1);
                if (s < 0 && u0 >= n1) continue;
                if (Lu >= 0) {
                    const int rt = Lu >> 1, ex = __builtin_amdgcn_readfirstlane(tb[96 + rt]), tl = rt - __builtin_amdgcn_readfirstlane(tb[32 + ex]), cn = __builtin_amdgcn_readfirstlane(tb[ex]);
                    const pg8::Gemm g{XB, WGU, nt * 256, 512, D, D, D, 0};
                    const GatherOrder F{rt, ex * 2 + (Lu & 1), TOKS + (size_t)ex * T, tl, cn};
                    const EpiHid e{(bf16_t*)(ws + WS_HID), TOKS + (size_t)ex * T, (const float*)(ws + WS_SEL + SEL_RS), (const float*)(ws + WS_SEL + SEL_SELW), tl, cn};
                    pg8::gemm_phase<EpiHid, GatherOrder, true, true>(lds, g, F, e, wv);
                    if (tid == 0) (void)xb_add(READY + 16 * rt, 1u);
                    TS_MARK(s < 0 ? 21 : 22);
                } else {
                    int rt, j0, nj;
                    if (s - r1 < ne) { rt = s - r1; j0 = 0; nj = 4; } else { const int q = s - r1 - ne; rt = ne + (q >> 2); j0 = q & 3; nj = 1; }
                    if (tid == 0) { unsigned sp = 0; while (xb_ld(READY + 16 * rt) < 2u) { __builtin_amdgcn_s_sleep(2); if (++sp > (1u << 20)) break; }
                        __builtin_amdgcn_fence(__ATOMIC_ACQUIRE, "agent"); asm volatile("s_waitcnt vmcnt(0)" ::: "memory"); }
                    __syncthreads();
                    const int ex = __builtin_amdgcn_readfirstlane(tb[96 + rt]);
                    const pg8::Gemm g{(const bf16_t*)(ws + WS_HID), WDT, nt * 256, D, EF, EF, EF, 0};
                    const QuadOrder F{rt, ex * 4 + j0, nj};
                    const EpiY e{(bf16_t*)(ws + WS_XG)};
                    pg8::gemm_phase<EpiY, QuadOrder, true, true>(lds, g, F, e, wv);
                }
            }
        }
        PH_END;
        PH_RUN { PH_PTRS ph_combine(ws, l, vcu, G, (l + 1 < DEPTH) ? XN : nullptr, (l + 1 < DEPTH) ? nullptr : (float*)dout, in.final_g, wv, rep_ > 1 ? (bf16_t*)dout : XB); }
        PH_END;
    }
    if ((MK_TS_PHASE >= 0 || MK_TS_A >= 0) && blockIdx.x == MK_TS_WG && tid_of(opaque_int(wv0)) == 0) { asm volatile("s_waitcnt vmcnt(0)" ::: "memory"); ((float*)a.dout)[(size_t)MK_TS_WG * 8 * D] = (float)(TS_[1] - TS_[0]) * 0.01f; }
#undef PH_ON
#undef PH_RUN
#undef PH_PTRS
#undef PH_END
#undef GEMM
#undef GEMM_AT
#undef SS
#undef XB
#undef AQ
#undef AK
#undef AVT
#undef XN
#undef BQ
#undef BK
#undef BVT
#undef BRS
#undef GA
#undef GB
#undef MG
#undef Q
#undef MEMN
#undef KVB
#undef LOGA
#undef OAB
#undef DSF
#undef DEC
#undef SBB
#undef TMP
#undef SELE
#undef SELW
#undef WD
#undef SSA
#undef MK_EP
}

extern "C" void kernel_launch(void* const* d_in, const int* in_sizes, int n_in, void* d_out, int out_size, void* d_ws, size_t ws_size, hipStream_t stream) {
    static int grid = 0;
    if (grid == 0) {
        int dev = 0, cus = 0;
        if (hipGetDevice(&dev) != hipSuccess || hipDeviceGetAttribute(&cus, hipDeviceAttributeMultiprocessorCount, dev) != hipSuccess || cus <= 0) cus = 256;
        grid = 256;
        if (cus != 256) fprintf(stderr, "kernel_launch: device reports %d CUs; this kernel is built for 256\n", cus);
        if (hipFuncSetAttribute((const void*)mk_fwd, hipFuncAttributeMaxDynamicSharedMemorySize, LDS_BYTES) != hipSuccess) fprintf(stderr, "kernel_launch: hipFuncSetAttribute failed\n");
        int per_cu = 0;
        if (hipOccupancyMaxActiveBlocksPerMultiprocessor(&per_cu, (const void*)mk_fwd, 512, LDS_BYTES) != hipSuccess || per_cu < 1) fprintf(stderr, "kernel_launch: occupancy query says %d blocks per CU\n", per_cu);
        (void)hipGetLastError();
        if (ws_size < WS_END || n_in != 24) fprintf(stderr, "kernel_launch: unexpected ws_size %zu / n_in %d\n", ws_size, n_in);
    }
    MKArgs a{};
    { const float** p = (const float**)&a.in; for (int i = 0; i < 24; ++i) p[i] = (const float*)d_in[i]; }
    a.ws = (unsigned char*)d_ws; a.dout = (unsigned char*)d_out;
    (void)hipMemsetAsync((unsigned char*)d_ws + WS_CTL, 0, CTL_ZERO_BYTES, stream);
#if MK_LAUNCHES == 1
    a.ph_lo = 0; a.ph_hi = N_PHASES; a.rep_phase = MK_REP_PHASE; a.rep_n = MK_REP_N;
    hipLaunchKernelGGL(mk_fwd, dim3(grid), dim3(512), LDS_BYTES, stream, a);
#else
    for (int p = 0; p < N_PHASES; ++p) { a.ph_lo = p; a.ph_hi = p + 1; a.rep_phase = -1; a.rep_n = 1; hipLaunchKernelGGL(mk_fwd, dim3(grid), dim3(512), LDS_BYTES, stream, a); }
#endif
}
```

```cpp
#include <hip/hip_runtime.h>
#include <cstdint>
#include <cstdio>
#include <cmath>

namespace cfg {
constexpr int D = 1024, NB = 2, L = 8192, T = NB * L, DEPTH = 2;
constexpr int CH = 64, NMEM = 256, NCH = L / CH;
constexpr int AH = 8, AW = 512, ALC = 8, ABAND = 576, AMAXREL = 256, RELW = 2 * AMAXREL + 1;
constexpr int BH = 4, BKW = 256, BVW = 512, BR = 16;
constexpr int INW = 5136;
constexpr int XH = 4, XD = 256;
constexpr int NG = 4, EPG = 8, NE = NG * EPG, EF = 256;
constexpr float EPS = 1e-6f;
constexpr int NPROJ_A = 9 * 256, NPROJ_V = 4 * 256, NPROJ_B = 8 * 256;

constexpr size_t MiB = 1u << 20;
constexpr size_t WS_CTL = 0, CTL_BYTES = 2 * MiB;
constexpr size_t WS_WDENSE = 2 * MiB, WDENSE_STRIDE = 23 * MiB;
constexpr size_t WD_WIN = 0, WD_WB = 11 * MiB, WD_WMO = 13 * MiB, WD_WXQ = 15 * MiB, WD_WXKV = 17 * MiB, WD_WXO = 21 * MiB;
constexpr size_t WS_WEXP = 48 * MiB, WEXP_STRIDE = 48 * MiB;
constexpr size_t WS_XB = 144 * MiB;
constexpr size_t WS_XN = 176 * MiB;
constexpr size_t WS_MIX = 208 * MiB;
constexpr size_t WS_AQ = WS_MIX, WS_AK = WS_MIX + 16 * MiB, WS_AVT = WS_MIX + 32 * MiB, WS_BVT = WS_MIX + 48 * MiB, WS_BQ = WS_MIX + 64 * MiB, WS_BK = WS_MIX + 72 * MiB,
                 WS_BRS = WS_MIX + 80 * MiB, WS_LOGA = WS_MIX + 96 * MiB;
constexpr size_t WS_SB = WS_AQ;
constexpr size_t WS_GA = WS_MIX + 16 * MiB, WS_TMP = WS_MIX + 48 * MiB, WS_MG = WS_XN;
constexpr size_t WS_XG = WS_MIX, WS_HID = WS_MIX + 80 * MiB;
constexpr size_t WS_MEMN = 320 * MiB, WS_KVB = 321 * MiB;
constexpr size_t WS_SEL = 325 * MiB;
constexpr size_t WS_SSP = 326 * MiB;
constexpr size_t WS_DEC = 333 * MiB + 512 * 1024;
constexpr size_t WS_WR = 333 * MiB;
constexpr size_t WS_TOK = 334 * MiB;
constexpr size_t WS_MT = 336 * MiB, WS_NT = 340 * MiB;
constexpr size_t WS_END = 344 * MiB;
constexpr size_t DO_OAB = 0, DO_ST = 32 * MiB, DO_GB = 32 * MiB;
}
using namespace cfg;

#define LAS __attribute__((address_space(3)))
typedef unsigned short bf16_t;
typedef float f32x4 __attribute__((ext_vector_type(4)));
typedef unsigned u32x4 __attribute__((ext_vector_type(4)));
typedef unsigned u32x2 __attribute__((ext_vector_type(2)));

__device__ __forceinline__ float bf2f(unsigned short b) { return __uint_as_float((unsigned)b << 16); }
__device__ __forceinline__ float bflo(unsigned w) { return __uint_as_float(w << 16); }
__device__ __forceinline__ float bfhi(unsigned w) { return __uint_as_float(w & 0xffff0000u); }
__device__ __forceinline__ unsigned pkbf(float lo, float hi) { unsigned r; asm volatile("v_cvt_pk_bf16_f32 %0, %1, %2" : "=v"(r) : "v"(lo), "v"(hi)); return r; }
__device__ __forceinline__ unsigned short f2bf(float f) { return (unsigned short)(pkbf(f, 0.f) & 0xffffu); }
__device__ __forceinline__ float fsigmoid(float x) { return __builtin_amdgcn_rcpf(1.0f + __expf(-x)); }
__device__ __forceinline__ float fsilu(float x) { return x * fsigmoid(x); }
__device__ __forceinline__ float flogsigmoid(float x) { return fminf(x, 0.f) - __logf(1.0f + __expf(-fabsf(x))); }
template <int MASK> __device__ __forceinline__ float swz_xor(float v) { return __int_as_float(__builtin_amdgcn_ds_swizzle(__float_as_int(v), (MASK << 10) | 0x1f)); }
__device__ __forceinline__ float add_xor32(float v) { const auto r = __builtin_amdgcn_permlane32_swap(__float_as_uint(v), __float_as_uint(v), false, false); return __uint_as_float(r[0]) + __uint_as_float(r[1]); }
__device__ __forceinline__ float max_xor32(float v) { const auto r = __builtin_amdgcn_permlane32_swap(__float_as_uint(v), __float_as_uint(v), false, false); return fmaxf(__uint_as_float(r[0]), __uint_as_float(r[1])); }
__device__ __forceinline__ float add_xor16(float v) { return v + swz_xor<16>(v); }
__device__ __forceinline__ float wave_sum(float v) { v += swz_xor<1>(v); v += swz_xor<2>(v); v += swz_xor<4>(v); v += swz_xor<8>(v); v += swz_xor<16>(v); return add_xor32(v); }
__device__ __forceinline__ float wave_max(float v) { v = fmaxf(v, swz_xor<1>(v)); v = fmaxf(v, swz_xor<2>(v)); v = fmaxf(v, swz_xor<4>(v)); v = fmaxf(v, swz_xor<8>(v)); v = fmaxf(v, swz_xor<16>(v)); return max_xor32(v); }
__device__ __forceinline__ int shfl_idx(int v, int src_lane) { return __builtin_amdgcn_ds_bpermute(src_lane << 2, v); }
typedef __attribute__((address_space(1))) unsigned char* gbl_u8_ptr;
__device__ __forceinline__ unsigned char* opaque_ptr(unsigned char* p) { gbl_u8_ptr g = (gbl_u8_ptr)p; asm volatile("" : "+s"(g)); return (unsigned char*)g; }
__device__ __forceinline__ int lane_now() { unsigned z; asm volatile("v_mov_b32 %0, 0" : "=v"(z)); return (int)__builtin_amdgcn_mbcnt_hi(~0u, __builtin_amdgcn_mbcnt_lo(~0u, z)); }
__device__ __forceinline__ int opaque_int(int v) { asm volatile("" : "+s"(v)); return v; }
__device__ __forceinline__ int tid_of(int wv) { return (wv << 6) | lane_now(); }
__device__ __forceinline__ void st16_wt(void* p, const u32x4 v) { asm volatile("global_store_dwordx4 %0, %1, off sc1\n\ts_nop 1" :: "v"(p), "v"(v) : "memory"); }
#ifndef MK_WT
#define MK_WT 1
#endif
#if MK_WT
#define ST16_OUT(p, v) st16_wt((void*)(p), (v))
#else
#define ST16_OUT(p, v) (*(u32x4*)(p) = (v))
#endif
namespace pg8 {
#define PG8_LAS __attribute__((address_space(3)))
typedef unsigned short bf16_t;
typedef short bf16x8 __attribute__((ext_vector_type(8)));
typedef float f32x4 __attribute__((ext_vector_type(4)));
typedef unsigned u32x4 __attribute__((ext_vector_type(4)));
constexpr int BM = 256, BK = 64, HALF = 128, HTB = HALF * BK * 2  , STAGE_BYTES = 8 * HTB, NXCD = 8, WGM = 8;

__host__ __device__ __forceinline__ int lds_byte(int r, int c) { const int st = (r >> 4) * 2 + (c >> 5), rr = r & 15, cc = c & 31, ob = rr * 64 + cc * 2; return st * 1024 + (ob ^ (((ob >> 9) & 1) << 5)); }
__host__ __device__ __forceinline__ void stage_rc(int b, int& R, int& C) { const int st = b / 1024, sb = b % 1024, swz = sb ^ (((sb >> 9) & 1) << 5); R = (st >> 1) * 16 + swz / 64; C = (st & 1) * 32 + (swz % 64) / 2; }
__host__ __device__ __forceinline__ int perm32(int rho) { const int n = rho >> 4, i = rho & 15; return 8 * (i >> 2) + 4 * n + (i & 3); }

struct Unit { int pm, pn; };
struct Gemm { const bf16_t* A; const bf16_t* Bt; int M, N, K, lda, ldb, pad; };

struct StaticOrder {
    static constexpr bool GATHER = false;
    int nM, nN, nwg, G, c;
    __host__ __device__ __forceinline__ void init(int M, int N, int G_, int c_) { nM = M / BM; nN = N / BM; nwg = nM * nN; G = G_; c = c_; }
    __host__ __device__ __forceinline__ bool next(int i, Unit& u) const {
        const long L = (long)i * G + c; if (L >= nwg) return false;
        int wgid = (int)L; { const int q = nwg / NXCD, r = nwg % NXCD, xcd = wgid % NXCD, off = wgid / NXCD; wgid = (xcd < r ? xcd * (q + 1) : r * (q + 1) + (xcd - r) * q) + off; }
        const int nig = WGM * nN, gid = wgid / nig, fm = gid * WGM, gsz = (nM - fm) < WGM ? (nM - fm) : WGM;
        u.pm = fm + ((wgid % nig) % gsz); u.pn = (wgid % nig) / gsz; return true;
    }
    __device__ __forceinline__ void a_ready(const Unit&) const {}
    __device__ __forceinline__ void done(const Unit&) const {}
};


#ifndef MK_TS_A
#define MK_TS_A (-1)
#define MK_TS_B (-1)
#endif
#define PG8_TS(id) do { if (MK_TS_A >= 0 && g.pad == 77 && ((id) == MK_TS_A || (id) == MK_TS_B) && wid == 0 && lane_now() == 0) ((volatile PG8_LAS unsigned long long*)(lds + 131072 + 640))[(id) == MK_TS_B ? 1 : 0] = __builtin_amdgcn_s_memrealtime(); } while (0)
template <class Epi, class Sched, bool ALIGN_EPI = false, bool SP2 = false>
__device__ __forceinline__ void gemm_phase(PG8_LAS unsigned char* lds, const Gemm g, const Sched& S, const Epi& E, const int wv  ) {
    const int tid = tid_of(wv), wid = wv, lane = tid & 63, wr = wid >> 2, wc = wid & 3, fr = lane & 15, fq = lane >> 4;
    const int K = g.K, nt = K / BK;
    unsigned voffA[2], voffA1[2], voffB[2];
#pragma unroll
    for (int i = 0; i < 2; ++i) { int R, C; stage_rc(tid * 16 + i * 8192, R, C); const int Rb = Epi::PERM ? ((R & ~31) + perm32(R & 31)) : R;
        voffA[i] = (unsigned)(R * g.lda + C) * 2u; voffA1[i] = voffA[i]; voffB[i] = (unsigned)(Rb * g.ldb + C) * 2u; }
    const size_t kstep = (size_t)(BK * 2);
    const size_t hstepA = Sched::GATHER ? 0 : (size_t)HALF * g.lda * 2, hstepB = (size_t)HALF * g.ldb * 2;
    const size_t tstepA = 2 * hstepA, tstepB = 2 * hstepB;
    const unsigned ldsw = (unsigned)wid * 1024u;
    const int aoff = lds_byte(wr * 64 + fr, fq * 8), boff = lds_byte(wc * 32 + fr, fq * 8);
#define PG8_SA(b, h) (((b) * 2 + (h)) * HTB)
#define PG8_SB(b, h) ((4 + (b) * 2 + (h)) * HTB)
#define PG8_STAGE(bufoff, gbase, voff) do { _Pragma("unroll") for (int _i = 0; _i < 2; ++_i) \
        __builtin_amdgcn_global_load_lds((const unsigned*)((const char*)(gbase) + (voff)[_i]), (PG8_LAS unsigned*)(lds + (bufoff) + ldsw + _i * 8192), 16, 0, 0); } while (0)
#define PG8_LDA(dst, b, h) do { _Pragma("unroll") for (int m = 0; m < 4; ++m) _Pragma("unroll") for (int k = 0; k < 2; ++k) dst[m][k] = *(const PG8_LAS bf16x8*)(lds + PG8_SA(b, h) + aoff + m * 2048 + k * 1024); } while (0)
#define PG8_LDB(dst, b, h) do { _Pragma("unroll") for (int n = 0; n < 2; ++n) _Pragma("unroll") for (int k = 0; k < 2; ++k) dst[n][k] = *(const PG8_LAS bf16x8*)(lds + PG8_SB(b, h) + boff + n * 2048 + k * 1024); } while (0)
#define PG8_MMA(ai, bj, At, Bt) do { __builtin_amdgcn_s_setprio(1); _Pragma("unroll") for (int m = 0; m < 4; ++m) _Pragma("unroll") for (int n = 0; n < 2; ++n) _Pragma("unroll") for (int k = 0; k < 2; ++k) \
        acc[ai][bj][m][n] = __builtin_amdgcn_mfma_f32_16x16x32_bf16(Bt[n][k], At[m][k], acc[ai][bj][m][n], 0, 0, 0); __builtin_amdgcn_s_setprio(0); } while (0)
#define PG8_WAIT_V(n) asm volatile("s_waitcnt vmcnt(" #n ")" ::: "memory")
#define PG8_WAIT_L(n) asm volatile("s_waitcnt lgkmcnt(" #n ")" ::: "memory")
#define PG8_BAR __builtin_amdgcn_s_barrier()
#define PG8_SCHED __builtin_amdgcn_sched_barrier(0)
    Unit cur, nxt; int ui = 0;
    if (!S.next(0, cur)) return;
    PG8_TS(50);
    if constexpr (Sched::GATHER) {
#pragma unroll
        for (int i = 0; i < 2; ++i) { int R, C; stage_rc(tid * 16 + i * 8192, R, C);
            voffA[i] = (unsigned)(S.arow(R) * g.lda + C) * 2u; voffA1[i] = (unsigned)(S.arow(R + HALF) * g.lda + C) * 2u; }
    }
    f32x4 acc[2][2][4][2];
#pragma unroll
    for (int a = 0; a < 2; ++a)
#pragma unroll
        for (int b = 0; b < 2; ++b)
#pragma unroll
            for (int m = 0; m < 4; ++m)
#pragma unroll
                for (int n = 0; n < 2; ++n) acc[a][b][m][n] = (f32x4){0.f, 0.f, 0.f, 0.f};
    bf16x8 At[4][2], B0[2][2], B1[2][2];
    const char* cA = (const char*)g.A + (size_t)cur.pm * tstepA; const char* cB = (const char*)g.Bt + (size_t)cur.pn * tstepB;
    S.a_ready(cur);
    if constexpr (SP2) {
        PG8_STAGE(PG8_SB(0, 0), cB, voffB); PG8_STAGE(PG8_SB(0, 1), cB + hstepB, voffB); PG8_STAGE(PG8_SA(0, 0), cA, voffA); PG8_STAGE(PG8_SA(0, 1), cA + hstepA, voffA1);
        if (wr == 1) PG8_BAR;
        PG8_WAIT_V(2); PG8_BAR;
        PG8_STAGE(PG8_SB(1, 0), cB + kstep, voffB); PG8_STAGE(PG8_SA(1, 0), cA + kstep, voffA); PG8_STAGE(PG8_SB(1, 1), cB + hstepB + kstep, voffB);
        PG8_WAIT_V(6); PG8_BAR;
    } else {
        PG8_STAGE(PG8_SB(0, 0), cB, voffB); PG8_STAGE(PG8_SA(0, 0), cA, voffA); PG8_STAGE(PG8_SB(0, 1), cB + hstepB, voffB); PG8_STAGE(PG8_SA(0, 1), cA + hstepA, voffA1);
        if (wr == 1) PG8_BAR;
        PG8_WAIT_V(4); PG8_BAR;
        PG8_STAGE(PG8_SB(1, 0), cB + kstep, voffB); PG8_STAGE(PG8_SA(1, 0), cA + kstep, voffA); PG8_STAGE(PG8_SB(1, 1), cB + hstepB + kstep, voffB);
        PG8_WAIT_V(6); PG8_BAR;
    }
    PG8_TS(51);
    for (;;) {
        const bool has_next = S.next(ui + 1, nxt);
        const char* nA = has_next ? (const char*)g.A + (size_t)nxt.pm * tstepA : cA; const char* nB = has_next ? (const char*)g.Bt + (size_t)nxt.pn * tstepB : cB;
        for (int t = 0; t < nt; t += 2) {
            if constexpr (Epi::MIDK) { if (t == nt / 2) { const int lm_ = lane_now(); E.mid(acc, cur, wr, wc, lm_ & 15, lm_ >> 4); } }
            const bool last = (t == nt - 2);
            const char* a1 = cA + (size_t)(t + 1) * kstep;
            const char* a2 = last ? nA : cA + (size_t)(t + 2) * kstep; const char* b2 = last ? nB : cB + (size_t)(t + 2) * kstep;
            const char* a3 = a2 + kstep; const char* b3 = b2 + kstep;
            if (last && has_next) S.a_ready(nxt);
            if constexpr (SP2) {
            PG8_LDB(B0, 0, 0); PG8_LDB(B1, 0, 1); PG8_SCHED; PG8_LDA(At, 0, 0); PG8_STAGE(PG8_SA(1, 1), a1 + hstepA, voffA1);
            PG8_WAIT_V(8); PG8_WAIT_L(0); PG8_BAR; PG8_MMA(0, 0, At, B0); PG8_MMA(0, 1, At, B1); PG8_BAR; PG8_SCHED;
            PG8_LDA(At, 0, 1); PG8_STAGE(PG8_SB(0, 0), b2, voffB); PG8_STAGE(PG8_SB(0, 1), b2 + hstepB, voffB); PG8_STAGE(PG8_SA(0, 0), a2, voffA);
            PG8_WAIT_V(8); PG8_WAIT_L(0); PG8_BAR; PG8_MMA(1, 0, At, B0); PG8_MMA(1, 1, At, B1); PG8_BAR; PG8_SCHED;
            PG8_LDB(B0, 1, 0); PG8_LDB(B1, 1, 1); PG8_SCHED; PG8_LDA(At, 1, 0); PG8_STAGE(PG8_SA(0, 1), a2 + hstepA, voffA1);
            PG8_WAIT_V(8); PG8_WAIT_L(0); PG8_BAR; PG8_MMA(0, 0, At, B0); PG8_MMA(0, 1, At, B1); PG8_BAR; PG8_SCHED;
            PG8_LDA(At, 1, 1); PG8_STAGE(PG8_SB(1, 0), b3, voffB); PG8_STAGE(PG8_SB(1, 1), b3 + hstepB, voffB); PG8_STAGE(PG8_SA(1, 0), a3, voffA);
            PG8_WAIT_V(8); PG8_WAIT_L(0); PG8_BAR; PG8_MMA(1, 0, At, B0); PG8_MMA(1, 1, At, B1); PG8_BAR; PG8_SCHED;
            } else {
            PG8_LDB(B0, 0, 0); PG8_SCHED; PG8_LDA(At, 0, 0); PG8_STAGE(PG8_SA(1, 1), a1 + hstepA, voffA1);
            PG8_WAIT_L(8); PG8_BAR; PG8_WAIT_L(0); PG8_MMA(0, 0, At, B0); PG8_BAR; PG8_SCHED;
            PG8_LDB(B1, 0, 1); PG8_STAGE(PG8_SB(0, 0), b2, voffB);
            PG8_BAR; PG8_WAIT_L(0); PG8_MMA(0, 1, At, B1); PG8_BAR;
            PG8_LDA(At, 0, 1); PG8_STAGE(PG8_SA(0, 0), a2, voffA);
            PG8_BAR; PG8_WAIT_L(0); PG8_MMA(1, 0, At, B0); PG8_BAR; PG8_SCHED;
            PG8_STAGE(PG8_SB(0, 1), b2 + hstepB, voffB);
            PG8_WAIT_V(6); PG8_BAR; PG8_MMA(1, 1, At, B1); PG8_BAR;
            PG8_LDB(B0, 1, 0); PG8_SCHED; PG8_LDA(At, 1, 0); PG8_STAGE(PG8_SA(0, 1), a2 + hstepA, voffA1);
            PG8_WAIT_L(8); PG8_BAR; PG8_WAIT_L(0); PG8_MMA(0, 0, At, B0); PG8_BAR; PG8_SCHED;
            PG8_LDB(B1, 1, 1); PG8_STAGE(PG8_SB(1, 0), b3, voffB);
            PG8_BAR; PG8_WAIT_L(0); PG8_MMA(0, 1, At, B1); PG8_BAR;
            PG8_LDA(At, 1, 1); PG8_STAGE(PG8_SA(1, 0), a3, voffA);
            PG8_BAR; PG8_WAIT_L(0); PG8_MMA(1, 0, At, B0); PG8_BAR; PG8_SCHED;
            PG8_STAGE(PG8_SB(1, 1), b3 + hstepB, voffB);
            PG8_WAIT_V(6); PG8_BAR; PG8_MMA(1, 1, At, B1); PG8_BAR;
            }
        }
        PG8_TS(52);
        if constexpr (ALIGN_EPI) { if (wr == 0) PG8_BAR; }
        if constexpr (!Epi::AFTER_DRAIN) { const int le_ = lane_now(); E(acc, cur, wr, wc, le_ & 15, le_ >> 4); S.done(cur); }
        PG8_TS(53);
        if (!has_next) break;
#pragma unroll
        for (int a = 0; a < 2; ++a)
#pragma unroll
            for (int b = 0; b < 2; ++b)
#pragma unroll
                for (int m = 0; m < 4; ++m)
#pragma unroll
                    for (int n = 0; n < 2; ++n) acc[a][b][m][n] = (f32x4){0.f, 0.f, 0.f, 0.f};
        cur = nxt; cA = nA; cB = nB; ++ui;
        if constexpr (ALIGN_EPI) { if (wr == 1) PG8_BAR; }
    }
    PG8_WAIT_V(0);
    if constexpr (!ALIGN_EPI) { if (wr == 0) PG8_BAR; }
    PG8_BAR;
    PG8_TS(54);
    if constexpr (Epi::AFTER_DRAIN) { const int le_ = lane_now(); E.fused(acc, cur, wr, wc, le_ & 15, le_ >> 4, lds, wid, le_); S.done(cur); }
    PG8_TS(55);
#undef PG8_SA
#undef PG8_SB
#undef PG8_STAGE
#undef PG8_LDA
#undef PG8_LDB
#undef PG8_MMA
#undef PG8_WAIT_V
#undef PG8_WAIT_L
#undef PG8_BAR
#undef PG8_SCHED
}
}
#define XB_TMO      128
#define XB_XCNT(j)  (256  + 64 * (j))
#define XB_XSUB(j)  (1280 + 64 * (j))
#define XB_XGEN(j)  (2304 + 64 * (j))
#define XB_TOP      3328
#define XB_TOPGEN   3392
#define XCD_BAR_WORDS 3456
#define XB_SPIN_CAP (1u << 18)

__device__ __forceinline__ unsigned xb_ld(unsigned* p)              { return __hip_atomic_load(p, __ATOMIC_RELAXED, __HIP_MEMORY_SCOPE_AGENT); }
__device__ __forceinline__ unsigned xb_add(unsigned* p, unsigned v) { return __hip_atomic_fetch_add(p, v, __ATOMIC_RELAXED, __HIP_MEMORY_SCOPE_AGENT); }
__device__ __forceinline__ unsigned xb_xcc_id() { return (unsigned)__builtin_amdgcn_s_getreg((3 << 11) | 20) & 0xFu; }
#define XB_SPIN(cond, bar) do { unsigned _sp = 0; while (cond) { __builtin_amdgcn_s_sleep(1); \
    if ((++_sp & 255u) == 0u) { if (xb_ld(&(bar)[XB_TMO])) break; if (_sp > XB_SPIN_CAP) { atomicAdd(&(bar)[XB_TMO], 1u); break; } } } } while (0)

struct XcdBarrier {
    unsigned* bar; unsigned x;
    volatile LAS unsigned* st;
};

__device__ __forceinline__ XcdBarrier xcd_barrier_post(unsigned* bar, volatile LAS unsigned* st) {
    XcdBarrier b; b.bar = bar; b.x = xb_xcc_id(); b.st = st;
    if (threadIdx.x == 0) (void)xb_add(&bar[XB_XCNT(b.x)], 1u);
    return b;
}
__device__ __forceinline__ void xcd_barrier_complete(unsigned* bar, unsigned x, unsigned& nloc, unsigned& nx) {
    const unsigned G = gridDim.x * gridDim.y * gridDim.z;
    unsigned sum, cnt, mine, sp = 0u;
    for (;;) {
        sum = 0u; cnt = 0u; mine = 0u;
#pragma unroll
        for (unsigned j = 0; j < 16; ++j) { const unsigned c = xb_ld(&bar[XB_XCNT(j)]); sum += c; cnt += (c > 0u) ? 1u : 0u; }
        if (sum == G) { mine = xb_ld(&bar[XB_XCNT(x)]); break; }
        __builtin_amdgcn_s_sleep(1);
        if ((++sp & 255u) == 0u) { if (xb_ld(&bar[XB_TMO])) break; if (sp > XB_SPIN_CAP) { atomicAdd(&bar[XB_TMO], 1u); break; } }
    }
    nloc = mine > 0u ? mine : 1u; nx = cnt > 0u ? cnt : 1u;
}

__device__ __forceinline__ void xcd_barrier(const XcdBarrier& b, const bool t0  ) {
    asm volatile("s_waitcnt vmcnt(0)" ::: "memory");
    __syncthreads();
    if (t0) {
        unsigned* bar = (unsigned*)opaque_ptr((unsigned char*)b.bar);
        __builtin_amdgcn_s_waitcnt(0);
        unsigned nloc = b.st[0], nx = b.st[1];
        if (nloc == 0u) { xcd_barrier_complete(bar, b.x, nloc, nx); b.st[0] = nloc; b.st[1] = nx; }
        const unsigned old = xb_add(&bar[XB_XSUB(b.x)], 1u);
        const unsigned gen = old / nloc;
        if (old == gen * nloc && nloc > 1u) {
            __builtin_amdgcn_fence(__ATOMIC_RELEASE, "agent");
            asm volatile("s_waitcnt vmcnt(0)" ::: "memory");
        }
        if (old + 1u == (gen + 1u) * nloc) {
            __builtin_amdgcn_fence(__ATOMIC_RELEASE, "agent");
            asm volatile("s_waitcnt vmcnt(0)" ::: "memory");
            const unsigned og = xb_add(&bar[XB_TOP], 1u);
            const unsigned tg = og / nx;
            if (og + 1u == (tg + 1u) * nx) xb_add(&bar[XB_TOPGEN], 1u);
            else XB_SPIN(xb_ld(&bar[XB_TOPGEN]) == tg, bar);
            __builtin_amdgcn_fence(__ATOMIC_ACQUIRE, "agent");
            xb_add(&bar[XB_XGEN(b.x)], 1u);
            asm volatile("s_waitcnt vmcnt(0)" ::: "memory");
        } else {
            XB_SPIN(xb_ld(&bar[XB_XGEN(b.x)]) == gen, bar);
            __builtin_amdgcn_fence(__ATOMIC_ACQUIRE, "agent");
            asm volatile("s_waitcnt vmcnt(0)" ::: "memory");
        }
    }
    __syncthreads();
}

__device__ __forceinline__ void panel_sync(unsigned* cnt, unsigned target, const bool t0) {
    asm volatile("s_waitcnt vmcnt(0)" ::: "memory");
    __syncthreads();
    if (t0) {
        __builtin_amdgcn_s_waitcnt(0);
#if !MK_WT
        __builtin_amdgcn_fence(__ATOMIC_RELEASE, "agent");
        asm volatile("s_waitcnt vmcnt(0)" ::: "memory");
#endif
        (void)xb_add(cnt, 1u);
        unsigned sp = 0;
        while (xb_ld(cnt) < target) { __builtin_amdgcn_s_sleep(1); if (++sp > (1u << 20)) break; }
        __builtin_amdgcn_fence(__ATOMIC_ACQUIRE, "agent");
        asm volatile("s_waitcnt vmcnt(0)" ::: "memory");
    }
    __syncthreads();
}
typedef pg8::f32x4 A4;
#define EPI_ROWS_BEGIN _Pragma("unroll") for (int ai = 0; ai < 2; ++ai) _Pragma("unroll") for (int m = 0; m < 4; ++m) { const int row = u.pm * 256 + ai * 128 + wr * 64 + m * 16 + fr;
#define EPI_ROWS_END }
__device__ __forceinline__ float rstd_of(const float* ss, int row, int fq) {
    if (!ss) return 1.0f;
    const f32x4 p = *(const f32x4*)(ss + (size_t)row * 16 + fq * 4);
    float s = (p[0] + p[1]) + (p[2] + p[3]);
    s = add_xor32(add_xor16(s));
    return rsqrtf(s * (1.0f / D) + EPS);
}
__device__ __forceinline__ float rstd_row(const float* ss, size_t row) {
    const f32x4* p = (const f32x4*)(ss + row * 16); float s = 0.f;
#pragma unroll
    for (int i = 0; i < 4; ++i) { const f32x4 v = p[i]; s += (v[0] + v[1]) + (v[2] + v[3]); }
    return rsqrtf(s * (1.0f / D) + EPS);
}
__device__ __forceinline__ u32x4 pack8(const A4& a, const A4& b) { u32x4 w; w.x = pkbf(a[0], a[1]); w.y = pkbf(a[2], a[3]); w.z = pkbf(b[0], b[1]); w.w = pkbf(b[2], b[3]); return w; }
__device__ __forceinline__ void unpack8(const u32x4& w, A4& a, A4& b) { a[0] = bflo(w.x); a[1] = bfhi(w.x); a[2] = bflo(w.y); a[3] = bfhi(w.y); b[0] = bflo(w.z); b[1] = bfhi(w.z); b[2] = bflo(w.w); b[3] = bfhi(w.w); }

struct EpiScale {
    static constexpr bool PERM = true, AFTER_DRAIN = false, MIDK = false;
    bf16_t* O; const float* ss; int ld; float scale; int wt, pad;
    __device__ __forceinline__ void operator()(const A4 (&acc)[2][2][4][2], const pg8::Unit& u, int wr, int wc, int fr, int fq) const {
        const int col0 = u.pn * 256 + wc * 32 + 8 * fq;
        EPI_ROWS_BEGIN
            const float s = rstd_of(ss, row, fq) * scale;
#pragma unroll
            for (int bj = 0; bj < 2; ++bj) { const u32x4 w = pack8(acc[ai][bj][m][0] * s, acc[ai][bj][m][1] * s); bf16_t* p = O + (size_t)row * ld + col0 + bj * 128; if (wt) ST16_OUT(p, w); else *(u32x4*)p = w; }
        EPI_ROWS_END
    }
};

__device__ __forceinline__ size_t band_frag_off(int t, int f) { return ((((size_t)(t >> 5) * AH + (f >> 6)) * 4 + ((f >> 4) & 3)) * 64 + ((f >> 3) & 1) * 32 + (t & 31)) * 8; }
__device__ __forceinline__ size_t band_vfrag_off(int F, int t) { return (((((size_t)(t >> 5) * AH + (F >> 6)) * 2 + ((F >> 5) & 1)) * 2 + ((t >> 4) & 1)) * 64 + ((t >> 3) & 1) * 32 + (F & 31)) * 8; }
struct EpiVT {
    static constexpr bool PERM = true, AFTER_DRAIN = false, MIDK = false;
    bf16_t *AVTp, *BVTp;
    __device__ __forceinline__ void operator()(const A4 (&acc)[2][2][4][2], const pg8::Unit& u, int wr, int wc, int fr, int fq) const {
        const int col0 = u.pn * 256 + wc * 32 + 8 * fq;
        EPI_ROWS_BEGIN
#pragma unroll
            for (int bj = 0; bj < 2; ++bj) { const u32x4 w = pack8(acc[ai][bj][m][0], acc[ai][bj][m][1]); const int t = col0 + bj * 128;
                bf16_t* p = u.pm < 2 ? AVTp + band_vfrag_off(row, t) : BVTp + (size_t)(row - 512) * T + t; ST16_OUT(p, w); }
        EPI_ROWS_END
    }
};

struct EpiProj {
    static constexpr bool PERM = true, AFTER_DRAIN = false, MIDK = false;
    bf16_t *AQ, *AK, *BQ, *BK, *BRS, *GA, *GB; float* LOGA; const float* balpha; int tile0, pad;
    __device__ __forceinline__ void operator()(const A4 (&acc)[2][2][4][2], const pg8::Unit& u, int wr, int wc, int fr, int fq) const {
        const int tile = u.pn + tile0;
        bf16_t* dst; int ld, c0, mode = 0; float sc = 1.f;
        if (tile < 2) { dst = AQ; ld = 512; c0 = tile * 256; sc = 0.125f * 1.4426950408889634f; }
        else if (tile < 4) { dst = AK; ld = 512; c0 = (tile - 2) * 256; }
        else if (tile == 4) { dst = BQ; ld = 256; c0 = 0; sc = 0.125f; }
        else if (tile == 5) { dst = BK; ld = 256; c0 = 0; }
        else if (tile < 8) { dst = BRS; ld = 512; c0 = (tile - 6) * 256; mode = 1; }
        else if (tile == 8) { dst = nullptr; ld = 256; c0 = 0; mode = 3; }
        else if (tile < 13) { dst = GA; ld = 1024; c0 = (tile - 9) * 256; mode = 2; }
        else { dst = GB; ld = 1024; c0 = (tile - 13) * 256; mode = 2; }
        const int cl = wc * 32 + 8 * fq;
        EPI_ROWS_BEGIN
#pragma unroll
            for (int bj = 0; bj < 2; ++bj) {
                A4 v0 = acc[ai][bj][m][0] * sc, v1 = acc[ai][bj][m][1] * sc;
                const int c = cl + bj * 128;
                if (mode == 3) {
                    const A4 b0 = *(const A4*)(balpha + c), b1 = *(const A4*)(balpha + c + 4);
#pragma unroll
                    for (int i = 0; i < 4; ++i) { v0[i] = flogsigmoid(v0[i] + b0[i]) * 0.0625f; v1[i] = flogsigmoid(v1[i] + b1[i]) * 0.0625f; }
                    float* o = LOGA + (size_t)row * 256 + c; *(A4*)o = v0; *(A4*)(o + 4) = v1;
                } else {
                    if (mode == 1) {
#pragma unroll
                        for (int i = 0; i < 4; ++i) { v0[i] = fsilu(v0[i]); v1[i] = fsilu(v1[i]); }
                    } else if (mode == 2) {
#pragma unroll
                        for (int i = 0; i < 4; ++i) { v0[i] = fsigmoid(v0[i]); v1[i] = fsigmoid(v1[i]); }
                    }
                    { const u32x4 w = pack8(v0, v1); const int f = c0 + c;
                      bf16_t* p = tile < 4 ? dst + band_frag_off(row, f) : dst + (size_t)row * ld + f; if (mode == 2) *(u32x4*)p = w; else ST16_OUT(p, w); }
                }
            }
        EPI_ROWS_END
    }
};

struct EpiResid {
    static constexpr bool PERM = true, AFTER_DRAIN = false, MIDK = false;
    bf16_t* Xo; const bf16_t* X; float* ss_out;
    __device__ __forceinline__ void operator()(const A4 (&acc)[2][2][4][2], const pg8::Unit& u, int wr, int wc, int fr, int fq) const {
        const int col0 = u.pn * 256 + wc * 32 + 8 * fq;
#pragma unroll
        for (int ai = 0; ai < 2; ++ai) {
            u32x4 xin[4][2];
#pragma unroll
            for (int m = 0; m < 4; ++m)
#pragma unroll
                for (int bj = 0; bj < 2; ++bj) xin[m][bj] = *(const u32x4*)(X + (size_t)(u.pm * 256 + ai * 128 + wr * 64 + m * 16 + fr) * D + col0 + bj * 128);
#pragma unroll
            for (int m = 0; m < 4; ++m) {
                const int row = u.pm * 256 + ai * 128 + wr * 64 + m * 16 + fr;
                float q = 0.f;
#pragma unroll
                for (int bj = 0; bj < 2; ++bj) {
                    A4 x0, x1; unpack8(xin[m][bj], x0, x1);
                    x0 += acc[ai][bj][m][0]; x1 += acc[ai][bj][m][1];
                    q += (x0[0] * x0[0] + x0[1] * x0[1]) + (x0[2] * x0[2] + x0[3] * x0[3]) + (x1[0] * x1[0] + x1[1] * x1[1]) + (x1[2] * x1[2] + x1[3] * x1[3]);
                    ST16_OUT(Xo + (size_t)row * D + col0 + bj * 128, pack8(x0, x1));
                }
                q = add_xor32(add_xor16(q));
                if (fq == 0) __hip_atomic_store(ss_out + (size_t)row * 16 + u.pn * 4 + wc, q, __ATOMIC_RELAXED, __HIP_MEMORY_SCOPE_AGENT);
            }
        }
    }
};

struct EpiResidT {
    static constexpr bool PERM = true, AFTER_DRAIN = true, MIDK = false;
    bf16_t* Xo; const bf16_t* X; float* ss_out;
    __device__ __forceinline__ void fused(A4 (&acc)[2][2][4][2], const pg8::Unit& u, int wr, int wc, int fr, int fq, PG8_LAS unsigned char* lds, int wid, int lane) const {
        const int col0 = u.pn * 256 + wc * 32 + 8 * fq;
#pragma unroll
        for (int ai = 0; ai < 2; ++ai) {
            u32x4 xin[4][2];
#pragma unroll
            for (int m = 0; m < 4; ++m)
#pragma unroll
                for (int bj = 0; bj < 2; ++bj) xin[m][bj] = *(const u32x4*)(X + (size_t)(u.pm * 256 + ai * 128 + wr * 64 + m * 16 + fr) * D + col0 + bj * 128);
#pragma unroll
            for (int m = 0; m < 4; ++m) {
                const int rl = ai * 128 + wr * 64 + m * 16 + fr;
                float q = 0.f;
#pragma unroll
                for (int bj = 0; bj < 2; ++bj) {
                    A4 x0, x1; unpack8(xin[m][bj], x0, x1);
                    x0 += acc[ai][bj][m][0]; x1 += acc[ai][bj][m][1];
                    q += (x0[0] * x0[0] + x0[1] * x0[1]) + (x0[2] * x0[2] + x0[3] * x0[3]) + (x1[0] * x1[0] + x1[1] * x1[1]) + (x1[2] * x1[2] + x1[3] * x1[3]);
                    *(PG8_LAS u32x4*)(lds + rl * 512 + (((wc * 4 + fq + bj * 16) ^ (rl & 15)) << 4)) = pack8(x0, x1);
                }
                q = add_xor32(add_xor16(q));
                if (fq == 0) __hip_atomic_store(ss_out + (size_t)(u.pm * 256 + rl) * 16 + u.pn * 4 + wc, q, __ATOMIC_RELAXED, __HIP_MEMORY_SCOPE_AGENT);
            }
        }
        asm volatile("s_waitcnt lgkmcnt(0)" ::: "memory"); __builtin_amdgcn_s_barrier(); asm volatile("" ::: "memory");
        u32x4 v[16];
#pragma unroll
        for (int i = 0; i < 16; ++i) { const int r = wid * 32 + 2 * i + (lane >> 5); v[i] = *(const PG8_LAS u32x4*)(lds + r * 512 + (((lane & 31) ^ (r & 15)) << 4)); }
#pragma unroll
        for (int i = 0; i < 16; ++i) { const int r = wid * 32 + 2 * i + (lane >> 5); ST16_OUT(Xo + (size_t)(u.pm * 256 + r) * D + u.pn * 256 + (lane & 31) * 8, v[i]); }
    }
};

struct EpiMerge {
    static constexpr bool PERM = true, AFTER_DRAIN = false, MIDK = true;
    const bf16_t* GAp; const bf16_t* GBp; bf16_t* O;
    __device__ __forceinline__ void mid(A4 (&acc)[2][2][4][2], const pg8::Unit& u, int wr, int wc, int fr, int fq) const {
        const int col0 = u.pn * 256 + wc * 32 + 8 * fq;
        EPI_ROWS_BEGIN
#pragma unroll
            for (int bj = 0; bj < 2; ++bj) {
                const size_t off = (size_t)row * D + col0 + bj * 128;
                A4 a0, a1, b0, b1; unpack8(*(const u32x4*)(GAp + off), a0, a1); unpack8(*(const u32x4*)(GBp + off), b0, b1);
#pragma unroll
                for (int i = 0; i < 4; ++i) { acc[ai][bj][m][0][i] *= a0[i] * __builtin_amdgcn_rcpf(b0[i]); acc[ai][bj][m][1][i] *= a1[i] * __builtin_amdgcn_rcpf(b1[i]); }
            }
        EPI_ROWS_END
    }
    __device__ __forceinline__ void operator()(const A4 (&acc)[2][2][4][2], const pg8::Unit& u, int wr, int wc, int fr, int fq) const {
        const int col0 = u.pn * 256 + wc * 32 + 8 * fq;
#pragma unroll
        for (int ai = 0; ai < 2; ++ai) {
            u32x4 gin[4][2];
#pragma unroll
            for (int m = 0; m < 4; ++m)
#pragma unroll
                for (int bj = 0; bj < 2; ++bj) gin[m][bj] = *(const u32x4*)(GBp + (size_t)(u.pm * 256 + ai * 128 + wr * 64 + m * 16 + fr) * D + col0 + bj * 128);
#pragma unroll
            for (int m = 0; m < 4; ++m)
#pragma unroll
                for (int bj = 0; bj < 2; ++bj) {
                    A4 b0, b1; unpack8(gin[m][bj], b0, b1);
                    ST16_OUT(O + (size_t)(u.pm * 256 + ai * 128 + wr * 64 + m * 16 + fr) * D + col0 + bj * 128, pack8(acc[ai][bj][m][0] * b0, acc[ai][bj][m][1] * b1));
                }
        }
    }
};
struct ConvRegs { f32x4 v[8]; };
__device__ __forceinline__ void conv_load(ConvRegs& R, const float* __restrict__ W, int ldw, int k0, int n0, int lane) {
#pragma unroll
    for (int i = 0; i < 8; ++i) { const int kk = (lane >> 3) + 8 * i; R.v[i] = __builtin_nontemporal_load((const f32x4*)(W + (size_t)(k0 + kk) * ldw + n0 + (lane & 7) * 4)); }
}
__device__ __forceinline__ void conv_store(const ConvRegs& R, const float* __restrict__ gk, bf16_t* __restrict__ WT, int ldt, int k0, int n0, LAS float* scr, int lane) {
#pragma unroll
    for (int i = 0; i < 8; ++i) { const int kk = (lane >> 3) + 8 * i; const float s = gk ? gk[k0 + kk] : 1.0f; LAS float* p = scr + kk * 33 + (lane & 7) * 4;
        p[0] = R.v[i][0] * s; p[1] = R.v[i][1] * s; p[2] = R.v[i][2] * s; p[3] = R.v[i][3] * s; }
    asm volatile("s_waitcnt lgkmcnt(0)" ::: "memory");
    const int c = lane & 7;
#pragma unroll
    for (int j = 0; j < 4; ++j) { const int n = (lane >> 3) + 8 * j; const LAS float* s = scr + (8 * c) * 33 + n;
        u32x4 o; o.x = pkbf(s[0 * 33], s[1 * 33]); o.y = pkbf(s[2 * 33], s[3 * 33]); o.z = pkbf(s[4 * 33], s[5 * 33]); o.w = pkbf(s[6 * 33], s[7 * 33]);
        *(u32x4*)(WT + (size_t)(n0 + n) * ldt + k0 + 8 * c) = o; }
    asm volatile("s_waitcnt lgkmcnt(0)" ::: "memory");
}
__device__ __forceinline__ void conv_item(const float* __restrict__ W, int ldw, const float* __restrict__ gk, bf16_t* __restrict__ WT, int ldt, int k0, int n0, LAS float* scr, int lane) {
    ConvRegs R; conv_load(R, W, ldw, k0, n0, lane); conv_store(R, gk, WT, ldt, k0, n0, scr, lane);
}

struct InPtrs {
    const float *x, *mem, *norm_mix_g, *w_in, *rel_bias, *gla_w_alpha, *gla_b_alpha, *gla_norm_g, *w_branch, *w_mix_out, *norm_x_g, *mem_norm_g, *w_xq, *w_xkv, *w_xo,
                *norm_ffn_g, *w_gr, *b_gr, *w_er, *b_er, *w_eg, *w_eu, *w_ed, *final_g;
};

struct ConvJob { const float* W; const float* gk; bf16_t* WT; int ldw, ldt, K, N; };
__device__ __forceinline__ ConvJob dense_job(const InPtrs& in, unsigned char* ws, int l, int j) {
    unsigned char* wd = ws + WS_WDENSE + (size_t)l * WDENSE_STRIDE;
    const float* Win = in.w_in + (size_t)l * D * INW; bf16_t* WIN_T = (bf16_t*)(wd + WD_WIN);
    const float* gm = in.norm_mix_g + l * D;
    ConvJob J;
    switch (j) {
    case 0: J = {Win + 0, gm, WIN_T + (size_t)0 * D, INW, D, D, 1024}; break;
    case 1: J = {Win + 1024, gm, WIN_T + (size_t)2304 * D, INW, D, D, 512}; break;
    case 2: J = {Win + 1536, gm, WIN_T + (size_t)1024 * D, INW, D, D, 512}; break;
    case 3: J = {Win + 2048, gm, WIN_T + (size_t)2816 * D, INW, D, D, 512}; break;
    case 4: J = {Win + 3088, gm, WIN_T + (size_t)3328 * D, INW, D, D, 2048}; break;
    case 11: J = {Win + 2576, gm, WIN_T + (size_t)1536 * D, INW, D, D, 512}; break;
    case 5: J = {in.w_branch + (size_t)(l * 2 + 0) * 512 * D, nullptr, (bf16_t*)(wd + WD_WB), D, D, 512, D}; break;
    case 6: J = {in.w_branch + (size_t)(l * 2 + 1) * 512 * D, nullptr, (bf16_t*)(wd + WD_WB) + 512, D, D, 512, D}; break;
    case 7: J = {in.w_mix_out + (size_t)l * D * D, nullptr, (bf16_t*)(wd + WD_WMO), D, D, D, D}; break;
    case 8: J = {in.w_xq + (size_t)l * D * D, in.norm_x_g + l * D, (bf16_t*)(wd + WD_WXQ), D, D, D, 0}; break;
    case 9: J = {in.w_xkv + (size_t)l * D * 2 * D, nullptr, (bf16_t*)(wd + WD_WXKV), 2 * D, D, D, 2 * D}; break;
    default: J = {in.w_xo + (size_t)l * D * D, nullptr, (bf16_t*)(wd + WD_WXO), D, D, D, D}; break;
    }
    return J;
}

__device__ __forceinline__ void conv_dense_layer(const InPtrs& in, unsigned char* ws, int l, int gw, int NGW, int gt, int NGT, LAS float* scr, int lane) {
    constexpr int NITEMS = 5632 - 512;
#pragma nounroll
    for (int it = gw; it < NITEMS; it += 2 * NGW) {
        ConvRegs R[2]; ConvJob J[2]; int k0[2], n0[2];
#pragma unroll
        for (int q = 0; q < 2; ++q) {
            int r = it + q * NGW; const bool on = r < NITEMS; if (!on) r = it;
            int j = 0;
#pragma unroll
            for (int jj = 0; jj < 12; ++jj) { const ConvJob Jt = dense_job(in, ws, l, jj); const int n = (Jt.K / 64) * (Jt.N / 32); if (j == jj && r >= n) { r -= n; ++j; } }
            J[q] = dense_job(in, ws, l, j); const int nnb = J[q].N / 32; k0[q] = (r / nnb) * 64; n0[q] = (r % nnb) * 32;
            if (on) conv_load(R[q], J[q].W, J[q].ldw, k0[q], n0[q], lane);
        }
#pragma unroll
        for (int q = 0; q < 2; ++q) if (it + q * NGW < NITEMS) conv_store(R[q], J[q].gk, J[q].WT, J[q].ldt, k0[q], n0[q], scr, lane);
    }
    {
        bf16_t* WIN_T = (bf16_t*)(ws + WS_WDENSE + (size_t)l * WDENSE_STRIDE + WD_WIN);
        const float* Win = in.w_in + (size_t)l * D * INW; const float* Wa = in.gla_w_alpha + (size_t)l * BR * BKW; const float* gm = in.norm_mix_g + l * D;
        for (int i = gt; i < 256 * D; i += NGT) {
            const int c = i >> 10, k = i & 1023; float s = 0.f;
#pragma unroll
            for (int r = 0; r < BR; ++r) s += Win[(size_t)k * INW + 2560 + r] * Wa[r * BKW + c];
            WIN_T[(size_t)(2048 + c) * D + k] = f2bf(s * gm[k]);
        }
    }
    {
        bf16_t* WQN = (bf16_t*)(ws + WS_WDENSE + (size_t)l * WDENSE_STRIDE + WD_WXQ);
        const float* Wq = in.w_xq + (size_t)l * D * D; const float* gx = in.norm_x_g + l * D;
        for (int i = gt; i < D * D / 4; i += NGT) { const f32x4 v = ((const f32x4*)Wq)[i]; const float g = gx[i >> 8]; u32x2 o; o.x = pkbf(v[0] * g, v[1] * g); o.y = pkbf(v[2] * g, v[3] * g); ((u32x2*)WQN)[i] = o; }
    }
}
__device__ __forceinline__ void ph_prologue(const InPtrs& in, unsigned char* ws, LAS unsigned char* lds, int vcu, int G, int wv) {
    const int tid = tid_of(wv), lane = tid & 63, wave = wv;
    LAS float* scr = (LAS float*)(lds + wave * 16384);
    const int gw = vcu * 8 + wave, NGW = G * 8;
#pragma nounroll
    for (int l = 0; l < (G == 256 ? 1 : DEPTH); ++l) conv_dense_layer(in, ws, l, gw, NGW, vcu * 512 + tid, G * 512, scr, lane);
    bf16_t* XB = (bf16_t*)(ws + WS_XB); bf16_t* XN = (bf16_t*)(ws + WS_XN);
    for (int r = gw; r < T; r += NGW) {
        const float4* xr = (const float4*)(in.x + (size_t)r * D) + lane; float4 v[4]; float s = 0.f;
#pragma unroll
        for (int j = 0; j < 4; ++j) { v[j] = xr[64 * j]; s += v[j].x * v[j].x + v[j].y * v[j].y + v[j].z * v[j].z + v[j].w * v[j].w;
            u32x2 o; o.x = pkbf(v[j].x, v[j].y); o.y = pkbf(v[j].z, v[j].w); *(u32x2*)(XB + (size_t)r * D + (lane + 64 * j) * 4) = o; }
        const float rs = rsqrtf(wave_sum(s) * (1.0f / D) + EPS);
#pragma unroll
        for (int j = 0; j < 4; ++j) { u32x2 o; o.x = pkbf(v[j].x * rs, v[j].y * rs); o.y = pkbf(v[j].z * rs, v[j].w * rs); *(u32x2*)(XN + (size_t)r * D + (lane + 64 * j) * 4) = o; }
    }
    bf16_t* MEMN = (bf16_t*)(ws + WS_MEMN);
    for (int r = gw; r < NB * NMEM; r += NGW) {
        const float4* xr = (const float4*)(in.mem + (size_t)r * D) + lane; float4 v[4]; float s = 0.f;
#pragma unroll
        for (int j = 0; j < 4; ++j) { v[j] = xr[64 * j]; s += v[j].x * v[j].x + v[j].y * v[j].y + v[j].z * v[j].z + v[j].w * v[j].w; }
        const float rs = rsqrtf(wave_sum(s) * (1.0f / D) + EPS);
#pragma unroll
        for (int j = 0; j < 4; ++j) { const float4 g = ((const float4*)in.mem_norm_g)[lane + 64 * j];
            u32x2 o; o.x = pkbf(v[j].x * rs * g.x, v[j].y * rs * g.y); o.y = pkbf(v[j].z * rs * g.z, v[j].w * rs * g.w); *(u32x2*)(MEMN + (size_t)r * D + (lane + 64 * j) * 4) = o; }
    }
}

typedef short bf16x8_t __attribute__((ext_vector_type(8)));
constexpr int NRMAX = 40960;
constexpr int NTMAX = NRMAX / 256;
constexpr int CW_CNT = 256;
constexpr size_t SEL_SELE = 0, SEL_SELW = 128 * 1024, SEL_LPOS = 256 * 1024, SEL_POS = 384 * 1024, SEL_GW = 512 * 1024, SEL_TILE = 768 * 1024, SEL_NT = 768 * 1024 + 4096, SEL_RS = 896 * 1024;

struct ExpItem { const float* W; const float* gk; bf16_t* WT; int ldw, ldt, k0, n0; };
__device__ __forceinline__ ExpItem expert_item(const InPtrs& in, unsigned char* ws, int it) {
    const int le = it / 384, r = it % 384, l = le >> 5, e = le & 31;
    bf16_t* WGU = (bf16_t*)(ws + WS_WEXP + (size_t)l * WEXP_STRIDE) + (size_t)e * 512 * D;
    bf16_t* WDT = (bf16_t*)(ws + WS_WEXP + (size_t)l * WEXP_STRIDE + 32 * MiB) + (size_t)e * D * EF;
    const size_t eo = ((size_t)l * NE + e) * D * EF;
    ExpItem I;
    if (r < 256) { const int p = r >> 6, q = r & 63; I = {((p & 1) ? in.w_eu : in.w_eg) + eo + (p >> 1) * 128, in.norm_ffn_g + l * D, WGU + (size_t)(p * 128) * D, EF, D, (q >> 2) * 64, (q & 3) * 32}; }
    else { const int q = r - 256; I = {in.w_ed + eo, nullptr, WDT, D, EF, (q >> 5) * 64, (q & 31) * 32}; }
    return I;
}
__device__ __forceinline__ void conv_expert_run(const InPtrs& in, unsigned char* ws, int it0, int n, LAS float* scr, int lane) {
#pragma nounroll
    for (int i = 0; i < n; i += 2) {
        ConvRegs R0, R1;
        const ExpItem A = expert_item(in, ws, it0 + i); conv_load(R0, A.W, A.ldw, A.k0, A.n0, lane);
        ExpItem B = A; if (i + 1 < n) { B = expert_item(in, ws, it0 + i + 1); conv_load(R1, B.W, B.ldw, B.k0, B.n0, lane); }
        conv_store(R0, A.gk, A.WT, A.ldt, A.k0, A.n0, scr, lane);
        if (i + 1 < n) conv_store(R1, B.gk, B.WT, B.ldt, B.k0, B.n0, scr, lane);
    }
}
__device__ __forceinline__ void conv_expert_items(const InPtrs& in, unsigned char* ws, int it_lo, int it_hi, int gw, int NGW, LAS float* scr, int lane) {
#pragma nounroll
    for (int it = it_lo + gw; it < it_hi; it += 2 * NGW) {
        const int it2 = it + NGW; ConvRegs R0, R1;
        const ExpItem A = expert_item(in, ws, it); conv_load(R0, A.W, A.ldw, A.k0, A.n0, lane);
        ExpItem B = A; if (it2 < it_hi) { B = expert_item(in, ws, it2); conv_load(R1, B.W, B.ldw, B.k0, B.n0, lane); }
        conv_store(R0, A.gk, A.WT, A.ldt, A.k0, A.n0, scr, lane);
        if (it2 < it_hi) conv_store(R1, B.gk, B.WT, B.ldt, B.k0, B.n0, scr, lane);
    }
}
__device__ __forceinline__ void conv_router(const InPtrs& in, unsigned char* ws, int vcu, int G, int tid) {
    for (int i = vcu * 512 + tid; i < DEPTH * 48 * D; i += G * 512) {
        const int l = i / (48 * D), r = (i / D) % 48, k = i % D; float v = 0.f;
        if (r < NG) v = in.w_gr[((size_t)l * D + k) * NG + r]; else if (r < NG + NE) v = in.w_er[((size_t)l * D + k) * NE + (r - NG)];
        ((bf16_t*)(ws + WS_WR))[i] = f2bf(v * in.norm_ffn_g[l * D + k]);
    }
}

__device__ __forceinline__ void ph_route(const InPtrs& in, unsigned char* ws, LAS unsigned char* lds, int l, int t0  , int wv, bool dummy_cnt) {
    const int tid = tid_of(wv), lane = tid & 63, wave = wv;
    const bf16_t* XB = (const bf16_t*)(ws + WS_XB); const bf16_t* WR = (const bf16_t*)(ws + WS_WR) + (size_t)l * 48 * D;
    const float* ss = (const float*)(ws + WS_SSP) + (size_t)(3 * l + 2) * T * 16;
    int* SELE = (int*)(ws + WS_SEL + SEL_SELE); float* SELW = (float*)(ws + WS_SEL + SEL_SELW); int* LPOS = (int*)(ws + WS_SEL + SEL_LPOS);
    float* RSTD = (float*)(ws + WS_SEL + SEL_RS); int* TOKS = (int*)(ws + WS_TOK);
    unsigned* CNT = (unsigned*)(ws + WS_CTL) + CW_CNT + 32 * l + (dummy_cnt ? 128 : 0);
    LAS float* lg = (LAS float*)lds + wave * (16 * 49);
    LAS unsigned* hist = (LAS unsigned*)(lds + 32768); LAS unsigned* gbase = hist + 32;
    {
        if (tid < 32) hist[tid] = 0u;
        int e0 = 0, e1 = 0; unsigned r0 = 0, r1 = 0;
        {
            const int tw = t0 + (wave & 3) * 16, kh = (wave >> 2) * (D / 2);
            f32x4 acc[3];
#pragma unroll
            for (int nb = 0; nb < 3; ++nb) acc[nb] = (f32x4){0.f, 0.f, 0.f, 0.f};
            const bf16_t* ap = XB + (size_t)(tw + (lane & 15)) * D + kh + 8 * (lane >> 4);
            const bf16_t* bp = WR + (size_t)(lane & 15) * D + kh + 8 * (lane >> 4);
#pragma unroll
            for (int k0 = 0; k0 < D / 64; k0 += 8) {
                bf16x8_t a[8], b[8][3];
#pragma unroll
                for (int kk = 0; kk < 8; ++kk) { a[kk] = *(const bf16x8_t*)(ap + (k0 + kk) * 32);
#pragma unroll
                    for (int nb = 0; nb < 3; ++nb) b[kk][nb] = *(const bf16x8_t*)(bp + (size_t)nb * 16 * D + (k0 + kk) * 32); }
#pragma unroll
                for (int kk = 0; kk < 8; ++kk)
#pragma unroll
                    for (int nb = 0; nb < 3; ++nb) acc[nb] = __builtin_amdgcn_mfma_f32_16x16x32_bf16(a[kk], b[kk][nb], acc[nb], 0, 0, 0);
            }
#pragma unroll
            for (int nb = 0; nb < 3; ++nb)
#pragma unroll
                for (int r = 0; r < 4; ++r) lg[((lane >> 4) * 4 + r) * 49 + nb * 16 + (lane & 15)] = acc[nb][r];
        }
        __syncthreads();
        if (wave < 4 && lane < 16) {
            const int t = t0 + wave * 16 + lane; const float rs = rstd_row(ss, (size_t)t);
            const LAS float* p = lg + lane * 49; const LAS float* p2 = p + 4 * (16 * 49);
            float gm = -INFINITY; int gi = 0;
#pragma unroll
            for (int i = 0; i < NG; ++i) { const float x = (p[i] + p2[i]) * rs + in.b_gr[l * NG + i]; if (x > gm) { gm = x; gi = i; } }
            float gs = 0.f;
#pragma unroll
            for (int i = 0; i < NG; ++i) gs += __expf((p[i] + p2[i]) * rs + in.b_gr[l * NG + i] - gm);
            const float gw = 1.0f / gs;
            float v0 = -INFINITY, v1 = -INFINITY; int i0 = 0, i1 = 0;
#pragma unroll
            for (int e = 0; e < EPG; ++e) { const float x = (p[NG + gi * EPG + e] + p2[NG + gi * EPG + e]) * rs + in.b_er[l * NE + gi * EPG + e];
                if (x > v0) { v1 = v0; i1 = i0; v0 = x; i0 = e; } else if (x > v1) { v1 = x; i1 = e; } }
            const float ex = __expf(v1 - v0), den = 1.0f + ex;
            e0 = gi * EPG + i0; e1 = gi * EPG + i1;
            SELE[t * 2] = e0; SELE[t * 2 + 1] = e1; SELW[t * 2] = gw / den; SELW[t * 2 + 1] = gw * ex / den; RSTD[t] = rs;
            r0 = __hip_atomic_fetch_add(&hist[e0], 1u, __ATOMIC_RELAXED, __HIP_MEMORY_SCOPE_WORKGROUP); r1 = __hip_atomic_fetch_add(&hist[e1], 1u, __ATOMIC_RELAXED, __HIP_MEMORY_SCOPE_WORKGROUP);
        }
        __syncthreads();
        if (tid < 32) gbase[tid] = hist[tid] ? atomicAdd(&CNT[tid], hist[tid]) : 0u;
        __syncthreads();
        if (wave < 4 && lane < 16) { const int t = t0 + wave * 16 + lane; const int p0 = (int)(gbase[e0] + r0), p1 = (int)(gbase[e1] + r1);
            LPOS[t * 2] = p0; LPOS[t * 2 + 1] = p1; TOKS[(size_t)e0 * T + p0] = 2 * t; TOKS[(size_t)e1 * T + p1] = 2 * t + 1; }
        __syncthreads();
    }
}

__device__ __forceinline__ int moe_prefix(const unsigned* CNT, int lane, int& cnt, int& tile0, int& ntile) {
    cnt = (lane < 32) ? (int)__hip_atomic_load(CNT + (lane & 31), __ATOMIC_RELAXED, __HIP_MEMORY_SCOPE_AGENT) : 0;
    ntile = (cnt + 255) >> 8;
    int incl = ntile;
#pragma unroll
    for (int o = 1; o < 32; o <<= 1) { const int y = shfl_idx(incl, (lane - o) & 63); if ((lane & 31) >= o) incl += y; }
    tile0 = incl - ntile;
    return shfl_idx(incl, 31);
}
__device__ __forceinline__ void moe_tables(unsigned char* ws, int l, LAS int* tb, int vcu, int wave, int lane) {
    if (wave == 0) {
        int cnt, t0, nt_e; const int nt = moe_prefix((const unsigned*)(ws + WS_CTL) + CW_CNT + 32 * l, lane, cnt, t0, nt_e);
        if (lane < 32) { tb[lane] = cnt; tb[32 + lane] = t0; for (int r = t0; r < t0 + nt_e; ++r) tb[96 + r] = lane; }
        if (lane == 0) tb[64] = nt;
        if (vcu == 0) {
            int* TILE_E = (int*)(ws + WS_SEL + SEL_TILE);
            if (lane < 32) for (int r = t0; r < t0 + nt_e; ++r) TILE_E[r] = lane;
            if (lane == 0) *(int*)(ws + WS_SEL + SEL_NT) = nt;
        }
    }
    asm volatile("s_waitcnt lgkmcnt(0)" ::: "memory");
    __syncthreads();
}
struct GatherOrder {
    static constexpr bool GATHER = true;
    int pm, pn; const int* toks; int tl, cnt;
    __device__ __forceinline__ bool next(int i, pg8::Unit& u) const { if (i != 0) return false; u.pm = pm; u.pn = pn; return true; }
    __device__ __forceinline__ int arow(int R) const { const int p = tl * 256 + R; return p < cnt ? (toks[p] >> 1) : 0; }
    __device__ __forceinline__ void a_ready(const pg8::Unit&) const {}
    __device__ __forceinline__ void done(const pg8::Unit&) const {}
};
template <int NJ> struct GroupedOrder {
    static constexpr bool GATHER = false;
    const int* tile_e; int nunits, G, c;
    __device__ __forceinline__ void init(const int* te, int nt, int G_, int c_) { tile_e = te; nunits = nt * NJ; G = G_; c = c_; }
    __device__ __forceinline__ bool next(int i, pg8::Unit& u) const {
        const int L = i * G + c; if (L >= nunits) return false;
        const int rt = L / NJ, j = L % NJ;
        u.pm = rt; u.pn = __builtin_amdgcn_readfirstlane(tile_e[rt]) * NJ + j; return true;
    }
    __device__ __forceinline__ void a_ready(const pg8::Unit&) const {}
    __device__ __forceinline__ void done(const pg8::Unit&) const {}
};
struct QuadOrder {
    static constexpr bool GATHER = false;
    int pm, pn0, n;
    __device__ __forceinline__ bool next(int i, pg8::Unit& u) const { if (i >= n) return false; u.pm = pm; u.pn = pn0 + i; return true; }
    __device__ __forceinline__ void a_ready(const pg8::Unit&) const {}
    __device__ __forceinline__ void done(const pg8::Unit&) const {}
};
constexpr int CW_READY = 24576;
struct EpiHid {
    static constexpr bool PERM = true, AFTER_DRAIN = false, MIDK = false;
    bf16_t* HID; const int* toks; const float* RSTD; const float* SELW; int tl, cnt;
    __device__ __forceinline__ void operator()(const A4 (&acc)[2][2][4][2], const pg8::Unit& u, int wr, int wc, int fr, int fq) const {
        const int f0 = (u.pn & 1) * 128 + wc * 32 + 8 * fq;
        float rsv[2][4], wv_[2][4];
#pragma unroll
        for (int ai = 0; ai < 2; ++ai)
#pragma unroll
            for (int m = 0; m < 4; ++m) {
                const int p = tl * 256 + ai * 128 + wr * 64 + m * 16 + fr;
                const int slot = p < cnt ? toks[p] : 0;
                rsv[ai][m] = RSTD[slot >> 1]; wv_[ai][m] = SELW[slot];
            }
        EPI_ROWS_BEGIN
            const float rs = rsv[ai][m], w = wv_[ai][m];
            A4 h0, h1;
#pragma unroll
            for (int i = 0; i < 4; ++i) { h0[i] = fsilu(acc[ai][0][m][0][i] * rs) * (acc[ai][1][m][0][i] * rs) * w; h1[i] = fsilu(acc[ai][0][m][1][i] * rs) * (acc[ai][1][m][1][i] * rs) * w; }
            st16_wt(HID + (size_t)row * EF + f0, pack8(h0, h1));
        EPI_ROWS_END
    }
};
struct EpiY {
    static constexpr bool PERM = true, AFTER_DRAIN = false, MIDK = false;
    bf16_t* Y;
    __device__ __forceinline__ void operator()(const A4 (&acc)[2][2][4][2], const pg8::Unit& u, int wr, int wc, int fr, int fq) const {
        const int col0 = (u.pn & 3) * 256 + wc * 32 + 8 * fq;
        EPI_ROWS_BEGIN
#pragma unroll
            for (int bj = 0; bj < 2; ++bj) *(u32x4*)(Y + (size_t)row * D + col0 + bj * 128) = pack8(acc[ai][bj][m][0], acc[ai][bj][m][1]);
        EPI_ROWS_END
    }
};

__device__ __forceinline__ void ph_combine(unsigned char* ws, int l, int vcu, int G, bf16_t* XN, float* OUT, const float* __restrict__ fg, int wv, bf16_t* XBo) {
    const int tid = tid_of(wv), lane = tid & 63, wave = wv; (void)tid;
    const bf16_t* XB = (const bf16_t*)(ws + WS_XB); const bf16_t* Y = (const bf16_t*)(ws + WS_XG);
    const int* SELE = (const int*)(ws + WS_SEL + SEL_SELE); const int* LPOS = (const int*)(ws + WS_SEL + SEL_LPOS); float* ssn = (float*)(ws + WS_SSP) + (size_t)(3 * l + 3) * T * 16;
    int cnt_, tile0_, ntile_; (void)moe_prefix((const unsigned*)(ws + WS_CTL) + CW_CNT + 32 * l, lane, cnt_, tile0_, ntile_);
    const int stride = G * 8;
#pragma nounroll
    for (int tb = vcu * 8 + wave; tb < T; tb += 4 * stride) {
        int p0[4], p1[4];
#pragma unroll
        for (int i = 0; i < 4; ++i) { const int t = (tb + i * stride < T) ? tb + i * stride : tb;
            p0[i] = shfl_idx(tile0_, SELE[2 * t]) * 256 + LPOS[2 * t]; p1[i] = shfl_idx(tile0_, SELE[2 * t + 1]) * 256 + LPOS[2 * t + 1]; }
        u32x4 rx[4][2], ry0[4][2], ry1[4][2];
#pragma unroll
        for (int i = 0; i < 4; ++i) { const int t = (tb + i * stride < T) ? tb + i * stride : tb;
#pragma unroll
            for (int j = 0; j < 2; ++j) { rx[i][j] = ((const u32x4*)(XB + (size_t)t * D) + lane)[64 * j]; ry0[i][j] = ((const u32x4*)(Y + (size_t)p0[i] * D) + lane)[64 * j]; ry1[i][j] = ((const u32x4*)(Y + (size_t)p1[i] * D) + lane)[64 * j]; } }
#pragma unroll
        for (int i = 0; i < 4; ++i) {
            const int t = tb + i * stride;
            if (t < T) {
                A4 v[4]; float q = 0.f;
#pragma unroll
                for (int j = 0; j < 2; ++j) { A4 a0, a1, b0, b1, c0, c1; unpack8(rx[i][j], a0, a1); unpack8(ry0[i][j], b0, b1); unpack8(ry1[i][j], c0, c1);
                    a0 += b0 + c0; a1 += b1 + c1; v[2 * j] = a0; v[2 * j + 1] = a1;
                    q += (a0[0] * a0[0] + a0[1] * a0[1]) + (a0[2] * a0[2] + a0[3] * a0[3]) + (a1[0] * a1[0] + a1[1] * a1[1]) + (a1[2] * a1[2] + a1[3] * a1[3]);
                    if (!OUT) ST16_OUT((u32x4*)(XBo + (size_t)t * D) + lane + 64 * j, pack8(a0, a1)); }
                q = wave_sum(q);
                if (lane < 16) ssn[(size_t)t * 16 + lane] = lane == 0 ? q : 0.f;
                const float rs = rsqrtf(q * (1.0f / D) + EPS);
                if (XN) { u32x4* xn = (u32x4*)(XN + (size_t)t * D) + lane;
#pragma unroll
                    for (int j = 0; j < 2; ++j) ST16_OUT(xn + 64 * j, pack8(v[2 * j] * rs, v[2 * j + 1] * rs)); }
                if (OUT) {
#pragma unroll
                    for (int j = 0; j < 2; ++j) { const int c0 = 8 * lane + 512 * j; const A4 g0 = *(const A4*)(fg + c0), g1 = *(const A4*)(fg + c0 + 4);
                        float* o = OUT + (size_t)t * D + c0; *(A4*)o = v[2 * j] * rs * g0; *(A4*)(o + 4) = v[2 * j + 1] * rs * g1; }
                }
            }
        }
    }
}
struct FixedOrder {
    static constexpr bool GATHER = false;
    int pm, pn;
    __device__ __forceinline__ bool next(int i, pg8::Unit& u) const { if (i != 0) return false; u.pm = pm; u.pn = pn; return true; }
    __device__ __forceinline__ void a_ready(const pg8::Unit&) const {}
    __device__ __forceinline__ void done(const pg8::Unit&) const {}
};
struct PermOrder {
    static constexpr bool GATHER = false, MULTI = false;
    pg8::StaticOrder S; unsigned long long perm;
    __device__ __forceinline__ bool next(int i, pg8::Unit& u) const { if (!S.next(i, u)) return false; u.pn = (int)((perm >> (4 * u.pn)) & 15ull); return true; }
    __device__ __forceinline__ void a_ready(const pg8::Unit&) const {}
    __device__ __forceinline__ void done(const pg8::Unit&) const {}
};
struct PairOrder {
    static constexpr bool GATHER = false;
    int pm, pn0, pn1;
    __device__ __forceinline__ bool next(int i, pg8::Unit& u) const { if (i > 1) return false; u.pm = pm; u.pn = i ? pn1 : pn0; return true; }
    __device__ __forceinline__ void a_ready(const pg8::Unit&) const {}
    __device__ __forceinline__ void done(const pg8::Unit&) const {}
};
struct EpiSoftmax {
    static constexpr bool PERM = true, AFTER_DRAIN = true, MIDK = false;
    bf16_t* P; const float* ss; int ld; float scale;
    __device__ __forceinline__ void fused(A4 (&acc)[2][2][4][2], const pg8::Unit& u, int wr, int wc, int fr, int fq, PG8_LAS unsigned char* lds, int wid, int lane) const {
        typedef float f32x2v __attribute__((ext_vector_type(2)));
        PG8_LAS f32x2v* X = (PG8_LAS f32x2v*)lds;
        float mw[2][4];
#pragma unroll
        for (int ai = 0; ai < 2; ++ai)
#pragma unroll
            for (int m = 0; m < 4; ++m) {
                const float rsc = rstd_of(ss, u.pm * 256 + ai * 128 + wr * 64 + m * 16 + fr, fq) * scale;
                float mx = -INFINITY;
#pragma unroll
                for (int bj = 0; bj < 2; ++bj)
#pragma unroll
                    for (int n = 0; n < 2; ++n)
#pragma unroll
                        for (int i = 0; i < 4; ++i) { acc[ai][bj][m][n][i] *= rsc; mx = fmaxf(mx, acc[ai][bj][m][n][i]); }
                mx = fmaxf(mx, swz_xor<16>(mx)); mx = max_xor32(mx);
                float s = 0.f;
#pragma unroll
                for (int bj = 0; bj < 2; ++bj)
#pragma unroll
                    for (int n = 0; n < 2; ++n)
#pragma unroll
                        for (int i = 0; i < 4; ++i) { const float e = __expf(acc[ai][bj][m][n][i] - mx); acc[ai][bj][m][n][i] = e; s += e; }
                s = add_xor32(add_xor16(s));
                mw[ai][m] = mx;
                if (fq == 0) X[(ai * 128 + wr * 64 + m * 16 + fr) * 4 + wc] = (f32x2v){mx, s};
            }
        asm volatile("s_waitcnt lgkmcnt(0)" ::: "memory"); __builtin_amdgcn_s_barrier(); asm volatile("" ::: "memory");
#pragma unroll
        for (int ai = 0; ai < 2; ++ai)
#pragma unroll
            for (int m = 0; m < 4; ++m) {
                const int r = ai * 128 + wr * 64 + m * 16 + fr;
                const f32x2v a = X[r * 4 + 0], b = X[r * 4 + 1], c = X[r * 4 + 2], d = X[r * 4 + 3];
                const float M = fmaxf(fmaxf(a.x, b.x), fmaxf(c.x, d.x));
                const float S = (a.y * __expf(a.x - M) + b.y * __expf(b.x - M)) + (c.y * __expf(c.x - M) + d.y * __expf(d.x - M));
                const float f = __expf(mw[ai][m] - M) * __builtin_amdgcn_rcpf(S);
#pragma unroll
                for (int bj = 0; bj < 2; ++bj) ST16_OUT(P + (size_t)(u.pm * 256 + r) * ld + bj * 128 + wc * 32 + 8 * fq, pack8(acc[ai][bj][m][0] * f, acc[ai][bj][m][1] * f));
            }
    }
};
typedef float f32x16 __attribute__((ext_vector_type(16)));
constexpr int RTAB = 640;
__device__ __forceinline__ bf16x8_t as_bf16x8(const u32x4 w) { return __builtin_bit_cast(bf16x8_t, w); }
constexpr float LOG2E = 1.4426950408889634f;
__device__ __forceinline__ void band_tables(const float* __restrict__ rel  , LAS float* Rt, int tid, int h_lo = 0, int nh = AH) {
    rel += h_lo * RELW;
    for (int i = tid; i < nh * RTAB; i += 512) { const int h = i / RTAB, k = i % RTAB; int r = 575 - k; r = r < -AMAXREL ? -AMAXREL : (r > AMAXREL ? AMAXREL : r); Rt[i] = rel[h * RELW + r + AMAXREL] * LOG2E; }
}
__device__ __forceinline__ void band_load_k(bf16x8_t (&Kf)[4], const bf16_t* __restrict__ AK, long kt, int lane) {
#pragma unroll
    for (int s = 0; s < 4; ++s) Kf[s] = *(const bf16x8_t*)(AK + ((kt * 4 + s) * 64 + lane) * 8);
}
__device__ __forceinline__ void band_load_v(u32x4 (&Vr)[2][2], const bf16_t* __restrict__ AVT, long kt, int lane) {
#pragma unroll
    for (int db = 0; db < 2; ++db)
#pragma unroll
        for (int s = 0; s < 2; ++s) Vr[db][s] = *(const u32x4*)(AVT + (((kt * 2 + db) * 2 + s) * 64 + lane) * 8);
}
__device__ __forceinline__ bf16x8_t band_v_frag(const u32x4 r) {
    const auto a = __builtin_amdgcn_permlane32_swap(r.x, r.z, false, false); const auto c = __builtin_amdgcn_permlane32_swap(r.y, r.w, false, false);
    return as_bf16x8((u32x4){a[0], c[0], a[1], c[1]});
}
__device__ __forceinline__ void band_item(int item, int lane, const bf16_t* __restrict__ AQ, const bf16_t* __restrict__ AK, const bf16_t* __restrict__ AVT, const LAS float* Rt  , bf16_t* __restrict__ OAB, int h_tab0 = 0) {
    const int n = item % NCH, h = (item / NCH) % AH, b = item / (NCH * AH);
    const int ql = lane & 31, hh = lane >> 5;
    const size_t tok0 = (size_t)b * L + (size_t)n * CH;
    bf16x8_t Qf[2][4];
#pragma unroll
    for (int qb = 0; qb < 2; ++qb)
#pragma unroll
        for (int s = 0; s < 4; ++s) Qf[qb][s] = *(const bf16x8_t*)(AQ + (((((long)(tok0 >> 5) + qb) * AH + h) * 4 + s) * 64 + lane) * 8);
    f32x16 O[2][2];
#pragma unroll
    for (int db = 0; db < 2; ++db)
#pragma unroll
        for (int qb = 0; qb < 2; ++qb)
#pragma unroll
            for (int r = 0; r < 16; ++r) O[db][qb][r] = 0.f;
    float mrun[2] = {-INFINITY, -INFINITY}, lrun[2] = {0.f, 0.f};
    const LAS float* Rh = Rt + (h - h_tab0) * RTAB + (31 - ql + 4 * hh);
    const float bias_far = Rt[(h - h_tab0) * RTAB];
    const int j_lo = (n < ALC ? 2 * (ALC - n) : 0), j_hi = 2 * ALC + 1;
    const long ktb = ((long)b * L + (long)(n - ALC) * CH) / 32 * AH + h;
    bf16x8_t Kf0[4], Kf1[4]; u32x4 Vf0[2][2], Vf1[2][2];
    f32x16 S[2];
#define BAND_CL(jj) (ktb + (long)((jj) <= j_hi ? (jj) : j_hi) * AH)
    band_load_k(Kf0, AK, BAND_CL(j_lo), lane);
    band_load_v(Vf0, AVT, BAND_CL(j_lo), lane);
    band_load_k(Kf1, AK, BAND_CL(j_lo + 1), lane);
    band_load_v(Vf1, AVT, BAND_CL(j_lo + 1), lane);
#define BAND_SCORES(jj, Kf) do { const LAS float* Rc_ = Rh + (jj) * 32; \
        _Pragma("unroll") for (int qb = 0; qb < 2; ++qb) { \
            if ((jj) < 8) { _Pragma("unroll") for (int r = 0; r < 16; ++r) S[qb][r] = bias_far; } \
            else { _Pragma("unroll") for (int r = 0; r < 16; ++r) S[qb][r] = Rc_[32 - 32 * qb + (r & 3) + 8 * (r >> 2)]; } \
            _Pragma("unroll") for (int s = 0; s < 4; ++s) S[qb] = __builtin_amdgcn_mfma_f32_32x32x16_bf16(Kf[s], Qf[qb][s], S[qb], 0, 0, 0); } } while (0)
#define BAND_SOFTMAX_PV(Vr) do { \
        bf16x8_t Vf[2][2]; \
        _Pragma("unroll") for (int db = 0; db < 2; ++db) _Pragma("unroll") for (int s = 0; s < 2; ++s) Vf[db][s] = band_v_frag(Vr[db][s]); \
        _Pragma("unroll") for (int qb = 0; qb < 2; ++qb) { \
            float mx = S[qb][0]; \
            _Pragma("unroll") for (int r = 1; r < 16; ++r) mx = fmaxf(mx, S[qb][r]); \
            mx = max_xor32(mx); \
              \
              \
            if (__builtin_amdgcn_ballot_w64(mx - mrun[qb] > 8.0f) != 0ull) { \
                const float mn_ = fmaxf(mrun[qb], mx), alpha = __builtin_amdgcn_exp2f(mrun[qb] - mn_); \
                mrun[qb] = mn_; lrun[qb] *= alpha; \
                _Pragma("unroll") for (int db = 0; db < 2; ++db) \
                    _Pragma("unroll") for (int r = 0; r < 16; ++r) O[db][qb][r] *= alpha; \
            } \
            const float mn = mrun[qb]; \
            float sum = 0.f; \
            _Pragma("unroll") for (int r = 0; r < 16; ++r) { const float p = __builtin_amdgcn_exp2f(S[qb][r] - mn); S[qb][r] = p; sum += p; } \
            lrun[qb] += add_xor32(sum); \
            _Pragma("unroll") for (int s = 0; s < 2; ++s) { \
                u32x4 w; w.x = pkbf(S[qb][8 * s + 0], S[qb][8 * s + 1]); w.y = pkbf(S[qb][8 * s + 2], S[qb][8 * s + 3]); w.z = pkbf(S[qb][8 * s + 4], S[qb][8 * s + 5]); w.w = pkbf(S[qb][8 * s + 6], S[qb][8 * s + 7]); \
                const bf16x8_t Pf = as_bf16x8(w); \
                _Pragma("unroll") for (int db = 0; db < 2; ++db) O[db][qb] = __builtin_amdgcn_mfma_f32_32x32x16_bf16(Vf[db][s], Pf, O[db][qb], 0, 0, 0); \
            } } } while (0)
    BAND_SCORES(j_lo, Kf0);
    band_load_k(Kf0, AK, BAND_CL(j_lo + 2), lane);
#pragma nounroll
    for (int j = j_lo; j <= j_hi; j += 2) {
        BAND_SOFTMAX_PV(Vf0);
        band_load_v(Vf0, AVT, BAND_CL(j + 2), lane);
        BAND_SCORES(j + 1, Kf1);
        band_load_k(Kf1, AK, BAND_CL(j + 3), lane);
        BAND_SOFTMAX_PV(Vf1);
        if (j + 2 <= j_hi) {
            band_load_v(Vf1, AVT, BAND_CL(j + 3), lane);
            BAND_SCORES(j + 2, Kf0);
            band_load_k(Kf0, AK, BAND_CL(j + 4), lane);
        }
    }
#undef BAND_SOFTMAX_PV
#undef BAND_CL
#undef BAND_SCORES
#pragma unroll
    for (int qb = 0; qb < 2; ++qb) {
        const float inv = 1.0f / lrun[qb];
        bf16_t* orow = OAB + (tok0 + 32 * qb + ql) * D + h * 64 + 8 * hh;
#pragma unroll
        for (int db = 0; db < 2; ++db)
#pragma unroll
            for (int gp = 0; gp < 2; ++gp) {
                const int g = 2 * gp;
                const unsigned ax = pkbf(O[db][qb][4 * g] * inv, O[db][qb][4 * g + 1] * inv), ay = pkbf(O[db][qb][4 * g + 2] * inv, O[db][qb][4 * g + 3] * inv);
                const unsigned bx = pkbf(O[db][qb][4 * g + 4] * inv, O[db][qb][4 * g + 5] * inv), by = pkbf(O[db][qb][4 * g + 6] * inv, O[db][qb][4 * g + 7] * inv);
                const auto sx = __builtin_amdgcn_permlane32_swap(ax, bx, false, false), sy = __builtin_amdgcn_permlane32_swap(ay, by, false, false);
                *(u32x4*)(orow + 32 * db + 8 * g) = (u32x4){sx[0], sy[0], sx[1], sy[1]};
            }
    }
}
#ifndef MK_TS_A
#define MK_TS_A (-1)
#define MK_TS_B (-1)
#endif
#define GLA_TS(id) do { if (MK_TS_A >= 0 && ts && ((id) == MK_TS_A || (id) == MK_TS_B) && lane == 0) ts[(id) == MK_TS_B ? 1 : 0] = __builtin_amdgcn_s_memrealtime(); } while (0)
constexpr size_t DS_ITEM = 128 * 64;
__device__ __forceinline__ int rowmap32(int r, int hh) { return (r & 3) + 8 * (r >> 2) + 4 * hh; }

__device__ __forceinline__ float gla_scan_tile(const float* __restrict__ LOGA, size_t tok0, int h, int lane, LAS float* Gt) {
    const float* p = LOGA + tok0 * BKW + h * 64 + lane;
    float cum = 0.f;
#pragma unroll
    for (int t0 = 0; t0 < 64; t0 += 16) {
        float la[16];
#pragma unroll
        for (int i = 0; i < 16; ++i) la[i] = p[(size_t)(t0 + i) * BKW];
#pragma unroll
        for (int i = 0; i < 16; ++i) { cum += la[i]; Gt[(t0 + i) * 64 + lane] = cum; }
    }
    asm volatile("s_waitcnt lgkmcnt(0)" ::: "memory");
    return cum;
}

__device__ __forceinline__ void gla1_item(int idx, int lane, LAS float* Gt, const bf16_t* __restrict__ BK, const bf16_t* __restrict__ BVT, const float* __restrict__ LOGA, float* __restrict__ DS, float* __restrict__ DEC) {
    const int c = idx & 127, h = (idx >> 7) & 3, b = idx >> 9;
    const size_t tok0 = (size_t)b * L + (size_t)c * CH;
    const int ql = lane & 31, hh = lane >> 5;
    LAS bf16_t* Kt = (LAS bf16_t*)(Gt + 64 * 64);
    {
        u32x4 kr[8];
#pragma unroll
        for (int i = 0; i < 8; ++i) kr[i] = *(const u32x4*)(BK + (tok0 + 8 * i + (lane >> 3)) * BKW + h * 64 + (lane & 7) * 8);
#pragma unroll
        for (int i = 0; i < 8; ++i) *(LAS u32x4*)(Kt + (8 * i + (lane >> 3)) * 64 + (lane & 7) * 8) = kr[i];
    }
    const float last = gla_scan_tile(LOGA, tok0, h, lane, Gt);
    DEC[(size_t)idx * 64 + lane] = __expf(last);
    bf16x8_t Xf[2][2][2];
#pragma unroll
    for (int kb = 0; kb < 2; ++kb) {
        const float lk = __int_as_float(shfl_idx(__float_as_int(last), 32 * kb + ql));
#pragma unroll
        for (int tb = 0; tb < 2; ++tb) {
            float x[16];
#pragma unroll
            for (int r = 0; r < 16; ++r) { const int t = 32 * tb + rowmap32(r, hh);
                x[r] = bf2f(Kt[t * 64 + 32 * kb + ql]) * __expf(lk - Gt[t * 64 + 32 * kb + ql]); }
#pragma unroll
            for (int s = 0; s < 2; ++s) { u32x4 w; w.x = pkbf(x[8 * s], x[8 * s + 1]); w.y = pkbf(x[8 * s + 2], x[8 * s + 3]); w.z = pkbf(x[8 * s + 4], x[8 * s + 5]); w.w = pkbf(x[8 * s + 6], x[8 * s + 7]); Xf[tb][kb][s] = as_bf16x8(w); }
        }
    }
    const bf16_t* vbase = BVT + (size_t)(h * 128 + ql) * T + tok0 + 8 * hh;
    float* dsb = DS + (size_t)idx * DS_ITEM;
#pragma unroll
    for (int vb = 0; vb < 4; ++vb) {
        bf16x8_t Vf[2][2];
#pragma unroll
        for (int tb = 0; tb < 2; ++tb)
#pragma unroll
            for (int s = 0; s < 2; ++s) Vf[tb][s] = band_v_frag(*(const u32x4*)(vbase + (size_t)(32 * vb) * T + 32 * tb + 16 * s));
#pragma unroll
        for (int kb = 0; kb < 2; ++kb) {
            f32x16 acc;
#pragma unroll
            for (int r = 0; r < 16; ++r) acc[r] = 0.f;
#pragma unroll
            for (int tb = 0; tb < 2; ++tb)
#pragma unroll
                for (int s = 0; s < 2; ++s) acc = __builtin_amdgcn_mfma_f32_32x32x16_bf16(Vf[tb][s], Xf[tb][kb][s], acc, 0, 0, 0);
#pragma unroll
            for (int r = 0; r < 16; ++r) dsb[(size_t)(32 * vb + rowmap32(r, hh)) * 64 + 32 * kb + ql] = acc[r];
        }
    }
}

__device__ __forceinline__ void gla2_scan(int e, const float* __restrict__ DS, const float* __restrict__ DEC, bf16_t* __restrict__ SB) {
    const int k = e & 63, v = (e >> 6) & 127, bh = e >> 13;
    const size_t base = (size_t)bh * 128;
    float S = 0.f;
#pragma unroll 1
    for (int c0 = 0; c0 < 128; c0 += 8) {
        float d[8], a[8];
#pragma unroll
        for (int i = 0; i < 8; ++i) { d[i] = DS[(base + c0 + i) * DS_ITEM + (size_t)v * 64 + k]; a[i] = DEC[(base + c0 + i) * 64 + k]; }
#pragma unroll
        for (int i = 0; i < 8; ++i) { SB[(base + c0 + i) * DS_ITEM + (size_t)v * 64 + k] = f2bf(S); S = a[i] * S + d[i]; }
    }
}

__device__ __forceinline__ void gla3_unit(int unit, int lane, LAS float* Gt, const bf16_t* __restrict__ BQ, const bf16_t* __restrict__ BK, const bf16_t* __restrict__ BVT, const float* __restrict__ LOGA,
                                          const bf16_t* __restrict__ SB, const bf16_t* __restrict__ BRS, const float* __restrict__ gnorm, bf16_t* __restrict__ OAB, volatile LAS unsigned long long* ts = nullptr) {
    const int tb = unit & 1, idx = unit >> 1;
    const int c = idx & 127, h = (idx >> 7) & 3, b = idx >> 9;
    const size_t tok0 = (size_t)b * L + (size_t)c * CH;
    const int ql = lane & 31, hh = lane >> 5;
    GLA_TS(40);
    (void)gla_scan_tile(LOGA, tok0, h, lane, Gt);
    GLA_TS(41);
    bf16x8_t Qf[4];
    {
        const int t = 32 * tb + ql;
#pragma unroll
        for (int s = 0; s < 4; ++s) {
            const u32x4 q = *(const u32x4*)(BQ + (tok0 + t) * BKW + h * 64 + 16 * s + 8 * hh);
            const f32x4 g0 = *(const LAS f32x4*)(Gt + t * 64 + 16 * s + 8 * hh), g1 = *(const LAS f32x4*)(Gt + t * 64 + 16 * s + 8 * hh + 4);
            u32x4 w; w.x = pkbf(bflo(q.x) * __expf(g0[0]), bfhi(q.x) * __expf(g0[1])); w.y = pkbf(bflo(q.y) * __expf(g0[2]), bfhi(q.y) * __expf(g0[3]));
            w.z = pkbf(bflo(q.z) * __expf(g1[0]), bfhi(q.z) * __expf(g1[1])); w.w = pkbf(bflo(q.w) * __expf(g1[2]), bfhi(q.w) * __expf(g1[3]));
            Qf[s] = as_bf16x8(w);
        }
    }
    bf16x8_t Pf[2][2];
#pragma unroll
    for (int sb = 0; sb < 2; ++sb) {
        if (sb <= tb) {
            const int srow = 32 * sb + ql;
            f32x16 A;
#pragma unroll
            for (int r = 0; r < 16; ++r) A[r] = 0.f;
#pragma unroll
            for (int s = 0; s < 4; ++s) {
                const u32x4 kx = *(const u32x4*)(BK + (tok0 + srow) * BKW + h * 64 + 16 * s + 8 * hh);
                const f32x4 g0 = *(const LAS f32x4*)(Gt + srow * 64 + 16 * s + 8 * hh), g1 = *(const LAS f32x4*)(Gt + srow * 64 + 16 * s + 8 * hh + 4);
                u32x4 w; w.x = pkbf(bflo(kx.x) * __expf(-g0[0]), bfhi(kx.x) * __expf(-g0[1])); w.y = pkbf(bflo(kx.y) * __expf(-g0[2]), bfhi(kx.y) * __expf(-g0[3]));
                w.z = pkbf(bflo(kx.z) * __expf(-g1[0]), bfhi(kx.z) * __expf(-g1[1])); w.w = pkbf(bflo(kx.w) * __expf(-g1[2]), bfhi(kx.w) * __expf(-g1[3]));
                A = __builtin_amdgcn_mfma_f32_32x32x16_bf16(as_bf16x8(w), Qf[s], A, 0, 0, 0);
            }
            if (sb == tb) {
#pragma unroll
                for (int r = 0; r < 16; ++r) A[r] = (rowmap32(r, hh) <= ql) ? A[r] : 0.f;
            }
#pragma unroll
            for (int s2 = 0; s2 < 2; ++s2) { u32x4 w; w.x = pkbf(A[8 * s2], A[8 * s2 + 1]); w.y = pkbf(A[8 * s2 + 2], A[8 * s2 + 3]); w.z = pkbf(A[8 * s2 + 4], A[8 * s2 + 5]); w.w = pkbf(A[8 * s2 + 6], A[8 * s2 + 7]); Pf[sb][s2] = as_bf16x8(w); }
        }
    }
    GLA_TS(42);
    const int c16 = lane & 15, tr = lane >> 4;
    u32x4 bwv[8];
#pragma unroll
    for (int i = 0; i < 8; ++i) bwv[i] = *(const u32x4*)(BRS + (tok0 + 32 * tb + 4 * i + tr) * BVW + h * 128 + 8 * c16);
    f32x16 O[4];
    const bf16_t* vbase = BVT + (size_t)(h * 128 + ql) * T + tok0 + 8 * hh;
    const bf16_t* sbase = SB + (size_t)idx * DS_ITEM + (size_t)ql * 64 + 8 * hh;
#pragma unroll
    for (int vb = 0; vb < 4; ++vb) {
#pragma unroll
        for (int r = 0; r < 16; ++r) O[vb][r] = 0.f;
#pragma unroll
        for (int s = 0; s < 4; ++s) { const bf16x8_t Sf = *(const bf16x8_t*)(sbase + (size_t)(32 * vb) * 64 + 16 * s); O[vb] = __builtin_amdgcn_mfma_f32_32x32x16_bf16(Sf, Qf[s], O[vb], 0, 0, 0); }
#pragma unroll
        for (int sb = 0; sb < 2; ++sb) {
            if (sb <= tb) {
#pragma unroll
                for (int s2 = 0; s2 < 2; ++s2) { const u32x4 vr = *(const u32x4*)(vbase + (size_t)(32 * vb) * T + 32 * sb + 16 * s2);
                    O[vb] = __builtin_amdgcn_mfma_f32_32x32x16_bf16(band_v_frag(vr), Pf[sb][s2], O[vb], 0, 0, 0); }
            }
        }
    }
    GLA_TS(43);
    float q = 0.f;
#pragma unroll
    for (int vb = 0; vb < 4; ++vb)
#pragma unroll
        for (int r = 0; r < 16; ++r) q += O[vb][r] * O[vb][r];
    const float rs = rsqrtf(add_xor32(q) * (1.0f / 128.0f) + EPS);
    asm volatile("s_waitcnt lgkmcnt(0)" ::: "memory");
#pragma unroll
    for (int vb = 0; vb < 4; ++vb)
#pragma unroll
        for (int g4 = 0; g4 < 4; ++g4) {
            const int v0 = 32 * vb + 8 * g4 + 4 * hh; const f32x4 gv = *(const f32x4*)(gnorm + v0);
            f32x4 o; o[0] = O[vb][4 * g4] * rs * gv[0]; o[1] = O[vb][4 * g4 + 1] * rs * gv[1]; o[2] = O[vb][4 * g4 + 2] * rs * gv[2]; o[3] = O[vb][4 * g4 + 3] * rs * gv[3];
            *(LAS f32x4*)(Gt + ql * 128 + (((v0 >> 2) ^ ql) << 2)) = o;
        }
    asm volatile("s_waitcnt lgkmcnt(0)" ::: "memory");
    {
#pragma unroll
        for (int i = 0; i < 8; ++i) {
            const int t = 4 * i + tr; const size_t trow = tok0 + 32 * tb + t;
            const u32x4 bw = bwv[i];
            const f32x4 a0 = *(const LAS f32x4*)(Gt + t * 128 + (((2 * c16) ^ t) << 2)), a1 = *(const LAS f32x4*)(Gt + t * 128 + (((2 * c16 + 1) ^ t) << 2));
            u32x4 o; o.x = pkbf(a0[0] * bflo(bw.x), a0[1] * bfhi(bw.x)); o.y = pkbf(a0[2] * bflo(bw.y), a0[3] * bfhi(bw.y)); o.z = pkbf(a1[0] * bflo(bw.z), a1[1] * bfhi(bw.z)); o.w = pkbf(a1[2] * bflo(bw.w), a1[3] * bfhi(bw.w));
            st16_wt(OAB + trow * D + 512 + h * 128 + 8 * c16, o);
        }
    }
    GLA_TS(44);
}
#ifndef MK_TS_PHASE
#define MK_TS_PHASE (-1)
#define MK_TS_MODE 0
#endif
#ifndef MK_SIMD_W
#define MK_SIMD_W (-1)
#endif
#ifndef MK_ROLE_SWAP
#define MK_ROLE_SWAP 0
#endif
#ifndef MK_TS_WG
#define MK_TS_WG 0
#endif
#define TS_MARKW(id, w) do { if (MK_TS_A >= 0 && l == 0 && ((id) == MK_TS_A || (id) == MK_TS_B) && tid_of(opaque_int(wv0)) == (w) * 64) TS_[(id) == MK_TS_B ? 1 : 0] = __builtin_amdgcn_s_memrealtime(); } while (0)
#define TS_MARK(id) do { if (MK_TS_A >= 0 && l == 0 && ((id) == MK_TS_A || (id) == MK_TS_B) && tid_of(opaque_int(wv0)) == 0) TS_[(id) == MK_TS_B ? 1 : 0] = __builtin_amdgcn_s_memrealtime(); } while (0)
#ifndef MK_REP_PHASE
#define MK_REP_PHASE (-1)
#define MK_REP_N 1
#endif
#ifndef MK_PANEL_TEST
#define MK_PANEL_TEST 0
#endif
#ifndef MK_LAUNCHES
#define MK_LAUNCHES 1
#endif
constexpr int RING_BYTES = 131072, MISC_OFF = RING_BYTES + 512, LDS_BYTES = 147456;
constexpr int CW_BAR = 1024;
constexpr size_t CTL_ZERO_BYTES = 128 * 1024;
constexpr int CW_PANEL = 8192;
static_assert((CW_BAR + XCD_BAR_WORDS) * 4 <= (int)CTL_ZERO_BYTES, "barrier words inside the memset region");
constexpr int N_PHASES = 1 + 6 * DEPTH;

struct MKArgs { InPtrs in; unsigned char* ws; unsigned char* dout; int ph_lo, ph_hi, rep_phase, rep_n; };

__global__ void __launch_bounds__(512, 2) mk_fwd(MKArgs a) {
    extern __shared__ __attribute__((aligned(16))) unsigned char lds_raw[];
    LAS unsigned char* lds = (LAS unsigned char*)lds_raw;
    const int G0 = (int)gridDim.x, vcu0 = (int)blockIdx.x;
    const int wv0 = __builtin_amdgcn_readfirstlane((int)threadIdx.x >> 6);
    volatile LAS unsigned* MISC = (volatile LAS unsigned*)(lds + MISC_OFF);
    if (threadIdx.x < 16) MISC[threadIdx.x] = 0u;
    __syncthreads();
    const bool one_launch = (a.ph_hi - a.ph_lo) > 1;
    XcdBarrier bar; bar.bar = (unsigned*)(a.ws + WS_CTL) + CW_BAR; bar.x = 0; bar.st = MISC + 8;
    if (one_launch) bar = xcd_barrier_post((unsigned*)(a.ws + WS_CTL) + CW_BAR, MISC + 8);

    const InPtrs& in = a.in;
#define SS ((float*)(ws + WS_SSP))
#define XB ((bf16_t*)(ws + WS_XB))
#define AQ ((bf16_t*)(ws + WS_AQ))
#define AK ((bf16_t*)(ws + WS_AK))
#define AVT ((bf16_t*)(ws + WS_AVT))
#define XN ((bf16_t*)(ws + WS_XN))
#define BQ ((bf16_t*)(ws + WS_BQ))
#define BK ((bf16_t*)(ws + WS_BK))
#define BVT ((bf16_t*)(ws + WS_BVT))
#define BRS ((bf16_t*)(ws + WS_BRS))
#define GA ((bf16_t*)(ws + WS_GA))
#define GB ((bf16_t*)(dout + DO_GB))
#define MG ((bf16_t*)(ws + WS_MG))
#define Q ((bf16_t*)(dout + DO_OAB))
#define MEMN ((bf16_t*)(ws + WS_MEMN))
#define KVB ((bf16_t*)(ws + WS_KVB))
#define LOGA ((float*)(ws + WS_LOGA))
#define OAB ((bf16_t*)(dout + DO_OAB))
#define DSF ((float*)(dout + DO_ST))
#define DEC ((float*)(ws + WS_DEC))
#define SBB ((bf16_t*)(ws + WS_SB))
#define TMP ((bf16_t*)(ws + WS_TMP))
#define SELE ((int*)(ws + WS_SEL))
#define SELW ((float*)(ws + WS_SEL + (size_t)T * 2 * 4))
#define WD(l) (ws + WS_WDENSE + (size_t)(l) * WDENSE_STRIDE)
#define SSA(i) (SS + (size_t)(i) * T * 16)
#define MK_EP(l, t0) EpiProj{AQ, AK, BQ, BK, BRS, GA, GB, LOGA, in.gla_b_alpha + (size_t)(l) * BKW, (t0), 0}
    int ph = 0;
    volatile LAS unsigned long long* TS_ = (volatile LAS unsigned long long*)(lds + RING_BYTES + 640);
#define PH_ON (ph >= a.ph_lo && ph < a.ph_hi)
#define PH_RUN for (int rep_ = (PH_ON ? (ph == a.rep_phase ? a.rep_n : 1) : 0); rep_ > 0; --rep_)
#define PH_PTRS const int G = opaque_int(G0), vcu = opaque_int(vcu0), wv = opaque_int(wv0); (void)G; (void)vcu; unsigned char* ws = opaque_ptr(a.ws); unsigned char* dout = opaque_ptr(a.dout); (void)ws; (void)dout; const int tid = tid_of(wv), lane = tid & 63, wave = wv; (void)lane; (void)wave;
#define PH_END do { if (MK_TS_PHASE >= 0 && ph == MK_TS_PHASE && MK_TS_MODE == 1 && tid_of(opaque_int(wv0)) == 0) TS_[1] = __builtin_amdgcn_s_memrealtime(); \
    if (PH_ON && ph + 1 < a.ph_hi) xcd_barrier(bar, tid_of(opaque_int(wv0)) == 0); \
    if (MK_TS_PHASE >= 0 && ph == MK_TS_PHASE && MK_TS_MODE == 0 && tid_of(opaque_int(wv0)) == 0) TS_[1] = __builtin_amdgcn_s_memrealtime(); \
    if (MK_TS_PHASE >= 0 && ph + 1 == MK_TS_PHASE && tid_of(opaque_int(wv0)) == 0) TS_[0] = __builtin_amdgcn_s_memrealtime(); ++ph; } while (0)
#define GEMM_AT(EpiT, gm, ep, cc) do { pg8::StaticOrder S_; S_.init((gm).M, (gm).N, G, (cc)); pg8::gemm_phase<EpiT, pg8::StaticOrder, true, true>(lds, gm, S_, ep, wv); } while (0)
#define GEMM(EpiT, gm, ep) do { pg8::StaticOrder S_; S_.init((gm).M, (gm).N, G, vcu); pg8::gemm_phase<EpiT, pg8::StaticOrder, true, true>(lds, gm, S_, ep, wv); } while (0)

    PH_RUN { PH_PTRS ph_prologue(in, ws, lds, vcu, G, wv);
        LAS float* scr = (LAS float*)(lds + wave * 16384);
        if (G != 256) conv_expert_items(in, ws, 0, DEPTH * NE * 384, vcu * 8 + wave, G * 8, scr, lane);
        conv_router(in, ws, vcu, G, tid); }
    PH_END;

#pragma nounroll
    for (int l = 0; l < DEPTH; ++l) {
        PH_RUN { PH_PTRS
            {
                const bf16_t* Wkv = (const bf16_t*)(WD(l) + WD_WXKV);
                { const pg8::Gemm g{MEMN, Wkv, NB * NMEM, D, D, D, D, 0}; const EpiScale e{KVB + (size_t)l * 2 * NB * NMEM * D, nullptr, D, 1.0f, 1, 0}; GEMM_AT(EpiScale, g, e, (vcu + G - (G > 128 ? 64 : 0)) % G); }
                { const pg8::Gemm g{MEMN, Wkv + (size_t)D * D, NB * NMEM, D, D, D, D, 0}; const EpiScale e{KVB + (size_t)l * 2 * NB * NMEM * D + (size_t)NB * NMEM * D, nullptr, D, 1.0f, 1, 0}; GEMM_AT(EpiScale, g, e, (vcu + G - (G > 128 ? 72 : 0)) % G); }
            }
            {
                const pg8::Gemm g{XN, (const bf16_t*)(WD(l) + WD_WIN), T, NPROJ_A, D, D, D, 0}; const EpiProj e = MK_EP(l, 0);
                PermOrder S_; S_.S.init(T, NPROJ_A, G, vcu); S_.perm = 0x274518630ull; pg8::gemm_phase<EpiProj, PermOrder, true, true>(lds, g, S_, e, wv); }
            { const pg8::Gemm g{(const bf16_t*)(WD(l) + WD_WIN) + (size_t)NPROJ_A * D, XN, NPROJ_V, T, D, D, D, 0}; const EpiVT e{AVT, AVT + (size_t)512 * T}; GEMM(EpiVT, g, e); }
            if (l == 0 && G == 256 && vcu >= 80) {
                LAS float* scr = (LAS float*)(lds + wave * 16384);
                conv_dense_layer(in, ws, 1, (vcu - 80) * 8 + wave, 176 * 8, (vcu - 80) * 512 + tid, 176 * 512, scr, lane);
                __syncthreads();
            }
        }
        PH_END;
        PH_RUN { PH_PTRS
            LAS float* Rt = (LAS float*)lds;
            const int rw = MK_ROLE_SWAP ? ((wave >> 1) | ((wave & 1) << 2)) : wave;
            const bool fill = (G == 256);
            const int h0 = fill ? ((vcu * 8) / NCH) % AH : 0;
            TS_MARK(30);
            band_tables(in.rel_bias + (size_t)l * AH * RELW, Rt, tid, h0, fill ? 1 : AH);
            __syncthreads();
            const int xit0 = l * NE * 384 + vcu * 48;
            if (fill) {
                const bool conv_first = ((vcu >> 3) & 1) != 0;
#define MK_HBM_PART do { \
                    if (rw < 4) { \
                        LAS float* Gt = (LAS float*)(lds + 32768 + rw * 24576);        \
                        _Pragma("nounroll") for (int it = vcu * 4 + rw; it < NB * BH * NCH; it += G * 4) gla1_item(it, lane, Gt, BK, BVT, LOGA, DSF, DEC); \
                        conv_expert_run(in, ws, xit0 + rw * 4, 4, Gt, lane); \
                    } else { \
                        LAS float* scr = (rw < 7) ? (LAS float*)(lds + 2560 + (rw - 4) * 8448) : (LAS float*)(lds + RING_BYTES + 4096); \
                        conv_expert_run(in, ws, xit0 + 16 + (rw - 4) * 8, 8, scr, lane); \
                    } } while (0)
                if (conv_first) MK_HBM_PART;
                band_item(vcu * 8 + rw, lane, AQ, AK, AVT, Rt, OAB, h0);
                TS_MARKW(33, 4);
                if (!conv_first) MK_HBM_PART;
                TS_MARKW(34, 4);
                TS_MARKW(32, 0);
#undef MK_HBM_PART
            } else {
                if (rw < 4) {
                    LAS float* Gt = (LAS float*)(lds + 32768 + rw * 24576);
#pragma nounroll
                    for (int it = vcu * 4 + rw; it < NB * BH * NCH; it += G * 4) gla1_item(it, lane, Gt, BK, BVT, LOGA, DSF, DEC);
                }
#pragma nounroll
                for (int it = vcu * 8 + rw; it < NB * AH * NCH; it += G * 8) band_item(it, lane, AQ, AK, AVT, Rt, OAB);
            }
        }
        PH_END;
        PH_RUN { PH_PTRS
            if (G == 256) { if (vcu >= 64) for (int e2 = (vcu - 64) * 512 + tid; e2 < NB * BH * 128 * 64; e2 += 192 * 512) gla2_scan(e2, DSF, DEC, SBB); }
            else for (int e2 = vcu * 512 + tid; e2 < NB * BH * 128 * 64; e2 += G * 512) gla2_scan(e2, DSF, DEC, SBB);
            __syncthreads();
            const bf16_t* KBl = KVB + (size_t)l * 2 * NB * NMEM * D; const bf16_t* VBl = KBl + (size_t)NB * NMEM * D;
#pragma nounroll
            for (int j = 0; j < NB * XH; ++j) {
                const int b = j >> 2, h = j & 3;
                { const pg8::Gemm g{KBl + (size_t)(b * NMEM) * D + h * XD, (const bf16_t*)(WD(l) + WD_WXQ) + h * XD, NMEM, D, XD, D, D, 0};
                  const EpiScale e{(bf16_t*)(ws + WS_MT) + (size_t)(j * NMEM) * D, nullptr, D, 1.0f, 1, 0}; GEMM_AT(EpiScale, g, e, (vcu + G - 4 * j) % G); }
                { const pg8::Gemm g{(const bf16_t*)(WD(l) + WD_WXO) + h * XD, VBl + (size_t)(b * NMEM) * D + h * XD, D, NMEM, XD, D, D, 0};
                  const EpiScale e{(bf16_t*)(ws + WS_NT) + (size_t)b * D * D + h * XD, nullptr, D, 1.0f, 1, 0}; GEMM_AT(EpiScale, g, e, (vcu + G - 32 - 4 * j) % G); }
            }
        }
        PH_END;
        PH_RUN { PH_PTRS
            pg8::StaticOrder S0; S0.init(T, D, G, vcu); pg8::Unit u;
            if (G == 256 && S0.next(0, u)) {
                unsigned* PC = (unsigned*)(ws + WS_CTL) + CW_PANEL + 16 * (l * 64 + u.pm);
#define P_ARRIVE(s) do { if (tid == 0) (void)xb_add(PC + 2048 * (s), 1u); } while (0)
#define P_WAIT(s) do { if (tid == 0) { unsigned sp_ = 0; while (xb_ld(PC + 2048 * (s)) < 4u) { __builtin_amdgcn_s_sleep(2); if (++sp_ > (1u << 20)) break; } \
                       __builtin_amdgcn_fence(__ATOMIC_ACQUIRE, "agent"); asm volatile("s_waitcnt vmcnt(0)" ::: "memory"); } __syncthreads(); } while (0)
                const int h = u.pn, b = u.pm >> 5;
                TS_MARK(0);
                {
                    LAS float* Gt = (LAS float*)(lds + wave * 16384);
                    const int idx = (b * BH + h) * NCH + (u.pm & 31) * 4 + (wave & 3);
                    gla3_unit(idx * 2 + (wave >> 2), lane, Gt, BQ, BK, BVT, LOGA, SBB, BRS, in.gla_norm_g + (size_t)l * 128, OAB, (MK_TS_A >= 0 && l == 0 && wave == 0) ? TS_ : nullptr);
                    asm volatile("s_waitcnt vmcnt(0)" ::: "memory"); __syncthreads();
                    P_ARRIVE(0);
                }
                TS_MARK(1);
                const bf16_t* Wg = (const bf16_t*)(WD(l) + WD_WIN) + (size_t)(NPROJ_A + NPROJ_V) * D;
                { const pg8::Gemm g{XN, Wg, T, NPROJ_B, D, D, D, 0}; const PairOrder F{u.pm, u.pn, 4 + u.pn}; const EpiProj e = MK_EP(l, 9); pg8::gemm_phase<EpiProj, PairOrder, true, true>(lds, g, F, e, wv); }
                P_ARRIVE(1);
                TS_MARK(2);
                if (tid == 0) { unsigned sp_ = 0; while (xb_ld(PC) < 4u || xb_ld(PC + 2048) < 4u) { __builtin_amdgcn_s_sleep(2); if (++sp_ > (1u << 20)) break; }
                    __builtin_amdgcn_fence(__ATOMIC_ACQUIRE, "agent"); asm volatile("s_waitcnt vmcnt(0)" ::: "memory"); }
                __syncthreads();
                TS_MARK(3);
                { const pg8::Gemm g{OAB, (const bf16_t*)(WD(l) + WD_WB), T, D, D, D, D, 0}; const FixedOrder F{u.pm, u.pn}; const EpiMerge e{GA, GB, MG}; pg8::gemm_phase<EpiMerge, FixedOrder, true, true>(lds, g, F, e, wv); }
                P_ARRIVE(2);
                TS_MARK(4);
                P_WAIT(2);
                TS_MARK(5);
                { const pg8::Gemm g{MG, (const bf16_t*)(WD(l) + WD_WMO), T, D, D, D, D, (MK_TS_A >= 50 && l == 0) ? 77 : 0}; const FixedOrder F{u.pm, u.pn}; const EpiResidT e{XB, XB, SSA(3 * l + 1)}; pg8::gemm_phase<EpiResidT, FixedOrder, false, true>(lds, g, F, e, wv); asm volatile("s_waitcnt vmcnt(0)" ::: "memory"); __syncthreads(); }
                P_ARRIVE(3);
                TS_MARK(6);
                P_WAIT(3);
                TS_MARK(7);
                {
                    const pg8::Gemm g{XB, (const bf16_t*)(ws + WS_MT) + (size_t)((b * XH + h) * NMEM) * D, T, NMEM, D, D, D, 0}; const FixedOrder F{u.pm, 0}; const EpiSoftmax e{Q + h * XD, SSA(3 * l + 1), D, 0.0625f};
                    pg8::gemm_phase<EpiSoftmax, FixedOrder, false, true>(lds, g, F, e, wv);
                    asm volatile("s_waitcnt vmcnt(0)" ::: "memory"); __syncthreads();
                }
                P_ARRIVE(4);
                TS_MARK(8);
                P_WAIT(4);
                TS_MARK(9);
                { const pg8::Gemm g{Q, (const bf16_t*)(ws + WS_NT) + (size_t)b * D * D, T, D, D, D, D, 0}; const FixedOrder F{u.pm, u.pn}; const EpiResidT e{XB, XB, SSA(3 * l + 2)}; pg8::gemm_phase<EpiResidT, FixedOrder, false, true>(lds, g, F, e, wv); asm volatile("s_waitcnt vmcnt(0)" ::: "memory"); __syncthreads(); }
                P_ARRIVE(5);
                TS_MARK(10);
                P_WAIT(5);
                TS_MARK(11);
                ph_route(in, ws, lds, l, u.pm * 256 + u.pn * 64, wv, false);
                TS_MARK(12);
#undef P_ARRIVE
#undef P_WAIT
            }
        }
        PH_END;
        PH_RUN { PH_PTRS
            LAS int* tb = (LAS int*)(lds + RING_BYTES + 1024);
            moe_tables(ws, l, tb, vcu, wave, lane);
            const int nt = tb[64], n1 = 2 * nt, r1 = n1 > G ? n1 - G : 0, ne = nt < G / 2 ? nt : G / 2, nl = nt - ne, tot1 = r1 + ne + 4 * nl;
            const int* TOKS = (const int*)(ws + WS_TOK);
            unsigned* READY = (unsigned*)(ws + WS_CTL) + CW_READY + 16 * (l * NTMAX);
            const bf16_t* WGU = (const bf16_t*)(ws + WS_WEXP + (size_t)l * WEXP_STRIDE); const bf16_t* WDT = (const bf16_t*)(ws + WS_WEXP + (size_t)l * WEXP_STRIDE + 32 * MiB);
#pragma nounroll
            TS_MARK(20);
            for (int s = vcu - G; s < tot1; s += G) {
                const int u0 = (G == 256) ? (vcu & 7) * 32 + (vcu >> 3) : vcu;
                const int Lu = s < 0 ? u0 : (s < r1 ? G + s : -1);
                if (s < 0 && u0 >= n1) continue;
                if (Lu >= 0) {
                    const int rt = Lu >> 1, ex = __builtin_amdgcn_readfirstlane(tb[96 + rt]), tl = rt - __builtin_amdgcn_readfirstlane(tb[32 + ex]), cn = __builtin_amdgcn_readfirstlane(tb[ex]);
                    const pg8::Gemm g{XB, WGU, nt * 256, 512, D, D, D, 0};
                    const GatherOrder F{rt, ex * 2 + (Lu & 1), TOKS + (size_t)ex * T, tl, cn};
                    const EpiHid e{(bf16_t*)(ws + WS_HID), TOKS + (size_t)ex * T, (const float*)(ws + WS_SEL + SEL_RS), (const float*)(ws + WS_SEL + SEL_SELW), tl, cn};
                    pg8::gemm_phase<EpiHid, GatherOrder, true, true>(lds, g, F, e, wv);
                    if (tid == 0) (void)xb_add(READY + 16 * rt, 1u);
                    TS_MARK(s < 0 ? 21 : 22);
                } else {
                    int rt, j0, nj;
                    if (s - r1 < ne) { rt = s - r1; j0 = 0; nj = 4; } else { const int q = s - r1 - ne; rt = ne + (q >> 2); j0 = q & 3; nj = 1; }
                    if (tid == 0) { unsigned sp = 0; while (xb_ld(READY + 16 * rt) < 2u) { __builtin_amdgcn_s_sleep(2); if (++sp > (1u << 20)) break; }
                        __builtin_amdgcn_fence(__ATOMIC_ACQUIRE, "agent"); asm volatile("s_waitcnt vmcnt(0)" ::: "memory"); }
                    __syncthreads();
                    const int ex = __builtin_amdgcn_readfirstlane(tb[96 + rt]);
                    const pg8::Gemm g{(const bf16_t*)(ws + WS_HID), WDT, nt * 256, D, EF, EF, EF, 0};
                    const QuadOrder F{rt, ex * 4 + j0, nj};
                    const EpiY e{(bf16_t*)(ws + WS_XG)};
                    pg8::gemm_phase<EpiY, QuadOrder, true, true>(lds, g, F, e, wv);
                }
            }
        }
        PH_END;
        PH_RUN { PH_PTRS ph_combine(ws, l, vcu, G, (l + 1 < DEPTH) ? XN : nullptr, (l + 1 < DEPTH) ? nullptr : (float*)dout, in.final_g, wv, rep_ > 1 ? (bf16_t*)dout : XB); }
        PH_END;
    }
    if ((MK_TS_PHASE >= 0 || MK_TS_A >= 0) && blockIdx.x == MK_TS_WG && tid_of(opaque_int(wv0)) == 0) { asm volatile("s_waitcnt vmcnt(0)" ::: "memory"); ((float*)a.dout)[(size_t)MK_TS_WG * 8 * D] = (float)(TS_[1] - TS_[0]) * 0.01f; }
#undef PH_ON
#undef PH_RUN
#undef PH_PTRS
#undef PH_END
#undef GEMM
#undef GEMM_AT
#undef SS
#undef XB
#undef AQ
#undef AK
#undef AVT
#undef XN
#undef BQ
#undef BK
#undef BVT
#undef BRS
#undef GA
#undef GB
#undef MG
#undef Q
#undef MEMN
#undef KVB
#undef LOGA
#undef OAB
#undef DSF
#undef DEC
#undef SBB
#undef TMP
#undef SELE
#undef SELW
#undef WD
#undef SSA
#undef MK_EP
}

extern "C" void kernel_launch(void* const* d_in, const int* in_sizes, int n_in, void* d_out, int out_size, void* d_ws, size_t ws_size, hipStream_t stream) {
    static int grid = 0;
    if (grid == 0) {
        int dev = 0, cus = 0;
        if (hipGetDevice(&dev) != hipSuccess || hipDeviceGetAttribute(&cus, hipDeviceAttributeMultiprocessorCount, dev) != hipSuccess || cus <= 0) cus = 256;
        grid = 256;
        if (cus != 256) fprintf(stderr, "kernel_launch: device reports %d CUs; this kernel is built for 256\n", cus);
        if (hipFuncSetAttribute((const void*)mk_fwd, hipFuncAttributeMaxDynamicSharedMemorySize, LDS_BYTES) != hipSuccess) fprintf(stderr, "kernel_launch: hipFuncSetAttribute failed\n");
        int per_cu = 0;
        if (hipOccupancyMaxActiveBlocksPerMultiprocessor(&per_cu, (const void*)mk_fwd, 512, LDS_BYTES) != hipSuccess || per_cu < 1) fprintf(stderr, "kernel_launch: occupancy query says %d blocks per CU\n", per_cu);
        (void)hipGetLastError();
        if (ws_size < WS_END || n_in != 24) fprintf(stderr, "kernel_launch: unexpected ws_size %zu / n_in %d\n", ws_size, n_in);
    }
    MKArgs a{};
    { const float** p = (const float**)&a.in; for (int i = 0; i < 24; ++i) p[i] = (const float*)d_in[i]; }
    a.ws = (unsigned char*)d_ws; a.dout = (unsigned char*)d_out;
    (void)hipMemsetAsync((unsigned char*)d_ws + WS_CTL, 0, CTL_ZERO_BYTES, stream);
#if MK_LAUNCHES == 1
    a.ph_lo = 0; a.ph_hi = N_PHASES; a.rep_phase = MK_REP_PHASE; a.rep_n = MK_REP_N;
    hipLaunchKernelGGL(mk_fwd, dim3(grid), dim3(512), LDS_BYTES, stream, a);
#else
    for (int p = 0; p < N_PHASES; ++p) { a.ph_lo = p; a.ph_hi = p + 1; a.rep_phase = -1; a.rep_n = 1; hipLaunchKernelGGL(mk_fwd, dim3(grid), dim3(512), LDS_BYTES, stream, a); }
#endif
}
```
